# Optimizing an MI355X kernel written in HIP

```python
import jax, jax.numpy as jnp
from jax import lax
import numpy as np

D_MODEL = 1024
BATCH = 16
SEQ = 2048
DEPTH = 2

D_MIX = D_MODEL
ATT_HEADS = 8
ATT_HEAD_DIM = 64
ATT_WIDTH = ATT_HEADS * ATT_HEAD_DIM
MLSTM_HEADS = 4
MLSTM_HEAD_DIM = 128
MLSTM_WIDTH = MLSTM_HEADS * MLSTM_HEAD_DIM
Q_RANK = 256
N_IDX_HEADS = 8
IDX_DIM = 64
INDEX_TOPK = 256
Q_BLOCK = 128
MLSTM_CHUNK = 64
CONV_WIDTH = 4
FFN_HIDDEN = -(-8 * D_MODEL // (3 * 256)) * 256
ROPE_THETA = 10000.0
EPS = 1e-6
IN_SPLITS = (Q_RANK, ATT_WIDTH, ATT_WIDTH, IDX_DIM, N_IDX_HEADS,
             MLSTM_WIDTH, MLSTM_WIDTH, MLSTM_WIDTH, MLSTM_WIDTH, MLSTM_HEADS, MLSTM_HEADS)
IN_COLS = sum(IN_SPLITS)

kernel_name = "hybrid_dsa_mlstm_sandwich_adaln_block"


def rms_norm(x, w):
    x32 = x.astype(jnp.float32)
    y = x32 * lax.rsqrt(jnp.mean(x32 * x32, axis=-1, keepdims=True) + EPS)
    return (y * w.astype(jnp.float32)).astype(x.dtype)


def rope(x, positions):
    d = x.shape[-1]
    inv_freq = ROPE_THETA ** (-jnp.arange(0, d, 2, dtype=jnp.float32) / d)
    ang = positions.astype(jnp.float32)[..., None] * inv_freq
    cos = jnp.cos(ang)[:, :, None, :]
    sin = jnp.sin(ang)[:, :, None, :]
    x1, x2 = jnp.split(x.astype(jnp.float32), 2, axis=-1)
    return jnp.concatenate([x1 * cos - x2 * sin, x2 * cos + x1 * sin], axis=-1).astype(x.dtype)


def causal_dwconv(x, w, b):
    ch = x.shape[-1]
    y = lax.conv_general_dilated(x, w[:, None, :].astype(x.dtype), window_strides=(1,),
                                 padding=[(CONV_WIDTH - 1, 0)],
                                 dimension_numbers=('NWC', 'WIO', 'NWC'),
                                 feature_group_count=ch)
    return y + b.astype(x.dtype)


def dsa_attention(q, k, v, q_idx, k_idx, w_idx):
    def one_seq(args):
        q_, k_, v_, qi_, ki_, wi_ = args
        seq = q_.shape[0]
        n_sel = min(INDEX_TOPK, seq // 4)
        key_pos = jnp.arange(seq)
        ki32 = ki_.astype(jnp.float32)
        scale = ATT_HEAD_DIM ** -0.5

        def block(i):
            start = i * Q_BLOCK
            t = start + jnp.arange(Q_BLOCK)
            qb = lax.dynamic_slice_in_dim(q_, start, Q_BLOCK, 0)
            qib = lax.dynamic_slice_in_dim(qi_, start, Q_BLOCK, 0).astype(jnp.float32)
            wib = lax.dynamic_slice_in_dim(wi_, start, Q_BLOCK, 0).astype(jnp.float32)
            idx_logits = jnp.einsum('thd,sd->ths', qib, ki32)
            idx_score = jnp.einsum('ths,th->ts', jax.nn.relu(idx_logits), wib)
            idx_score = jnp.where(key_pos[None, :] <= t[:, None], idx_score, -jnp.inf)
            _, sel = lax.top_k(idx_score, n_sel)
            valid = sel <= t[:, None]
            k_sel = k_[sel]
            v_sel = v_[sel]
            logits = jnp.einsum('thd,tkhd->thk', qb, k_sel).astype(jnp.float32) * scale
            logits = jnp.where(valid[:, None, :], logits, -jnp.inf)
            p = jax.nn.softmax(logits, axis=-1)
            return jnp.einsum('thk,tkhd->thd', p.astype(v_.dtype), v_sel)

        out = lax.map(block, jnp.arange(seq // Q_BLOCK))
        return out.reshape((seq,) + q_.shape[1:])

    return lax.map(one_seq, (q, k, v, q_idx, k_idx, w_idx))


def mlstm_chunkwise(q, k, v, ig, lf):
    b_, nh, seq, dk = q.shape
    dv = v.shape[-1]
    nc = seq // MLSTM_CHUNK

    def chunks(a):
        return jnp.moveaxis(a.reshape(a.shape[:2] + (nc, MLSTM_CHUNK) + a.shape[3:]), 2, 0)

    qc, kc, vc, igc, lfc = chunks(q), chunks(k), chunks(v), chunks(ig), chunks(lf)
    bc = jnp.cumsum(lfc, axis=-1)
    causal = jnp.tril(jnp.ones((MLSTM_CHUNK, MLSTM_CHUNK), dtype=bool))

    def step(carry, inp):
        c_s, n_s, m_s = carry
        q_, k_, v_, ig_, b_c = inp
        d_mat = b_c[..., :, None] - b_c[..., None, :] + ig_[..., None, :]
        d_mat = jnp.where(causal, d_mat, -jnp.inf)
        inter = b_c + m_s[..., None]
        m_row = jnp.maximum(inter, jnp.max(d_mat, axis=-1))
        w_intra = jnp.exp(d_mat - m_row[..., None])
        w_inter = jnp.exp(inter - m_row)
        s_mat = jnp.einsum('bhtd,bhsd->bhts', q_, k_) * w_intra
        num = (jnp.einsum('bhts,bhsv->bhtv', s_mat, v_)
               + w_inter[..., None] * jnp.einsum('bhtd,bhdv->bhtv', q_, c_s))
        den = jnp.sum(s_mat, axis=-1) + w_inter * jnp.einsum('bhtd,bhd->bht', q_, n_s)
        h = num / jnp.maximum(jnp.abs(den), jnp.exp(-m_row))[..., None]
        total = b_c[..., -1]
        w_log = total[..., None] - b_c + ig_
        m_new = jnp.maximum(total + m_s, jnp.max(w_log, axis=-1))
        decay = jnp.exp(total + m_s - m_new)
        w_state = jnp.exp(w_log - m_new[..., None])
        c_new = decay[..., None, None] * c_s + jnp.einsum('bhs,bhsd,bhsv->bhdv', w_state, k_, v_)
        n_new = decay[..., None] * n_s + jnp.einsum('bhs,bhsd->bhd', w_state, k_)
        return (c_new, n_new, m_new), h

    init = (jnp.zeros((b_, nh, dk, dv), jnp.float32), jnp.zeros((b_, nh, dk), jnp.float32),
            jnp.zeros((b_, nh), jnp.float32))
    _, hs = lax.scan(step, init, (qc, kc, vc, igc, bc))
    return jnp.moveaxis(hs, 0, 2).reshape(b_, nh, seq, dv)


def hybrid_mixer(h, positions, w_in, q_latent_norm, w_q_up, w_qidx_up, conv_w, conv_b,
                 b_igate, b_fgate, attn_out_norm, mlstm_out_norm, w_out):
    b_, seq, _ = h.shape
    split_pts = [int(s) for s in np.cumsum(IN_SPLITS)[:-1]]
    (cq, k_att, v_att, k_idx, w_idx,
     q_m, k_m, v_m, o_m, i_m, f_m) = jnp.split(h @ w_in, split_pts, axis=-1)

    cq = rms_norm(cq, q_latent_norm)
    q = rope((cq @ w_q_up).reshape(b_, seq, ATT_HEADS, ATT_HEAD_DIM), positions)
    q_idx = rope((cq @ w_qidx_up).reshape(b_, seq, N_IDX_HEADS, IDX_DIM), positions)
    k = rope(k_att.reshape(b_, seq, ATT_HEADS, ATT_HEAD_DIM), positions)
    v = v_att.reshape(b_, seq, ATT_HEADS, ATT_HEAD_DIM)
    k_idx = rope(k_idx[:, :, None, :], positions)[:, :, 0, :]
    w_idx = w_idx * (N_IDX_HEADS * IDX_DIM) ** -0.5
    att = dsa_attention(q, k, v, q_idx, k_idx, w_idx)
    att = rms_norm(att, attn_out_norm.reshape(ATT_HEADS, ATT_HEAD_DIM)).reshape(b_, seq, ATT_WIDTH)

    qk = jax.nn.silu(causal_dwconv(jnp.concatenate([q_m, k_m], axis=-1), conv_w, conv_b))
    q_m, k_m = jnp.split(qk, 2, axis=-1)

    def heads(a):
        return a.reshape(b_, seq, MLSTM_HEADS, MLSTM_HEAD_DIM).transpose(0, 2, 1, 3).astype(jnp.float32)

    ig = (i_m + b_igate).astype(jnp.float32).transpose(0, 2, 1)
    lf = jax.nn.log_sigmoid((f_m + b_fgate).astype(jnp.float32)).transpose(0, 2, 1)
    hm = mlstm_chunkwise(heads(q_m) * MLSTM_HEAD_DIM ** -0.5, heads(k_m), heads(v_m), ig, lf)
    hm = hm.transpose(0, 2, 1, 3).astype(h.dtype)
    hm = rms_norm(hm, mlstm_out_norm.reshape(MLSTM_HEADS, MLSTM_HEAD_DIM))
    hm = (jax.nn.sigmoid(o_m).reshape(b_, seq, MLSTM_HEADS, MLSTM_HEAD_DIM) * hm).reshape(b_, seq, MLSTM_WIDTH)

    return jnp.concatenate([att, hm], axis=-1) @ w_out


def swiglu(h, w_gate_up, w_down):
    g, u = jnp.split(h @ w_gate_up, 2, axis=-1)
    return (jax.nn.silu(g) * u) @ w_down


def setup_inputs(seed: int = 0) -> dict:
    key = jax.random.key(seed)
    ks = jax.random.split(key, 24)
    L = DEPTH

    def nrm(k, shape, scale):
        return jax.random.normal(k, shape, jnp.float32) * scale

    def gain(k, shape):
        return 1.0 + 0.05 * jax.random.normal(k, shape, jnp.float32)

    x = nrm(ks[0], (BATCH, SEQ, D_MODEL), 1.0)
    c = nrm(ks[1], (BATCH, D_MODEL), 1.0)
    offsets = jax.random.randint(ks[2], (BATCH, 1), 0, 1024, dtype=jnp.int32)
    positions = (offsets + jnp.arange(SEQ, dtype=jnp.int32)[None, :]).astype(jnp.int32)
    b_fgate = (jnp.linspace(3.0, 6.0, MLSTM_HEADS, dtype=jnp.float32)[None, :]
               + nrm(ks[14], (L, MLSTM_HEADS), 0.1))
    return {
        "x": x,
        "c": c,
        "positions": positions,
        "w_mod": nrm(ks[3], (L, D_MODEL, 6 * D_MODEL), 0.5 * D_MODEL ** -0.5),
        "b_mod": nrm(ks[4], (L, 6 * D_MODEL), 0.01),
        "mix_norm_pre": gain(ks[5], (L, D_MODEL)),
        "mix_norm_post": gain(ks[6], (L, D_MODEL)),
        "w_in": nrm(ks[7], (L, D_MODEL, IN_COLS), D_MODEL ** -0.5),
        "q_latent_norm": gain(ks[8], (L, Q_RANK)),
        "w_q_up": nrm(ks[9], (L, Q_RANK, ATT_WIDTH), Q_RANK ** -0.5),
        "w_qidx_up": nrm(ks[10], (L, Q_RANK, N_IDX_HEADS * IDX_DIM), Q_RANK ** -0.5),
        "conv_w": nrm(ks[11], (L, CONV_WIDTH, 2 * MLSTM_WIDTH), CONV_WIDTH ** -0.5),
        "conv_b": nrm(ks[12], (L, 2 * MLSTM_WIDTH), 0.01),
        "b_igate": nrm(ks[13], (L, MLSTM_HEADS), 0.1),
        "b_fgate": b_fgate,
        "attn_out_norm": gain(ks[15], (L, ATT_WIDTH)),
        "mlstm_out_norm": gain(ks[16], (L, MLSTM_WIDTH)),
        "w_out": nrm(ks[17], (L, D_MIX, D_MODEL), D_MIX ** -0.5),
        "ffn_norm_pre": gain(ks[18], (L, D_MODEL)),
        "ffn_norm_post": gain(ks[19], (L, D_MODEL)),
        "w_gate_up": nrm(ks[20], (L, D_MODEL, 2 * FFN_HIDDEN), D_MODEL ** -0.5),
        "w_down": nrm(ks[21], (L, FFN_HIDDEN, D_MODEL), FFN_HIDDEN ** -0.5),
    }


def reference(x, c, positions, w_mod, b_mod, mix_norm_pre, mix_norm_post, w_in, q_latent_norm,
              w_q_up, w_qidx_up, conv_w, conv_b, b_igate, b_fgate, attn_out_norm, mlstm_out_norm,
              w_out, ffn_norm_pre, ffn_norm_post, w_gate_up, w_down):
    c_act = jax.nn.silu(c)
    for l in range(DEPTH):
        mod = c_act @ w_mod[l] + b_mod[l]
        sh_m, sc_m, g_m, sh_f, sc_f, g_f = jnp.split(mod, 6, axis=-1)
        h = rms_norm(x, mix_norm_pre[l]) * (1.0 + sc_m[:, None, :]) + sh_m[:, None, :]
        y = hybrid_mixer(h, positions, w_in[l], q_latent_norm[l], w_q_up[l], w_qidx_up[l],
                         conv_w[l], conv_b[l], b_igate[l], b_fgate[l], attn_out_norm[l],
                         mlstm_out_norm[l], w_out[l])
        x = x + g_m[:, None, :] * rms_norm(y, mix_norm_post[l])
        h = rms_norm(x, ffn_norm_pre[l]) * (1.0 + sc_f[:, None, :]) + sh_f[:, None, :]
        y = swiglu(h, w_gate_up[l], w_down[l])
        x = x + g_f[:, None, :] * rms_norm(y, ffn_norm_post[l])
    return x
```

```cpp
#include <hip/hip_runtime.h>
#include <hip/hip_bf16.h>
#include <cstdio>
#include <cstdint>
#include <cmath>
namespace pg8 {
#define PG8_LAS __attribute__((address_space(3)))
typedef unsigned short bf16_t;
typedef short bf16x8 __attribute__((ext_vector_type(8)));
typedef float f32x4 __attribute__((ext_vector_type(4)));
typedef unsigned u32x4 __attribute__((ext_vector_type(4)));
constexpr int BM = 256, BK = 64, HALF = 128, HTB = HALF * BK * 2  , STAGE_BYTES = 8 * HTB, NXCD = 8, WGM = 8;

__host__ __device__ __forceinline__ int lds_byte(int r, int c) { const int st = (r >> 4) * 2 + (c >> 5), rr = r & 15, cc = c & 31, ob = rr * 64 + cc * 2; return st * 1024 + (ob ^ (((ob >> 9) & 1) << 5)); }
__host__ __device__ __forceinline__ void stage_rc(int b, int& R, int& C) { const int st = b / 1024, sb = b % 1024, swz = sb ^ (((sb >> 9) & 1) << 5); R = (st >> 1) * 16 + swz / 64; C = (st & 1) * 32 + (swz % 64) / 2; }
__host__ __device__ __forceinline__ int perm32(int rho) { const int n = rho >> 4, i = rho & 15; return 8 * (i >> 2) + 4 * n + (i & 3); }

struct Unit { int pm, pn; };
struct Gemm { const bf16_t* A; const bf16_t* Bt; int M, N, K; };

struct StaticOrder {
    int nM, nN, nwg, G, c;
    __host__ __device__ void init(int M, int N, int G_, int c_) { nM = M / BM; nN = N / BM; nwg = nM * nN; G = G_; c = c_; }
    __host__ __device__ bool next(int i, Unit& u) const {
        const long L = (long)i * G + c; if (L >= nwg) return false;
        int wgid = (int)L; { const int q = nwg / NXCD, r = nwg % NXCD, xcd = wgid % NXCD, off = wgid / NXCD; wgid = (xcd < r ? xcd * (q + 1) : r * (q + 1) + (xcd - r) * q) + off; }
        const int nig = WGM * nN, gid = wgid / nig, fm = gid * WGM, gsz = (nM - fm) < WGM ? (nM - fm) : WGM;
        u.pm = fm + ((wgid % nig) % gsz); u.pn = (wgid % nig) / gsz; return true;
    }
    __device__ __forceinline__ void a_ready(const Unit&) const {}
    __device__ __forceinline__ void done(const Unit&) const {}
};

__device__ __forceinline__ unsigned cvt_pk_bf16(float lo, float hi) { unsigned r; asm volatile("v_cvt_pk_bf16_f32 %0, %1, %2" : "=v"(r) : "v"(lo), "v"(hi)); return r; }
typedef float f32x2 __attribute__((ext_vector_type(2)));

__device__ __forceinline__ void store8(bf16_t* p, const f32x4 a, const f32x4 b) {
    u32x4 w; w.x = cvt_pk_bf16(a[0], a[1]); w.y = cvt_pk_bf16(a[2], a[3]); w.z = cvt_pk_bf16(b[0], b[1]); w.w = cvt_pk_bf16(b[2], b[3]); *(u32x4*)p = w;
}
__device__ __forceinline__ float sigmoid_f(float g) { return __builtin_amdgcn_rcpf(1.f + __builtin_amdgcn_exp2f(-1.4426950408889634f * g)); }
__device__ __forceinline__ float silu_f(float g) { return g * sigmoid_f(g); }
__device__ __forceinline__ void rope_invf(float (&invf)[4], int wc, int fq) {
    const int j = 4 * (wc & 1) + fq;
#pragma unroll
    for (int e = 0; e < 4; ++e) invf[e] = exp2f(-(float)(4 * j + e) * 0.41524101186092029f) * 0.15915494309189535f;
}
__device__ __forceinline__ void rope_sincos(float (&sn)[4], float (&cs)[4], float p, const float (&invf)[4]) {
#pragma unroll
    for (int e = 0; e < 4; ++e) { const float r = __builtin_amdgcn_fractf(p * invf[e]); sn[e] = __builtin_amdgcn_sinf(r); cs[e] = __builtin_amdgcn_cosf(r); }
}
__device__ __forceinline__ void rope_apply(f32x4& x1, f32x4& x2, const float (&sn)[4], const float (&cs)[4]) {
    f32x4 o1, o2;
#pragma unroll
    for (int e = 0; e < 4; ++e) { o1[e] = x1[e] * cs[e] - x2[e] * sn[e]; o2[e] = x2[e] * cs[e] + x1[e] * sn[e]; }
    x1 = o1; x2 = o2;
}

struct EpiIn {
    static constexpr bool PERM = true, AFTER_DRAIN = false;
    bf16_t *CQ, *K, *V, *KI, *QM, *KM, *VM, *OM; float *SSQ, *WI, *IG, *LF; const int* pos; const float *b_ig, *b_fg;
    __device__ __forceinline__ void operator()(const f32x4 (&acc)[2][2][4][2], const Unit& u, int wr, int wc, int fr, int fq) const {
        asm volatile("" : "+v"(fr), "+v"(fq));
        const int row0 = u.pm * BM + wr * 64 + fr, ct = wc * 32 + 8 * fq, pn = u.pn;
        if (pn == 0) {
#pragma unroll
            for (int ai = 0; ai < 2; ++ai)
#pragma unroll
                for (int m = 0; m < 4; ++m) { const int row = row0 + ai * HALF + m * 16; float s = 0.f;
#pragma unroll
                    for (int bj = 0; bj < 2; ++bj) { const f32x4 v0 = acc[ai][bj][m][0], v1 = acc[ai][bj][m][1];
                        s += (v0[0] * v0[0] + v0[1] * v0[1]) + (v0[2] * v0[2] + v0[3] * v0[3]) + (v1[0] * v1[0] + v1[1] * v1[1]) + (v1[2] * v1[2] + v1[3] * v1[3]);
                        store8(CQ + (size_t)row * 256 + bj * HALF + ct, v0, v1); }
                    s += __shfl_xor(s, 16); s += __shfl_xor(s, 32);
                    if (fq == 0) SSQ[(size_t)row * 4 + wc] = s; }
        } else if (pn <= 2) {
            float invf[4]; rope_invf(invf, wc, fq);
#pragma unroll
            for (int ai = 0; ai < 2; ++ai)
#pragma unroll
                for (int m = 0; m < 4; ++m) { const int row = row0 + ai * HALF + m * 16; float sn[4], cs[4]; rope_sincos(sn, cs, (float)pos[row], invf);
#pragma unroll
                    for (int bj = 0; bj < 2; ++bj) { f32x4 v0 = acc[ai][bj][m][0], v1 = acc[ai][bj][m][1]; rope_apply(v0, v1, sn, cs);
                        store8(K + (size_t)row * 512 + (pn - 1) * 256 + bj * HALF + ct, v0, v1); } }
        } else if (pn <= 12) {
            const int g = (pn - 3) >> 1; bf16_t* dst = (g == 0) ? V : (g == 1) ? QM : (g == 2) ? KM : (g == 3) ? VM : OM; const int cb = ((pn - 3) & 1) * 256 + ct;
#pragma unroll
            for (int ai = 0; ai < 2; ++ai)
#pragma unroll
                for (int m = 0; m < 4; ++m) { const int row = row0 + ai * HALF + m * 16;
#pragma unroll
                    for (int bj = 0; bj < 2; ++bj) { f32x4 v0 = acc[ai][bj][m][0], v1 = acc[ai][bj][m][1];
                        if (g == 4) {
#pragma unroll
                            for (int e = 0; e < 4; ++e) { v0[e] = sigmoid_f(v0[e]); v1[e] = sigmoid_f(v1[e]); } }
                        store8(dst + (size_t)row * 512 + cb + bj * HALF, v0, v1); } }
        } else {
            if (wc < 2) {
                float invf[4]; rope_invf(invf, wc, fq);
#pragma unroll
                for (int ai = 0; ai < 2; ++ai)
#pragma unroll
                    for (int m = 0; m < 4; ++m) { const int row = row0 + ai * HALF + m * 16; float sn[4], cs[4]; rope_sincos(sn, cs, (float)pos[row], invf);
                        f32x4 v0 = acc[ai][0][m][0], v1 = acc[ai][0][m][1]; rope_apply(v0, v1, sn, cs); store8(KI + (size_t)row * 64 + ct, v0, v1); }
            } else if (wc == 2 && fq == 0) {
#pragma unroll
                for (int ai = 0; ai < 2; ++ai)
#pragma unroll
                    for (int m = 0; m < 4; ++m) { const int row = row0 + ai * HALF + m * 16; const float s = 0.044194173824159216f;
                        *(f32x4*)(WI + (size_t)row * 8) = acc[ai][0][m][0] * s; *(f32x4*)(WI + (size_t)row * 8 + 4) = acc[ai][0][m][1] * s; }
            } else if (wc == 2 && fq == 1) {
                const f32x4 bi = *(const f32x4*)b_ig, bf = *(const f32x4*)b_fg;
#pragma unroll
                for (int ai = 0; ai < 2; ++ai)
#pragma unroll
                    for (int m = 0; m < 4; ++m) { const int row = row0 + ai * HALF + m * 16; const f32x4 iv = acc[ai][0][m][0] + bi, fv = acc[ai][0][m][1] + bf; f32x4 lf;
#pragma unroll
                        for (int e = 0; e < 4; ++e) lf[e] = fminf(fv[e], 0.f) - log1pf(expf(-fabsf(fv[e])));
                        *(f32x4*)(IG + (size_t)row * 4) = iv; *(f32x4*)(LF + (size_t)row * 4) = lf; }
            }
        }
    }
};

struct EpiQ {
    static constexpr bool PERM = true, AFTER_DRAIN = false;
    bf16_t *Q, *QI; const float* SSQ; const int* pos; float qscale;
    __device__ __forceinline__ void operator()(const f32x4 (&acc)[2][2][4][2], const Unit& u, int wr, int wc, int fr, int fq) const {
        asm volatile("" : "+v"(fr), "+v"(fq));
        const int row0 = u.pm * BM + wr * 64 + fr, ct = wc * 32 + 8 * fq, pn = u.pn;
        float invf[4]; rope_invf(invf, wc, fq);
        bf16_t* dst = (pn < 2) ? Q + pn * 256 : QI + (pn - 2) * 256; const float sc = (pn < 2) ? qscale : 1.f;
#pragma unroll
        for (int ai = 0; ai < 2; ++ai)
#pragma unroll
            for (int m = 0; m < 4; ++m) { const int row = row0 + ai * HALF + m * 16; const f32x4 ss = *(const f32x4*)(SSQ + (size_t)row * 4);
                const float rstd = rsqrtf(((ss[0] + ss[1]) + (ss[2] + ss[3])) * (1.f / 256.f) + 1e-6f) ;
                float sn[4], cs[4]; rope_sincos(sn, cs, (float)pos[row], invf);
#pragma unroll
                for (int bj = 0; bj < 2; ++bj) { f32x4 v0 = acc[ai][bj][m][0] * rstd, v1 = acc[ai][bj][m][1] * rstd; rope_apply(v0, v1, sn, cs);
                    store8(dst + (size_t)row * 512 + bj * HALF + ct, v0 * sc, v1 * sc); } }
    }
};

struct EpiPlain {
    static constexpr bool PERM = true, AFTER_DRAIN = false;
    bf16_t* O; int ldc;
    __device__ __forceinline__ void operator()(const f32x4 (&acc)[2][2][4][2], const Unit& u, int wr, int wc, int fr, int fq) const {
        asm volatile("" : "+v"(fr), "+v"(fq));
        const int row0 = u.pm * BM + wr * 64 + fr, col0 = u.pn * BM + wc * 32 + 8 * fq;
#pragma unroll
        for (int ai = 0; ai < 2; ++ai)
#pragma unroll
            for (int m = 0; m < 4; ++m) { bf16_t* rowp = O + (size_t)(row0 + ai * HALF + m * 16) * ldc + col0;
#pragma unroll
                for (int bj = 0; bj < 2; ++bj) store8(rowp + bj * HALF, acc[ai][bj][m][0], acc[ai][bj][m][1]); }
    }
};

struct EpiSwiglu {
    static constexpr bool PERM = true, AFTER_DRAIN = false;
    bf16_t* H; int ldc;
    __device__ __forceinline__ void operator()(const f32x4 (&acc)[2][2][4][2], const Unit& u, int wr, int wc, int fr, int fq) const {
        asm volatile("" : "+v"(fr), "+v"(fq));
        const int row0 = u.pm * BM + wr * 64 + fr, col0 = u.pn * HALF + wc * 32 + 8 * fq;
#pragma unroll
        for (int ai = 0; ai < 2; ++ai)
#pragma unroll
            for (int m = 0; m < 4; ++m) { f32x4 o0, o1;
#pragma unroll
                for (int e = 0; e < 4; ++e) { o0[e] = silu_f(acc[ai][0][m][0][e]) * acc[ai][1][m][0][e]; o1[e] = silu_f(acc[ai][0][m][1][e]) * acc[ai][1][m][1][e]; }
                store8(H + (size_t)(row0 + ai * HALF + m * 16) * ldc + col0, o0, o1); }
    }
};

template <class Epi, class Sched, bool ALIGN_EPI = false, bool SP2 = false>
__device__ __forceinline__ void gemm_phase(PG8_LAS unsigned char* lds, const Gemm g, const Sched& S, const Epi& E, int tid_in  ) {
    int tid_o = tid_in; asm volatile("" : "+v"(tid_o));
    const int tid = tid_o, wid = __builtin_amdgcn_readfirstlane(tid >> 6), lane = tid & 63, wr = wid >> 2, wc = wid & 3, fr = lane & 15, fq = lane >> 4;
    const int K = g.K, nt = K / BK;
    unsigned voffA[2], voffB[2];
#pragma unroll
    for (int i = 0; i < 2; ++i) { int R, C; stage_rc(tid * 16 + i * 8192, R, C); const int Rb = Epi::PERM ? ((R & ~31) + perm32(R & 31)) : R;
        voffA[i] = (unsigned)(R * K + C) * 2u; voffB[i] = (unsigned)(Rb * K + C) * 2u; }
    const size_t kstep = (size_t)(BK * 2);
    const size_t hstep = (size_t)HALF * K * 2;
    const size_t tstep = 2 * hstep;
    const unsigned ldsw = (unsigned)wid * 1024u;
    const int aoff = lds_byte(wr * 64 + fr, fq * 8), boff = lds_byte(wc * 32 + fr, fq * 8);
#define PG8_SA(b, h) (((b) * 2 + (h)) * HTB)
#define PG8_SB(b, h) ((4 + (b) * 2 + (h)) * HTB)
#define PG8_STAGE(bufoff, gbase, voff) do { _Pragma("unroll") for (int _i = 0; _i < 2; ++_i) \
        __builtin_amdgcn_global_load_lds((const unsigned*)((const char*)(gbase) + (voff)[_i]), (PG8_LAS unsigned*)(lds + (bufoff) + ldsw + _i * 8192), 16, 0, 0); } while (0)
#define PG8_LDA(dst, b, h) do { _Pragma("unroll") for (int m = 0; m < 4; ++m) _Pragma("unroll") for (int k = 0; k < 2; ++k) dst[m][k] = *(const PG8_LAS bf16x8*)(lds + PG8_SA(b, h) + aoff + m * 2048 + k * 1024); } while (0)
#define PG8_LDB(dst, b, h) do { _Pragma("unroll") for (int n = 0; n < 2; ++n) _Pragma("unroll") for (int k = 0; k < 2; ++k) dst[n][k] = *(const PG8_LAS bf16x8*)(lds + PG8_SB(b, h) + boff + n * 2048 + k * 1024); } while (0)
#define PG8_MMA(ai, bj, At, Bt) do { __builtin_amdgcn_s_setprio(1); _Pragma("unroll") for (int m = 0; m < 4; ++m) _Pragma("unroll") for (int n = 0; n < 2; ++n) _Pragma("unroll") for (int k = 0; k < 2; ++k) \
        acc[ai][bj][m][n] = __builtin_amdgcn_mfma_f32_16x16x32_bf16(Bt[n][k], At[m][k], acc[ai][bj][m][n], 0, 0, 0); __builtin_amdgcn_s_setprio(0); } while (0)
#define PG8_WAIT_V(n) asm volatile("s_waitcnt vmcnt(" #n ")" ::: "memory")
#define PG8_WAIT_L(n) asm volatile("s_waitcnt lgkmcnt(" #n ")" ::: "memory")
#define PG8_BAR __builtin_amdgcn_s_barrier()
#define PG8_SCHED __builtin_amdgcn_sched_barrier(0)
    Unit cur, nxt; int ui = 0;
    if (!S.next(0, cur)) return;
    f32x4 acc[2][2][4][2];
#pragma unroll
    for (int a = 0; a < 2; ++a)
#pragma unroll
        for (int b = 0; b < 2; ++b)
#pragma unroll
            for (int m = 0; m < 4; ++m)
#pragma unroll
                for (int n = 0; n < 2; ++n) acc[a][b][m][n] = (f32x4){0.f, 0.f, 0.f, 0.f};
    bf16x8 At[4][2], B0[2][2], B1[2][2];
    const char* cA = (const char*)g.A + (size_t)cur.pm * tstep; const char* cB = (const char*)g.Bt + (size_t)cur.pn * tstep;
    S.a_ready(cur);
    if constexpr (SP2) {
        PG8_STAGE(PG8_SB(0, 0), cB, voffB); PG8_STAGE(PG8_SB(0, 1), cB + hstep, voffB); PG8_STAGE(PG8_SA(0, 0), cA, voffA); PG8_STAGE(PG8_SA(0, 1), cA + hstep, voffA);
        if (wr == 1) PG8_BAR;
        PG8_WAIT_V(2); PG8_BAR;
        PG8_STAGE(PG8_SB(1, 0), cB + kstep, voffB); PG8_STAGE(PG8_SA(1, 0), cA + kstep, voffA); PG8_STAGE(PG8_SB(1, 1), cB + hstep + kstep, voffB);
        PG8_WAIT_V(6); PG8_BAR;
    } else {
        PG8_STAGE(PG8_SB(0, 0), cB, voffB); PG8_STAGE(PG8_SA(0, 0), cA, voffA); PG8_STAGE(PG8_SB(0, 1), cB + hstep, voffB); PG8_STAGE(PG8_SA(0, 1), cA + hstep, voffA);
        if (wr == 1) PG8_BAR;
        PG8_WAIT_V(4); PG8_BAR;
        PG8_STAGE(PG8_SB(1, 0), cB + kstep, voffB); PG8_STAGE(PG8_SA(1, 0), cA + kstep, voffA); PG8_STAGE(PG8_SB(1, 1), cB + hstep + kstep, voffB);
        PG8_WAIT_V(6); PG8_BAR;
    }
    for (;;) {
        const bool has_next = S.next(ui + 1, nxt);
        const char* nA = has_next ? (const char*)g.A + (size_t)nxt.pm * tstep : cA; const char* nB = has_next ? (const char*)g.Bt + (size_t)nxt.pn * tstep : cB;
        for (int t = 0; t < nt; t += 2) {
            const bool last = (t == nt - 2);
            const char* a1 = cA + (size_t)(t + 1) * kstep;
            const char* a2 = last ? nA : cA + (size_t)(t + 2) * kstep; const char* b2 = last ? nB : cB + (size_t)(t + 2) * kstep;
            const char* a3 = a2 + kstep; const char* b3 = b2 + kstep;
            if (last && has_next) S.a_ready(nxt);
            if constexpr (SP2) {
            PG8_LDB(B0, 0, 0); PG8_LDB(B1, 0, 1); PG8_SCHED; PG8_LDA(At, 0, 0); PG8_STAGE(PG8_SA(1, 1), a1 + hstep, voffA);
            PG8_WAIT_V(8); PG8_WAIT_L(0); PG8_BAR; PG8_MMA(0, 0, At, B0); PG8_MMA(0, 1, At, B1); PG8_BAR; PG8_SCHED;
            PG8_LDA(At, 0, 1); PG8_STAGE(PG8_SB(0, 0), b2, voffB); PG8_STAGE(PG8_SB(0, 1), b2 + hstep, voffB); PG8_STAGE(PG8_SA(0, 0), a2, voffA);
            PG8_WAIT_V(8); PG8_WAIT_L(0); PG8_BAR; PG8_MMA(1, 0, At, B0); PG8_MMA(1, 1, At, B1); PG8_BAR; PG8_SCHED;
            PG8_LDB(B0, 1, 0); PG8_LDB(B1, 1, 1); PG8_SCHED; PG8_LDA(At, 1, 0); PG8_STAGE(PG8_SA(0, 1), a2 + hstep, voffA);
            PG8_WAIT_V(8); PG8_WAIT_L(0); PG8_BAR; PG8_MMA(0, 0, At, B0); PG8_MMA(0, 1, At, B1); PG8_BAR; PG8_SCHED;
            PG8_LDA(At, 1, 1); PG8_STAGE(PG8_SB(1, 0), b3, voffB); PG8_STAGE(PG8_SB(1, 1), b3 + hstep, voffB); PG8_STAGE(PG8_SA(1, 0), a3, voffA);
            PG8_WAIT_V(8); PG8_WAIT_L(0); PG8_BAR; PG8_MMA(1, 0, At, B0); PG8_MMA(1, 1, At, B1); PG8_BAR; PG8_SCHED;
            } else {
            PG8_LDB(B0, 0, 0); PG8_SCHED; PG8_LDA(At, 0, 0); PG8_STAGE(PG8_SA(1, 1), a1 + hstep, voffA);
            PG8_WAIT_L(8); PG8_BAR; PG8_WAIT_L(0); PG8_MMA(0, 0, At, B0); PG8_BAR; PG8_SCHED;
            PG8_LDB(B1, 0, 1); PG8_STAGE(PG8_SB(0, 0), b2, voffB);
            PG8_BAR; PG8_WAIT_L(0); PG8_MMA(0, 1, At, B1); PG8_BAR;
            PG8_LDA(At, 0, 1); PG8_STAGE(PG8_SA(0, 0), a2, voffA);
            PG8_BAR; PG8_WAIT_L(0); PG8_MMA(1, 0, At, B0); PG8_BAR; PG8_SCHED;
            PG8_STAGE(PG8_SB(0, 1), b2 + hstep, voffB);
            PG8_WAIT_V(6); PG8_BAR; PG8_MMA(1, 1, At, B1); PG8_BAR;
            PG8_LDB(B0, 1, 0); PG8_SCHED; PG8_LDA(At, 1, 0); PG8_STAGE(PG8_SA(0, 1), a2 + hstep, voffA);
            PG8_WAIT_L(8); PG8_BAR; PG8_WAIT_L(0); PG8_MMA(0, 0, At, B0); PG8_BAR; PG8_SCHED;
            PG8_LDB(B1, 1, 1); PG8_STAGE(PG8_SB(1, 0), b3, voffB);
            PG8_BAR; PG8_WAIT_L(0); PG8_MMA(0, 1, At, B1); PG8_BAR;
            PG8_LDA(At, 1, 1); PG8_STAGE(PG8_SA(1, 0), a3, voffA);
            PG8_BAR; PG8_WAIT_L(0); PG8_MMA(1, 0, At, B0); PG8_BAR; PG8_SCHED;
            PG8_STAGE(PG8_SB(1, 1), b3 + hstep, voffB);
            PG8_WAIT_V(6); PG8_BAR; PG8_MMA(1, 1, At, B1); PG8_BAR;
            }
        }
        if constexpr (ALIGN_EPI) { if (wr == 0) PG8_BAR; }
        if constexpr (!Epi::AFTER_DRAIN) { E(acc, cur, wr, wc, fr, fq); S.done(cur); }
        if (!has_next) break;
#pragma unroll
        for (int a = 0; a < 2; ++a)
#pragma unroll
            for (int b = 0; b < 2; ++b)
#pragma unroll
                for (int m = 0; m < 4; ++m)
#pragma unroll
                    for (int n = 0; n < 2; ++n) acc[a][b][m][n] = (f32x4){0.f, 0.f, 0.f, 0.f};
        cur = nxt; cA = nA; cB = nB; ++ui;
        if constexpr (ALIGN_EPI) { if (wr == 1) PG8_BAR; }
    }
    PG8_WAIT_V(0);
    if constexpr (!ALIGN_EPI) { if (wr == 0) PG8_BAR; }
    PG8_BAR;
    if constexpr (Epi::AFTER_DRAIN) { E.fused(acc, cur, wr, wc, fr, fq, lds, wid, lane); S.done(cur); }
#undef PG8_SA
#undef PG8_SB
#undef PG8_STAGE
#undef PG8_LDA
#undef PG8_LDB
#undef PG8_MMA
#undef PG8_WAIT_V
#undef PG8_WAIT_L
#undef PG8_BAR
#undef PG8_SCHED
}
}
namespace attn_body {
using bf16=__hip_bfloat16;
using bf16x8=__attribute__((ext_vector_type(8)))short;
using s16x4=__attribute__((ext_vector_type(4)))short;
using f32x16=__attribute__((ext_vector_type(16)))float;
using u32x4=__attribute__((ext_vector_type(4)))unsigned;
constexpr int BATCH=16,NHEAD=8,SEQ=2048,D=64,DM=NHEAD*D,DMO=1024;
constexpr int NW=8,QBLK=32,QB=QBLK*NW,KVBLK=64,NQB=SEQ/QB;
constexpr int ATTN_PITCH=DM, ATTN_UNIT_ROWS=QB;
__device__ __forceinline__ int crow(int r,int hi){return (r&3)+8*(r>>2)+4*hi;}
#define SBAR() __builtin_amdgcn_sched_barrier(0)
__device__ __forceinline__ void cmask(f32x16&p0,f32x16&p1,int jb,int qrel,int hi){
  const float NEG=-INFINITY; int kb=64*jb+4*hi;
  #pragma unroll
  for(int r=0;r<16;++r){int kv=kb+(r&3)+8*(r>>2); if(kv>qrel)p0[r]=NEG; if(kv+32>qrel)p1[r]=NEG;}
}

__device__ __forceinline__ void bmask(f32x16&p0,f32x16&p1,unsigned long long mw,int hi){
  const unsigned lo=(unsigned)mw>>(4*hi), up=(unsigned)(mw>>32)>>(4*hi);
  #pragma unroll
  for(int r=0;r<16;++r){ const int ps=(r&3)+8*(r>>2);
    const unsigned x0=(unsigned)__builtin_amdgcn_sbfe((int)lo,ps,1), x1=(unsigned)__builtin_amdgcn_sbfe((int)up,ps,1);
    p0[r]=__uint_as_float((__float_as_uint(p0[r])&x0)|(0xFF800000u&~x0)); p1[r]=__uint_as_float((__float_as_uint(p1[r])&x1)|(0xFF800000u&~x1)); }
}
constexpr int NSLOT=3, SLOTB=8192;
constexpr int LDS_K=0, LDS_V=NSLOT*SLOTB, LDS_WS=2*NSLOT*SLOTB, LDS_OST=LDS_WS+NW*64*4, LDS_MASK=LDS_OST+NW*4096, LDS_BYTES=LDS_MASK+32*256*8;
constexpr float C2=0.125f*1.4426950408889634f;
__device__ __forceinline__ void glds16(const void*gsrc,unsigned lds_dst){unsigned keep;
  asm volatile("s_mov_b32 %0, m0\n\ts_mov_b32 m0, %2\n\ts_nop 0\n\tglobal_load_lds_dwordx4 %1, off\n\ts_mov_b32 m0, %0":"=&s"(keep):"v"(gsrc),"s"(lds_dst):"memory");}
__device__ __forceinline__ float max3f(float a,float b,float c){float r;asm("v_max3_f32 %0, %1, %2, %3":"=v"(r):"v"(a),"v"(b),"v"(c));return r;}
__device__ __forceinline__ float max2f(float a,float b){float r;asm("v_max_f32_e32 %0, %1, %2":"=v"(r):"v"(a),"v"(b));return r;}
__device__ __forceinline__ float fadd_s(float a,float b){float r;asm("v_add_f32_e32 %0, %1, %2":"=v"(r):"v"(a),"v"(b));return r;}
__device__ __forceinline__ float fsub_s(float a,float b){float r;asm("v_sub_f32_e32 %0, %1, %2":"=v"(r):"v"(a),"v"(b));return r;}
typedef float f32x2_t __attribute__((ext_vector_type(2))); typedef __bf16 bf16x2_t __attribute__((ext_vector_type(2)));
__device__ __forceinline__ unsigned cvtpk_s(float lo,float hi){f32x2_t v={lo,hi};bf16x2_t b=__builtin_convertvector(v,bf16x2_t);return __builtin_bit_cast(unsigned,b);}
#define WAIT_BAR(N) asm volatile("s_waitcnt vmcnt(" #N ") lgkmcnt(0)\n\ts_barrier":::"memory")

__device__ __forceinline__ void qkt(f32x16&p0,f32x16&p1,const char*Kslot,const bf16x8*qr,const f32x16&negm,int r32,int hi){
  const char*kb=Kslot+hi*1024+r32*16;
  #pragma unroll
  for(int d0=0;d0<4;++d0){
    const bf16x8 b0=*reinterpret_cast<const bf16x8*>(kb+d0*2048);
    const bf16x8 b1=*reinterpret_cast<const bf16x8*>(kb+d0*2048+512);
    if(d0==0){p0=__builtin_amdgcn_mfma_f32_32x32x16_bf16(b0,qr[0],negm,0,0,0);p1=__builtin_amdgcn_mfma_f32_32x32x16_bf16(b1,qr[0],negm,0,0,0);}
    else{p0=__builtin_amdgcn_mfma_f32_32x32x16_bf16(b0,qr[d0],p0,0,0,0);p1=__builtin_amdgcn_mfma_f32_32x32x16_bf16(b1,qr[d0],p1,0,0,0);}}
}
typedef __attribute__((address_space(3))) const char* lds_cptr;
typedef short v4i16_t __attribute__((ext_vector_type(4)));
__device__ __forceinline__ void kload8(bf16x8*kf,lds_cptr kp){
  kf[0]=*(const __attribute__((address_space(3))) bf16x8*)(kp);      kf[1]=*(const __attribute__((address_space(3))) bf16x8*)(kp+512);
  kf[2]=*(const __attribute__((address_space(3))) bf16x8*)(kp+2048); kf[3]=*(const __attribute__((address_space(3))) bf16x8*)(kp+2560);
  kf[4]=*(const __attribute__((address_space(3))) bf16x8*)(kp+4096); kf[5]=*(const __attribute__((address_space(3))) bf16x8*)(kp+4608);
  kf[6]=*(const __attribute__((address_space(3))) bf16x8*)(kp+6144); kf[7]=*(const __attribute__((address_space(3))) bf16x8*)(kp+6656);
}
__device__ __forceinline__ void kload2(bf16x8*kf,lds_cptr kp,int j){ kf[2*j]=*(const __attribute__((address_space(3))) bf16x8*)(kp+j*2048); kf[2*j+1]=*(const __attribute__((address_space(3))) bf16x8*)(kp+j*2048+512); }
__device__ __forceinline__ s16x4 vtr(lds_cptr p){ return __builtin_bit_cast(s16x4,__builtin_amdgcn_ds_read_tr16_b64_v4i16((__attribute__((address_space(3))) v4i16_t*)p)); }
__device__ __forceinline__ float rowmax(const f32x16&p0,const f32x16&p1){
  float a=max3f(p0[0],p0[1],p1[0]),b=max3f(p0[2],p0[3],p1[1]);a=max3f(a,p1[2],p1[3]);
  #pragma unroll
  for(int r=4;r<16;r+=4){a=max3f(a,p0[r],p0[r+1]);b=max3f(b,p0[r+2],p0[r+3]);a=max3f(a,p1[r],p1[r+1]);b=max3f(b,p1[r+2],p1[r+3]);}
  const float m=max2f(a,b);
  auto rr=__builtin_amdgcn_permlane32_swap(__float_as_uint(m),__float_as_uint(m),false,false);
  return max2f(__uint_as_float(rr[0]),__uint_as_float(rr[1]));
}
__device__ __forceinline__ void pv(f32x16*o,int vb,bf16x8 pa0,bf16x8 pa1,bf16x8 pa2,bf16x8 pa3){
  #pragma unroll
  for(int d0=0;d0<2;++d0){s16x4 lo[4],hi[4];
    #pragma unroll
    for(int ks=0;ks<4;++ks){
      asm volatile("ds_read_b64_tr_b16 %0,%1 offset:%c2":"=&v"(lo[ks]):"v"(vb),"i"(d0*4096+ks*1024):"memory");
      asm volatile("ds_read_b64_tr_b16 %0,%1 offset:%c2":"=&v"(hi[ks]):"v"(vb),"i"(d0*4096+ks*1024+512):"memory");}
    asm volatile("s_waitcnt lgkmcnt(0)":::"memory");SBAR();
    #define PK(k) (bf16x8){lo[k][0],lo[k][1],lo[k][2],lo[k][3],hi[k][0],hi[k][1],hi[k][2],hi[k][3]}
    o[d0]=__builtin_amdgcn_mfma_f32_32x32x16_bf16(pa0,PK(0),o[d0],0,0,0);
    o[d0]=__builtin_amdgcn_mfma_f32_32x32x16_bf16(pa1,PK(1),o[d0],0,0,0);
    o[d0]=__builtin_amdgcn_mfma_f32_32x32x16_bf16(pa2,PK(2),o[d0],0,0,0);
    o[d0]=__builtin_amdgcn_mfma_f32_32x32x16_bf16(pa3,PK(3),o[d0],0,0,0);
    #undef PK
  }
}

#ifndef ATTN_STORE16
#define ATTN_STORE16(p,v) (*(u32x4*)(p)=(v))
#endif
template<int THRL> __device__ __forceinline__ void attn_unit(int b,int h,int qb,const bf16*Q,const bf16*__restrict__ K,const bf16*__restrict__ V,bf16*O,const u32x4*__restrict__ MaskG,const float*__restrict__ gain,char*shm,int tid_in){
  int tid_o=tid_in; asm volatile("":"+v"(tid_o)); const int tid=tid_o,lane=tid&63,r32=lane&31,hi=lane>>5; const int wid=__builtin_amdgcn_readfirstlane(tid>>6);
  const long rowbase=(long)b*SEQ; const int q0=qb*QB;
  const bf16*Qw=Q+(rowbase+q0+wid*QBLK)*DM+h*D;
  const bf16*Kh=K+rowbase*DM+h*D,*Vh=V+rowbase*DM+h*D;
  const unsigned lds0=(unsigned)(uintptr_t)shm;
  float*wsf=(float*)(shm+LDS_WS)+wid*64;
  const bf16*ksrc=Kh+(long)lane*DM+wid*8;
  const bf16*vsrc=Vh+(long)(16*(wid&3)+(lane>>2))*DM+(wid>>2)*32+(lane&3)*8;
  const unsigned kdst=lds0+LDS_K+wid*1024, vdst=lds0+LDS_V+wid*1024;
  #define DMA_K(t,slot) glds16(ksrc+(long)(t)*KVBLK*DM,(unsigned)__builtin_amdgcn_readfirstlane(kdst+(slot)))
  #define DMA_V(t,slot) glds16(vsrc+(long)(t)*KVBLK*DM,(unsigned)__builtin_amdgcn_readfirstlane(vdst+(slot)))
  const int vb0=(int)(lds0+LDS_V)+((lane>>4)&1)*32+(lane&3)*8+(4*hi+((lane&15)>>2))*64;
  const char*Kbase=shm+LDS_K; bf16x8 kf[8];
  const lds_cptr shm3=(lds_cptr)shm; const lds_cptr kp0=shm3+LDS_K+hi*1024+r32*16; const lds_cptr vp0=shm3+LDS_V+((lane>>4)&1)*32+(lane&3)*8+(4*hi+((lane&15)>>2))*64;
  const int NT=(q0+QB)/KVBLK;
  { const u32x4*mg=MaskG+(long)(b*NQB+qb)*32*128;
    __attribute__((address_space(3))) u32x4*ml=(__attribute__((address_space(3))) u32x4*)((__attribute__((address_space(3))) char*)shm+LDS_MASK);
    for(int i=tid;i<NT*128;i+=NW*64){ const u32x4 v=mg[i]; ml[i]=v; }
    asm volatile("s_waitcnt vmcnt(0)":::"memory"); }
  DMA_K(0,0);DMA_V(0,0);DMA_K(1,SLOTB);
  bf16x8 qr[4];
  #pragma unroll
  for(int d0=0;d0<4;++d0)qr[d0]=*reinterpret_cast<const bf16x8*>(&Qw[(long)r32*DM+d0*16+hi*8]);
  float mhat=0.f,l_reg=0.f;f32x16 o[2];o[0]=f32x16{};o[1]=f32x16{};f32x16 negm=f32x16{};asm volatile("":"+v"(negm));
  const int qrel=wid*QBLK+r32;
  const lds_cptr mkp=(lds_cptr)shm+LDS_MASK+qrel*8;
  #define CMASK(P0,P1,t) do{ const unsigned long long mw_=*(const __attribute__((address_space(3))) unsigned long long*)(mkp+(t)*2048); bmask(P0,P1,mw_,hi); }while(0)
  bool resc=false;
  #define START(P0,P1) do{ const float rm=rowmax(P0,P1); resc=false; \
    { const float dl=max2f(rm,-256.f); mhat=fadd_s(mhat,dl); \
      _Pragma("unroll") for(int r=0;r<16;++r){P0[r]=fsub_s(P0[r],dl);P1[r]=fsub_s(P1[r],dl);} \
      _Pragma("unroll") for(int r=0;r<16;++r)negm[r]=-mhat; asm volatile("":"+v"(negm)); } \
    _Pragma("unroll") for(int r=0;r<16;++r)P0[r]=__builtin_amdgcn_exp2f(P0[r]); }while(0)
  #define RESC() do{ if(resc){ asm volatile("s_waitcnt lgkmcnt(0)":::"memory"); \
      _Pragma("unroll") for(int d_=0;d_<2;++d_) _Pragma("unroll") for(int r=0;r<16;++r)o[d_][r]*=wsf[crow(r,hi)]; } }while(0)
  f32x16 pA0,pA1,pB0,pB1;
  int sl_prev=0,sl_cur=0,sl_next=SLOTB;
  #define ROT() do{sl_prev=sl_cur;sl_cur=sl_next;sl_next=(sl_next==(NSLOT-1)*SLOTB)?0:sl_next+SLOTB;}while(0)
  DMA_K(2,2*SLOTB);
  WAIT_BAR(3);
  qkt(pA0,pA1,Kbase,qr,negm,r32,hi);asm volatile("s_nop 15\n\ts_nop 7":"+v"(pA0),"+v"(pA1));CMASK(pA0,pA1,0);
  START(pA0,pA1);
  _Pragma("unroll") for(int r=0;r<16;++r)pA1[r]=__builtin_amdgcn_exp2f(pA1[r]);
  WAIT_BAR(0);
  DMA_K(3,0);DMA_V(1,SLOTB);
  ROT();
  kload8(kf,kp0+sl_cur);
  WAIT_BAR(2);
  s16x4 vlo[8],vhi[8]; u32x4 pw0,pw1,pw2,pw3;
  #define PKW(P,B) cvtpk_s(P[B],P[B+1])
  #define PAF(k) __builtin_bit_cast(bf16x8,pw##k)
  #define VFR(i) (bf16x8){vlo[i][0],vlo[i][1],vlo[i][2],vlo[i][3],vhi[i][0],vhi[i][1],vhi[i][2],vhi[i][3]}
  #define PIN(x) asm volatile("":"+v"(x))
  #define MX3(a,b,c) __builtin_fmaxf(__builtin_fmaxf((a),(b)),(c))
  #define GAPA(MF,A0,A1,A2,A3,W0,W1,PW) do{ MF; sacc+=A0; sacc+=A1; sacc+=A2; sacc+=A3; PIN(sacc); W0; W1; PIN(PW); SBAR(); }while(0)
  #define EX(v) __builtin_amdgcn_exp2f(v)
  #define GAPB(MF,X,B) do{ MF; X[B]=EX(X[B]); X[B+1]=EX(X[B+1]); X[B+2]=EX(X[B+2]); X[B+3]=EX(X[B+3]); PIN(X); SBAR(); }while(0)
  #define VRD(i) do{ vlo[i]=vtr(vp_+(((i)>>2)*4096+((i)&3)*1024)); vhi[i]=vtr(vp_+(((i)>>2)*4096+((i)&3)*1024+512)); }while(0)
  #define KRD(G,j) do{ if(G){ kload2(kf,kp0+sl_next,j); SBAR(); } }while(0)
  #define STEP(C0,C1,P0,P1,t,GK,GV,GL) do{ SBAR(); \
    const lds_cptr vp_=vp0+sl_prev; \
    VRD(0); SBAR(); float sacc=(P0[0]+P0[1]); \
    GAPA(C0=__builtin_amdgcn_mfma_f32_32x32x16_bf16(kf[0],qr[0],negm,0,0,0), P0[2],P0[3],P0[4],P0[5],     pw0[0]=PKW(P0,0), pw0[1]=PKW(P0,2), pw0); \
    VRD(4); SBAR(); GAPA(C1=__builtin_amdgcn_mfma_f32_32x32x16_bf16(kf[1],qr[0],negm,0,0,0), P0[6],P0[7],P0[8],P0[9],     pw0[2]=PKW(P0,4), pw0[3]=PKW(P0,6), pw0); \
    VRD(1); SBAR(); GAPA(C0=__builtin_amdgcn_mfma_f32_32x32x16_bf16(kf[2],qr[1],C0,0,0,0),   P0[10],P0[11],P0[12],P0[13], pw1[0]=PKW(P0,8), pw1[1]=PKW(P0,10), pw1); \
    VRD(5); SBAR(); GAPA(C1=__builtin_amdgcn_mfma_f32_32x32x16_bf16(kf[3],qr[1],C1,0,0,0),   P0[14],P0[15],P1[0],P1[1],   pw1[2]=PKW(P0,12),pw1[3]=PKW(P0,14), pw1); \
    VRD(2); SBAR(); GAPA(C0=__builtin_amdgcn_mfma_f32_32x32x16_bf16(kf[4],qr[2],C0,0,0,0),   P1[2],P1[3],P1[4],P1[5],     pw2[0]=PKW(P1,0), pw2[1]=PKW(P1,2), pw2); \
    VRD(6); SBAR(); GAPA(C1=__builtin_amdgcn_mfma_f32_32x32x16_bf16(kf[5],qr[2],C1,0,0,0),   P1[6],P1[7],P1[8],P1[9],     pw2[2]=PKW(P1,4), pw2[3]=PKW(P1,6), pw2); \
    VRD(3); SBAR(); GAPA(C0=__builtin_amdgcn_mfma_f32_32x32x16_bf16(kf[6],qr[3],C0,0,0,0),   P1[10],P1[11],P1[12],P1[13], pw3[0]=PKW(P1,8), pw3[1]=PKW(P1,10), pw3); \
    VRD(7); SBAR(); GAPA(C1=__builtin_amdgcn_mfma_f32_32x32x16_bf16(kf[7],qr[3],C1,0,0,0),   P1[14],P1[15],0.f,0.f,       pw3[2]=PKW(P1,12),pw3[3]=PKW(P1,14), pw3); \
    l_reg+=sacc; \
    if(GK){DMA_K((t)+3,sl_cur);} if(GV){DMA_V((t)+1,sl_next);} \
    CMASK(C0,C1,t); \
    { float a=MX3(C0[0],C0[1],C1[0]),b=MX3(C0[2],C0[3],C1[1]); a=MX3(a,C1[2],C1[3]); \
      _Pragma("unroll") for(int r=4;r<16;r+=4){a=MX3(a,C0[r],C0[r+1]);b=MX3(b,C0[r+2],C0[r+3]);a=MX3(a,C1[r],C1[r+1]);b=MX3(b,C1[r+2],C1[r+3]);} \
      float rm=__builtin_fmaxf(a,b); { auto rr=__builtin_amdgcn_permlane32_swap(__float_as_uint(rm),__float_as_uint(rm),false,false); rm=__builtin_fmaxf(__uint_as_float(rr[0]),__uint_as_float(rr[1])); } \
      resc=false; \
      if(__builtin_expect(__any(rm>(float)THRL),0)){ const float dl=__builtin_fmaxf(rm,0.f); mhat+=dl; \
        _Pragma("unroll") for(int r=0;r<16;++r){C0[r]-=dl;C1[r]-=dl;} \
        _Pragma("unroll") for(int r=0;r<16;++r)negm[r]=-mhat; asm volatile("":"+v"(negm)); \
        const float f=__builtin_amdgcn_exp2f(-dl); l_reg*=f; if(hi==0)wsf[r32]=f; resc=true; } } \
    SBAR(); \
    GAPB(o[0]=__builtin_amdgcn_mfma_f32_32x32x16_bf16(PAF(0),VFR(0),o[0],0,0,0), C0,0); \
    GAPB(o[1]=__builtin_amdgcn_mfma_f32_32x32x16_bf16(PAF(0),VFR(4),o[1],0,0,0), C0,4); \
    KRD(GL,0); GAPB(o[0]=__builtin_amdgcn_mfma_f32_32x32x16_bf16(PAF(1),VFR(1),o[0],0,0,0), C0,8); \
    KRD(GL,1); GAPB(o[1]=__builtin_amdgcn_mfma_f32_32x32x16_bf16(PAF(1),VFR(5),o[1],0,0,0), C0,12); \
    KRD(GL,2); GAPB(o[0]=__builtin_amdgcn_mfma_f32_32x32x16_bf16(PAF(2),VFR(2),o[0],0,0,0), C1,0); \
    KRD(GL,3); GAPB(o[1]=__builtin_amdgcn_mfma_f32_32x32x16_bf16(PAF(2),VFR(6),o[1],0,0,0), C1,4); \
    GAPB(o[0]=__builtin_amdgcn_mfma_f32_32x32x16_bf16(PAF(3),VFR(3),o[0],0,0,0), C1,8); \
    GAPB(o[1]=__builtin_amdgcn_mfma_f32_32x32x16_bf16(PAF(3),VFR(7),o[1],0,0,0), C1,12); \
    }while(0)
  int t=1;
  for(;t+5<NT;t+=2){
    STEP(pB0,pB1,pA0,pA1,t,true,true,true);     WAIT_BAR(2); RESC(); ROT();
    STEP(pA0,pA1,pB0,pB1,t+1,true,true,true);   WAIT_BAR(2); RESC(); ROT();
  }
  #define ENDW(tt) do{ if((tt)+3<NT){WAIT_BAR(2);} else if((tt)+2<NT){WAIT_BAR(1);} else {WAIT_BAR(0);} }while(0)
  for(;t+1<NT;t+=2){
    STEP(pB0,pB1,pA0,pA1,t,(t+3<NT),(t+1<NT),(t+1<NT));       ENDW(t);   RESC(); ROT();
    STEP(pA0,pA1,pB0,pB1,t+1,(t+4<NT),(t+2<NT),(t+2<NT));     ENDW(t+1); RESC(); ROT();
  }
  STEP(pB0,pB1,pA0,pA1,NT-1,false,false,false); RESC();
  { float sacc=pB0[0]+pB0[1]; _Pragma("unroll") for(int r=2;r<16;++r)sacc+=pB0[r]; _Pragma("unroll") for(int r=0;r<16;++r)sacc+=pB1[r]; l_reg+=sacc;
    pw0=(u32x4){PKW(pB0,0),PKW(pB0,2),PKW(pB0,4),PKW(pB0,6)};pw1=(u32x4){PKW(pB0,8),PKW(pB0,10),PKW(pB0,12),PKW(pB0,14)};pw2=(u32x4){PKW(pB1,0),PKW(pB1,2),PKW(pB1,4),PKW(pB1,6)};pw3=(u32x4){PKW(pB1,8),PKW(pB1,10),PKW(pB1,12),PKW(pB1,14)};
    SBAR(); pv(o,vb0+sl_cur,PAF(0),PAF(1),PAF(2),PAF(3)); }
  #undef PKW
  #undef PAF
  #undef VFR
  #undef PIN
  #undef MX3
  #undef GAPA
  #undef GAPB
  #undef EX
  #undef VRD
  #undef KRD
  #undef STEP
  #undef ENDW
  {auto rr=__builtin_amdgcn_permlane32_swap(__float_as_uint(l_reg),__float_as_uint(l_reg),false,false);l_reg=__uint_as_float(rr[0])+__uint_as_float(rr[1]);}
  if(hi==0)wsf[32+r32]=l_reg;asm volatile("s_waitcnt lgkmcnt(0)":::"memory");
  float rli[16];
  #pragma unroll
  for(int r=0;r<16;++r)rli[r]=__builtin_amdgcn_rcpf(wsf[32+crow(r,hi)]);
  bf16*Ow=O+(rowbase+q0+wid*QBLK)*DMO+h*D;
  { bf16*stg=(bf16*)(shm+LDS_OST)+wid*2048;
    #pragma unroll
    for(int r=0;r<16;++r){const int orow=crow(r,hi);
      #pragma unroll
      for(int d0=0;d0<2;++d0)stg[orow*64+d0*32+r32]=__float2bfloat16(o[d0][r]*rli[r]);}
    asm volatile("s_waitcnt lgkmcnt(0)":::"memory");
    float gn[8];
    #pragma unroll
    for(int e=0;e<8;++e)gn[e]=gain[h*D+(lane&7)*8+e];
    #pragma unroll
    for(int i=0;i<4;++i){const int row=i*8+(lane>>3),ch=lane&7; const u32x4 v=*(const u32x4*)(stg+row*64+ch*8);
      float f[8]; f[0]=__uint_as_float(v.x<<16);f[1]=__uint_as_float(v.x&0xffff0000u);f[2]=__uint_as_float(v.y<<16);f[3]=__uint_as_float(v.y&0xffff0000u);
      f[4]=__uint_as_float(v.z<<16);f[5]=__uint_as_float(v.z&0xffff0000u);f[6]=__uint_as_float(v.w<<16);f[7]=__uint_as_float(v.w&0xffff0000u);
      float ss=0.f;
      #pragma unroll
      for(int e=0;e<8;++e)ss+=f[e]*f[e];
      ss+=__shfl_xor(ss,1);ss+=__shfl_xor(ss,2);ss+=__shfl_xor(ss,4);
      const float rs=rsqrtf(ss*(1.f/64.f)+1e-6f);
      u32x4 w; w.x=cvtpk_s(f[0]*rs*gn[0],f[1]*rs*gn[1]); w.y=cvtpk_s(f[2]*rs*gn[2],f[3]*rs*gn[3]); w.z=cvtpk_s(f[4]*rs*gn[4],f[5]*rs*gn[5]); w.w=cvtpk_s(f[6]*rs*gn[6],f[7]*rs*gn[7]);
      ATTN_STORE16(Ow+(long)row*DMO+ch*8,w);} }
  asm volatile("s_waitcnt lgkmcnt(0)\n\ts_barrier":::"memory");
  #undef DMA_K
  #undef DMA_V
  #undef CMASK
  #undef START
  #undef RESC
  #undef ROT
}
constexpr int ATTN_LDS_BYTES=LDS_BYTES;
struct AttnTensors { const bf16* Q; const bf16* K; const bf16* V; bf16* O; const u32x4* Mask; const float* gain; };
struct AttnUnit { int bh; int qb; };
struct StaticOrder {
  int vcu, G;
  __device__ __forceinline__ explicit StaticOrder(int grid,int block):vcu((grid%8==0)?(block%8)*(grid/8)+block/8:block),G(grid){}
  __device__ __forceinline__ bool next(int i,AttnUnit&u)const{
    if(G==256){ if(i>=4)return false; const int s=vcu&1; u.bh=vcu>>1; u.qb=(i==0)?s:(i==1)?7-s:(i==2)?3-s:4+s; return true; }
    const int L=i*G+vcu; if(L>=BATCH*NHEAD*NQB)return false; u.bh=L/NQB; u.qb=L%NQB; return true; }
  __device__ __forceinline__ void a_ready(const AttnUnit&)const{}
  __device__ __forceinline__ void done(const AttnUnit&)const{}
};
template<class Sched,int THRL=8> __device__ __forceinline__ void attn_phase(char*lds,const AttnTensors&T,const Sched&S,int tid_in){
  AttnUnit u;
  for(int i=0;S.next(i,u);++i){ S.a_ready(u); attn_unit<THRL>(u.bh/NHEAD,u.bh%NHEAD,u.qb,T.Q,T.K,T.V,T.O,T.Mask,T.gain,lds,tid_in); S.done(u); }
}
#undef SBAR
#undef WAIT_BAR
}

constexpr int NWAVES = 8;
#ifndef MK_ONE_LAUNCH
#define MK_ONE_LAUNCH 0
#endif
constexpr int BATCH = 16, SEQ = 2048, D = 1024, M = BATCH * SEQ, DEPTH = 2;
constexpr int NIN = 3408, NINP = 3584, QRK = 256, FF = 2816, NMOD = 6 * D;
constexpr float EPS = 1e-6f;
constexpr int N_PHASES = 2 + 9 * DEPTH;

constexpr size_t MiB = 1u << 20;
constexpr size_t WS_CTL = 0, CTL_ZERO_BYTES = 64 * 1024;
constexpr size_t WS_MOD = 1 * MiB;
constexpr size_t WS_SSQ = 2 * MiB;
constexpr size_t WS_W = 3 * MiB, W_LAYER = 26 * MiB;
constexpr size_t WO_IN = 0, WO_Q = 7 * MiB, WO_OUT = 7 * MiB + 512 * 1024, WO_GU = 9 * MiB + 512 * 1024, WO_DN = 20 * MiB + 512 * 1024;
constexpr size_t WS_XN = 56 * MiB;
constexpr size_t WS_MIX = 120 * MiB;
constexpr size_t MX_CQ = 0, MX_K = 16 * MiB, MX_V = 48 * MiB, MX_KI = 80 * MiB, MX_WI = 84 * MiB, MX_IG = 85 * MiB, MX_LF = 85 * MiB + 512 * 1024, MX_QM = 86 * MiB, MX_KM = 118 * MiB, MX_VM = 150 * MiB,
                 MX_OM = 182 * MiB, MX_Q = 214 * MiB, MX_QI = 246 * MiB, MX_MASK = 278 * MiB, MX_H = 0, MX_Y = 192 * MiB, MX_END = 286 * MiB;
constexpr size_t WS_END = WS_MIX + MX_END;
static_assert(WO_DN + (size_t)D * FF * 2 <= W_LAYER && WS_W + DEPTH * W_LAYER <= WS_XN && WS_XN + (size_t)M * D * 2 <= WS_MIX && (size_t)M * FF * 2 <= MX_Y && MX_Y + (size_t)M * D * 2 <= MX_END, "d_ws map");
constexpr int CW_BAR = 4096;

constexpr int RING_BYTES = attn_body::ATTN_LDS_BYTES;
constexpr int LDSCTL_OFF = RING_BYTES, LDS_BYTES = LDSCTL_OFF + 512;
static_assert(pg8::STAGE_BYTES <= RING_BYTES && LDS_BYTES <= 160 * 1024, "LDS map");

#define GAS __attribute__((address_space(1)))
#define LAS __attribute__((address_space(3)))
typedef unsigned short bf16;
typedef unsigned v4u __attribute__((ext_vector_type(4)));
typedef float f32x4 __attribute__((ext_vector_type(4)));
typedef short bf16x8 __attribute__((ext_vector_type(8)));
typedef GAS unsigned gu32;
typedef GAS unsigned long long gu64;
#define RLX_AGENT __ATOMIC_RELAXED, __HIP_MEMORY_SCOPE_AGENT
#define LDS_WAIT() asm volatile("s_waitcnt lgkmcnt(0)" ::: "memory")
#define VM_WAIT() asm volatile("s_waitcnt vmcnt(0)" ::: "memory")
__device__ __forceinline__ unsigned long long rt() { return __builtin_amdgcn_s_memrealtime(); }
__device__ __forceinline__ unsigned f2bf(float f) { unsigned u = __builtin_bit_cast(unsigned, f); return (u + 0x7fffu + ((u >> 16) & 1u)) >> 16; }
__device__ __forceinline__ unsigned pk2(float lo, float hi) { return f2bf(lo) | (f2bf(hi) << 16); }

#define XB_TMO      128
#define XB_XCNT(j)  (256  + 64 * (j))
#define XB_XSUB(j)  (1280 + 64 * (j))
#define XB_XGEN(j)  (2304 + 64 * (j))
#define XB_TOP      3328
#define XB_TOPGEN   3392
#define XCD_BAR_WORDS 3456
#define XB_SPIN_CAP (1u << 18)

__device__ __forceinline__ unsigned xb_ld(unsigned* p)              { return __hip_atomic_load(p, __ATOMIC_RELAXED, __HIP_MEMORY_SCOPE_AGENT); }
__device__ __forceinline__ unsigned xb_add(unsigned* p, unsigned v) { return __hip_atomic_fetch_add(p, v, __ATOMIC_RELAXED, __HIP_MEMORY_SCOPE_AGENT); }
__device__ __forceinline__ unsigned xb_xcc_id() { return (unsigned)__builtin_amdgcn_s_getreg((3 << 11) | 20) & 0xFu; }
#define XB_SPIN(cond, bar) do { unsigned _sp = 0; while (cond) { __builtin_amdgcn_s_sleep(1); \
    if ((++_sp & 255u) == 0u) { if (xb_ld(&(bar)[XB_TMO])) break; if (_sp > XB_SPIN_CAP) { atomicAdd(&(bar)[XB_TMO], 1u); break; } } } } while (0)

struct XcdBarrier {
    unsigned* bar; unsigned x;
    volatile LAS unsigned* st;
};

__device__ __forceinline__ XcdBarrier xcd_barrier_post(unsigned* bar, volatile LAS unsigned* st) {
    XcdBarrier b; b.bar = bar; b.x = xb_xcc_id(); b.st = st;
    if (threadIdx.x == 0) (void)xb_add(&bar[XB_XCNT(b.x)], 1u);
    return b;
}
__device__ __forceinline__ void xcd_barrier_complete(unsigned* bar, unsigned x, unsigned& nloc, unsigned& nx) {
    const unsigned G = gridDim.x * gridDim.y * gridDim.z;
    unsigned sum, cnt, mine, sp = 0u;
    for (;;) {
        sum = 0u; cnt = 0u; mine = 0u;
#pragma unroll
        for (unsigned j = 0; j < 16; ++j) { const unsigned c = xb_ld(&bar[XB_XCNT(j)]); sum += c; cnt += (c > 0u) ? 1u : 0u; mine = (j == x) ? c : mine; }
        if (sum == G) break;
        __builtin_amdgcn_s_sleep(1);
        if ((++sp & 255u) == 0u) { if (xb_ld(&bar[XB_TMO])) break; if (sp > XB_SPIN_CAP) { atomicAdd(&bar[XB_TMO], 1u); break; } }
    }
    nloc = mine > 0u ? mine : 1u; nx = cnt > 0u ? cnt : 1u;
}

__device__ __forceinline__ void xcd_barrier(const XcdBarrier& b) {
    asm volatile("s_waitcnt vmcnt(0)" ::: "memory");
    __syncthreads();
    if (threadIdx.x == 0) {
        unsigned* bar = b.bar;
        const unsigned bx = xb_xcc_id();
        __builtin_amdgcn_s_waitcnt(0);
        unsigned nloc = b.st[0], nx = b.st[1];
        if (nloc == 0u) { xcd_barrier_complete(bar, bx, nloc, nx); b.st[0] = nloc; b.st[1] = nx; }
        const unsigned old = xb_add(&bar[XB_XSUB(bx)], 1u);
        const unsigned gen = old / nloc;
        if (old + 1u == (gen + 1u) * nloc) {
            __builtin_amdgcn_fence(__ATOMIC_RELEASE, "agent");
            asm volatile("s_waitcnt vmcnt(0)" ::: "memory");
            const unsigned og = xb_add(&bar[XB_TOP], 1u);
            const unsigned tg = og / nx;
            if (og + 1u == (tg + 1u) * nx) xb_add(&bar[XB_TOPGEN], 1u);
            else XB_SPIN(xb_ld(&bar[XB_TOPGEN]) == tg, bar);
            __builtin_amdgcn_fence(__ATOMIC_ACQUIRE, "agent");
            xb_add(&bar[XB_XGEN(bx)], 1u);
            asm volatile("s_waitcnt vmcnt(0)" ::: "memory");
        } else {
            XB_SPIN(xb_ld(&bar[XB_XGEN(bx)]) == gen, bar);
            __builtin_amdgcn_fence(__ATOMIC_ACQUIRE, "agent");
            asm volatile("s_waitcnt vmcnt(0)" ::: "memory");
        }
    }
    __syncthreads();
}

typedef float f32x16 __attribute__((ext_vector_type(16)));
typedef unsigned u32x2 __attribute__((ext_vector_type(2)));
__device__ __forceinline__ float wave_sum(float v) {
#pragma unroll
    for (int o = 1; o < 64; o <<= 1) v += __shfl_xor(v, o);
    return v;
}
__device__ __forceinline__ float bf_lo(unsigned u) { return __uint_as_float(u << 16); }
__device__ __forceinline__ float bf_hi(unsigned u) { return __uint_as_float(u & 0xffff0000u); }
__device__ __forceinline__ float sigmoid_f(float g) { return __builtin_amdgcn_rcpf(1.f + __builtin_amdgcn_exp2f(-1.4426950408889634f * g)); }
__device__ __forceinline__ float silu_f(float g) { return g * sigmoid_f(g); }
__device__ __forceinline__ int ropeperm(int p) { const int j = p >> 3, e = p & 7; return (e < 4) ? 4 * j + e : 32 + 4 * j + (e - 4); }

__device__ __forceinline__ void conv_item(int kind, const float* W0, const float* W1, const float* gain, int K, int Nphys, bf16* WT, LAS float* scr, int item, int lane) {
    const int nblk = Nphys / 32, kb = item / nblk, nb = item % nblk, k0 = 64 * kb, n0 = 32 * nb;
    const int n = n0 + (lane & 31);
    const float* src = W0; int ld = Nphys, col = n;
    if (kind == 1) {
        ld = NIN; const int tile = n >> 8, r = n & 255;
        if (tile == 0) col = r;
        else if (tile <= 2) { const int idx = (tile - 1) * 256 + r; col = 256 + (idx >> 6) * 64 + ropeperm(idx & 63); }
        else if (tile <= 4) col = 768 + (tile - 3) * 256 + r;
        else if (tile <= 12) col = 1352 + (tile - 5) * 256 + r;
        else { if (r < 64) col = 1280 + ropeperm(r); else if (r < 72) col = 1344 + (r - 64); else if (r < 76) col = 3400 + (r - 72); else if (r < 80) col = 3404 + (r - 76); else { src = nullptr; col = 0; } }
    } else if (kind == 2) {
        ld = 512; src = (n < 512) ? W0 : W1; const int idx = n & 511; col = (idx >> 6) * 64 + ropeperm(idx & 63);
    } else if (kind == 3) {
        ld = 2 * FF; col = ((n >> 7) & 1) * FF + (n >> 8) * 128 + (n & 127);
    }
#pragma unroll 8
    for (int i = 0; i < 32; ++i) { const int kk = 2 * i + (lane >> 5); float v = src ? src[(size_t)(k0 + kk) * ld + col] : 0.f; if (gain) v *= gain[k0 + kk]; scr[kk * 33 + (lane & 31)] = v; }
    LDS_WAIT(); asm volatile("" ::: "memory");
    const int c = lane & 7;
#pragma unroll
    for (int j = 0; j < 4; ++j) { const int nn = (lane >> 3) + 8 * j; const LAS float* s = scr + (8 * c) * 33 + nn;
        v4u o; o.x = pk2(s[0 * 33], s[1 * 33]); o.y = pk2(s[2 * 33], s[3 * 33]); o.z = pk2(s[4 * 33], s[5 * 33]); o.w = pk2(s[6 * 33], s[7 * 33]);
        *(GAS v4u*)(WT + (size_t)(n0 + nn) * K + k0 + 8 * c) = o; }
    LDS_WAIT(); asm volatile("" ::: "memory");
}

enum { I_X = 0, I_C, I_POS, I_WMOD, I_BMOD, I_MIXPRE, I_MIXPOST, I_WIN, I_QLN, I_WQUP, I_WQIUP, I_CONVW, I_CONVB, I_BIG, I_BFG, I_ATTN, I_MLN, I_WOUT, I_FFNPRE, I_FFNPOST, I_WGU, I_WDN, I_OUT, I_WS };
__device__ __forceinline__ unsigned long long ldptr(LAS unsigned char* lds, int k) {
    const volatile LAS unsigned* p = (const volatile LAS unsigned*)(lds + LDSCTL_OFF + 64 + 8 * k);
    const unsigned lo = __builtin_amdgcn_readfirstlane(p[0]), hi = __builtin_amdgcn_readfirstlane(p[1]);
    return ((unsigned long long)hi << 32) | lo;
}
#define FP(k) ((const float*)ldptr(lds, (k)))
#define WSP() ((unsigned char*)ldptr(lds, I_WS))

__device__ __forceinline__ void p0_prologue(LAS unsigned char* lds, int tid, int lane, int wave, int vcu, int G) {
    LAS float* scr = (LAS float*)(lds + wave * 16384);
    const int gw = vcu * NWAVES + wave, NGW = G * NWAVES;
    constexpr int I_IN = (D / 64) * (NINP / 32), I_Q = (QRK / 64) * (1024 / 32), I_O = (D / 64) * (D / 32), I_GU = (D / 64) * (2 * FF / 32), I_DN = (FF / 64) * (D / 32);
    constexpr int I_LAYER = I_IN + I_Q + I_O + I_GU + I_DN;
    for (int it = gw; it < DEPTH * I_LAYER; it += NGW) {
        const int l = it / I_LAYER; int r = it % I_LAYER; unsigned char* wl = WSP() + WS_W + (size_t)l * W_LAYER;
        if (r < I_IN) { conv_item(1, FP(I_WIN) + (size_t)l * D * NIN, nullptr, nullptr, D, NINP, (bf16*)(wl + WO_IN), scr, r, lane); continue; } r -= I_IN;
        if (r < I_Q) { conv_item(2, FP(I_WQUP) + (size_t)l * QRK * 512, FP(I_WQIUP) + (size_t)l * QRK * 512, FP(I_QLN) + (size_t)l * QRK, QRK, 1024, (bf16*)(wl + WO_Q), scr, r, lane); continue; } r -= I_Q;
        if (r < I_O) { conv_item(0, FP(I_WOUT) + (size_t)l * D * D, nullptr, nullptr, D, D, (bf16*)(wl + WO_OUT), scr, r, lane); continue; } r -= I_O;
        if (r < I_GU) { conv_item(3, FP(I_WGU) + (size_t)l * D * 2 * FF, nullptr, nullptr, D, 2 * FF, (bf16*)(wl + WO_GU), scr, r, lane); continue; } r -= I_GU;
        conv_item(0, FP(I_WDN) + (size_t)l * FF * D, nullptr, nullptr, FF, D, (bf16*)(wl + WO_DN), scr, r, lane);
    }
    __syncthreads();
    constexpr int NU = DEPTH * (NMOD / 64);
    if (vcu < NU) {
        LAS float* sc = (LAS float*)lds;
        LAS float* part = (LAS float*)(lds + 65536);
        { const float* cin = FP(I_C); for (int i = tid; i < BATCH * D; i += NWAVES * 64) { const int b = i / D, k = i % D; sc[k * 16 + b] = silu_f(cin[i]); } }
        __syncthreads();
        const float* wmod = FP(I_WMOD); const float* bmod = FP(I_BMOD); float* modo = (float*)(WSP() + WS_MOD);
        for (int u = vcu; u < NU; u += G) {
            const int l = u / (NMOD / 64), n0 = (u % (NMOD / 64)) * 64;
            const float* W = wmod + (size_t)l * D * NMOD + n0 + lane;
            float acc[16];
#pragma unroll
            for (int b = 0; b < 16; ++b) acc[b] = 0.f;
            for (int k = wave * 128; k < wave * 128 + 128; ++k) { const float wv = W[(size_t)k * NMOD];
#pragma unroll
                for (int q = 0; q < 4; ++q) { const f32x4 s4 = *(const LAS f32x4*)(sc + k * 16 + 4 * q);
                    acc[4 * q + 0] += s4[0] * wv; acc[4 * q + 1] += s4[1] * wv; acc[4 * q + 2] += s4[2] * wv; acc[4 * q + 3] += s4[3] * wv; } }
#pragma unroll
            for (int b = 0; b < 16; ++b) part[(wave * 16 + b) * 64 + lane] = acc[b];
            __syncthreads();
            for (int i = tid; i < 16 * 64; i += NWAVES * 64) { const int b = i >> 6, ln = i & 63; float s = bmod[(size_t)l * NMOD + n0 + ln];
#pragma unroll
                for (int w = 0; w < 8; ++w) s += part[(w * 16 + b) * 64 + ln];
                modo[((size_t)l * BATCH + b) * NMOD + n0 + ln] = s; }
            __syncthreads();
        }
    }
}

__device__ __forceinline__ void norm_phase(const bf16* y, const float* xin, float* xout, const float* gpost, const float* gate, const float* gnext, const float* sc, const float* sh, bf16* XN,
                                           int lane, int wave, int vcu, int G) {
    const int gw = vcu * NWAVES + wave, NGW = G * NWAVES;
    for (int m0 = gw * 16; m0 < M; m0 += NGW * 16) {
        const int b = m0 / SEQ;
        f32x4 vg[4], vt[4], vn[4], vs[4], vh[4];
#pragma unroll
        for (int j = 0; j < 4; ++j) { const int e = 256 * j + 4 * lane;
            if (y) { vg[j] = *(const f32x4*)(gpost + e); vt[j] = *(const f32x4*)(gate + (size_t)b * NMOD + e); }
            if (gnext) { vn[j] = *(const f32x4*)(gnext + e); vs[j] = *(const f32x4*)(sc + (size_t)b * NMOD + e) + 1.f; vh[j] = *(const f32x4*)(sh + (size_t)b * NMOD + e); vn[j] = vn[j] * vs[j]; } }
        for (int r = 0; r < 16; ++r) {
            const size_t row = (size_t)(m0 + r);
            f32x4 xv[4];
#pragma unroll
            for (int j = 0; j < 4; ++j) xv[j] = *(const f32x4*)(xin + row * D + 256 * j + 4 * lane);
            if (y) {
                f32x4 yv[4]; float ss = 0.f;
#pragma unroll
                for (int j = 0; j < 4; ++j) { const u32x2 w = *(const u32x2*)(y + row * D + 256 * j + 4 * lane); yv[j] = (f32x4){bf_lo(w.x), bf_hi(w.x), bf_lo(w.y), bf_hi(w.y)};
                    ss += (yv[j][0] * yv[j][0] + yv[j][1] * yv[j][1]) + (yv[j][2] * yv[j][2] + yv[j][3] * yv[j][3]); }
                const float rstd = rsqrtf(wave_sum(ss) * (1.f / D) + EPS);
#pragma unroll
                for (int j = 0; j < 4; ++j) { xv[j] = xv[j] + vt[j] * (yv[j] * rstd * vg[j]); *(f32x4*)(xout + row * D + 256 * j + 4 * lane) = xv[j]; }
            }
            if (gnext) {
                float ss = 0.f;
#pragma unroll
                for (int j = 0; j < 4; ++j) ss += (xv[j][0] * xv[j][0] + xv[j][1] * xv[j][1]) + (xv[j][2] * xv[j][2] + xv[j][3] * xv[j][3]);
                const float rstd = rsqrtf(wave_sum(ss) * (1.f / D) + EPS);
#pragma unroll
                for (int j = 0; j < 4; ++j) { const f32x4 o = xv[j] * rstd * vn[j] + vh[j]; u32x2 w; w.x = pk2(o[0], o[1]); w.y = pk2(o[2], o[3]); *(u32x2*)(XN + row * D + 256 * j + 4 * lane) = w; }
            }
        }
    }
}

constexpr int IX_SC = 0, IX_KCH = 131072, IX_KPITCH = 144, IX_MSK = IX_KCH;
static_assert(IX_KCH + 128 * IX_KPITCH <= RING_BYTES, "indexer LDS");
__device__ __forceinline__ unsigned ord_key(float f) { const unsigned u = __float_as_uint(f); return u ^ ((unsigned)((int)u >> 31) | 0x80000000u); }
template <int NJ> __device__ __forceinline__ void select_rows(const LAS unsigned* scb, LAS unsigned long long* msk, int nk, int wave, int lane) {
    unsigned xa[NJ], xb[NJ];
#pragma unroll
    for (int j = 0; j < NJ; ++j) { const unsigned va = scb[(2 * wave) * 2048 + 64 * j + lane], vb = scb[(2 * wave + 1) * 2048 + 64 * j + lane]; const bool in = (64 * j + lane) < nk; xa[j] = in ? va : 0u; xb[j] = in ? vb : 0u; }
    unsigned pA = 0u, pB = 0u;
#pragma unroll 1
    for (int bit = 31; bit >= 0; --bit) {
        const unsigned cA = pA | (1u << bit), cB = pB | (1u << bit); unsigned nA = 0u, nB = 0u;
#pragma unroll
        for (int j = 0; j < NJ; ++j) { nA += (xa[j] >= cA) ? 1u : 0u; nB += (xb[j] >= cB) ? 1u : 0u; if ((j & 3) == 3) __builtin_amdgcn_sched_barrier(0); }
        unsigned n = nA | (nB << 16);
#pragma unroll
        for (int o = 1; o < 64; o <<= 1) n += __shfl_xor(n, o);
        if ((n & 0xffffu) >= 256u) pA = cA;
        if ((n >> 16) >= 256u) pB = cB;
    }
    unsigned gA = 0u, gB = 0u, eA = 0u, eB = 0u;
#pragma unroll
    for (int j = 0; j < NJ; ++j) { gA += (xa[j] > pA) ? 1u : 0u; gB += (xb[j] > pB) ? 1u : 0u; eA += (xa[j] == pA) ? 1u : 0u; eB += (xb[j] == pB) ? 1u : 0u; if (j & 1) __builtin_amdgcn_sched_barrier(0); }
    { unsigned n = gA | (gB << 16), e = eA | (eB << 16);
#pragma unroll
      for (int o = 1; o < 64; o <<= 1) { n += __shfl_xor(n, o); e += __shfl_xor(e, o); }
      gA = n & 0xffffu; gB = n >> 16; eA = e & 0xffffu; eB = e >> 16; }
    const unsigned needA = 256u - gA, needB = 256u - gB;
    unsigned xiA = 2047u, xiB = 2047u;
    asm volatile("" : "+v"(pA), "+v"(pB));
    if ((eA > needA) || (eB > needB)) {
        xiA = 0u; xiB = 0u;
#pragma unroll 1
        for (int bit = 10; bit >= 0; --bit) {
            const unsigned cA = xiA | (1u << bit), cB = xiB | (1u << bit); unsigned nA = 0u, nB = 0u;
#pragma unroll
            for (int j = 0; j < NJ; ++j) { int ll = lane; asm volatile("" : "+v"(ll)); const unsigned key = 64u * j + ll;
                nA += (xa[j] == pA && key < cA) ? 1u : 0u; nB += (xb[j] == pB && key < cB) ? 1u : 0u; if (j & 1) __builtin_amdgcn_sched_barrier(0); }
            unsigned n = nA | (nB << 16);
#pragma unroll
            for (int o = 1; o < 64; o <<= 1) n += __shfl_xor(n, o);
            if ((n & 0xffffu) < needA) xiA = cA;
            if ((n >> 16) < needB) xiB = cB;
        }
    }
    asm volatile("" : "+v"(pA), "+v"(pB));
    unsigned a0 = 0u, a1 = 0u, b0 = 0u, b1 = 0u;
#pragma unroll
    for (int j = 0; j < NJ; ++j) { int ll = lane; asm volatile("" : "+v"(ll)); const unsigned key = 64u * j + ll;
        const bool sA = (xa[j] > pA) || (xa[j] == pA && key <= xiA), sB = (xb[j] > pB) || (xb[j] == pB && key <= xiB);
        const unsigned long long ba = __ballot(sA), bb = __ballot(sB);
        asm volatile("v_writelane_b32 %0, %4, %8\n\tv_writelane_b32 %1, %5, %8\n\tv_writelane_b32 %2, %6, %8\n\tv_writelane_b32 %3, %7, %8"
                     : "+v"(a0), "+v"(a1), "+v"(b0), "+v"(b1) : "s"((unsigned)ba), "s"((unsigned)(ba >> 32)), "s"((unsigned)bb), "s"((unsigned)(bb >> 32)), "n"(j));
        __builtin_amdgcn_sched_barrier(0);
    }
    if (lane < 32) { msk[lane * 16 + 2 * wave] = (unsigned long long)a0 | ((unsigned long long)a1 << 32); msk[lane * 16 + 2 * wave + 1] = (unsigned long long)b0 | ((unsigned long long)b1 << 32); }
}
__device__ __forceinline__ void indexer_unit(LAS unsigned char* lds, int b, int qb16, const bf16* QI, const bf16* KI, const float* WI, unsigned long long* MaskG, int tid, int lane, int wave) {
    asm volatile("" : "+v"(tid), "+v"(lane));
    LAS unsigned* scb = (LAS unsigned*)(lds + IX_SC);
    LAS unsigned long long* msk = (LAS unsigned long long*)(lds + IX_MSK);
    const int q0 = qb16 * 16, n_kt = (q0 + 47) >> 5, nk = 32 * n_kt;
    const size_t rowb = (size_t)b * SEQ;
    __syncthreads();
    if (qb16 < 16) {
        { const int T = tid >> 4, i = tid & 15, t = q0 + i;
          msk[T * 16 + i] = (64 * T + 63 <= t) ? ~0ull : (64 * T > t) ? 0ull : ((1ull << (t - 64 * T + 1)) - 1ull); }
    } else {
        const int r = lane & 31, hh = lane >> 5, mt = wave & 3, par = wave >> 2;
        bf16x8 af[4];
        { const int g = r >> 2, ql = 2 * (g & 1) + (g >> 2), hd = 4 * ((g >> 1) & 1) + (r & 3);
          const bf16* qp = QI + (rowb + q0 + 4 * mt + ql) * 512 + hd * 64 + 8 * hh;
#pragma unroll
          for (int s = 0; s < 4; ++s) af[s] = *(const bf16x8*)(qp + 16 * s); }
        float wA[8], wB[8];
        { const float* wp = WI + (rowb + q0 + 4 * mt + 2 * hh) * 8;
#pragma unroll
          for (int j = 0; j < 8; ++j) { wA[j] = wp[j]; wB[j] = wp[8 + j]; } }
        const int rowA = 4 * mt + 2 * hh, tA = q0 + rowA;
        for (int c = 0; 4 * c < n_kt; ++c) {
            if (c) __syncthreads();
#pragma unroll
            for (int i = 0; i < 2; ++i) { const int idx = tid + 512 * i, key = idx >> 3, part = idx & 7;
                *(LAS v4u*)(lds + IX_KCH + key * IX_KPITCH + part * 16) = *(const v4u*)(KI + (rowb + 128 * c + key) * 64 + part * 8); }
            __syncthreads();
#pragma unroll
            for (int k = 0; k < 2; ++k) { const int tt = par + 2 * k, tile = 4 * c + tt;
                if (tile < n_kt) {
                    f32x16 acc = {};
#pragma unroll
                    for (int s = 0; s < 4; ++s) { const bf16x8 bfr = *(const LAS bf16x8*)(lds + IX_KCH + (32 * tt + r) * IX_KPITCH + 32 * s + 16 * hh);
                        acc = __builtin_amdgcn_mfma_f32_32x32x16_bf16(af[s], bfr, acc, 0, 0, 0); }
                    float sa = 0.f, sb = 0.f;
#pragma unroll
                    for (int j = 0; j < 8; ++j) { sa += wA[j] * fmaxf(acc[j], 0.f); sb += wB[j] * fmaxf(acc[8 + j], 0.f); }
                    const int key = 32 * tile + r;
                    scb[rowA * 2048 + key] = (key <= tA) ? ord_key(sa) : 0u; scb[(rowA + 1) * 2048 + key] = (key <= tA + 1) ? ord_key(sb) : 0u;
                } }
        }
        __syncthreads();
        if (nk <= 512) select_rows<8>(scb, msk, nk, wave, lane); else if (nk <= 1024) select_rows<16>(scb, msk, nk, wave, lane);
        else if (nk <= 1536) select_rows<24>(scb, msk, nk, wave, lane); else select_rows<32>(scb, msk, nk, wave, lane);
    }
    __syncthreads();
    asm volatile("" : "+v"(tid));
    { const int T = tid >> 4, i = tid & 15;
      MaskG[((size_t)(b * 8 + (qb16 >> 4)) * 32 + T) * 256 + (qb16 & 15) * 16 + i] = msk[T * 16 + i]; }
}

constexpr int ML_QT = 0, ML_KT = 17408, ML_NUM = 0, ML_KW = 41984, ML_VT = 60416, ML_SS = 83456, ML_CT = 92672, ML_GT = 136192, ML_END = 138240;
constexpr int ML_PQ = 272, ML_PK = 144, ML_PN = 164;
static_assert(ML_END <= RING_BYTES, "mLSTM LDS");
__device__ __forceinline__ int crow16(int reg, int hh) { return (reg & 3) + 8 * (reg >> 2) + 4 * hh; }
__device__ __forceinline__ void mma_tile(f32x16& acc, const LAS unsigned char* a, int pa, const LAS unsigned char* bt, int pb, int ks, int r, int hh) {
    for (int s = 0; s < ks; ++s) { const bf16x8 av = *(const LAS bf16x8*)(a + r * pa + 32 * s + 16 * hh), bv = *(const LAS bf16x8*)(bt + r * pb + 32 * s + 16 * hh);
        acc = __builtin_amdgcn_mfma_f32_32x32x16_bf16(av, bv, acc, 0, 0, 0); }
}
__device__ __forceinline__ void mlstm_unit(LAS unsigned char* lds, int b, int hd, const bf16* QM, const bf16* KM, const bf16* VM, const bf16* OM, const float* IG, const float* LF,
                                           const float* conv_w, const float* conv_b, const float* gain, bf16* ATT, int tid, int lane, int wave) {
    LAS float* gt = (LAS float*)(lds + ML_GT);
    LAS bf16* vt = (LAS bf16*)(lds + ML_VT); LAS bf16* ct = (LAS bf16*)(lds + ML_CT);
    __syncthreads();
    for (int i = tid; i < 32 * (ML_PK / 2); i += NWAVES * 64) vt[128 * (ML_PK / 2) + i] = (i < 64) ? (bf16)0x3F80 : (bf16)0;
    for (int i = tid; i < 160 * (ML_PQ / 2); i += NWAVES * 64) ct[i] = 0;
    f32x16 cs[3]; cs[0] = f32x16{}; cs[1] = f32x16{}; cs[2] = f32x16{};
    float m_prev = 0.f;
    const size_t rowb = (size_t)b * SEQ;
    for (int c = 0; c < SEQ / 64; ++c) {
        const size_t t0 = rowb + 64 * c;
        asm volatile("" : "+s"(wave));
        asm volatile("" : "+v"(tid), "+v"(lane));
        const int r = lane & 31, hh = lane >> 5;
        __syncthreads();
        if (wave == 0) {
            const float ig = IG[(t0 + lane) * 4 + hd], lf = LF[(t0 + lane) * 4 + hd];
            float bc = lf;
#pragma unroll
            for (int o = 1; o < 64; o <<= 1) { const float v = __shfl_up(bc, o); if (lane >= o) bc += v; }
            const float a = ig - bc; float pm = a;
#pragma unroll
            for (int o = 1; o < 64; o <<= 1) { const float v = __shfl_up(pm, o); if (lane >= o) pm = fmaxf(pm, v); }
            const float Mt = fmaxf(m_prev, pm), M63 = __shfl(Mt, 63), tot = __shfl(bc, 63);
            gt[lane] = a; gt[64 + lane] = Mt; gt[128 + lane] = bc;
            if (lane == 0) { gt[192] = __expf(m_prev - M63); gt[193] = M63; gt[194] = m_prev; }
            m_prev = tot + M63;
        }
#pragma unroll
        for (int it = 0; it < 4; ++it) { const int idx = tid + 512 * it, z = idx >> 10, t = (idx >> 4) & 63, g = idx & 15;
            const bf16* src = (z ? KM : QM) + hd * 128 + 8 * g; const int ch = z * 512 + hd * 128 + 8 * g;
            float y[8];
#pragma unroll
            for (int e = 0; e < 8; ++e) y[e] = conv_b[ch + e];
#pragma unroll
            for (int j = 0; j < 4; ++j) { const int tt = 64 * c + t - 3 + j;
                if (tt >= 0) { const v4u xw = *(const v4u*)(src + (rowb + tt) * 512); const float* wj = conv_w + j * 1024 + ch;
                    y[0] += wj[0] * bf_lo(xw.x); y[1] += wj[1] * bf_hi(xw.x); y[2] += wj[2] * bf_lo(xw.y); y[3] += wj[3] * bf_hi(xw.y);
                    y[4] += wj[4] * bf_lo(xw.z); y[5] += wj[5] * bf_hi(xw.z); y[6] += wj[6] * bf_lo(xw.w); y[7] += wj[7] * bf_hi(xw.w); } }
            const float sc = z ? 1.f : 0.08838834764831845f;
#pragma unroll
            for (int e = 0; e < 8; ++e) y[e] = silu_f(y[e]) * sc;
            v4u o; o.x = pk2(y[0], y[1]); o.y = pk2(y[2], y[3]); o.z = pk2(y[4], y[5]); o.w = pk2(y[6], y[7]);
            *(LAS v4u*)(lds + (z ? ML_KT : ML_QT) + t * ML_PQ + 16 * g) = o; }
#pragma unroll
        for (int it = 0; it < 2; ++it) { const int idx = tid + 512 * it, s = idx >> 4, g = idx & 15;
            const v4u xw = *(const v4u*)(VM + (t0 + s) * 512 + hd * 128 + 8 * g); LAS bf16* vp = vt + (8 * g) * (ML_PK / 2) + s;
            vp[0 * (ML_PK / 2)] = (bf16)(xw.x & 0xffff); vp[1 * (ML_PK / 2)] = (bf16)(xw.x >> 16); vp[2 * (ML_PK / 2)] = (bf16)(xw.y & 0xffff); vp[3 * (ML_PK / 2)] = (bf16)(xw.y >> 16);
            vp[4 * (ML_PK / 2)] = (bf16)(xw.z & 0xffff); vp[5 * (ML_PK / 2)] = (bf16)(xw.z >> 16); vp[6 * (ML_PK / 2)] = (bf16)(xw.w & 0xffff); vp[7 * (ML_PK / 2)] = (bf16)(xw.w >> 16); }
        __syncthreads();
        { const float M63 = gt[193];
#pragma unroll
          for (int it = 0; it < 2; ++it) { const int idx = tid + 512 * it, s = idx >> 4, g = idx & 15; const float ws = __expf(gt[s] - M63);
              const v4u xw = *(const LAS v4u*)(lds + ML_KT + s * ML_PQ + 16 * g); LAS bf16* kp = (LAS bf16*)(lds + ML_KW) + (8 * g) * (ML_PK / 2) + s;
              kp[0 * (ML_PK / 2)] = (bf16)f2bf(ws * bf_lo(xw.x)); kp[1 * (ML_PK / 2)] = (bf16)f2bf(ws * bf_hi(xw.x)); kp[2 * (ML_PK / 2)] = (bf16)f2bf(ws * bf_lo(xw.y)); kp[3 * (ML_PK / 2)] = (bf16)f2bf(ws * bf_hi(xw.y));
              kp[4 * (ML_PK / 2)] = (bf16)f2bf(ws * bf_lo(xw.z)); kp[5 * (ML_PK / 2)] = (bf16)f2bf(ws * bf_hi(xw.z)); kp[6 * (ML_PK / 2)] = (bf16)f2bf(ws * bf_lo(xw.w)); kp[7 * (ML_PK / 2)] = (bf16)f2bf(ws * bf_hi(xw.w)); } }
        if (wave < 4) { const int ti = wave >> 1, si = wave & 1; f32x16 g = f32x16{};
            if (si <= ti) mma_tile(g, lds + ML_QT + 32 * ti * ML_PQ, ML_PQ, lds + ML_KT + 32 * si * ML_PQ, ML_PQ, 8, r, hh);
            const float as = gt[32 * si + r]; LAS bf16* sp = (LAS bf16*)(lds + ML_SS);
#pragma unroll
            for (int q = 0; q < 16; ++q) { const int tl = crow16(q, hh), t = 32 * ti + tl, s = 32 * si + r;
                const float v = (s <= t) ? g[q] * __expf(as - gt[64 + t]) : 0.f; sp[t * (ML_PK / 2) + s] = (bf16)f2bf(v); } }
        __syncthreads();
        f32x16 nm[2];
#pragma unroll
        for (int k = 0; k < 2; ++k) { const int id = wave + 8 * k; nm[k] = f32x16{};
            if (id < 10) { const int ti = id / 5, vi = id % 5;
                mma_tile(nm[k], lds + ML_QT + 32 * ti * ML_PQ, ML_PQ, lds + ML_CT + 32 * vi * ML_PQ, ML_PQ, 8, r, hh);
                const float mp = gt[194];
#pragma unroll
                for (int q = 0; q < 16; ++q) nm[k][q] *= __expf(mp - gt[64 + 32 * ti + crow16(q, hh)]);
                mma_tile(nm[k], lds + ML_SS + 32 * ti * ML_PK, ML_PK, lds + ML_VT + 32 * vi * ML_PK, ML_PK, 4, r, hh); } }
        __syncthreads();
#pragma unroll
        for (int k = 0; k < 2; ++k) { const int id = wave + 8 * k;
            if (id < 10) { const int ti = id / 5, vi = id % 5; LAS float* np = (LAS float*)(lds + ML_NUM);
#pragma unroll
                for (int q = 0; q < 16; ++q) np[(32 * ti + crow16(q, hh)) * ML_PN + 32 * vi + r] = nm[k][q]; } }
        __syncthreads();
        { const int t = tid >> 3, p = tid & 7; const LAS float* np = (const LAS float*)(lds + ML_NUM) + t * ML_PN;
          const float den = np[128], mrow = gt[128 + t] + gt[64 + t], scl = 1.f / fmaxf(fabsf(den), __expf(-mrow));
          float hv[16]; float ss = 0.f;
#pragma unroll
          for (int e = 0; e < 16; ++e) { hv[e] = np[16 * p + e] * scl; ss += hv[e] * hv[e]; }
          ss += __shfl_xor(ss, 1); ss += __shfl_xor(ss, 2); ss += __shfl_xor(ss, 4);
          const float rs = rsqrtf(ss * (1.f / 128.f) + EPS);
          const v4u o0 = *(const v4u*)(OM + (t0 + t) * 512 + hd * 128 + 16 * p), o1 = *(const v4u*)(OM + (t0 + t) * 512 + hd * 128 + 16 * p + 8);
          const float og[16] = {bf_lo(o0.x), bf_hi(o0.x), bf_lo(o0.y), bf_hi(o0.y), bf_lo(o0.z), bf_hi(o0.z), bf_lo(o0.w), bf_hi(o0.w), bf_lo(o1.x), bf_hi(o1.x), bf_lo(o1.y), bf_hi(o1.y), bf_lo(o1.z), bf_hi(o1.z), bf_lo(o1.w), bf_hi(o1.w)};
          const float* gp = gain + hd * 128 + 16 * p;
#pragma unroll
          for (int e = 0; e < 16; ++e) hv[e] = hv[e] * rs * gp[e] * og[e];
          v4u w0, w1; w0.x = pk2(hv[0], hv[1]); w0.y = pk2(hv[2], hv[3]); w0.z = pk2(hv[4], hv[5]); w0.w = pk2(hv[6], hv[7]); w1.x = pk2(hv[8], hv[9]); w1.y = pk2(hv[10], hv[11]); w1.z = pk2(hv[12], hv[13]); w1.w = pk2(hv[14], hv[15]);
          bf16* op = ATT + (t0 + t) * 1024 + 512 + hd * 128 + 16 * p; *(v4u*)op = w0; *(v4u*)(op + 8) = w1; }
        { const float decay = gt[192];
#pragma unroll
          for (int k = 0; k < 3; ++k) { const int vi = (k < 2) ? (wave >> 1) : 4, di = (k < 2) ? 2 * (wave & 1) + k : wave;
              if (k < 2 || wave < 4) {
#pragma unroll
                  for (int q = 0; q < 16; ++q) cs[k][q] *= decay;
                  mma_tile(cs[k], lds + ML_VT + 32 * vi * ML_PK, ML_PK, lds + ML_KW + 32 * di * ML_PK, ML_PK, 4, r, hh);
#pragma unroll
                  for (int q = 0; q < 16; ++q) ct[(32 * vi + crow16(q, hh)) * (ML_PQ / 2) + 32 * di + r] = (bf16)f2bf(cs[k][q]); } } }
    }
}

struct Args { const void* in[22]; float* out; unsigned char* ws; int ph_lo, ph_hi; };
__global__ void __launch_bounds__(NWAVES * 64, 2) hybrid_fwd(Args args) {
    extern __shared__ __attribute__((aligned(16))) unsigned char lds_raw[];
    LAS unsigned char* lds = (LAS unsigned char*)lds_raw;
    volatile LAS unsigned* MISC = (volatile LAS unsigned*)(lds + LDSCTL_OFF);
    const int G0 = gridDim.x, bid0 = blockIdx.x; const int vcu0 = (G0 % 8 == 0) ? (bid0 % 8) * (G0 / 8) + bid0 / 8 : bid0;
#define PHASE_BEGIN() unsigned ones_ = ~0u; asm volatile("" : "+s"(ones_)); int lane = (int)__builtin_amdgcn_mbcnt_hi(ones_, __builtin_amdgcn_mbcnt_lo(ones_, 0u)), tid = wave0 * 64 + lane; asm volatile("" : "+v"(tid), "+v"(lane)); const int wave = __builtin_amdgcn_readfirstlane(tid >> 6); \
    int G = G0, vcu = vcu0, bid = bid0; asm volatile("" : "+s"(G), "+s"(vcu), "+s"(bid)); (void)wave; (void)lane; (void)vcu; (void)bid; (void)G
    const int wave0 = __builtin_amdgcn_readfirstlane((int)threadIdx.x >> 6);
    { const int tid = threadIdx.x;
    for (int u = tid; u < (LDS_BYTES - LDSCTL_OFF) / 4; u += NWAVES * 64) ((LAS unsigned*)(lds + LDSCTL_OFF))[u] = 0u;
    __syncthreads();
    if (tid == 0) { LAS unsigned long long* pb = (LAS unsigned long long*)(lds + LDSCTL_OFF + 64);
#pragma unroll
        for (int k = 0; k < 22; ++k) pb[k] = (unsigned long long)args.in[k];
        pb[I_OUT] = (unsigned long long)args.out; pb[I_WS] = (unsigned long long)args.ws; }
    __syncthreads(); }
    const int lo = args.ph_lo, hi = args.ph_hi;
    XcdBarrier bar; bar.bar = (unsigned*)(args.ws + WS_CTL) + CW_BAR; bar.x = 0; bar.st = nullptr;
    if (hi - lo > 1) bar = xcd_barrier_post((unsigned*)(args.ws + WS_CTL) + CW_BAR, MISC + 8);
#ifndef ONLY
#define ONLY -1
#endif
#define PH_ON(c) (ONLY < 0 || ONLY == (c))
#define IN(k) (lo <= (k) && (k) < hi)
#define OPAQUE_GEMM(g) asm volatile("" : "+s"(g.A), "+s"(g.Bt))
#define SEAM(k) do { if (IN(k) && IN((k) + 1)) { bar.bar = (unsigned*)(WSP() + WS_CTL) + CW_BAR; xcd_barrier(bar); } } while (0)
#define XNB   ((bf16*)(WSP() + WS_XN))
#define MXB(o) (WSP() + WS_MIX + (o))
#define MODB  ((float*)(WSP() + WS_MOD))
#define SSQB  ((float*)(WSP() + WS_SSQ))

    { PHASE_BEGIN(); if (PH_ON(0) && IN(0)) p0_prologue(lds, tid, lane, wave, vcu, G); }
    SEAM(0);
    { PHASE_BEGIN(); if (PH_ON(1) && IN(1)) norm_phase(nullptr, FP(I_X), nullptr, nullptr, nullptr, FP(I_MIXPRE), MODB + 1 * D, MODB + 0 * D, XNB, lane, wave, vcu, G); }
    SEAM(1);

    for (int l = 0; l < DEPTH; ++l) {
        const int pb = 2 + 9 * l;
        if (PH_ON(2) && IN(pb + 0)) { PHASE_BEGIN();
            unsigned char* wl = WSP() + WS_W + (size_t)l * W_LAYER;
            pg8::Gemm g{XNB, (const bf16*)(wl + WO_IN), M, NINP, D}; OPAQUE_GEMM(g); pg8::StaticOrder S; S.init(M, NINP, G, bid);
            pg8::EpiIn E{(bf16*)MXB(MX_CQ), (bf16*)MXB(MX_K), (bf16*)MXB(MX_V), (bf16*)MXB(MX_KI), (bf16*)MXB(MX_QM), (bf16*)MXB(MX_KM), (bf16*)MXB(MX_VM), (bf16*)MXB(MX_OM), SSQB, (float*)MXB(MX_WI), (float*)MXB(MX_IG), (float*)MXB(MX_LF),
                         (const int*)ldptr(lds, I_POS), FP(I_BIG) + l * 4, FP(I_BFG) + l * 4};
            pg8::gemm_phase<pg8::EpiIn, pg8::StaticOrder, true, true>(lds, g, S, E, tid);
        }
        SEAM(pb + 0);
        if (PH_ON(3) && IN(pb + 1)) { PHASE_BEGIN();
            unsigned char* wl = WSP() + WS_W + (size_t)l * W_LAYER;
            pg8::Gemm g{(const bf16*)MXB(MX_CQ), (const bf16*)(wl + WO_Q), M, 1024, QRK}; OPAQUE_GEMM(g); pg8::StaticOrder S; S.init(M, 1024, G, bid);
            pg8::EpiQ E{(bf16*)MXB(MX_Q), (bf16*)MXB(MX_QI), SSQB, (const int*)ldptr(lds, I_POS), attn_body::C2};
            pg8::gemm_phase<pg8::EpiQ, pg8::StaticOrder, true, true>(lds, g, S, E, tid);
        }
        SEAM(pb + 1);
        if (PH_ON(4) && IN(pb + 2)) { PHASE_BEGIN();
            const int NML = (G >= 128) ? 64 : 0;
#ifndef SUB
#define SUB 0
#endif
#define MLSTM_UNIT(u) mlstm_unit(lds, (u) >> 2, (u) & 3, (const bf16*)MXB(MX_QM), (const bf16*)MXB(MX_KM), (const bf16*)MXB(MX_VM), (const bf16*)MXB(MX_OM), (const float*)MXB(MX_IG), (const float*)MXB(MX_LF), \
                               FP(I_CONVW) + (size_t)l * 4 * 1024, FP(I_CONVB) + (size_t)l * 1024, FP(I_MLN) + (size_t)l * 512, XNB, tid, lane, wave)
            if (SUB != 1 && vcu < NML) MLSTM_UNIT(vcu);
            else {
                const int nw = G - NML, w = vcu - NML;
                for (int i = 0; i * nw < BATCH * 128; ++i) { const int L = i * nw + ((i & 1) ? nw - 1 - w : w);
                    if (SUB != 2 && L < BATCH * 128) indexer_unit(lds, L & 15, 127 - (L >> 4), (const bf16*)MXB(MX_QI), (const bf16*)MXB(MX_KI), (const float*)MXB(MX_WI), (unsigned long long*)MXB(MX_MASK), tid, lane, wave); }
                if (SUB != 1 && NML == 0) for (int u = vcu; u < 64; u += G) MLSTM_UNIT(u);
            }
        }
        SEAM(pb + 2);
        if (PH_ON(5) && IN(pb + 3)) { PHASE_BEGIN();
            const attn_body::AttnTensors AT{(const attn_body::bf16*)MXB(MX_Q), (const attn_body::bf16*)MXB(MX_K), (const attn_body::bf16*)MXB(MX_V), (attn_body::bf16*)XNB, (const attn_body::u32x4*)MXB(MX_MASK), FP(I_ATTN) + (size_t)l * 512};
            const attn_body::StaticOrder S(G, bid);
            attn_body::attn_phase<attn_body::StaticOrder>((char*)lds_raw, AT, S, tid);
        }
        SEAM(pb + 3);
        if (PH_ON(6) && IN(pb + 4)) { PHASE_BEGIN();
            unsigned char* wl = WSP() + WS_W + (size_t)l * W_LAYER;
            pg8::Gemm g{XNB, (const bf16*)(wl + WO_OUT), M, D, D}; OPAQUE_GEMM(g); pg8::StaticOrder S; S.init(M, D, G, bid);
            pg8::EpiPlain E{(bf16*)MXB(MX_Y), D};
            pg8::gemm_phase<pg8::EpiPlain, pg8::StaticOrder, true, true>(lds, g, S, E, tid);
        }
        SEAM(pb + 4);
        if (PH_ON(1) && IN(pb + 5)) { PHASE_BEGIN(); const float* modl = MODB + (size_t)l * BATCH * NMOD; float* outp = (float*)ldptr(lds, I_OUT);
            norm_phase((const bf16*)MXB(MX_Y), l == 0 ? FP(I_X) : (const float*)outp, outp, FP(I_MIXPOST) + (size_t)l * D, modl + 2 * D, FP(I_FFNPRE) + (size_t)l * D, modl + 4 * D, modl + 3 * D, XNB, lane, wave, vcu, G); }
        SEAM(pb + 5);
        if (PH_ON(7) && IN(pb + 6)) { PHASE_BEGIN();
            unsigned char* wl = WSP() + WS_W + (size_t)l * W_LAYER;
            pg8::Gemm g{XNB, (const bf16*)(wl + WO_GU), M, 2 * FF, D}; OPAQUE_GEMM(g); pg8::StaticOrder S; S.init(M, 2 * FF, G, bid);
            pg8::EpiSwiglu E{(bf16*)MXB(MX_H), FF};
            pg8::gemm_phase<pg8::EpiSwiglu, pg8::StaticOrder, true, true>(lds, g, S, E, tid);
        }
        SEAM(pb + 6);
        if (PH_ON(6) && IN(pb + 7)) { PHASE_BEGIN();
            unsigned char* wl = WSP() + WS_W + (size_t)l * W_LAYER;
            pg8::Gemm g{(const bf16*)MXB(MX_H), (const bf16*)(wl + WO_DN), M, D, FF}; OPAQUE_GEMM(g); pg8::StaticOrder S; S.init(M, D, G, bid);
            pg8::EpiPlain E{(bf16*)MXB(MX_Y), D};
            pg8::gemm_phase<pg8::EpiPlain, pg8::StaticOrder, true, true>(lds, g, S, E, tid);
        }
        SEAM(pb + 7);
        if (PH_ON(1) && IN(pb + 8)) { PHASE_BEGIN();
            const bool last = (l == DEPTH - 1); const float* modl = MODB + (size_t)l * BATCH * NMOD; const float* modn = MODB + (size_t)(l + 1) * BATCH * NMOD; float* outp = (float*)ldptr(lds, I_OUT);
            norm_phase((const bf16*)MXB(MX_Y), outp, outp, FP(I_FFNPOST) + (size_t)l * D, modl + 5 * D, last ? nullptr : FP(I_MIXPRE) + (size_t)(l + 1) * D, modn + 1 * D, modn + 0 * D, XNB, lane, wave, vcu, G);
        }
        SEAM(pb + 8);
    }
#undef IN
#undef SEAM
}

extern "C" void kernel_launch(void* const* d_in, const int* in_sizes, int n_in, void* d_out, int out_size, void* d_ws, size_t ws_size, hipStream_t stream) {
    static int grid = 0;
    if (grid == 0) {
        if (n_in != 22 || in_sizes[0] != M * D || out_size != M * D || ws_size < WS_END) { fprintf(stderr, "kernel_launch: built for 22 inputs, x/out of %d floats, >= %zu bytes of workspace; got n_in %d, in0 %d, out %d, ws %zu; nothing launched\n", M * D, (size_t)WS_END, n_in, n_in > 0 ? in_sizes[0] : -1, out_size, ws_size); grid = -1; return; }
        int dev = 0, cus = 0, per_cu = 0;
        if (hipGetDevice(&dev) != hipSuccess || hipDeviceGetAttribute(&cus, hipDeviceAttributeMultiprocessorCount, dev) != hipSuccess) { fprintf(stderr, "kernel_launch: device query failed\n"); grid = -1; return; }
        if (hipFuncSetAttribute((const void*)hybrid_fwd, hipFuncAttributeMaxDynamicSharedMemorySize, LDS_BYTES) != hipSuccess) { fprintf(stderr, "kernel_launch: hipFuncSetAttribute(%d B LDS) failed\n", LDS_BYTES); grid = -1; return; }
        if (hipOccupancyMaxActiveBlocksPerMultiprocessor(&per_cu, (const void*)hybrid_fwd, NWAVES * 64, LDS_BYTES) != hipSuccess || per_cu < 1)
            fprintf(stderr, "kernel_launch: note: occupancy query reports %d workgroups per CU\n", per_cu);
        (void)hipGetLastError();
        grid = cus;
    }
    if (grid < 0) return;
    if (hipMemsetAsync((char*)d_ws + WS_CTL, 0, CTL_ZERO_BYTES, stream) != hipSuccess) { fprintf(stderr, "kernel_launch: hipMemsetAsync failed\n"); return; }
    Args a{};
    for (int i = 0; i < 22; ++i) a.in[i] = d_in[i];
    a.out = (float*)d_out; a.ws = (unsigned char*)d_ws;
#if MK_ONE_LAUNCH
    a.ph_lo = 0; a.ph_hi = N_PHASES;
    hipLaunchKernelGGL(hybrid_fwd, dim3(grid), dim3(NWAVES * 64), LDS_BYTES, stream, a);
#else
    for (int p = 0; p < N_PHASES; ++p) { a.ph_lo = p; a.ph_hi = p + 1; hipLaunchKernelGGL(hybrid_fwd, dim3(grid), dim3(NWAVES * 64), LDS_BYTES, stream, a); }
#endif
    const hipError_t le = hipPeekAtLastError();
    if (le != hipSuccess) fprintf(stderr, "kernel_launch: launch failed: %s (grid %d x %d threads, %d B LDS)\n", hipGetErrorName(le), grid, NWAVES * 64, LDS_BYTES);
}
```

```cpp
#include <hip/hip_runtime.h>
#include <hip/hip_bf16.h>
#include <cstdio>
#include <cstdint>
#include <cmath>
namespace pg8 {
#define PG8_LAS __attribute__((address_space(3)))
typedef unsigned short bf16_t;
typedef short bf16x8 __attribute__((ext_vector_type(8)));
typedef float f32x4 __attribute__((ext_vector_type(4)));
typedef unsigned u32x4 __attribute__((ext_vector_type(4)));
constexpr int BM = 256, BK = 64, HALF = 128, HTB = HALF * BK * 2  , STAGE_BYTES = 8 * HTB, NXCD = 8, WGM = 8;

__host__ __device__ __forceinline__ int lds_byte(int r, int c) { const int st = (r >> 4) * 2 + (c >> 5), rr = r & 15, cc = c & 31, ob = rr * 64 + cc * 2; return st * 1024 + (ob ^ (((ob >> 9) & 1) << 5)); }
__host__ __device__ __forceinline__ void stage_rc(int b, int& R, int& C) { const int st = b / 1024, sb = b % 1024, swz = sb ^ (((sb >> 9) & 1) << 5); R = (st >> 1) * 16 + swz / 64; C = (st & 1) * 32 + (swz % 64) / 2; }
__host__ __device__ __forceinline__ int perm32(int rho) { const int n = rho >> 4, i = rho & 15; return 8 * (i >> 2) + 4 * n + (i & 3); }

struct Unit { int pm, pn; };
struct Gemm { const bf16_t* A; const bf16_t* Bt; int M, N, K; };

struct StaticOrder {
    int nM, nN, nwg, G, c;
    __host__ __device__ void init(int M, int N, int G_, int c_) { nM = M / BM; nN = N / BM; nwg = nM * nN; G = G_; c = c_; }
    __host__ __device__ bool next(int i, Unit& u) const {
        const long L = (long)i * G + c; if (L >= nwg) return false;
        int wgid = (int)L; { const int q = nwg / NXCD, r = nwg % NXCD, xcd = wgid % NXCD, off = wgid / NXCD; wgid = (xcd < r ? xcd * (q + 1) : r * (q + 1) + (xcd - r) * q) + off; }
        const int nig = WGM * nN, gid = wgid / nig, fm = gid * WGM, gsz = (nM - fm) < WGM ? (nM - fm) : WGM;
        u.pm = fm + ((wgid % nig) % gsz); u.pn = (wgid % nig) / gsz; return true;
    }
    __device__ __forceinline__ void a_ready(const Unit&) const {}
    __device__ __forceinline__ void done(const Unit&) const {}
};

__device__ __forceinline__ unsigned cvt_pk_bf16(float lo, float hi) { unsigned r; asm volatile("v_cvt_pk_bf16_f32 %0, %1, %2" : "=v"(r) : "v"(lo), "v"(hi)); return r; }
typedef float f32x2 __attribute__((ext_vector_type(2)));

__device__ __forceinline__ void store8(bf16_t* p, const f32x4 a, const f32x4 b) {
    u32x4 w; w.x = cvt_pk_bf16(a[0], a[1]); w.y = cvt_pk_bf16(a[2], a[3]); w.z = cvt_pk_bf16(b[0], b[1]); w.w = cvt_pk_bf16(b[2], b[3]);
#ifdef STORE_SC1
    asm volatile("global_store_dwordx4 %0, %1, off sc1\n\ts_nop 1" :: "v"(p), "v"(w) : "memory");
#else
    *(u32x4*)p = w;
#endif

}
__device__ __forceinline__ float sigmoid_f(float g) { return __builtin_amdgcn_rcpf(1.f + __builtin_amdgcn_exp2f(-1.4426950408889634f * g)); }
__device__ __forceinline__ float silu_f(float g) { return g * sigmoid_f(g); }
__device__ __forceinline__ void rope_invf(float (&invf)[4], int wc, int fq) {
    const int j = 4 * (wc & 1) + fq;
#pragma unroll
    for (int e = 0; e < 4; ++e) invf[e] = exp2f(-(float)(4 * j + e) * 0.41524101186092029f) * 0.15915494309189535f;
}
__device__ __forceinline__ void rope_sincos(float (&sn)[4], float (&cs)[4], float p, const float (&invf)[4]) {
#pragma unroll
    for (int e = 0; e < 4; ++e) { const float r = __builtin_amdgcn_fractf(p * invf[e]); sn[e] = __builtin_amdgcn_sinf(r); cs[e] = __builtin_amdgcn_cosf(r); }
}
__device__ __forceinline__ void rope_apply(f32x4& x1, f32x4& x2, const float (&sn)[4], const float (&cs)[4]) {
    f32x4 o1, o2;
#pragma unroll
    for (int e = 0; e < 4; ++e) { o1[e] = x1[e] * cs[e] - x2[e] * sn[e]; o2[e] = x2[e] * cs[e] + x1[e] * sn[e]; }
    x1 = o1; x2 = o2;
}

struct EpiIn {
    static constexpr bool PERM = true, AFTER_DRAIN = false;
    bf16_t *CQ, *K, *V, *KI, *QM, *KM, *VM, *OM; float *SSQ, *WI, *IG, *LF; const int* pos; const float *b_ig, *b_fg;
    __device__ __forceinline__ void operator()(const f32x4 (&acc)[2][2][4][2], const Unit& u, int wr, int wc, int fr, int fq) const {
        { unsigned ones_ = ~0u; asm volatile("" : "+s"(ones_)); const int ln_ = (int)__builtin_amdgcn_mbcnt_hi(ones_, __builtin_amdgcn_mbcnt_lo(ones_, 0u)); fr = ln_ & 15; fq = ln_ >> 4; }
        const int row0 = u.pm * BM + wr * 64 + fr, ct = wc * 32 + 8 * fq, pn = u.pn;
        if (pn == 0) {
#pragma unroll
            for (int ai = 0; ai < 2; ++ai)
#pragma unroll
                for (int m = 0; m < 4; ++m) { const int row = row0 + ai * HALF + m * 16; float s = 0.f;
#pragma unroll
                    for (int bj = 0; bj < 2; ++bj) { const f32x4 v0 = acc[ai][bj][m][0], v1 = acc[ai][bj][m][1];
                        s += (v0[0] * v0[0] + v0[1] * v0[1]) + (v0[2] * v0[2] + v0[3] * v0[3]) + (v1[0] * v1[0] + v1[1] * v1[1]) + (v1[2] * v1[2] + v1[3] * v1[3]);
                        store8(CQ + (size_t)row * 256 + bj * HALF + ct, v0, v1); }
                    s += __shfl_xor(s, 16); s += __shfl_xor(s, 32);
                    if (fq == 0) SSQ[(size_t)row * 4 + wc] = s; }
        } else if (pn <= 2) {
            float invf[4]; rope_invf(invf, wc, fq);
            int psv[2][4];
#pragma unroll
            for (int ai = 0; ai < 2; ++ai)
#pragma unroll
                for (int m = 0; m < 4; ++m) psv[ai][m] = pos[row0 + ai * HALF + m * 16];
#pragma unroll
            for (int ai = 0; ai < 2; ++ai)
#pragma unroll
                for (int m = 0; m < 4; ++m) { const int row = row0 + ai * HALF + m * 16; float sn[4], cs[4]; rope_sincos(sn, cs, (float)psv[ai][m], invf);
#pragma unroll
                    for (int bj = 0; bj < 2; ++bj) { f32x4 v0 = acc[ai][bj][m][0], v1 = acc[ai][bj][m][1]; rope_apply(v0, v1, sn, cs);
                        store8(K + (size_t)row * 512 + (pn - 1) * 256 + bj * HALF + ct, v0, v1); } }
        } else if (pn <= 12) {
            const int g = (pn - 3) >> 1; bf16_t* dst = (g == 0) ? V : (g == 1) ? QM : (g == 2) ? KM : (g == 3) ? VM : OM; const int cb = ((pn - 3) & 1) * 256 + ct;
#pragma unroll
            for (int ai = 0; ai < 2; ++ai)
#pragma unroll
                for (int m = 0; m < 4; ++m) { const int row = row0 + ai * HALF + m * 16;
#pragma unroll
                    for (int bj = 0; bj < 2; ++bj) { f32x4 v0 = acc[ai][bj][m][0], v1 = acc[ai][bj][m][1];
                        if (g == 4) {
#pragma unroll
                            for (int e = 0; e < 4; ++e) { v0[e] = sigmoid_f(v0[e]); v1[e] = sigmoid_f(v1[e]); } }
                        store8(dst + (size_t)row * 512 + cb + bj * HALF, v0, v1); } }
        } else {
            if (wc < 2) {
                float invf[4]; rope_invf(invf, wc, fq);
                int psv[2][4];
#pragma unroll
                for (int ai = 0; ai < 2; ++ai)
#pragma unroll
                    for (int m = 0; m < 4; ++m) psv[ai][m] = pos[row0 + ai * HALF + m * 16];
#pragma unroll
                for (int ai = 0; ai < 2; ++ai)
#pragma unroll
                    for (int m = 0; m < 4; ++m) { const int row = row0 + ai * HALF + m * 16; float sn[4], cs[4]; rope_sincos(sn, cs, (float)psv[ai][m], invf);
                        f32x4 v0 = acc[ai][0][m][0], v1 = acc[ai][0][m][1]; rope_apply(v0, v1, sn, cs); store8(KI + (size_t)row * 64 + ct, v0, v1); }
            } else if (wc == 2 && fq == 0) {
#pragma unroll
                for (int ai = 0; ai < 2; ++ai)
#pragma unroll
                    for (int m = 0; m < 4; ++m) { const int row = row0 + ai * HALF + m * 16; const float s = 0.044194173824159216f;
                        *(f32x4*)(WI + (size_t)row * 8) = acc[ai][0][m][0] * s; *(f32x4*)(WI + (size_t)row * 8 + 4) = acc[ai][0][m][1] * s; }
            } else if (wc == 2 && fq == 1) {
                const f32x4 bi = *(const f32x4*)b_ig, bf = *(const f32x4*)b_fg;
#pragma unroll
                for (int ai = 0; ai < 2; ++ai)
#pragma unroll
                    for (int m = 0; m < 4; ++m) { const int row = row0 + ai * HALF + m * 16; const f32x4 iv = acc[ai][0][m][0] + bi, fv = acc[ai][0][m][1] + bf; f32x4 lf;
#pragma unroll
                        for (int e = 0; e < 4; ++e) lf[e] = fminf(fv[e], 0.f) - 0.6931471805599453f * __builtin_amdgcn_logf(1.f + __builtin_amdgcn_exp2f(-1.4426950408889634f * fabsf(fv[e])));
                        *(f32x4*)(IG + (size_t)row * 4) = iv; *(f32x4*)(LF + (size_t)row * 4) = lf; }
            }
        }
    }
};

struct EpiQ {
    static constexpr bool PERM = true, AFTER_DRAIN = false;
    bf16_t *Q, *QI; const float* SSQ; const int* pos; float qscale;
    __device__ __forceinline__ void operator()(const f32x4 (&acc)[2][2][4][2], const Unit& u, int wr, int wc, int fr, int fq) const {
        { unsigned ones_ = ~0u; asm volatile("" : "+s"(ones_)); const int ln_ = (int)__builtin_amdgcn_mbcnt_hi(ones_, __builtin_amdgcn_mbcnt_lo(ones_, 0u)); fr = ln_ & 15; fq = ln_ >> 4; }
        const int row0 = u.pm * BM + wr * 64 + fr, ct = wc * 32 + 8 * fq, pn = u.pn;
        float invf[4]; rope_invf(invf, wc, fq);
        bf16_t* dst = (pn < 2) ? Q + pn * 256 : QI + (pn - 2) * 256; const float sc = (pn < 2) ? qscale : 1.f;
#pragma unroll
        for (int ai = 0; ai < 2; ++ai) {
            float rsv[4]; int psv[4];
#pragma unroll
            for (int m = 0; m < 4; ++m) { const int row = row0 + ai * HALF + m * 16; const f32x4 ss = *(const f32x4*)(SSQ + (size_t)row * 4); psv[m] = pos[row]; rsv[m] = ((ss[0] + ss[1]) + (ss[2] + ss[3])) * (1.f / 256.f) + 1e-6f; }
#pragma unroll
            for (int m = 0; m < 4; ++m) { const int row = row0 + ai * HALF + m * 16;
                const float rstd = rsqrtf(rsv[m]);
                float sn[4], cs[4]; rope_sincos(sn, cs, (float)psv[m], invf);
#pragma unroll
                for (int bj = 0; bj < 2; ++bj) { f32x4 v0 = acc[ai][bj][m][0] * rstd, v1 = acc[ai][bj][m][1] * rstd; rope_apply(v0, v1, sn, cs);
                    store8(dst + (size_t)row * 512 + bj * HALF + ct, v0 * sc, v1 * sc); } } }
    }
};

struct EpiPlain {
    static constexpr bool PERM = true, AFTER_DRAIN = false;
    bf16_t* O; int ldc;
    __device__ __forceinline__ void operator()(const f32x4 (&acc)[2][2][4][2], const Unit& u, int wr, int wc, int fr, int fq) const {
        { unsigned ones_ = ~0u; asm volatile("" : "+s"(ones_)); const int ln_ = (int)__builtin_amdgcn_mbcnt_hi(ones_, __builtin_amdgcn_mbcnt_lo(ones_, 0u)); fr = ln_ & 15; fq = ln_ >> 4; }
        const int row0 = u.pm * BM + wr * 64 + fr, col0 = u.pn * BM + wc * 32 + 8 * fq;
#pragma unroll
        for (int ai = 0; ai < 2; ++ai)
#pragma unroll
            for (int m = 0; m < 4; ++m) { bf16_t* rowp = O + (size_t)(row0 + ai * HALF + m * 16) * ldc + col0;
#pragma unroll
                for (int bj = 0; bj < 2; ++bj) store8(rowp + bj * HALF, acc[ai][bj][m][0], acc[ai][bj][m][1]); }
    }
};

struct EpiSwiglu {
    static constexpr bool PERM = true, AFTER_DRAIN = false;
    bf16_t* H; int ldc;
    __device__ __forceinline__ void operator()(const f32x4 (&acc)[2][2][4][2], const Unit& u, int wr, int wc, int fr, int fq) const {
        { unsigned ones_ = ~0u; asm volatile("" : "+s"(ones_)); const int ln_ = (int)__builtin_amdgcn_mbcnt_hi(ones_, __builtin_amdgcn_mbcnt_lo(ones_, 0u)); fr = ln_ & 15; fq = ln_ >> 4; }
        const int row0 = u.pm * BM + wr * 64 + fr, col0 = u.pn * HALF + wc * 32 + 8 * fq;
#pragma unroll
        for (int ai = 0; ai < 2; ++ai)
#pragma unroll
            for (int m = 0; m < 4; ++m) { f32x4 o0, o1;
#pragma unroll
                for (int e = 0; e < 4; ++e) { o0[e] = silu_f(acc[ai][0][m][0][e]) * acc[ai][1][m][0][e]; o1[e] = silu_f(acc[ai][0][m][1][e]) * acc[ai][1][m][1][e]; }
                store8(H + (size_t)(row0 + ai * HALF + m * 16) * ldc + col0, o0, o1); }
    }
};

template <class Epi, class Sched, bool ALIGN_EPI = false, bool SP2 = false>
__device__ __forceinline__ void gemm_phase(PG8_LAS unsigned char* lds, const Gemm g, const Sched& S, const Epi& E, int tid_in  ) {
    int tid_o = tid_in; asm volatile("" : "+v"(tid_o));
    const int tid = tid_o, wid = __builtin_amdgcn_readfirstlane(tid >> 6), lane = tid & 63, wr = wid >> 2, wc = wid & 3, fr = lane & 15, fq = lane >> 4;
    const int K = g.K, nt = K / BK;
    unsigned voffA[2], voffB[2];
#pragma unroll
    for (int i = 0; i < 2; ++i) { int R, C; stage_rc(tid * 16 + i * 8192, R, C); const int Rb = Epi::PERM ? ((R & ~31) + perm32(R & 31)) : R;
        voffA[i] = (unsigned)(R * K + C) * 2u; voffB[i] = (unsigned)(Rb * K + C) * 2u; }
    const size_t kstep = (size_t)(BK * 2);
    const size_t hstep = (size_t)HALF * K * 2;
    const size_t tstep = 2 * hstep;
    const unsigned ldsw = (unsigned)wid * 1024u;
    const int aoff = lds_byte(wr * 64 + fr, fq * 8), boff = lds_byte(wc * 32 + fr, fq * 8);
#define PG8_SA(b, h) (((b) * 2 + (h)) * HTB)
#define PG8_SB(b, h) ((4 + (b) * 2 + (h)) * HTB)
#define PG8_STAGE(bufoff, gbase, voff) do { _Pragma("unroll") for (int _i = 0; _i < 2; ++_i) \
        __builtin_amdgcn_global_load_lds((const unsigned*)((const char*)(gbase) + (voff)[_i]), (PG8_LAS unsigned*)(lds + (bufoff) + ldsw + _i * 8192), 16, 0, 0); } while (0)
#define PG8_LDA(dst, b, h) do { _Pragma("unroll") for (int m = 0; m < 4; ++m) _Pragma("unroll") for (int k = 0; k < 2; ++k) dst[m][k] = *(const PG8_LAS bf16x8*)(lds + PG8_SA(b, h) + aoff + m * 2048 + k * 1024); } while (0)
#define PG8_LDB(dst, b, h) do { _Pragma("unroll") for (int n = 0; n < 2; ++n) _Pragma("unroll") for (int k = 0; k < 2; ++k) dst[n][k] = *(const PG8_LAS bf16x8*)(lds + PG8_SB(b, h) + boff + n * 2048 + k * 1024); } while (0)
#define PG8_MMA(ai, bj, At, Bt) do { __builtin_amdgcn_s_setprio(1); _Pragma("unroll") for (int m = 0; m < 4; ++m) _Pragma("unroll") for (int n = 0; n < 2; ++n) _Pragma("unroll") for (int k = 0; k < 2; ++k) \
        acc[ai][bj][m][n] = __builtin_amdgcn_mfma_f32_16x16x32_bf16(Bt[n][k], At[m][k], acc[ai][bj][m][n], 0, 0, 0); __builtin_amdgcn_s_setprio(0); } while (0)
#define PG8_WAIT_V(n) asm volatile("s_waitcnt vmcnt(" #n ")" ::: "memory")
#define PG8_WAIT_L(n) asm volatile("s_waitcnt lgkmcnt(" #n ")" ::: "memory")
#define PG8_BAR __builtin_amdgcn_s_barrier()
#define PG8_SCHED __builtin_amdgcn_sched_barrier(0)
    Unit cur, nxt; int ui = 0;
    if (!S.next(0, cur)) return;
    f32x4 acc[2][2][4][2];
#pragma unroll
    for (int a = 0; a < 2; ++a)
#pragma unroll
        for (int b = 0; b < 2; ++b)
#pragma unroll
            for (int m = 0; m < 4; ++m)
#pragma unroll
                for (int n = 0; n < 2; ++n) acc[a][b][m][n] = (f32x4){0.f, 0.f, 0.f, 0.f};
    bf16x8 At[4][2], B0[2][2], B1[2][2];
    const char* cA = (const char*)g.A + (size_t)cur.pm * tstep; const char* cB = (const char*)g.Bt + (size_t)cur.pn * tstep;
    S.a_ready(cur);
    if constexpr (SP2) {
        PG8_STAGE(PG8_SB(0, 0), cB, voffB); PG8_STAGE(PG8_SB(0, 1), cB + hstep, voffB); PG8_STAGE(PG8_SA(0, 0), cA, voffA); PG8_STAGE(PG8_SA(0, 1), cA + hstep, voffA);
        if (wr == 1) PG8_BAR;
        PG8_WAIT_V(2); PG8_BAR;
        PG8_STAGE(PG8_SB(1, 0), cB + kstep, voffB); PG8_STAGE(PG8_SA(1, 0), cA + kstep, voffA); PG8_STAGE(PG8_SB(1, 1), cB + hstep + kstep, voffB);
        PG8_WAIT_V(6); PG8_BAR;
    } else {
        PG8_STAGE(PG8_SB(0, 0), cB, voffB); PG8_STAGE(PG8_SA(0, 0), cA, voffA); PG8_STAGE(PG8_SB(0, 1), cB + hstep, voffB); PG8_STAGE(PG8_SA(0, 1), cA + hstep, voffA);
        if (wr == 1) PG8_BAR;
        PG8_WAIT_V(4); PG8_BAR;
        PG8_STAGE(PG8_SB(1, 0), cB + kstep, voffB); PG8_STAGE(PG8_SA(1, 0), cA + kstep, voffA); PG8_STAGE(PG8_SB(1, 1), cB + hstep + kstep, voffB);
        PG8_WAIT_V(6); PG8_BAR;
    }
    for (;;) {
        const bool has_next = S.next(ui + 1, nxt);
        const char* nA = has_next ? (const char*)g.A + (size_t)nxt.pm * tstep : cA; const char* nB = has_next ? (const char*)g.Bt + (size_t)nxt.pn * tstep : cB;
        for (int t = 0; t < nt; t += 2) {
            const bool last = (t == nt - 2);
            const char* a1 = cA + (size_t)(t + 1) * kstep;
            const char* a2 = last ? nA : cA + (size_t)(t + 2) * kstep; const char* b2 = last ? nB : cB + (size_t)(t + 2) * kstep;
            const char* a3 = a2 + kstep; const char* b3 = b2 + kstep;
            if (last && has_next) S.a_ready(nxt);
            if constexpr (SP2) {
            PG8_LDB(B0, 0, 0); PG8_LDB(B1, 0, 1); PG8_SCHED; PG8_LDA(At, 0, 0); PG8_STAGE(PG8_SA(1, 1), a1 + hstep, voffA);
            PG8_WAIT_V(8); PG8_WAIT_L(0); PG8_BAR; PG8_MMA(0, 0, At, B0); PG8_MMA(0, 1, At, B1); PG8_BAR; PG8_SCHED;
            PG8_LDA(At, 0, 1); PG8_STAGE(PG8_SB(0, 0), b2, voffB); PG8_STAGE(PG8_SB(0, 1), b2 + hstep, voffB); PG8_STAGE(PG8_SA(0, 0), a2, voffA);
            PG8_WAIT_V(8); PG8_WAIT_L(0); PG8_BAR; PG8_MMA(1, 0, At, B0); PG8_MMA(1, 1, At, B1); PG8_BAR; PG8_SCHED;
            PG8_LDB(B0, 1, 0); PG8_LDB(B1, 1, 1); PG8_SCHED; PG8_LDA(At, 1, 0); PG8_STAGE(PG8_SA(0, 1), a2 + hstep, voffA);
            PG8_WAIT_V(8); PG8_WAIT_L(0); PG8_BAR; PG8_MMA(0, 0, At, B0); PG8_MMA(0, 1, At, B1); PG8_BAR; PG8_SCHED;
            PG8_LDA(At, 1, 1); PG8_STAGE(PG8_SB(1, 0), b3, voffB); PG8_STAGE(PG8_SB(1, 1), b3 + hstep, voffB); PG8_STAGE(PG8_SA(1, 0), a3, voffA);
            PG8_WAIT_V(8); PG8_WAIT_L(0); PG8_BAR; PG8_MMA(1, 0, At, B0); PG8_MMA(1, 1, At, B1); PG8_BAR; PG8_SCHED;
            } else {
            PG8_LDB(B0, 0, 0); PG8_SCHED; PG8_LDA(At, 0, 0); PG8_STAGE(PG8_SA(1, 1), a1 + hstep, voffA);
            PG8_WAIT_L(8); PG8_BAR; PG8_WAIT_L(0); PG8_MMA(0, 0, At, B0); PG8_BAR; PG8_SCHED;
            PG8_LDB(B1, 0, 1); PG8_STAGE(PG8_SB(0, 0), b2, voffB);
            PG8_BAR; PG8_WAIT_L(0); PG8_MMA(0, 1, At, B1); PG8_BAR;
            PG8_LDA(At, 0, 1); PG8_STAGE(PG8_SA(0, 0), a2, voffA);
            PG8_BAR; PG8_WAIT_L(0); PG8_MMA(1, 0, At, B0); PG8_BAR; PG8_SCHED;
            PG8_STAGE(PG8_SB(0, 1), b2 + hstep, voffB);
            PG8_WAIT_V(6); PG8_BAR; PG8_MMA(1, 1, At, B1); PG8_BAR;
            PG8_LDB(B0, 1, 0); PG8_SCHED; PG8_LDA(At, 1, 0); PG8_STAGE(PG8_SA(0, 1), a2 + hstep, voffA);
            PG8_WAIT_L(8); PG8_BAR; PG8_WAIT_L(0); PG8_MMA(0, 0, At, B0); PG8_BAR; PG8_SCHED;
            PG8_LDB(B1, 1, 1); PG8_STAGE(PG8_SB(1, 0), b3, voffB);
            PG8_BAR; PG8_WAIT_L(0); PG8_MMA(0, 1, At, B1); PG8_BAR;
            PG8_LDA(At, 1, 1); PG8_STAGE(PG8_SA(1, 0), a3, voffA);
            PG8_BAR; PG8_WAIT_L(0); PG8_MMA(1, 0, At, B0); PG8_BAR; PG8_SCHED;
            PG8_STAGE(PG8_SB(1, 1), b3 + hstep, voffB);
            PG8_WAIT_V(6); PG8_BAR; PG8_MMA(1, 1, At, B1); PG8_BAR;
            }
        }
        if constexpr (ALIGN_EPI) { if (wr == 0) PG8_BAR; }
        if constexpr (!Epi::AFTER_DRAIN) { E(acc, cur, wr, wc, fr, fq); S.done(cur); }
        if (!has_next) break;
#pragma unroll
        for (int a = 0; a < 2; ++a)
#pragma unroll
            for (int b = 0; b < 2; ++b)
#pragma unroll
                for (int m = 0; m < 4; ++m)
#pragma unroll
                    for (int n = 0; n < 2; ++n) acc[a][b][m][n] = (f32x4){0.f, 0.f, 0.f, 0.f};
        cur = nxt; cA = nA; cB = nB; ++ui;
        if constexpr (ALIGN_EPI) { if (wr == 1) PG8_BAR; }
    }
    PG8_WAIT_V(0);
    if constexpr (!ALIGN_EPI) { if (wr == 0) PG8_BAR; }
    PG8_BAR;
    if constexpr (Epi::AFTER_DRAIN) { E.fused(acc, cur, wr, wc, fr, fq, lds, wid, lane); S.done(cur); }
#undef PG8_SA
#undef PG8_SB
#undef PG8_STAGE
#undef PG8_LDA
#undef PG8_LDB
#undef PG8_MMA
#undef PG8_WAIT_V
#undef PG8_WAIT_L
#undef PG8_BAR
#undef PG8_SCHED
}
}
namespace attn_body {
using bf16=__hip_bfloat16;
using bf16x8=__attribute__((ext_vector_type(8)))short;
using s16x4=__attribute__((ext_vector_type(4)))short;
using f32x16=__attribute__((ext_vector_type(16)))float;
using u32x4=__attribute__((ext_vector_type(4)))unsigned;
constexpr int BATCH=16,NHEAD=8,SEQ=2048,D=64,DM=NHEAD*D,DMO=1024;
constexpr int NW=8,QBLK=32,QB=QBLK*NW,KVBLK=64,NQB=SEQ/QB;
constexpr int ATTN_PITCH=DM, ATTN_UNIT_ROWS=QB;
__device__ __forceinline__ int crow(int r,int hi){return (r&3)+8*(r>>2)+4*hi;}
#define SBAR() __builtin_amdgcn_sched_barrier(0)
__device__ __forceinline__ void cmask(f32x16&p0,f32x16&p1,int jb,int qrel,int hi){
  const float NEG=-INFINITY; int kb=64*jb+4*hi;
  #pragma unroll
  for(int r=0;r<16;++r){int kv=kb+(r&3)+8*(r>>2); if(kv>qrel)p0[r]=NEG; if(kv+32>qrel)p1[r]=NEG;}
}

__device__ __forceinline__ void bmask(f32x16&p0,f32x16&p1,unsigned long long mw,int hi){
  const unsigned lo=(unsigned)mw>>(4*hi), up=(unsigned)(mw>>32)>>(4*hi);
  #pragma unroll
  for(int r=0;r<16;++r){ const int ps=(r&3)+8*(r>>2);
    const unsigned x0=(unsigned)__builtin_amdgcn_sbfe((int)lo,ps,1), x1=(unsigned)__builtin_amdgcn_sbfe((int)up,ps,1);
    p0[r]=__uint_as_float((__float_as_uint(p0[r])&x0)|(0xFF800000u&~x0)); p1[r]=__uint_as_float((__float_as_uint(p1[r])&x1)|(0xFF800000u&~x1)); }
}
constexpr int NSLOT=3, SLOTB=8192;
constexpr int LDS_K=0, LDS_V=NSLOT*SLOTB, LDS_WS=2*NSLOT*SLOTB, LDS_OST=LDS_WS+NW*64*4, LDS_MASK=LDS_OST+NW*4096, LDS_BYTES=LDS_MASK+32*256*8;
constexpr float C2=0.125f*1.4426950408889634f;
__device__ __forceinline__ void glds16(const void*gsrc,unsigned lds_dst){unsigned keep;
  asm volatile("s_mov_b32 %0, m0\n\ts_mov_b32 m0, %2\n\ts_nop 0\n\tglobal_load_lds_dwordx4 %1, off\n\ts_mov_b32 m0, %0":"=&s"(keep):"v"(gsrc),"s"(lds_dst):"memory");}
__device__ __forceinline__ float max3f(float a,float b,float c){float r;asm("v_max3_f32 %0, %1, %2, %3":"=v"(r):"v"(a),"v"(b),"v"(c));return r;}
__device__ __forceinline__ float max2f(float a,float b){float r;asm("v_max_f32_e32 %0, %1, %2":"=v"(r):"v"(a),"v"(b));return r;}
__device__ __forceinline__ float fadd_s(float a,float b){float r;asm("v_add_f32_e32 %0, %1, %2":"=v"(r):"v"(a),"v"(b));return r;}
__device__ __forceinline__ float fsub_s(float a,float b){float r;asm("v_sub_f32_e32 %0, %1, %2":"=v"(r):"v"(a),"v"(b));return r;}
typedef float f32x2_t __attribute__((ext_vector_type(2))); typedef __bf16 bf16x2_t __attribute__((ext_vector_type(2)));
__device__ __forceinline__ unsigned cvtpk_s(float lo,float hi){f32x2_t v={lo,hi};bf16x2_t b=__builtin_convertvector(v,bf16x2_t);return __builtin_bit_cast(unsigned,b);}
#define WAIT_BAR(N) asm volatile("s_waitcnt vmcnt(" #N ") lgkmcnt(0)\n\ts_barrier":::"memory")

__device__ __forceinline__ void qkt(f32x16&p0,f32x16&p1,const char*Kslot,const bf16x8*qr,const f32x16&negm,int r32,int hi){
  const char*kb=Kslot+hi*1024+r32*16;
  #pragma unroll
  for(int d0=0;d0<4;++d0){
    const bf16x8 b0=*reinterpret_cast<const bf16x8*>(kb+d0*2048);
    const bf16x8 b1=*reinterpret_cast<const bf16x8*>(kb+d0*2048+512);
    if(d0==0){p0=__builtin_amdgcn_mfma_f32_32x32x16_bf16(b0,qr[0],negm,0,0,0);p1=__builtin_amdgcn_mfma_f32_32x32x16_bf16(b1,qr[0],negm,0,0,0);}
    else{p0=__builtin_amdgcn_mfma_f32_32x32x16_bf16(b0,qr[d0],p0,0,0,0);p1=__builtin_amdgcn_mfma_f32_32x32x16_bf16(b1,qr[d0],p1,0,0,0);}}
}
typedef __attribute__((address_space(3))) const char* lds_cptr;
typedef short v4i16_t __attribute__((ext_vector_type(4)));
__device__ __forceinline__ void kload8(bf16x8*kf,lds_cptr kp){
  kf[0]=*(const __attribute__((address_space(3))) bf16x8*)(kp);      kf[1]=*(const __attribute__((address_space(3))) bf16x8*)(kp+512);
  kf[2]=*(const __attribute__((address_space(3))) bf16x8*)(kp+2048); kf[3]=*(const __attribute__((address_space(3))) bf16x8*)(kp+2560);
  kf[4]=*(const __attribute__((address_space(3))) bf16x8*)(kp+4096); kf[5]=*(const __attribute__((address_space(3))) bf16x8*)(kp+4608);
  kf[6]=*(const __attribute__((address_space(3))) bf16x8*)(kp+6144); kf[7]=*(const __attribute__((address_space(3))) bf16x8*)(kp+6656);
}
__device__ __forceinline__ void kload2(bf16x8*kf,lds_cptr kp,int j){ kf[2*j]=*(const __attribute__((address_space(3))) bf16x8*)(kp+j*2048); kf[2*j+1]=*(const __attribute__((address_space(3))) bf16x8*)(kp+j*2048+512); }
__device__ __forceinline__ s16x4 vtr(lds_cptr p){ return __builtin_bit_cast(s16x4,__builtin_amdgcn_ds_read_tr16_b64_v4i16((__attribute__((address_space(3))) v4i16_t*)p)); }
__device__ __forceinline__ float rowmax(const f32x16&p0,const f32x16&p1){
  float a=max3f(p0[0],p0[1],p1[0]),b=max3f(p0[2],p0[3],p1[1]);a=max3f(a,p1[2],p1[3]);
  #pragma unroll
  for(int r=4;r<16;r+=4){a=max3f(a,p0[r],p0[r+1]);b=max3f(b,p0[r+2],p0[r+3]);a=max3f(a,p1[r],p1[r+1]);b=max3f(b,p1[r+2],p1[r+3]);}
  const float m=max2f(a,b);
  auto rr=__builtin_amdgcn_permlane32_swap(__float_as_uint(m),__float_as_uint(m),false,false);
  return max2f(__uint_as_float(rr[0]),__uint_as_float(rr[1]));
}
__device__ __forceinline__ void pv(f32x16*o,int vb,bf16x8 pa0,bf16x8 pa1,bf16x8 pa2,bf16x8 pa3){
  #pragma unroll
  for(int d0=0;d0<2;++d0){s16x4 lo[4],hi[4];
    #pragma unroll
    for(int ks=0;ks<4;++ks){
      asm volatile("ds_read_b64_tr_b16 %0,%1 offset:%c2":"=&v"(lo[ks]):"v"(vb),"i"(d0*4096+ks*1024):"memory");
      asm volatile("ds_read_b64_tr_b16 %0,%1 offset:%c2":"=&v"(hi[ks]):"v"(vb),"i"(d0*4096+ks*1024+512):"memory");}
    asm volatile("s_waitcnt lgkmcnt(0)":::"memory");SBAR();
    #define PK(k) (bf16x8){lo[k][0],lo[k][1],lo[k][2],lo[k][3],hi[k][0],hi[k][1],hi[k][2],hi[k][3]}
    o[d0]=__builtin_amdgcn_mfma_f32_32x32x16_bf16(pa0,PK(0),o[d0],0,0,0);
    o[d0]=__builtin_amdgcn_mfma_f32_32x32x16_bf16(pa1,PK(1),o[d0],0,0,0);
    o[d0]=__builtin_amdgcn_mfma_f32_32x32x16_bf16(pa2,PK(2),o[d0],0,0,0);
    o[d0]=__builtin_amdgcn_mfma_f32_32x32x16_bf16(pa3,PK(3),o[d0],0,0,0);
    #undef PK
  }
}

#ifndef ATTN_STORE16
#define ATTN_STORE16(p,v) (*(u32x4*)(p)=(v))
#endif
template<int THRL> __device__ __forceinline__ void attn_unit(int b,int h,int qb,const bf16*Q,const bf16*__restrict__ K,const bf16*__restrict__ V,bf16*O,const u32x4*__restrict__ MaskG,const float*__restrict__ gain,char*shm,int tid_in){
  int tid_o=tid_in; asm volatile("":"+v"(tid_o)); const int tid=tid_o,lane=tid&63,r32=lane&31,hi=lane>>5; const int wid=__builtin_amdgcn_readfirstlane(tid>>6);
  const long rowbase=(long)b*SEQ; const int q0=qb*QB;
  const bf16*Qw=Q+(rowbase+q0+wid*QBLK)*DM+h*D;
  const bf16*Kh=K+rowbase*DM+h*D,*Vh=V+rowbase*DM+h*D;
  const unsigned lds0=(unsigned)(uintptr_t)shm;
  float*wsf=(float*)(shm+LDS_WS)+wid*64;
  const bf16*ksrc=Kh+(long)lane*DM+wid*8;
  const bf16*vsrc=Vh+(long)(16*(wid&3)+(lane>>2))*DM+(wid>>2)*32+(lane&3)*8;
  const unsigned kdst=lds0+LDS_K+wid*1024, vdst=lds0+LDS_V+wid*1024;
  #define DMA_K(t,slot) glds16(ksrc+(long)(t)*KVBLK*DM,(unsigned)__builtin_amdgcn_readfirstlane(kdst+(slot)))
  #define DMA_V(t,slot) glds16(vsrc+(long)(t)*KVBLK*DM,(unsigned)__builtin_amdgcn_readfirstlane(vdst+(slot)))
  const int vb0=(int)(lds0+LDS_V)+((lane>>4)&1)*32+(lane&3)*8+(4*hi+((lane&15)>>2))*64;
  const char*Kbase=shm+LDS_K; bf16x8 kf[8];
  const lds_cptr shm3=(lds_cptr)shm; const lds_cptr kp0=shm3+LDS_K+hi*1024+r32*16; const lds_cptr vp0=shm3+LDS_V+((lane>>4)&1)*32+(lane&3)*8+(4*hi+((lane&15)>>2))*64;
  const int NT=(q0+QB)/KVBLK;
  DMA_K(0,0);DMA_V(0,0);DMA_K(1,SLOTB);
  { const u32x4*mg=MaskG+(long)(b*NQB+qb)*32*128;
    __attribute__((address_space(3))) u32x4*ml=(__attribute__((address_space(3))) u32x4*)((__attribute__((address_space(3))) char*)shm+LDS_MASK);
    u32x4 mv[8];
    _Pragma("unroll") for(int k=0;k<8;++k){ const int i=tid+NW*64*k; mv[k]=u32x4{0u,0u,0u,0u}; if(i<NT*128)mv[k]=mg[i]; }
    _Pragma("unroll") for(int k=0;k<8;++k){ const int i=tid+NW*64*k; if(i<NT*128)ml[i]=mv[k]; }
    asm volatile("s_waitcnt vmcnt(0)":::"memory"); }
  bf16x8 qr[4];
  #pragma unroll
  for(int d0=0;d0<4;++d0)qr[d0]=*reinterpret_cast<const bf16x8*>(&Qw[(long)r32*DM+d0*16+hi*8]);
  float mhat=0.f,l_reg=0.f;f32x16 o[2];o[0]=f32x16{};o[1]=f32x16{};f32x16 negm=f32x16{};asm volatile("":"+v"(negm));
  const int qrel=wid*QBLK+r32;
  const lds_cptr mkp=(lds_cptr)shm+LDS_MASK+qrel*8;
  unsigned long long mwn=0ull;
  #define CMASK(P0,P1,t) do{ bmask(P0,P1,mwn,hi); mwn=*(const __attribute__((address_space(3))) unsigned long long*)(mkp+((t)+1)*2048); }while(0)
  bool resc=false;
  #define START(P0,P1) do{ const float rm=rowmax(P0,P1); resc=false; \
    { const float dl=max2f(rm,-256.f); mhat=fadd_s(mhat,dl); \
      _Pragma("unroll") for(int r=0;r<16;++r){P0[r]=fsub_s(P0[r],dl);P1[r]=fsub_s(P1[r],dl);} \
      _Pragma("unroll") for(int r=0;r<16;++r)negm[r]=-mhat; asm volatile("":"+v"(negm)); } \
    _Pragma("unroll") for(int r=0;r<16;++r)P0[r]=__builtin_amdgcn_exp2f(P0[r]); }while(0)
  #define RESC() do{ if(resc){ asm volatile("s_waitcnt lgkmcnt(0)":::"memory"); \
      _Pragma("unroll") for(int d_=0;d_<2;++d_) _Pragma("unroll") for(int r=0;r<16;++r)o[d_][r]*=wsf[crow(r,hi)]; } }while(0)
  f32x16 pA0,pA1,pB0,pB1;
  int sl_prev=0,sl_cur=0,sl_next=SLOTB;
  #define ROT() do{sl_prev=sl_cur;sl_cur=sl_next;sl_next=(sl_next==(NSLOT-1)*SLOTB)?0:sl_next+SLOTB;}while(0)
  DMA_K(2,2*SLOTB);
  WAIT_BAR(3);
  mwn=*(const __attribute__((address_space(3))) unsigned long long*)(mkp);
  qkt(pA0,pA1,Kbase,qr,negm,r32,hi);asm volatile("s_nop 15\n\ts_nop 7":"+v"(pA0),"+v"(pA1));CMASK(pA0,pA1,0);
  START(pA0,pA1);
  _Pragma("unroll") for(int r=0;r<16;++r)pA1[r]=__builtin_amdgcn_exp2f(pA1[r]);
  WAIT_BAR(0);
  DMA_K(3,0);DMA_V(1,SLOTB);
  ROT();
  kload8(kf,kp0+sl_cur);
  WAIT_BAR(2);
  s16x4 vlo[8],vhi[8]; u32x4 pw0,pw1,pw2,pw3;
  #define PKW(P,B) cvtpk_s(P[B],P[B+1])
  #define PAF(k) __builtin_bit_cast(bf16x8,pw##k)
  #define VFR(i) (bf16x8){vlo[i][0],vlo[i][1],vlo[i][2],vlo[i][3],vhi[i][0],vhi[i][1],vhi[i][2],vhi[i][3]}
  #define PIN(x) asm volatile("":"+v"(x))
  #define MX3(a,b,c) __builtin_fmaxf(__builtin_fmaxf((a),(b)),(c))
  #define GAPA(MF,A0,A1,A2,A3,W0,W1,PW) do{ MF; sacc+=A0; sacc+=A1; sacc+=A2; sacc+=A3; PIN(sacc); W0; W1; PIN(PW); SBAR(); }while(0)
  #define EX(v) __builtin_amdgcn_exp2f(v)
  #define GAPB(MF,X,B) do{ MF; X[B]=EX(X[B]); X[B+1]=EX(X[B+1]); X[B+2]=EX(X[B+2]); X[B+3]=EX(X[B+3]); PIN(X); SBAR(); }while(0)
  #define VRD(i) do{ vlo[i]=vtr(vp_+(((i)>>2)*4096+((i)&3)*1024)); vhi[i]=vtr(vp_+(((i)>>2)*4096+((i)&3)*1024+512)); }while(0)
  #define KRD(G,j) do{ if(G){ kload2(kf,kp0+sl_next,j); SBAR(); } }while(0)
  #define STEP(C0,C1,P0,P1,t,GK,GV,GL) do{ SBAR(); \
    const lds_cptr vp_=vp0+sl_prev; \
    VRD(0); SBAR(); float sacc=(P0[0]+P0[1]); \
    GAPA(C0=__builtin_amdgcn_mfma_f32_32x32x16_bf16(kf[0],qr[0],negm,0,0,0), P0[2],P0[3],P0[4],P0[5],     pw0[0]=PKW(P0,0), pw0[1]=PKW(P0,2), pw0); \
    VRD(4); SBAR(); GAPA(C1=__builtin_amdgcn_mfma_f32_32x32x16_bf16(kf[1],qr[0],negm,0,0,0), P0[6],P0[7],P0[8],P0[9],     pw0[2]=PKW(P0,4), pw0[3]=PKW(P0,6), pw0); \
    VRD(1); SBAR(); GAPA(C0=__builtin_amdgcn_mfma_f32_32x32x16_bf16(kf[2],qr[1],C0,0,0,0),   P0[10],P0[11],P0[12],P0[13], pw1[0]=PKW(P0,8), pw1[1]=PKW(P0,10), pw1); \
    VRD(5); SBAR(); GAPA(C1=__builtin_amdgcn_mfma_f32_32x32x16_bf16(kf[3],qr[1],C1,0,0,0),   P0[14],P0[15],P1[0],P1[1],   pw1[2]=PKW(P0,12),pw1[3]=PKW(P0,14), pw1); \
    VRD(2); SBAR(); GAPA(C0=__builtin_amdgcn_mfma_f32_32x32x16_bf16(kf[4],qr[2],C0,0,0,0),   P1[2],P1[3],P1[4],P1[5],     pw2[0]=PKW(P1,0), pw2[1]=PKW(P1,2), pw2); \
    VRD(6); SBAR(); GAPA(C1=__builtin_amdgcn_mfma_f32_32x32x16_bf16(kf[5],qr[2],C1,0,0,0),   P1[6],P1[7],P1[8],P1[9],     pw2[2]=PKW(P1,4), pw2[3]=PKW(P1,6), pw2); \
    VRD(3); SBAR(); GAPA(C0=__builtin_amdgcn_mfma_f32_32x32x16_bf16(kf[6],qr[3],C0,0,0,0),   P1[10],P1[11],P1[12],P1[13], pw3[0]=PKW(P1,8), pw3[1]=PKW(P1,10), pw3); \
    VRD(7); SBAR(); GAPA(C1=__builtin_amdgcn_mfma_f32_32x32x16_bf16(kf[7],qr[3],C1,0,0,0),   P1[14],P1[15],0.f,0.f,       pw3[2]=PKW(P1,12),pw3[3]=PKW(P1,14), pw3); \
    l_reg+=sacc; \
    if(GK){DMA_K((t)+3,sl_cur);} if(GV){DMA_V((t)+1,sl_next);} \
    CMASK(C0,C1,t); \
    { float a=MX3(C0[0],C0[1],C1[0]),b=MX3(C0[2],C0[3],C1[1]); a=MX3(a,C1[2],C1[3]); \
      _Pragma("unroll") for(int r=4;r<16;r+=4){a=MX3(a,C0[r],C0[r+1]);b=MX3(b,C0[r+2],C0[r+3]);a=MX3(a,C1[r],C1[r+1]);b=MX3(b,C1[r+2],C1[r+3]);} \
      float rm=__builtin_fmaxf(a,b); { auto rr=__builtin_amdgcn_permlane32_swap(__float_as_uint(rm),__float_as_uint(rm),false,false); rm=__builtin_fmaxf(__uint_as_float(rr[0]),__uint_as_float(rr[1])); } \
      resc=false; \
      if(__builtin_expect(__any(rm>(float)THRL),0)){ const float dl=__builtin_fmaxf(rm,0.f); mhat+=dl; \
        _Pragma("unroll") for(int r=0;r<16;++r){C0[r]-=dl;C1[r]-=dl;} \
        _Pragma("unroll") for(int r=0;r<16;++r)negm[r]=-mhat; asm volatile("":"+v"(negm)); \
        const float f=__builtin_amdgcn_exp2f(-dl); l_reg*=f; if(hi==0)wsf[r32]=f; resc=true; } } \
    SBAR(); \
    GAPB(o[0]=__builtin_amdgcn_mfma_f32_32x32x16_bf16(PAF(0),VFR(0),o[0],0,0,0), C0,0); \
    GAPB(o[1]=__builtin_amdgcn_mfma_f32_32x32x16_bf16(PAF(0),VFR(4),o[1],0,0,0), C0,4); \
    KRD(GL,0); GAPB(o[0]=__builtin_amdgcn_mfma_f32_32x32x16_bf16(PAF(1),VFR(1),o[0],0,0,0), C0,8); \
    KRD(GL,1); GAPB(o[1]=__builtin_amdgcn_mfma_f32_32x32x16_bf16(PAF(1),VFR(5),o[1],0,0,0), C0,12); \
    KRD(GL,2); GAPB(o[0]=__builtin_amdgcn_mfma_f32_32x32x16_bf16(PAF(2),VFR(2),o[0],0,0,0), C1,0); \
    KRD(GL,3); GAPB(o[1]=__builtin_amdgcn_mfma_f32_32x32x16_bf16(PAF(2),VFR(6),o[1],0,0,0), C1,4); \
    GAPB(o[0]=__builtin_amdgcn_mfma_f32_32x32x16_bf16(PAF(3),VFR(3),o[0],0,0,0), C1,8); \
    GAPB(o[1]=__builtin_amdgcn_mfma_f32_32x32x16_bf16(PAF(3),VFR(7),o[1],0,0,0), C1,12); \
    }while(0)
  int t=1;
  for(;t+5<NT;t+=2){
    STEP(pB0,pB1,pA0,pA1,t,true,true,true);     WAIT_BAR(2); RESC(); ROT();
    STEP(pA0,pA1,pB0,pB1,t+1,true,true,true);   WAIT_BAR(2); RESC(); ROT();
  }
  #define ENDW(tt) do{ if((tt)+3<NT){WAIT_BAR(2);} else if((tt)+2<NT){WAIT_BAR(1);} else {WAIT_BAR(0);} }while(0)
  for(;t+1<NT;t+=2){
    STEP(pB0,pB1,pA0,pA1,t,(t+3<NT),(t+1<NT),(t+1<NT));       ENDW(t);   RESC(); ROT();
    STEP(pA0,pA1,pB0,pB1,t+1,(t+4<NT),(t+2<NT),(t+2<NT));     ENDW(t+1); RESC(); ROT();
  }
  STEP(pB0,pB1,pA0,pA1,NT-1,false,false,false); RESC();
  { float sacc=pB0[0]+pB0[1]; _Pragma("unroll") for(int r=2;r<16;++r)sacc+=pB0[r]; _Pragma("unroll") for(int r=0;r<16;++r)sacc+=pB1[r]; l_reg+=sacc;
    pw0=(u32x4){PKW(pB0,0),PKW(pB0,2),PKW(pB0,4),PKW(pB0,6)};pw1=(u32x4){PKW(pB0,8),PKW(pB0,10),PKW(pB0,12),PKW(pB0,14)};pw2=(u32x4){PKW(pB1,0),PKW(pB1,2),PKW(pB1,4),PKW(pB1,6)};pw3=(u32x4){PKW(pB1,8),PKW(pB1,10),PKW(pB1,12),PKW(pB1,14)};
    SBAR(); pv(o,vb0+sl_cur,PAF(0),PAF(1),PAF(2),PAF(3)); }
  #undef PKW
  #undef PAF
  #undef VFR
  #undef PIN
  #undef MX3
  #undef GAPA
  #undef GAPB
  #undef EX
  #undef VRD
  #undef KRD
  #undef STEP
  #undef ENDW
  {auto rr=__builtin_amdgcn_permlane32_swap(__float_as_uint(l_reg),__float_as_uint(l_reg),false,false);l_reg=__uint_as_float(rr[0])+__uint_as_float(rr[1]);}
  if(hi==0)wsf[32+r32]=l_reg;asm volatile("s_waitcnt lgkmcnt(0)":::"memory");
  float rli[16];
  #pragma unroll
  for(int r=0;r<16;++r)rli[r]=__builtin_amdgcn_rcpf(wsf[32+crow(r,hi)]);
  bf16*Ow=O+(rowbase+q0+wid*QBLK)*DMO+h*D;
  { bf16*stg=(bf16*)(shm+LDS_OST)+wid*2048;
    #pragma unroll
    for(int r=0;r<16;++r){const int orow=crow(r,hi);
      #pragma unroll
      for(int d0=0;d0<2;++d0)stg[orow*64+d0*32+r32]=__float2bfloat16(o[d0][r]*rli[r]);}
    asm volatile("s_waitcnt lgkmcnt(0)":::"memory");
    float gn[8];
    #pragma unroll
    for(int e=0;e<8;++e)gn[e]=gain[h*D+(lane&7)*8+e];
    #pragma unroll
    for(int i=0;i<4;++i){const int row=i*8+(lane>>3),ch=lane&7; const u32x4 v=*(const u32x4*)(stg+row*64+ch*8);
      float f[8]; f[0]=__uint_as_float(v.x<<16);f[1]=__uint_as_float(v.x&0xffff0000u);f[2]=__uint_as_float(v.y<<16);f[3]=__uint_as_float(v.y&0xffff0000u);
      f[4]=__uint_as_float(v.z<<16);f[5]=__uint_as_float(v.z&0xffff0000u);f[6]=__uint_as_float(v.w<<16);f[7]=__uint_as_float(v.w&0xffff0000u);
      float ss=0.f;
      #pragma unroll
      for(int e=0;e<8;++e)ss+=f[e]*f[e];
      ss+=__shfl_xor(ss,1);ss+=__shfl_xor(ss,2);ss+=__shfl_xor(ss,4);
      const float rs=rsqrtf(ss*(1.f/64.f)+1e-6f);
      u32x4 w; w.x=cvtpk_s(f[0]*rs*gn[0],f[1]*rs*gn[1]); w.y=cvtpk_s(f[2]*rs*gn[2],f[3]*rs*gn[3]); w.z=cvtpk_s(f[4]*rs*gn[4],f[5]*rs*gn[5]); w.w=cvtpk_s(f[6]*rs*gn[6],f[7]*rs*gn[7]);
      ATTN_STORE16(Ow+(long)row*DMO+ch*8,w);} }
  asm volatile("s_waitcnt lgkmcnt(0)\n\ts_barrier":::"memory");
  #undef DMA_K
  #undef DMA_V
  #undef CMASK
  #undef START
  #undef RESC
  #undef ROT
}
constexpr int ATTN_LDS_BYTES=LDS_BYTES;
struct AttnTensors { const bf16* Q; const bf16* K; const bf16* V; bf16* O; const u32x4* Mask; const float* gain; };
struct AttnUnit { int bh; int qb; };
struct StaticOrder {
  int vcu, G;
  __device__ __forceinline__ explicit StaticOrder(int grid,int block):vcu((grid%8==0)?(block%8)*(grid/8)+block/8:block),G(grid){}
  __device__ __forceinline__ bool next(int i,AttnUnit&u)const{
    if(G==256){ if(i>=4)return false; const int s=vcu&1; u.bh=vcu>>1; u.qb=(i==0)?s:(i==1)?7-s:(i==2)?3-s:4+s; return true; }
    const int L=i*G+vcu; if(L>=BATCH*NHEAD*NQB)return false; u.bh=L/NQB; u.qb=L%NQB; return true; }
  __device__ __forceinline__ void a_ready(const AttnUnit&)const{}
  __device__ __forceinline__ void done(const AttnUnit&)const{}
};
template<class Sched,int THRL=8> __device__ __forceinline__ void attn_phase(char*lds,const AttnTensors&T,const Sched&S,int tid_in){
  AttnUnit u;
  for(int i=0;S.next(i,u);++i){ S.a_ready(u); attn_unit<THRL>(u.bh/NHEAD,u.bh%NHEAD,u.qb,T.Q,T.K,T.V,T.O,T.Mask,T.gain,lds,tid_in); S.done(u); }
}
#undef SBAR
#undef WAIT_BAR
}

constexpr int NWAVES = 8;
#ifndef MK_ONE_LAUNCH
#define MK_ONE_LAUNCH 1
#endif
constexpr int BATCH = 16, SEQ = 2048, D = 1024, M = BATCH * SEQ, DEPTH = 2;
constexpr int NIN = 3408, NINP = 3584, QRK = 256, FF = 2816, NMOD = 6 * D;
constexpr float EPS = 1e-6f;
constexpr int N_PHASES = 2 + 9 * DEPTH;

constexpr size_t MiB = 1u << 20;
constexpr size_t WS_CTL = 0, CTL_ZERO_BYTES = 64 * 1024;
constexpr size_t WS_MOD = 1 * MiB;
constexpr size_t WS_SSQ = 2 * MiB;
constexpr size_t WS_W = 3 * MiB, W_LAYER = 26 * MiB;
constexpr size_t WO_IN = 0, WO_Q = 7 * MiB, WO_OUT = 7 * MiB + 512 * 1024, WO_GU = 9 * MiB + 512 * 1024, WO_DN = 20 * MiB + 512 * 1024;
constexpr size_t WS_XN = 56 * MiB;
constexpr size_t WS_MIX = 120 * MiB;
constexpr size_t MX_CQ = 0, MX_K = 16 * MiB, MX_V = 48 * MiB, MX_KI = 80 * MiB, MX_WI = 84 * MiB, MX_IG = 85 * MiB, MX_LF = 85 * MiB + 512 * 1024, MX_QM = 86 * MiB, MX_KM = 118 * MiB, MX_VM = 150 * MiB,
                 MX_OM = 182 * MiB, MX_Q = 214 * MiB, MX_QI = 246 * MiB, MX_MASK = 278 * MiB, MX_CL = 286 * MiB, MX_KC = 352 * MiB, MX_H = 0, MX_Y = 192 * MiB, MX_END = 384 * MiB;
constexpr size_t WS_END = WS_MIX + MX_END;
static_assert(WO_DN + (size_t)D * FF * 2 <= W_LAYER && WS_W + DEPTH * W_LAYER <= WS_XN && WS_XN + (size_t)M * D * 2 <= WS_MIX && (size_t)M * FF * 2 <= MX_Y && MX_Y + (size_t)M * D * 2 <= MX_CL && MX_CL + (size_t)2048 * 129 * 128 * 2 <= MX_KC && MX_KC + (size_t)2048 * 64 * 128 * 2 <= MX_END, "d_ws map");
constexpr int CW_BAR = 4096;

constexpr int RING_BYTES = 153600;
constexpr int LDSCTL_OFF = RING_BYTES, LDS_BYTES = LDSCTL_OFF + 512;
static_assert(pg8::STAGE_BYTES <= RING_BYTES && attn_body::ATTN_LDS_BYTES <= RING_BYTES && LDS_BYTES <= 160 * 1024, "LDS map");

#define GAS __attribute__((address_space(1)))
#define LAS __attribute__((address_space(3)))
typedef unsigned short bf16;
typedef unsigned v4u __attribute__((ext_vector_type(4)));
typedef float f32x4 __attribute__((ext_vector_type(4)));
typedef short bf16x8 __attribute__((ext_vector_type(8)));
typedef GAS unsigned gu32;
typedef GAS unsigned long long gu64;
#define RLX_AGENT __ATOMIC_RELAXED, __HIP_MEMORY_SCOPE_AGENT
#define LDS_WAIT() asm volatile("s_waitcnt lgkmcnt(0)" ::: "memory")
#define VM_WAIT() asm volatile("s_waitcnt vmcnt(0)" ::: "memory")
__device__ __forceinline__ unsigned long long rt() { return __builtin_amdgcn_s_memrealtime(); }
__device__ __forceinline__ unsigned f2bf(float f) { unsigned u = __builtin_bit_cast(unsigned, f); return (u + 0x7fffu + ((u >> 16) & 1u)) >> 16; }
__device__ __forceinline__ unsigned pk2(float lo, float hi) { return f2bf(lo) | (f2bf(hi) << 16); }

#define XB_TMO      128
#define XB_XCNT(j)  (256  + 64 * (j))
#define XB_XSUB(j)  (1280 + 64 * (j))
#define XB_XGEN(j)  (2304 + 64 * (j))
#define XB_TOP      3328
#define XB_TOPGEN   3392
#define XCD_BAR_WORDS 3456
#define XB_SPIN_CAP (1u << 18)

__device__ __forceinline__ unsigned xb_ld(unsigned* p)              { return __hip_atomic_load(p, __ATOMIC_RELAXED, __HIP_MEMORY_SCOPE_AGENT); }
__device__ __forceinline__ unsigned xb_add(unsigned* p, unsigned v) { return __hip_atomic_fetch_add(p, v, __ATOMIC_RELAXED, __HIP_MEMORY_SCOPE_AGENT); }
__device__ __forceinline__ unsigned xb_xcc_id() { return (unsigned)__builtin_amdgcn_s_getreg((3 << 11) | 20) & 0xFu; }
#define XB_SPIN(cond, bar) do { unsigned _sp = 0; while (cond) { __builtin_amdgcn_s_sleep(1); \
    if ((++_sp & 255u) == 0u) { if (xb_ld(&(bar)[XB_TMO])) break; if (_sp > XB_SPIN_CAP) { atomicAdd(&(bar)[XB_TMO], 1u); break; } } } } while (0)

struct XcdBarrier {
    unsigned* bar; unsigned x;
    volatile LAS unsigned* st;
};

__device__ __forceinline__ XcdBarrier xcd_barrier_post(unsigned* bar, volatile LAS unsigned* st) {
    XcdBarrier b; b.bar = bar; b.x = xb_xcc_id(); b.st = st;
    if (threadIdx.x == 0) (void)xb_add(&bar[XB_XCNT(b.x)], 1u);
    return b;
}
__device__ __forceinline__ void xcd_barrier_complete(unsigned* bar, unsigned x, unsigned& nloc, unsigned& nx) {
    const unsigned G = gridDim.x * gridDim.y * gridDim.z;
    unsigned sum, cnt, mine, sp = 0u;
    for (;;) {
        sum = 0u; cnt = 0u; mine = 0u;
#pragma unroll
        for (unsigned j = 0; j < 16; ++j) { const unsigned c = xb_ld(&bar[XB_XCNT(j)]); sum += c; cnt += (c > 0u) ? 1u : 0u; mine = (j == x) ? c : mine; }
        if (sum == G) break;
        __builtin_amdgcn_s_sleep(1);
        if ((++sp & 255u) == 0u) { if (xb_ld(&bar[XB_TMO])) break; if (sp > XB_SPIN_CAP) { atomicAdd(&bar[XB_TMO], 1u); break; } }
    }
    nloc = mine > 0u ? mine : 1u; nx = cnt > 0u ? cnt : 1u;
}

__device__ __forceinline__ void xcd_barrier(const XcdBarrier& b) {
    asm volatile("s_waitcnt vmcnt(0)" ::: "memory");
    __syncthreads();
    if (threadIdx.x == 0) {
        unsigned* bar = b.bar;
        const unsigned bx = xb_xcc_id();
        __builtin_amdgcn_s_waitcnt(0);
        unsigned nloc = b.st[0], nx = b.st[1];
        if (nloc == 0u) { xcd_barrier_complete(bar, bx, nloc, nx); b.st[0] = nloc; b.st[1] = nx; }
        const unsigned old = xb_add(&bar[XB_XSUB(bx)], 1u);
        const unsigned gen = old / nloc;
        if (old + 1u == (gen + 1u) * nloc) {
            __builtin_amdgcn_fence(__ATOMIC_RELEASE, "agent");
            asm volatile("s_waitcnt vmcnt(0)" ::: "memory");
            const unsigned og = xb_add(&bar[XB_TOP], 1u);
            const unsigned tg = og / nx;
            if (og + 1u == (tg + 1u) * nx) xb_add(&bar[XB_TOPGEN], 1u);
            else XB_SPIN(xb_ld(&bar[XB_TOPGEN]) == tg, bar);
            __builtin_amdgcn_fence(__ATOMIC_ACQUIRE, "agent");
            xb_add(&bar[XB_XGEN(bx)], 1u);
            asm volatile("s_waitcnt vmcnt(0)" ::: "memory");
        } else {
            XB_SPIN(xb_ld(&bar[XB_XGEN(bx)]) == gen, bar);
            __builtin_amdgcn_fence(__ATOMIC_ACQUIRE, "agent");
            asm volatile("s_waitcnt vmcnt(0)" ::: "memory");
        }
    }
    __syncthreads();
}

typedef float f32x16 __attribute__((ext_vector_type(16)));
typedef unsigned u32x2 __attribute__((ext_vector_type(2)));
__device__ __forceinline__ float wave_sum(float v) {
#pragma unroll
    for (int o = 1; o < 64; o <<= 1) v += __shfl_xor(v, o);
    return v;
}
__device__ __forceinline__ float bf_lo(unsigned u) { return __uint_as_float(u << 16); }
__device__ __forceinline__ float bf_hi(unsigned u) { return __uint_as_float(u & 0xffff0000u); }
__device__ __forceinline__ float sigmoid_f(float g) { return __builtin_amdgcn_rcpf(1.f + __builtin_amdgcn_exp2f(-1.4426950408889634f * g)); }
__device__ __forceinline__ float silu_f(float g) { return g * sigmoid_f(g); }
__device__ __forceinline__ int ropeperm(int p) { const int j = p >> 3, e = p & 7; return (e < 4) ? 4 * j + e : 32 + 4 * j + (e - 4); }

__device__ __forceinline__ void conv_item(int kind, const float* W0, const float* W1, const float* gain, int K, int Nphys, bf16* WT, LAS float* scr, int item, int lane) {
    const int nblk = Nphys / 32, kb = item / nblk, nb = item % nblk, k0 = 64 * kb, n0 = 32 * nb;
    const int n = n0 + (lane & 31);
    const float* src = W0; int ld = Nphys, col = n;
    if (kind == 1) {
        ld = NIN; const int tile = n >> 8, r = n & 255;
        if (tile == 0) col = r;
        else if (tile <= 2) { const int idx = (tile - 1) * 256 + r; col = 256 + (idx >> 6) * 64 + ropeperm(idx & 63); }
        else if (tile <= 4) col = 768 + (tile - 3) * 256 + r;
        else if (tile <= 12) col = 1352 + (tile - 5) * 256 + r;
        else { if (r < 64) col = 1280 + ropeperm(r); else if (r < 72) col = 1344 + (r - 64); else if (r < 76) col = 3400 + (r - 72); else if (r < 80) col = 3404 + (r - 76); else { src = nullptr; col = 0; } }
    } else if (kind == 2) {
        ld = 512; src = (n < 512) ? W0 : W1; const int idx = n & 511; col = (idx >> 6) * 64 + ropeperm(idx & 63);
    } else if (kind == 3) {
        ld = 2 * FF; col = ((n >> 7) & 1) * FF + (n >> 8) * 128 + (n & 127);
    }
    float wv[32];
#pragma unroll
    for (int i = 0; i < 32; ++i) { const int kk = 2 * i + (lane >> 5); wv[i] = src ? src[(size_t)(k0 + kk) * ld + col] : 0.f; }
#pragma unroll
    for (int i = 0; i < 32; ++i) { const int kk = 2 * i + (lane >> 5); float v = wv[i]; if (gain) v *= gain[k0 + kk]; scr[kk * 33 + (lane & 31)] = v; }
    LDS_WAIT(); asm volatile("" ::: "memory");
    const int c = lane & 7;
#pragma unroll
    for (int j = 0; j < 4; ++j) { const int nn = (lane >> 3) + 8 * j; const LAS float* s = scr + (8 * c) * 33 + nn;
        v4u o; o.x = pk2(s[0 * 33], s[1 * 33]); o.y = pk2(s[2 * 33], s[3 * 33]); o.z = pk2(s[4 * 33], s[5 * 33]); o.w = pk2(s[6 * 33], s[7 * 33]);
        *(GAS v4u*)(WT + (size_t)(n0 + nn) * K + k0 + 8 * c) = o; }
    LDS_WAIT(); asm volatile("" ::: "memory");
}

enum { I_X = 0, I_C, I_POS, I_WMOD, I_BMOD, I_MIXPRE, I_MIXPOST, I_WIN, I_QLN, I_WQUP, I_WQIUP, I_CONVW, I_CONVB, I_BIG, I_BFG, I_ATTN, I_MLN, I_WOUT, I_FFNPRE, I_FFNPOST, I_WGU, I_WDN, I_OUT, I_WS };
__device__ __forceinline__ unsigned long long ldptr(LAS unsigned char* lds, int k) {
    const volatile LAS unsigned* p = (const volatile LAS unsigned*)(lds + LDSCTL_OFF + 64 + 8 * k);
    const unsigned lo = __builtin_amdgcn_readfirstlane(p[0]), hi = __builtin_amdgcn_readfirstlane(p[1]);
    return ((unsigned long long)hi << 32) | lo;
}
#define GPTR(T, x) ((T*)(GAS T*)(x))
#define FP(k) GPTR(const float, ldptr(lds, (k)))
#define WSP() ((unsigned char*)ldptr(lds, I_WS))
#define WSPG() GPTR(unsigned char, ldptr(lds, I_WS))

__device__ __forceinline__ void p0_prologue(LAS unsigned char* lds, int tid, int lane, int wave, int vcu, int G) {
    LAS float* scr = (LAS float*)(lds + wave * 16384);
    const int gw = vcu * NWAVES + wave, NGW = G * NWAVES;
    constexpr int I_IN = (D / 64) * (NINP / 32), I_Q = (QRK / 64) * (1024 / 32), I_O = (D / 64) * (D / 32), I_GU = (D / 64) * (2 * FF / 32), I_DN = (FF / 64) * (D / 32);
    constexpr int I_LAYER = I_IN + I_Q + I_O + I_GU + I_DN;
    for (int it = gw; it < DEPTH * I_LAYER; it += NGW) {
        const int l = it / I_LAYER; int r = it % I_LAYER; unsigned char* wl = WSP() + WS_W + (size_t)l * W_LAYER;
        if (r < I_IN) { conv_item(1, FP(I_WIN) + (size_t)l * D * NIN, nullptr, nullptr, D, NINP, (bf16*)(wl + WO_IN), scr, r, lane); continue; } r -= I_IN;
        if (r < I_Q) { conv_item(2, FP(I_WQUP) + (size_t)l * QRK * 512, FP(I_WQIUP) + (size_t)l * QRK * 512, FP(I_QLN) + (size_t)l * QRK, QRK, 1024, (bf16*)(wl + WO_Q), scr, r, lane); continue; } r -= I_Q;
        if (r < I_O) { conv_item(0, FP(I_WOUT) + (size_t)l * D * D, nullptr, nullptr, D, D, (bf16*)(wl + WO_OUT), scr, r, lane); continue; } r -= I_O;
        if (r < I_GU) { conv_item(3, FP(I_WGU) + (size_t)l * D * 2 * FF, nullptr, nullptr, D, 2 * FF, (bf16*)(wl + WO_GU), scr, r, lane); continue; } r -= I_GU;
        conv_item(0, FP(I_WDN) + (size_t)l * FF * D, nullptr, nullptr, FF, D, (bf16*)(wl + WO_DN), scr, r, lane);
    }
    __syncthreads();
    constexpr int NU = DEPTH * (NMOD / 64);
    if (vcu < NU) {
        LAS float* sc = (LAS float*)lds;
        LAS float* part = (LAS float*)(lds + 65536);
        { const float* cin = FP(I_C);
#pragma unroll
          for (int h2 = 0; h2 < 2; ++h2) { float cv[16];
#pragma unroll
              for (int q = 0; q < 16; ++q) cv[q] = cin[tid + NWAVES * 64 * (16 * h2 + q)];
#pragma unroll
              for (int q = 0; q < 16; ++q) { const int i = tid + NWAVES * 64 * (16 * h2 + q), b = i / D, k = i % D; sc[k * 16 + b] = silu_f(cv[q]); } } }
        __syncthreads();
        const float* wmod = FP(I_WMOD); const float* bmod = FP(I_BMOD); float* modo = (float*)(WSP() + WS_MOD);
        for (int u = vcu; u < NU; u += G) {
            const int l = u / (NMOD / 64), n0 = (u % (NMOD / 64)) * 64;
            const float* W = wmod + (size_t)l * D * NMOD + n0 + lane;
            float acc[16];
#pragma unroll
            for (int b = 0; b < 16; ++b) acc[b] = 0.f;
            for (int k0 = wave * 128; k0 < wave * 128 + 128; k0 += 32) { float wv[32];
#pragma unroll
                for (int kk = 0; kk < 32; ++kk) wv[kk] = W[(size_t)(k0 + kk) * NMOD];
#pragma unroll
                for (int kk = 0; kk < 32; ++kk) {
#pragma unroll
                    for (int q = 0; q < 4; ++q) { const f32x4 s4 = *(const LAS f32x4*)(sc + (k0 + kk) * 16 + 4 * q);
                        acc[4 * q + 0] += s4[0] * wv[kk]; acc[4 * q + 1] += s4[1] * wv[kk]; acc[4 * q + 2] += s4[2] * wv[kk]; acc[4 * q + 3] += s4[3] * wv[kk]; }
                    __builtin_amdgcn_sched_barrier(0); } }
#pragma unroll
            for (int b = 0; b < 16; ++b) part[(wave * 16 + b) * 64 + lane] = acc[b];
            __syncthreads();
            for (int i = tid; i < 16 * 64; i += NWAVES * 64) { const int b = i >> 6, ln = i & 63; float s = bmod[(size_t)l * NMOD + n0 + ln];
#pragma unroll
                for (int w = 0; w < 8; ++w) s += part[(w * 16 + b) * 64 + ln];
                modo[((size_t)l * BATCH + b) * NMOD + n0 + ln] = s; }
            __syncthreads();
        }
    }
}

__device__ __forceinline__ void norm_phase(const bf16* y, const float* xin32, const bf16* xin16, float* xout32, bf16* xout16, const float* gpost, const float* gate, const float* gnext, const float* sc,
                                           const float* sh, bf16* XN, int lane, int wave, int vcu, int G) {
    const int gw = vcu * NWAVES + wave, NGW = G * NWAVES;
    for (int m0 = gw * 16; m0 < M; m0 += NGW * 16) {
        const int b = m0 / SEQ;
        f32x4 vg[4], vt[4], vn[4], vs[4], vh[4];
#pragma unroll
        for (int j = 0; j < 4; ++j) { const int e = 256 * j + 4 * lane;
            if (y) { vg[j] = *(const f32x4*)(gpost + e); vt[j] = *(const f32x4*)(gate + (size_t)b * NMOD + e); }
            if (gnext) { vn[j] = *(const f32x4*)(gnext + e); vs[j] = *(const f32x4*)(sc + (size_t)b * NMOD + e) + 1.f; vh[j] = *(const f32x4*)(sh + (size_t)b * NMOD + e); vn[j] = vn[j] * vs[j]; } }
        for (int r = 0; r < 16; ++r) {
            const size_t row = (size_t)(m0 + r);
            f32x4 xv[4];
#pragma unroll
            for (int j = 0; j < 4; ++j) {
                if (xin32) xv[j] = *(const f32x4*)(xin32 + row * D + 256 * j + 4 * lane);
                else { const u32x2 w = *(const u32x2*)(xin16 + row * D + 256 * j + 4 * lane); xv[j] = (f32x4){bf_lo(w.x), bf_hi(w.x), bf_lo(w.y), bf_hi(w.y)}; } }
            if (y) {
                f32x4 yv[4]; float ss = 0.f;
#pragma unroll
                for (int j = 0; j < 4; ++j) { const u32x2 w = *(const u32x2*)(y + row * D + 256 * j + 4 * lane); yv[j] = (f32x4){bf_lo(w.x), bf_hi(w.x), bf_lo(w.y), bf_hi(w.y)};
                    ss += (yv[j][0] * yv[j][0] + yv[j][1] * yv[j][1]) + (yv[j][2] * yv[j][2] + yv[j][3] * yv[j][3]); }
                const float rstd = rsqrtf(wave_sum(ss) * (1.f / D) + EPS);
#pragma unroll
                for (int j = 0; j < 4; ++j) { xv[j] = xv[j] + vt[j] * (yv[j] * rstd * vg[j]);
                    if (xout32) *(f32x4*)(xout32 + row * D + 256 * j + 4 * lane) = xv[j];
                    else if (xout16) { u32x2 w; w.x = pk2(xv[j][0], xv[j][1]); w.y = pk2(xv[j][2], xv[j][3]); *(u32x2*)(xout16 + row * D + 256 * j + 4 * lane) = w;
                        xv[j] = (f32x4){bf_lo(w.x), bf_hi(w.x), bf_lo(w.y), bf_hi(w.y)}; } }
            }
            if (gnext) {
                float ss = 0.f;
#pragma unroll
                for (int j = 0; j < 4; ++j) ss += (xv[j][0] * xv[j][0] + xv[j][1] * xv[j][1]) + (xv[j][2] * xv[j][2] + xv[j][3] * xv[j][3]);
                const float rstd = rsqrtf(wave_sum(ss) * (1.f / D) + EPS);
#pragma unroll
                for (int j = 0; j < 4; ++j) { const f32x4 o = xv[j] * rstd * vn[j] + vh[j]; u32x2 w; w.x = pk2(o[0], o[1]); w.y = pk2(o[2], o[3]); *(u32x2*)(XN + row * D + 256 * j + 4 * lane) = w; }
            }
        }
    }
}

constexpr int IX_SC = 0, IX_KCH = 131072, IX_KPITCH = 144, IX_HIST = IX_KCH, IX_MSK = IX_KCH + 128 * IX_KPITCH, IX_END = IX_MSK + 4096;
static_assert(IX_END <= RING_BYTES && 8 * 576 * 4 <= 128 * IX_KPITCH, "indexer LDS");
__device__ __forceinline__ unsigned ord_key(float f) { const unsigned u = __float_as_uint(f); return u ^ ((unsigned)((int)u >> 31) | 0x80000000u); }
__device__ __forceinline__ unsigned wave_scan_add(unsigned v) {
    v += (unsigned)__builtin_amdgcn_update_dpp(0, (int)v, 0x111, 0xf, 0xf, false);
    v += (unsigned)__builtin_amdgcn_update_dpp(0, (int)v, 0x112, 0xf, 0xf, false);
    v += (unsigned)__builtin_amdgcn_update_dpp(0, (int)v, 0x114, 0xf, 0xf, false);
    v += (unsigned)__builtin_amdgcn_update_dpp(0, (int)v, 0x118, 0xf, 0xf, false);
    v += (unsigned)__builtin_amdgcn_update_dpp(0, (int)v, 0x142, 0xa, 0xf, false);
    v += (unsigned)__builtin_amdgcn_update_dpp(0, (int)v, 0x143, 0xc, 0xf, false);
    return v;
}
template <int NJ> __device__ __forceinline__ void radix_rows(const unsigned (&xa)[NJ], const unsigned (&xb)[NJ], LAS unsigned* hist, int lane,
                                                              unsigned& thrA, unsigned& needA_o, unsigned& eqA_o, unsigned& thrB, unsigned& needB_o, unsigned& eqB_o) {
    unsigned pfA = 0u, ndA = 256u, eA = 0u, pfB = 0u, ndB = 256u, eB = 0u;
    unsigned zero = 0u, one = 1u; asm volatile("" : "+v"(zero), "+v"(one));
    const int rl = 63 - lane;
#if defined(DUP) && DUP == 45
    { *(LAS v4u*)(hist + 4 * lane) = (v4u){zero, zero, zero, zero}; *(LAS v4u*)(hist + 256 + 4 * lane) = (v4u){zero, zero, zero, zero};
#pragma unroll
      for (int j = 0; j < NJ; ++j) { __hip_atomic_fetch_add(hist + ((xa[j] >> 24) & 255u), one, __ATOMIC_RELAXED, __HIP_MEMORY_SCOPE_WORKGROUP); __hip_atomic_fetch_add(hist + 256u + ((xb[j] >> 24) & 255u), one, __ATOMIC_RELAXED, __HIP_MEMORY_SCOPE_WORKGROUP);
          if ((j & 3) == 3) __builtin_amdgcn_sched_barrier(0); } }
#endif
#if defined(DUP) && DUP == 46
    { unsigned acc_ = 0u;
#pragma unroll
      for (int j = 0; j < NJ; ++j) { acc_ += (xa[j] >= one) ? 1u : 0u; acc_ += (xb[j] >= one) ? 1u : 0u; }
      acc_ = wave_scan_add(acc_); asm volatile("" :: "v"(acc_)); }
#endif
#pragma unroll 1
    for (int bit = 31; bit >= 24; --bit) {
        const unsigned cA = pfA | (1u << bit), cB = pfB | (1u << bit); unsigned nA = 0u, nB = 0u;
#pragma unroll
        for (int j = 0; j < NJ; ++j) { nA += (xa[j] >= cA) ? 1u : 0u; nB += (xb[j] >= cB) ? 1u : 0u; if ((j & 3) == 3) __builtin_amdgcn_sched_barrier(0); }
        const unsigned n = (unsigned)__builtin_amdgcn_readlane((int)wave_scan_add(nA | (nB << 16)), 63);
        if ((n & 0xffffu) >= 256u) pfA = cA;
        if ((n >> 16) >= 256u) pfB = cB;
    }
    { const unsigned uA = pfA + (1u << 24), uB = pfB + (1u << 24); unsigned nA = 0u, nB = 0u;
#pragma unroll
      for (int j = 0; j < NJ; ++j) { nA += (uA != 0u && xa[j] >= uA) ? 1u : 0u; nB += (uB != 0u && xb[j] >= uB) ? 1u : 0u; if ((j & 3) == 3) __builtin_amdgcn_sched_barrier(0); }
      const unsigned n = (unsigned)__builtin_amdgcn_readlane((int)wave_scan_add(nA | (nB << 16)), 63);
      ndA = 256u - (n & 0xffffu); ndB = 256u - (n >> 16); }
#pragma unroll
    for (int p = 1; p < 4; ++p) { const int sh = 24 - 8 * p;
        *(LAS v4u*)(hist + 4 * lane) = (v4u){zero, zero, zero, zero}; *(LAS v4u*)(hist + 256 + 4 * lane) = (v4u){zero, zero, zero, zero};
#pragma unroll
        for (int j0 = 0; j0 < NJ; j0 += 4) {
            unsigned mm = 0xffffffffu;
#pragma unroll
            for (int j = j0; j < j0 + 4; ++j) mm = min(mm, min((xa[j] ^ pfA) >> (sh + 8), (xb[j] ^ pfB) >> (sh + 8)));
            if (__any(mm == 0u)) {
#pragma unroll
                for (int j = j0; j < j0 + 4; ++j) { const unsigned va = xa[j], vb = xb[j];
                    if (((va ^ pfA) >> (sh + 8)) == 0u) __hip_atomic_fetch_add(hist + ((va >> sh) & 255u), one, __ATOMIC_RELAXED, __HIP_MEMORY_SCOPE_WORKGROUP);
                    if (((vb ^ pfB) >> (sh + 8)) == 0u) __hip_atomic_fetch_add(hist + 256u + ((vb >> sh) & 255u), one, __ATOMIC_RELAXED, __HIP_MEMORY_SCOPE_WORKGROUP); } }
        }
        const v4u ca = *(const LAS v4u*)(hist + 4 * rl), cb = *(const LAS v4u*)(hist + 256 + 4 * rl);
        const unsigned ta = (ca.x + ca.y) + (ca.z + ca.w), tb = (cb.x + cb.y) + (cb.z + cb.w);
        const unsigned sa = wave_scan_add(ta), sb = wave_scan_add(tb);
#define RADIX_PICK(c, t, sfx, need, pf, eqv) { const unsigned above = sfx - t; const bool mine = (above < need) && (need <= sfx); unsigned bsel, nn, cn, cum = above; \
          if (cum + c.w >= need) { bsel = 3u; nn = need - cum; cn = c.w; } \
          else { cum += c.w; if (cum + c.z >= need) { bsel = 2u; nn = need - cum; cn = c.z; } \
              else { cum += c.z; if (cum + c.y >= need) { bsel = 1u; nn = need - cum; cn = c.y; } else { cum += c.y; bsel = 0u; nn = need - cum; cn = c.x; } } } \
          const unsigned long long bm = __ballot(mine); const int L = (int)__builtin_ctzll(bm | (1ull << 63)); \
          const unsigned bin = (unsigned)__builtin_amdgcn_readlane((int)(4u * (unsigned)rl + bsel), L); \
          need = (unsigned)__builtin_amdgcn_readlane((int)nn, L); eqv = (unsigned)__builtin_amdgcn_readlane((int)cn, L); pf |= bin << sh; }
        RADIX_PICK(ca, ta, sa, ndA, pfA, eA)
        RADIX_PICK(cb, tb, sb, ndB, pfB, eB)
#undef RADIX_PICK
    }
    thrA = pfA; needA_o = ndA; eqA_o = eA; thrB = pfB; needB_o = ndB; eqB_o = eB;
}
template <int NJ> __device__ __forceinline__ void select_rows(const LAS unsigned* scb, LAS unsigned long long* msk, LAS unsigned* hist, int nk, int wave, int lane) {
    unsigned xa[NJ], xb[NJ];
#pragma unroll
    for (int j = 0; j < NJ; ++j) { const unsigned va = scb[(2 * wave) * 2048 + 64 * j + lane], vb = scb[(2 * wave + 1) * 2048 + 64 * j + lane]; const bool in = (64 * j + lane) < nk; xa[j] = in ? va : 0u; xb[j] = in ? vb : 0u; }
    unsigned pA, pB, needA, needB, eA, eB;
    radix_rows<NJ>(xa, xb, hist, lane, pA, needA, eA, pB, needB, eB);
    unsigned xiA = 2047u, xiB = 2047u;
    if ((eA > needA) || (eB > needB)) {
        xiA = 0u; xiB = 0u;
#pragma unroll 1
        for (int bit = 10; bit >= 0; --bit) {
            const unsigned cA = xiA | (1u << bit), cB = xiB | (1u << bit); unsigned nA = 0u, nB = 0u;
#pragma unroll
            for (int j = 0; j < NJ; ++j) { int ll = lane; asm volatile("" : "+v"(ll)); const unsigned key = 64u * j + ll;
                nA += (xa[j] == pA && key < cA) ? 1u : 0u; nB += (xb[j] == pB && key < cB) ? 1u : 0u; if (j & 1) __builtin_amdgcn_sched_barrier(0); }
            unsigned n = nA | (nB << 16);
#pragma unroll
            for (int o = 1; o < 64; o <<= 1) n += __shfl_xor(n, o);
            if ((n & 0xffffu) < needA) xiA = cA;
            if ((n >> 16) < needB) xiB = cB;
        }
    }
    unsigned a0 = 0u, a1 = 0u, b0 = 0u, b1 = 0u;
    const bool ties = (xiA != 2047u) || (xiB != 2047u);
#pragma unroll
    for (int j = 0; j < NJ; ++j) { int ll = lane; asm volatile("" : "+v"(ll)); const unsigned key = 64u * j + ll;
        bool sA = xa[j] >= pA, sB = xb[j] >= pB;
        if (ties) { sA = (xa[j] > pA) || (xa[j] == pA && key <= xiA); sB = (xb[j] > pB) || (xb[j] == pB && key <= xiB); }
        const unsigned long long ba = __ballot(sA), bb = __ballot(sB);
        asm volatile("v_writelane_b32 %0, %4, %8\n\tv_writelane_b32 %1, %5, %8\n\tv_writelane_b32 %2, %6, %8\n\tv_writelane_b32 %3, %7, %8"
                     : "+v"(a0), "+v"(a1), "+v"(b0), "+v"(b1) : "s"((unsigned)ba), "s"((unsigned)(ba >> 32)), "s"((unsigned)bb), "s"((unsigned)(bb >> 32)), "n"(j));
        __builtin_amdgcn_sched_barrier(0);
    }
    if (lane < 32) { msk[lane * 16 + 2 * wave] = (unsigned long long)a0 | ((unsigned long long)a1 << 32); msk[lane * 16 + 2 * wave + 1] = (unsigned long long)b0 | ((unsigned long long)b1 << 32); }
}
struct IxReg { bf16x8 af[4]; float wA[8], wB[8]; v4u pre[2]; };
__device__ __forceinline__ void indexer_load(IxReg& R, int b, int qb16, const bf16* QI, const bf16* KI, const float* WI, int tid, int lane, int wave) {
    if (qb16 < 16) return;
    const int r = lane & 31, hh = lane >> 5, mt = wave & 3, q0 = qb16 * 16; const size_t rowb = (size_t)b * SEQ;
    { const int g = r >> 2, ql = 2 * (g & 1) + (g >> 2), hd = 4 * ((g >> 1) & 1) + (r & 3);
      const bf16* qp = QI + (rowb + q0 + 4 * mt + ql) * 512 + hd * 64 + 8 * hh;
#pragma unroll
      for (int s = 0; s < 4; ++s) R.af[s] = *(const bf16x8*)(qp + 16 * s); }
    { const float* wp = WI + (rowb + q0 + 4 * mt + 2 * hh) * 8;
#pragma unroll
      for (int j = 0; j < 8; ++j) { R.wA[j] = wp[j]; R.wB[j] = wp[8 + j]; } }
#pragma unroll
    for (int i = 0; i < 2; ++i) { const int idx = tid + 512 * i; R.pre[i] = *(const v4u*)(KI + (rowb + (idx >> 3)) * 64 + (idx & 7) * 8); }
}
__device__ __forceinline__ void indexer_unit(LAS unsigned char* lds, int b, int qb16, int nb, int nqb16, IxReg& R, const bf16* QI, const bf16* KI, const float* WI, unsigned long long* MaskG, int tid, int lane, int wave) {
    asm volatile("" : "+v"(tid), "+v"(lane));
    LAS unsigned* scb = (LAS unsigned*)(lds + IX_SC);
    LAS unsigned long long* msk = (LAS unsigned long long*)(lds + IX_MSK);
    const int q0 = qb16 * 16, n_kt = (q0 + 47) >> 5, nk = 32 * n_kt;
    const size_t rowb = (size_t)b * SEQ;
    __syncthreads();
    if (qb16 < 16) {
        { const int T = tid >> 4, i = tid & 15, t = q0 + i;
          msk[T * 16 + i] = (64 * T + 63 <= t) ? ~0ull : (64 * T > t) ? 0ull : ((1ull << (t - 64 * T + 1)) - 1ull); }
        if (nqb16 >= 0) indexer_load(R, nb, nqb16, QI, KI, WI, tid, lane, wave);
    } else {
        const int r = lane & 31, hh = lane >> 5, mt = wave & 3, par = wave >> 2;
        bf16x8 af[4]; float wA[8], wB[8]; v4u pre[2];
#pragma unroll
        for (int s = 0; s < 4; ++s) af[s] = R.af[s];
#pragma unroll
        for (int j = 0; j < 8; ++j) { wA[j] = R.wA[j]; wB[j] = R.wB[j]; }
        pre[0] = R.pre[0]; pre[1] = R.pre[1];
        const int rowA = 4 * mt + 2 * hh, tA = q0 + rowA;
        for (int c = 0; 4 * c < n_kt; ++c) {
            if (c) __syncthreads();
#pragma unroll
            for (int i = 0; i < 2; ++i) { const int idx = tid + 512 * i; *(LAS v4u*)(lds + IX_KCH + (idx >> 3) * IX_KPITCH + (idx & 7) * 16) = pre[i]; }
            __syncthreads();
            if (4 * (c + 1) < n_kt) {
#pragma unroll
                for (int i = 0; i < 2; ++i) { const int idx = tid + 512 * i; pre[i] = *(const v4u*)(KI + (rowb + 128 * (c + 1) + (idx >> 3)) * 64 + (idx & 7) * 8); } }
#pragma unroll
            for (int k = 0; k < 2; ++k) { const int tt = par + 2 * k, tile = 4 * c + tt;
                if (tile < n_kt) {
                    f32x16 acc = {};
#pragma unroll
                    for (int s = 0; s < 4; ++s) { const bf16x8 bfr = *(const LAS bf16x8*)(lds + IX_KCH + (32 * tt + r) * IX_KPITCH + 32 * s + 16 * hh);
                        acc = __builtin_amdgcn_mfma_f32_32x32x16_bf16(af[s], bfr, acc, 0, 0, 0); }
                    float sa = 0.f, sb = 0.f;
#pragma unroll
                    for (int j = 0; j < 8; ++j) { sa += wA[j] * fmaxf(acc[j], 0.f); sb += wB[j] * fmaxf(acc[8 + j], 0.f); }
                    const int key = 32 * tile + r;
                    scb[rowA * 2048 + key] = (key <= tA) ? ord_key(sa) : 0u; scb[(rowA + 1) * 2048 + key] = (key <= tA + 1) ? ord_key(sb) : 0u;
                } }
        }
        __syncthreads();
        if (nqb16 >= 0) indexer_load(R, nb, nqb16, QI, KI, WI, tid, lane, wave);
#ifdef DUP
#pragma unroll 1
        for (int rep_ = 0; rep_ < ((DUP == 44) ? 2 : 1); ++rep_)
#endif
        { LAS unsigned* hist = (LAS unsigned*)(lds + IX_HIST) + 576 * wave;
          if (nk <= 512) select_rows<8>(scb, msk, hist, nk, wave, lane); else if (nk <= 1024) select_rows<16>(scb, msk, hist, nk, wave, lane);
          else if (nk <= 1536) select_rows<24>(scb, msk, hist, nk, wave, lane); else select_rows<32>(scb, msk, hist, nk, wave, lane); }
    }
    __syncthreads();
    asm volatile("" : "+v"(tid));
    { const int T = tid >> 4, i = tid & 15;
      MaskG[((size_t)(b * 8 + (qb16 >> 4)) * 32 + T) * 256 + (qb16 & 15) * 16 + i] = msk[T * 16 + i]; }
}

constexpr int ML_PQ = 272, ML_PV = 320, ML_PS = 144, ML_PN = 132;
constexpr int MA_VS = 0, MA_KW = 20480, MA_CT = 40960, MA_GT = 76288, ML_CW = 137216, ML_END = 142336;
constexpr int MC_QT = 0, MC_KT = 17408, MC_NUM = 0, MC_VS = 34816, MC_SS = 55296, MC_CT = 64512, MC_GT = 99840;
constexpr int ML_CLE = 129 * 128;
static_assert(ML_END <= RING_BYTES && MA_GT + 1024 <= ML_CW && MC_GT + 1024 <= ML_CW && 64 * ML_PN * 4 <= MC_VS && MC_CT + 129 * ML_PQ <= MC_GT && MA_CT + 129 * ML_PQ <= MA_GT, "mLSTM LDS");
__device__ __forceinline__ int crow16(int reg, int hh) { return (reg & 3) + 8 * (reg >> 2) + 4 * hh; }
typedef short v4i16_t __attribute__((ext_vector_type(4)));
__device__ __forceinline__ bf16x8 tr_frag(const LAS unsigned char* tb, int pitch, int c, int ks) {
    const v4i16_t lo = __builtin_amdgcn_ds_read_tr16_b64_v4i16((LAS v4i16_t*)(tb + (16 * ks) * pitch + 64 * c));
    const v4i16_t hi = __builtin_amdgcn_ds_read_tr16_b64_v4i16((LAS v4i16_t*)(tb + (16 * ks + 4) * pitch + 64 * c));
    return (bf16x8){lo[0], lo[1], lo[2], lo[3], hi[0], hi[1], hi[2], hi[3]};
}
__device__ __forceinline__ int tr_base(int lane, int pitch) { return ((lane >> 5) * 8 + ((lane & 15) >> 2)) * pitch + (((lane >> 4) & 1) * 16 + (lane & 3) * 4) * 2; }
__device__ __forceinline__ void mma_tile(f32x16& acc, const LAS unsigned char* a, int pa, const LAS unsigned char* bt, int pb, int ks, int r, int hh) {
    for (int s = 0; s < ks; ++s) { const bf16x8 av = *(const LAS bf16x8*)(a + r * pa + 32 * s + 16 * hh), bv = *(const LAS bf16x8*)(bt + r * pb + 32 * s + 16 * hh);
        acc = __builtin_amdgcn_mfma_f32_32x32x16_bf16(av, bv, acc, 0, 0, 0); }
}
__device__ __forceinline__ void ml_stage_cw(LAS unsigned char* lds, const float* conv_w, const float* conv_b, int hd, int tid) {
    LAS float* cwl = (LAS float*)(lds + ML_CW);
    float tv[3];
#pragma unroll
    for (int k = 0; k < 3; ++k) { const int i = tid + NWAVES * 64 * k; tv[k] = 0.f; if (i < 2 * 5 * 128) { const int z = i / 640, j = (i % 640) >> 7, ch = i & 127, gch = z * 512 + hd * 128 + ch; tv[k] = (j < 4) ? conv_w[j * 1024 + gch] : conv_b[gch]; } }
#pragma unroll
    for (int k = 0; k < 3; ++k) { const int i = tid + NWAVES * 64 * k; if (i < 2 * 5 * 128) cwl[i] = tv[k]; }
}
__device__ __forceinline__ void conv8(float (&y)[8], const bf16* src, int tt0, const LAS float* cw) {
    { const f32x4 b0 = *(const LAS f32x4*)(cw + 4 * 128), b1 = *(const LAS f32x4*)(cw + 4 * 128 + 4); y[0] = b0[0]; y[1] = b0[1]; y[2] = b0[2]; y[3] = b0[3]; y[4] = b1[0]; y[5] = b1[1]; y[6] = b1[2]; y[7] = b1[3]; }
#pragma unroll
    for (int j = 0; j < 4; ++j) { const int tt = tt0 - 3 + j;
        if (tt >= 0) { const v4u xw = *(const v4u*)(src + (size_t)tt * 512); const f32x4 w0 = *(const LAS f32x4*)(cw + j * 128), w1 = *(const LAS f32x4*)(cw + j * 128 + 4);
            y[0] += w0[0] * bf_lo(xw.x); y[1] += w0[1] * bf_hi(xw.x); y[2] += w0[2] * bf_lo(xw.y); y[3] += w0[3] * bf_hi(xw.y);
            y[4] += w1[0] * bf_lo(xw.z); y[5] += w1[1] * bf_hi(xw.z); y[6] += w1[2] * bf_lo(xw.w); y[7] += w1[3] * bf_hi(xw.w); } }
#pragma unroll
    for (int e = 0; e < 8; ++e) y[e] = silu_f(y[e]);
}

__device__ __forceinline__ void conv8r(float (&y)[8], const v4u (&xr)[4], const LAS float* cw) {
    { const f32x4 b0 = *(const LAS f32x4*)(cw + 4 * 128), b1 = *(const LAS f32x4*)(cw + 4 * 128 + 4); y[0] = b0[0]; y[1] = b0[1]; y[2] = b0[2]; y[3] = b0[3]; y[4] = b1[0]; y[5] = b1[1]; y[6] = b1[2]; y[7] = b1[3]; }
#pragma unroll
    for (int j = 0; j < 4; ++j) { const v4u xw = xr[j]; const f32x4 w0 = *(const LAS f32x4*)(cw + j * 128), w1 = *(const LAS f32x4*)(cw + j * 128 + 4);
        y[0] += w0[0] * bf_lo(xw.x); y[1] += w0[1] * bf_hi(xw.x); y[2] += w0[2] * bf_lo(xw.y); y[3] += w0[3] * bf_hi(xw.y);
        y[4] += w1[0] * bf_lo(xw.z); y[5] += w1[1] * bf_hi(xw.z); y[6] += w1[2] * bf_lo(xw.w); y[7] += w1[3] * bf_hi(xw.w); }
#pragma unroll
    for (int e = 0; e < 8; ++e) y[e] = silu_f(y[e]);
}
__device__ __forceinline__ void load_taps(v4u (&xr)[4], const bf16* src, int tt0) {
#pragma unroll
    for (int j = 0; j < 4; ++j) { const int tt = tt0 - 3 + j; xr[j] = (v4u){0u, 0u, 0u, 0u}; if (tt >= 0) xr[j] = *(const v4u*)(src + (size_t)tt * 512); }
}

struct AReg { v4u kx[2][4]; v4u vv[2]; float ig, lf; };
__device__ __forceinline__ void mlstm_A_load(AReg& R, int u, const bf16* KM, const bf16* VM, const float* IG, const float* LF, int tid, int lane, int wave) {
    const int c = u & 31, hd = (u >> 5) & 3, b = u >> 7; const size_t rowb = (size_t)b * SEQ, t0 = rowb + 64 * c;
#pragma unroll
    for (int it = 0; it < 2; ++it) { const int idx = tid + 512 * it, t = (idx >> 4) & 63, g = idx & 15;
        load_taps(R.kx[it], KM + rowb * 512 + hd * 128 + 8 * g, 64 * c + t); R.vv[it] = *(const v4u*)(VM + (t0 + t) * 512 + hd * 128 + 8 * g); }
    R.ig = 0.f; R.lf = 0.f; if (wave == 0) { R.ig = IG[(t0 + lane) * 4 + hd]; R.lf = LF[(t0 + lane) * 4 + hd]; }
}
__device__ __forceinline__ void mlstm_A(LAS unsigned char* lds, int u, int u_next, AReg& R, const bf16* KM, const bf16* VM, const float* IG, const float* LF, bf16* KC, bf16* CL, float* MSC,
                                        int tid, int lane, int wave) {
    asm volatile("" : "+v"(tid), "+v"(lane)); asm volatile("" : "+s"(wave));
    const int r = lane & 31, hh = lane >> 5;
    LAS float* gt = (LAS float*)(lds + MA_GT); LAS bf16* ct = (LAS bf16*)(lds + MA_CT);
    __syncthreads();
    if (wave == 0) {
        float bc = R.lf;
#pragma unroll
        for (int o = 1; o < 64; o <<= 1) { const float v = __shfl_up(bc, o); if (lane >= o) bc += v; }
        const float a = R.ig - bc; float am = a;
#pragma unroll
        for (int o = 1; o < 64; o <<= 1) am = fmaxf(am, __shfl_xor(am, o));
        gt[lane] = __expf(a - am);
        if (lane == 63) { MSC[(size_t)u * 4 + 0] = am; MSC[(size_t)u * 4 + 1] = bc; }
    }
#pragma unroll
    for (int it = 0; it < 2; ++it) { const int idx = tid + 512 * it, t = (idx >> 4) & 63, g = idx & 15;
        float y[8]; conv8r(y, R.kx[it], (const LAS float*)(lds + ML_CW) + 640 + 8 * g);
        v4u o; o.x = pk2(y[0], y[1]); o.y = pk2(y[2], y[3]); o.z = pk2(y[4], y[5]); o.w = pk2(y[6], y[7]);
        *(LAS v4u*)(lds + MA_KW + t * ML_PV + 16 * g) = o; *(v4u*)(KC + ((size_t)u * 64 + t) * 128 + 8 * g) = o;
        *(LAS v4u*)(lds + MA_VS + t * ML_PV + 16 * g) = R.vv[it]; }
    if (u_next >= 0) mlstm_A_load(R, u_next, KM, VM, IG, LF, tid, lane, wave);
    __syncthreads();
#pragma unroll
    for (int it = 0; it < 2; ++it) { const int idx = tid + 512 * it, t = (idx >> 4) & 63, g = idx & 15; const float ws = gt[t];
        LAS v4u* kp = (LAS v4u*)(lds + MA_KW + t * ML_PV + 16 * g); const v4u xw = *kp;
        v4u o; o.x = pk2(ws * bf_lo(xw.x), ws * bf_hi(xw.x)); o.y = pk2(ws * bf_lo(xw.y), ws * bf_hi(xw.y)); o.z = pk2(ws * bf_lo(xw.z), ws * bf_hi(xw.z)); o.w = pk2(ws * bf_lo(xw.w), ws * bf_hi(xw.w)); *kp = o; }
    __syncthreads();
    { const int vi = wave >> 1; const LAS unsigned char* va = lds + MA_VS + tr_base(lane, ML_PV); const LAS unsigned char* kb = lds + MA_KW + tr_base(lane, ML_PV);
      f32x16 acc0 = f32x16{}, acc1 = f32x16{};
#pragma unroll
      for (int ks = 0; ks < 4; ++ks) { const bf16x8 af = tr_frag(va, ML_PV, vi, ks), b0 = tr_frag(kb, ML_PV, 2 * (wave & 1), ks), b1 = tr_frag(kb, ML_PV, 2 * (wave & 1) + 1, ks);
          acc0 = __builtin_amdgcn_mfma_f32_32x32x16_bf16(af, b0, acc0, 0, 0, 0); acc1 = __builtin_amdgcn_mfma_f32_32x32x16_bf16(af, b1, acc1, 0, 0, 0); }
#pragma unroll
      for (int q = 0; q < 16; ++q) { LAS bf16* cp = ct + (32 * vi + crow16(q, hh)) * (ML_PQ / 2) + 64 * (wave & 1) + r; cp[0] = (bf16)f2bf(acc0[q]); cp[32] = (bf16)f2bf(acc1[q]); } }
    if (tid < 128) { float sacc = 0.f;
#pragma unroll 8
        for (int s2 = 0; s2 < 64; ++s2) sacc += __uint_as_float((unsigned)(*(const LAS bf16*)(lds + MA_KW + s2 * ML_PV + 2 * tid)) << 16);
        ct[128 * (ML_PQ / 2) + tid] = (bf16)f2bf(sacc); }
    __syncthreads();
    bf16* dst = CL + (size_t)u * ML_CLE;
    for (int i = tid; i < 129 * 16; i += NWAVES * 64) { const int row = i >> 4, pc = i & 15; *(v4u*)(dst + row * 128 + pc * 8) = *(const LAS v4u*)(lds + MA_CT + row * ML_PQ + pc * 16); }
}

__device__ __forceinline__ void mlstm_B(bf16* CL, float* MSC, int tid, int vcu, int G) {
    constexpr int PCS = ML_CLE / 8;
    for (int item = vcu * (NWAVES * 64) + tid; item < 64 * PCS; item += G * NWAVES * 64) {
        const int bh = item / PCS, pc = item % PCS;
        bf16* base = CL + (size_t)bh * 32 * ML_CLE + pc * 8; float* ms = MSC + (size_t)bh * 32 * 4;
        float cst[8];
#pragma unroll
        for (int e = 0; e < 8; ++e) cst[e] = 0.f;
        float m = 0.f;
#pragma unroll 1
        for (int k0 = 0; k0 < 32; k0 += 8) {
            v4u x[8]; float ak[8], tk[8];
#pragma unroll
            for (int k = 0; k < 8; ++k) { x[k] = *(const v4u*)(base + (size_t)(k0 + k) * ML_CLE); ak[k] = ms[(k0 + k) * 4 + 0]; tk[k] = ms[(k0 + k) * 4 + 1]; }
#pragma unroll
            for (int k = 0; k < 8; ++k) {
                const float Mx = fmaxf(m, ak[k]), dec = __expf(m - Mx), w = __expf(ak[k] - Mx);
                v4u o; o.x = pk2(cst[0], cst[1]); o.y = pk2(cst[2], cst[3]); o.z = pk2(cst[4], cst[5]); o.w = pk2(cst[6], cst[7]);
                *(v4u*)(base + (size_t)(k0 + k) * ML_CLE) = o;
                if (pc == 0) ms[(k0 + k) * 4 + 2] = m;
                cst[0] = dec * cst[0] + w * bf_lo(x[k].x); cst[1] = dec * cst[1] + w * bf_hi(x[k].x); cst[2] = dec * cst[2] + w * bf_lo(x[k].y); cst[3] = dec * cst[3] + w * bf_hi(x[k].y);
                cst[4] = dec * cst[4] + w * bf_lo(x[k].z); cst[5] = dec * cst[5] + w * bf_hi(x[k].z); cst[6] = dec * cst[6] + w * bf_lo(x[k].w); cst[7] = dec * cst[7] + w * bf_hi(x[k].w);
                m = tk[k] + Mx; }
        }
    }
}

struct CReg { v4u cl[5]; v4u kc[2]; v4u vv[2]; v4u qx[2][4]; v4u om[2]; float ig, lf, mp; };
__device__ __forceinline__ void mlstm_C_load(CReg& R, int u, const bf16* QM, const bf16* KC, const bf16* VM, const bf16* OM, const float* IG, const float* LF, const bf16* CL, const float* MSC,
                                             int tid, int lane, int wave) {
    const int c = u & 31, hd = (u >> 5) & 3, b = u >> 7; const size_t rowb = (size_t)b * SEQ, t0 = rowb + 64 * c;
    const bf16* src = CL + (size_t)u * ML_CLE;
#pragma unroll
    for (int k = 0; k < 5; ++k) { const int i = tid + 512 * k; R.cl[k] = (v4u){0u, 0u, 0u, 0u}; if (i < 129 * 16) R.cl[k] = *(const v4u*)(src + (i >> 4) * 128 + (i & 15) * 8); }
#pragma unroll
    for (int it = 0; it < 2; ++it) { const int idx = tid + 512 * it, t = (idx >> 4) & 63, g = idx & 15;
        R.kc[it] = *(const v4u*)(KC + ((size_t)u * 64 + t) * 128 + 8 * g); R.vv[it] = *(const v4u*)(VM + (t0 + t) * 512 + hd * 128 + 8 * g);
        load_taps(R.qx[it], QM + rowb * 512 + hd * 128 + 8 * g, 64 * c + t); }
    { const int ot = tid >> 3, op8 = tid & 7; R.om[0] = *(const v4u*)(OM + (t0 + ot) * 512 + hd * 128 + 16 * op8); R.om[1] = *(const v4u*)(OM + (t0 + ot) * 512 + hd * 128 + 16 * op8 + 8); }
    R.ig = 0.f; R.lf = 0.f; R.mp = 0.f; if (wave == 0) { R.ig = IG[(t0 + lane) * 4 + hd]; R.lf = LF[(t0 + lane) * 4 + hd]; R.mp = MSC[(size_t)u * 4 + 2]; }
}
__device__ __forceinline__ void mlstm_C(LAS unsigned char* lds, int u, int u_next, CReg& R, const bf16* QM, const bf16* KC, const bf16* VM, const bf16* OM, const float* IG, const float* LF,
                                        const float* gain, const bf16* CL, const float* MSC, bf16* ATT, int tid, int lane, int wave) {
    asm volatile("" : "+v"(tid), "+v"(lane)); asm volatile("" : "+s"(wave));
    const int r = lane & 31, hh = lane >> 5, c = u & 31, hd = (u >> 5) & 3, b = u >> 7;
    LAS float* gt = (LAS float*)(lds + MC_GT);
    const size_t rowb = (size_t)b * SEQ, t0 = rowb + 64 * c;
    __syncthreads();
#pragma unroll
    for (int k = 0; k < 5; ++k) { const int i = tid + 512 * k; if (i < 129 * 16) *(LAS v4u*)(lds + MC_CT + (i >> 4) * ML_PQ + (i & 15) * 16) = R.cl[k]; }
    if (wave == 0) {
        const float m_prev = R.mp;
        float bc = R.lf;
#pragma unroll
        for (int o = 1; o < 64; o <<= 1) { const float v = __shfl_up(bc, o); if (lane >= o) bc += v; }
        const float a = R.ig - bc; float pm = a;
#pragma unroll
        for (int o = 1; o < 64; o <<= 1) { const float v = __shfl_up(pm, o); if (lane >= o) pm = fmaxf(pm, v); }
        gt[lane] = a; gt[64 + lane] = fmaxf(m_prev, pm); gt[128 + lane] = bc;
        if (lane == 0) gt[194] = m_prev;
    }
    const int ot = tid >> 3, op8 = tid & 7;
    const v4u og0 = R.om[0], og1 = R.om[1];
#pragma unroll
    for (int it = 0; it < 2; ++it) { const int idx = tid + 512 * it, t = (idx >> 4) & 63, g = idx & 15;
        *(LAS v4u*)(lds + MC_KT + t * ML_PQ + 16 * g) = R.kc[it];
        *(LAS v4u*)(lds + MC_VS + t * ML_PV + 16 * g) = R.vv[it];
        float y[8]; conv8r(y, R.qx[it], (const LAS float*)(lds + ML_CW) + 8 * g);
        const float sc = 0.08838834764831845f;
        v4u o; o.x = pk2(y[0] * sc, y[1] * sc); o.y = pk2(y[2] * sc, y[3] * sc); o.z = pk2(y[4] * sc, y[5] * sc); o.w = pk2(y[6] * sc, y[7] * sc);
        *(LAS v4u*)(lds + MC_QT + t * ML_PQ + 16 * g) = o; }
    if (u_next >= 0) mlstm_C_load(R, u_next, QM, KC, VM, OM, IG, LF, CL, MSC, tid, lane, wave);
    __syncthreads();
    if (wave < 4) { const int ti = wave >> 1, si = wave & 1; f32x16 g = f32x16{};
        if (si <= ti) mma_tile(g, lds + MC_QT + 32 * ti * ML_PQ, ML_PQ, lds + MC_KT + 32 * si * ML_PQ, ML_PQ, 8, r, hh);
        const float as = gt[32 * si + r]; LAS bf16* sp = (LAS bf16*)(lds + MC_SS);
#pragma unroll
        for (int q = 0; q < 16; ++q) { const int tl = crow16(q, hh), t = 32 * ti + tl, s2 = 32 * si + r;
            const float v = g[q] * __expf(fminf(as - gt[64 + t], 0.f)); sp[t * (ML_PS / 2) + s2] = (bf16)f2bf((s2 <= t) ? v : 0.f); } }
    __syncthreads();
    f32x16 nm = f32x16{};
    { const int ti = wave >> 2, vi = wave & 3;
      mma_tile(nm, lds + MC_QT + 32 * ti * ML_PQ, ML_PQ, lds + MC_CT + 32 * vi * ML_PQ, ML_PQ, 8, r, hh);
      const float mp = gt[194];
#pragma unroll
      for (int q = 0; q < 16; ++q) nm[q] *= __expf(mp - gt[64 + 32 * ti + crow16(q, hh)]);
      const LAS unsigned char* vb = lds + MC_VS + tr_base(lane, ML_PV);
#pragma unroll
      for (int ks = 0; ks < 4; ++ks) { const bf16x8 av = *(const LAS bf16x8*)(lds + MC_SS + (32 * ti + r) * ML_PS + 32 * ks + 16 * hh), bv = tr_frag(vb, ML_PV, vi, ks);
          nm = __builtin_amdgcn_mfma_f32_32x32x16_bf16(av, bv, nm, 0, 0, 0); } }
    float den;
    { const v4u sw = *(const LAS v4u*)(lds + MC_SS + ot * ML_PS + 16 * op8);
      float d1 = (bf_lo(sw.x) + bf_hi(sw.x)) + (bf_lo(sw.y) + bf_hi(sw.y)) + (bf_lo(sw.z) + bf_hi(sw.z)) + (bf_lo(sw.w) + bf_hi(sw.w)), d2 = 0.f;
#pragma unroll
      for (int k = 0; k < 2; ++k) { const v4u qw = *(const LAS v4u*)(lds + MC_QT + ot * ML_PQ + 32 * op8 + 16 * k), nw = *(const LAS v4u*)(lds + MC_CT + 128 * ML_PQ + 32 * op8 + 16 * k);
          d2 += bf_lo(qw.x) * bf_lo(nw.x) + bf_hi(qw.x) * bf_hi(nw.x) + bf_lo(qw.y) * bf_lo(nw.y) + bf_hi(qw.y) * bf_hi(nw.y) + bf_lo(qw.z) * bf_lo(nw.z) + bf_hi(qw.z) * bf_hi(nw.z) + bf_lo(qw.w) * bf_lo(nw.w) + bf_hi(qw.w) * bf_hi(nw.w); }
      den = d1 + __expf(gt[194] - gt[64 + ot]) * d2;
      den += __shfl_xor(den, 1); den += __shfl_xor(den, 2); den += __shfl_xor(den, 4); }
    __syncthreads();
    { const int ti = wave >> 2, vi = wave & 3; LAS float* np = (LAS float*)(lds + MC_NUM);
#pragma unroll
      for (int q = 0; q < 16; ++q) np[(32 * ti + crow16(q, hh)) * ML_PN + 32 * vi + r] = nm[q]; }
    __syncthreads();
    { const int t = ot, p = op8; const LAS float* np = (const LAS float*)(lds + MC_NUM) + t * ML_PN;
      const float mrow = gt[128 + t] + gt[64 + t], scl = 1.f / fmaxf(fabsf(den), __expf(-mrow));
      float hv[16]; float ss = 0.f;
#pragma unroll
      for (int e = 0; e < 16; ++e) { hv[e] = np[16 * p + e] * scl; ss += hv[e] * hv[e]; }
      ss += __shfl_xor(ss, 1); ss += __shfl_xor(ss, 2); ss += __shfl_xor(ss, 4);
      const float rs = rsqrtf(ss * (1.f / 128.f) + EPS);
      const v4u o0 = og0, o1 = og1;
      const float og[16] = {bf_lo(o0.x), bf_hi(o0.x), bf_lo(o0.y), bf_hi(o0.y), bf_lo(o0.z), bf_hi(o0.z), bf_lo(o0.w), bf_hi(o0.w), bf_lo(o1.x), bf_hi(o1.x), bf_lo(o1.y), bf_hi(o1.y), bf_lo(o1.z), bf_hi(o1.z), bf_lo(o1.w), bf_hi(o1.w)};
      const float* gp = gain + hd * 128 + 16 * p;
#pragma unroll
      for (int e = 0; e < 16; ++e) hv[e] = hv[e] * rs * gp[e] * og[e];
      v4u w0, w1; w0.x = pk2(hv[0], hv[1]); w0.y = pk2(hv[2], hv[3]); w0.z = pk2(hv[4], hv[5]); w0.w = pk2(hv[6], hv[7]); w1.x = pk2(hv[8], hv[9]); w1.y = pk2(hv[10], hv[11]); w1.z = pk2(hv[12], hv[13]); w1.w = pk2(hv[14], hv[15]);
      bf16* op = ATT + (t0 + t) * 1024 + 512 + hd * 128 + 16 * p; *(v4u*)op = w0; *(v4u*)(op + 8) = w1; }
}

struct Args { const void* in[22]; float* out; unsigned char* ws; int ph_lo, ph_hi; };
__global__ void __launch_bounds__(NWAVES * 64, 2) hybrid_fwd(Args args) {
    extern __shared__ __attribute__((aligned(16))) unsigned char lds_raw[];
    LAS unsigned char* lds = (LAS unsigned char*)lds_raw;
    volatile LAS unsigned* MISC = (volatile LAS unsigned*)(lds + LDSCTL_OFF);
    const int G0 = gridDim.x, bid0 = blockIdx.x; const int vcu0 = (G0 % 8 == 0) ? (bid0 % 8) * (G0 / 8) + bid0 / 8 : bid0;
#define PHASE_BEGIN() unsigned ones_ = ~0u; asm volatile("" : "+s"(ones_)); int lane = (int)__builtin_amdgcn_mbcnt_hi(ones_, __builtin_amdgcn_mbcnt_lo(ones_, 0u)), tid = wave0 * 64 + lane; asm volatile("" : "+v"(tid), "+v"(lane)); const int wave = __builtin_amdgcn_readfirstlane(tid >> 6); \
    int G = G0, vcu = vcu0, bid = bid0; asm volatile("" : "+s"(G), "+s"(vcu), "+s"(bid)); (void)wave; (void)lane; (void)vcu; (void)bid; (void)G
    const int wave0 = __builtin_amdgcn_readfirstlane((int)threadIdx.x >> 6);
    { const int tid = threadIdx.x;
    for (int u = tid; u < (LDS_BYTES - LDSCTL_OFF) / 4; u += NWAVES * 64) ((LAS unsigned*)(lds + LDSCTL_OFF))[u] = 0u;
    __syncthreads();
    if (tid == 0) { LAS unsigned long long* pb = (LAS unsigned long long*)(lds + LDSCTL_OFF + 64);
#pragma unroll
        for (int k = 0; k < 22; ++k) pb[k] = (unsigned long long)args.in[k];
        pb[I_OUT] = (unsigned long long)args.out; pb[I_WS] = (unsigned long long)args.ws; }
    __syncthreads(); }
    const int lo = args.ph_lo, hi = args.ph_hi;
    XcdBarrier bar; bar.bar = (unsigned*)(args.ws + WS_CTL) + CW_BAR; bar.x = 0; bar.st = nullptr;
    if (hi - lo > 1) bar = xcd_barrier_post((unsigned*)(args.ws + WS_CTL) + CW_BAR, MISC + 8);
#ifndef ONLY
#define ONLY -1
#endif
#define PH_ON(c) (ONLY < 0 || ONLY == (c))
#ifndef DUP
#define DUP -1
#endif
#define REPS(c) _Pragma("unroll 1") for (int rep_ = 0; rep_ < ((DUP == (c)) ? 2 : 1); ++rep_)
#define IN(k) (lo <= (k) && (k) < hi)
#define OPAQUE_GEMM(g) asm volatile("" : "+s"(g.A), "+s"(g.Bt))
#define SEAM(k) do { if (IN(k) && IN((k) + 1)) { bar.bar = (unsigned*)(WSP() + WS_CTL) + CW_BAR; xcd_barrier(bar); } } while (0)
#define XNB   ((bf16*)(WSPG() + WS_XN))
#define MXB(o) (WSPG() + WS_MIX + (o))
#define MODB  ((float*)(WSPG() + WS_MOD))
#define SSQB  ((float*)(WSPG() + WS_SSQ))

    REPS(0) { PHASE_BEGIN(); if (PH_ON(0) && IN(0)) p0_prologue(lds, tid, lane, wave, vcu, G); }
    SEAM(0);
#if defined(DUP) && DUP == 50
    for (int xb_ = 0; xb_ < 20; ++xb_) SEAM(0);
#endif
    { PHASE_BEGIN(); if (PH_ON(1) && IN(1)) norm_phase(nullptr, FP(I_X), nullptr, nullptr, nullptr, nullptr, nullptr, FP(I_MIXPRE), MODB + 1 * D, MODB + 0 * D, XNB, lane, wave, vcu, G); }
    SEAM(1);

    for (int l = 0; l < DEPTH; ++l) {
        const int pb = 2 + 9 * l;
        if (PH_ON(2) && IN(pb + 0)) REPS(2) { PHASE_BEGIN();
            unsigned char* wl = WSP() + WS_W + (size_t)l * W_LAYER;
            pg8::Gemm g{XNB, (const bf16*)(wl + WO_IN), M, NINP, D}; OPAQUE_GEMM(g); pg8::StaticOrder S; S.init(M, NINP, G, bid);
            pg8::EpiIn E{(bf16*)MXB(MX_CQ), (bf16*)MXB(MX_K), (bf16*)MXB(MX_V), (bf16*)MXB(MX_KI), (bf16*)MXB(MX_QM), (bf16*)MXB(MX_KM), (bf16*)MXB(MX_VM), (bf16*)MXB(MX_OM), SSQB, (float*)MXB(MX_WI), (float*)MXB(MX_IG), (float*)MXB(MX_LF),
                         GPTR(const int, ldptr(lds, I_POS)), FP(I_BIG) + l * 4, FP(I_BFG) + l * 4};
            pg8::gemm_phase<pg8::EpiIn, pg8::StaticOrder, true, true>(lds, g, S, E, tid);
        }
        SEAM(pb + 0);
#ifndef SUB
#define SUB 0
#endif
#define MSCB ((float*)(WSPG() + WS_SSQ + 512 * 1024))
#define MLSTM_A_BLOCK() do { PHASE_BEGIN(); int cur_hd = -1; \
            if (SUB != 1 && vcu < 2048) { AReg RA; mlstm_A_load(RA, vcu, (const bf16*)MXB(MX_KM), (const bf16*)MXB(MX_VM), (const float*)MXB(MX_IG), (const float*)MXB(MX_LF), tid, lane, wave); \
              for (int u = vcu; u < 2048; u += G) { const int hd = (u >> 5) & 3; \
                if (hd != cur_hd) { __syncthreads(); ml_stage_cw(lds, FP(I_CONVW) + (size_t)l * 4 * 1024, FP(I_CONVB) + (size_t)l * 1024, hd, tid); cur_hd = hd; }       \
                mlstm_A(lds, u, (u + G < 2048) ? u + G : -1, RA, (const bf16*)MXB(MX_KM), (const bf16*)MXB(MX_VM), (const float*)MXB(MX_IG), (const float*)MXB(MX_LF), (bf16*)MXB(MX_KC), (bf16*)MXB(MX_CL), MSCB, tid, lane, wave); } } \
            __syncthreads(); } while (0)
        if (PH_ON(3) && IN(pb + 1)) REPS(3) { PHASE_BEGIN();
            unsigned char* wl = WSP() + WS_W + (size_t)l * W_LAYER;
            pg8::Gemm g{(const bf16*)MXB(MX_CQ), (const bf16*)(wl + WO_Q), M, 1024, QRK}; OPAQUE_GEMM(g); pg8::StaticOrder S; S.init(M, 1024, G, bid);
            pg8::EpiQ E{(bf16*)MXB(MX_Q), (bf16*)MXB(MX_QI), SSQB, GPTR(const int, ldptr(lds, I_POS)), attn_body::C2};
            pg8::gemm_phase<pg8::EpiQ, pg8::StaticOrder, true, true>(lds, g, S, E, tid);
        }
        if (PH_ON(4) && IN(pb + 1)) REPS(41) MLSTM_A_BLOCK();
        SEAM(pb + 1);
        if (PH_ON(4) && IN(pb + 2)) { PHASE_BEGIN();
            if (SUB != 1) REPS(42) mlstm_B((bf16*)MXB(MX_CL), MSCB, tid, vcu, G);
            if (SUB != 2) REPS(40) { IxReg RI = {};
#define IX_L(i) ((i) * G + (((i) & 1) ? G - 1 - vcu : vcu))
                if (IX_L(0) < BATCH * 128) indexer_load(RI, IX_L(0) & 15, 127 - (IX_L(0) >> 4), (const bf16*)MXB(MX_QI), (const bf16*)MXB(MX_KI), (const float*)MXB(MX_WI), tid, lane, wave);
                for (int i = 0; i * G < BATCH * 128; ++i) { const int L = IX_L(i), Ln = IX_L(i + 1); const bool hn = ((i + 1) * G < BATCH * 128) && (Ln < BATCH * 128);
                    if (L < BATCH * 128) indexer_unit(lds, L & 15, 127 - (L >> 4), hn ? (Ln & 15) : 0, hn ? 127 - (Ln >> 4) : -1, RI, (const bf16*)MXB(MX_QI), (const bf16*)MXB(MX_KI), (const float*)MXB(MX_WI), (unsigned long long*)MXB(MX_MASK), tid, lane, wave); }
#undef IX_L
            }
        }
        SEAM(pb + 2);
#define MLSTM_C_BLOCK() do { PHASE_BEGIN(); int cur_hd = -1; \
            if (SUB != 1 && vcu < 2048) { CReg RC; mlstm_C_load(RC, vcu, (const bf16*)MXB(MX_QM), (const bf16*)MXB(MX_KC), (const bf16*)MXB(MX_VM), (const bf16*)MXB(MX_OM), (const float*)MXB(MX_IG), (const float*)MXB(MX_LF), (const bf16*)MXB(MX_CL), MSCB, tid, lane, wave); \
              for (int u = vcu; u < 2048; u += G) { const int hd = (u >> 5) & 3; \
                if (hd != cur_hd) { __syncthreads(); ml_stage_cw(lds, FP(I_CONVW) + (size_t)l * 4 * 1024, FP(I_CONVB) + (size_t)l * 1024, hd, tid); cur_hd = hd; } \
                mlstm_C(lds, u, (u + G < 2048) ? u + G : -1, RC, (const bf16*)MXB(MX_QM), (const bf16*)MXB(MX_KC), (const bf16*)MXB(MX_VM), (const bf16*)MXB(MX_OM), (const float*)MXB(MX_IG), (const float*)MXB(MX_LF), \
                        FP(I_MLN) + (size_t)l * 512, (const bf16*)MXB(MX_CL), MSCB, XNB, tid, lane, wave); } } \
            __syncthreads(); } while (0)
        if (PH_ON(4) && IN(pb + 3)) REPS(43) MLSTM_C_BLOCK();
        if (PH_ON(5) && IN(pb + 3)) REPS(5) { PHASE_BEGIN();
            const attn_body::AttnTensors AT{(const attn_body::bf16*)MXB(MX_Q), (const attn_body::bf16*)MXB(MX_K), (const attn_body::bf16*)MXB(MX_V), (attn_body::bf16*)XNB, (const attn_body::u32x4*)MXB(MX_MASK), FP(I_ATTN) + (size_t)l * 512};
            const attn_body::StaticOrder S(G, bid);
            attn_body::attn_phase<attn_body::StaticOrder>((char*)lds_raw, AT, S, tid);
        }
        SEAM(pb + 3);
        if (PH_ON(6) && IN(pb + 4)) REPS(6) { PHASE_BEGIN();
            unsigned char* wl = WSP() + WS_W + (size_t)l * W_LAYER;
            pg8::Gemm g{XNB, (const bf16*)(wl + WO_OUT), M, D, D}; OPAQUE_GEMM(g); pg8::StaticOrder S; S.init(M, D, G, bid);
            pg8::EpiPlain E{(bf16*)MXB(MX_Y), D};
            pg8::gemm_phase<pg8::EpiPlain, pg8::StaticOrder, true, true>(lds, g, S, E, tid);
        }
        SEAM(pb + 4);
#define RES1 ((bf16*)(GPTR(unsigned char, ldptr(lds, I_OUT)) + (size_t)M * D * 2))
#define RES2 ((bf16*)MXB(256 * MiB))
        if (PH_ON(1) && IN(pb + 5)) { PHASE_BEGIN(); const float* modl = MODB + (size_t)l * BATCH * NMOD; const bool last = (l == DEPTH - 1);
            norm_phase((const bf16*)MXB(MX_Y), l == 0 ? FP(I_X) : nullptr, l == 0 ? nullptr : (const bf16*)RES1, nullptr, last ? RES2 : RES1, FP(I_MIXPOST) + (size_t)l * D, modl + 2 * D, FP(I_FFNPRE) + (size_t)l * D, modl + 4 * D, modl + 3 * D, XNB, lane, wave, vcu, G); }
        SEAM(pb + 5);
        if (PH_ON(7) && IN(pb + 6)) REPS(7) { PHASE_BEGIN();
            unsigned char* wl = WSP() + WS_W + (size_t)l * W_LAYER;
            pg8::Gemm g{XNB, (const bf16*)(wl + WO_GU), M, 2 * FF, D}; OPAQUE_GEMM(g); pg8::StaticOrder S; S.init(M, 2 * FF, G, bid);
            pg8::EpiSwiglu E{(bf16*)MXB(MX_H), FF};
            pg8::gemm_phase<pg8::EpiSwiglu, pg8::StaticOrder, true, true>(lds, g, S, E, tid);
        }
        SEAM(pb + 6);
        if (PH_ON(6) && IN(pb + 7)) REPS(8) { PHASE_BEGIN();
            unsigned char* wl = WSP() + WS_W + (size_t)l * W_LAYER;
            pg8::Gemm g{(const bf16*)MXB(MX_H), (const bf16*)(wl + WO_DN), M, D, FF}; OPAQUE_GEMM(g); pg8::StaticOrder S; S.init(M, D, G, bid);
            pg8::EpiPlain E{(bf16*)MXB(MX_Y), D};
            pg8::gemm_phase<pg8::EpiPlain, pg8::StaticOrder, true, true>(lds, g, S, E, tid);
        }
        SEAM(pb + 7);
        if (PH_ON(1) && IN(pb + 8)) { PHASE_BEGIN();
            const bool last = (l == DEPTH - 1); const float* modl = MODB + (size_t)l * BATCH * NMOD; const float* modn = MODB + (size_t)(l + 1) * BATCH * NMOD; float* outp = GPTR(float, ldptr(lds, I_OUT));
            norm_phase((const bf16*)MXB(MX_Y), nullptr, last ? (const bf16*)RES2 : (const bf16*)RES1, last ? outp : nullptr, last ? nullptr : RES1, FP(I_FFNPOST) + (size_t)l * D, modl + 5 * D,
                       last ? nullptr : FP(I_MIXPRE) + (size_t)(l + 1) * D, modn + 1 * D, modn + 0 * D, XNB, lane, wave, vcu, G);
        }
        SEAM(pb + 8);
    }
#undef IN
#undef SEAM
}

extern "C" void kernel_launch(void* const* d_in, const int* in_sizes, int n_in, void* d_out, int out_size, void* d_ws, size_t ws_size, hipStream_t stream) {
    static int grid = 0;
    if (grid == 0) {
        if (n_in != 22 || in_sizes[0] != M * D || out_size != M * D || ws_size < WS_END) { fprintf(stderr, "kernel_launch: built for 22 inputs, x/out of %d floats, >= %zu bytes of workspace; got n_in %d, in0 %d, out %d, ws %zu; nothing launched\n", M * D, (size_t)WS_END, n_in, n_in > 0 ? in_sizes[0] : -1, out_size, ws_size); grid = -1; return; }
        int dev = 0, cus = 0, per_cu = 0;
        if (hipGetDevice(&dev) != hipSuccess || hipDeviceGetAttribute(&cus, hipDeviceAttributeMultiprocessorCount, dev) != hipSuccess) { fprintf(stderr, "kernel_launch: device query failed\n"); grid = -1; return; }
        if (hipFuncSetAttribute((const void*)hybrid_fwd, hipFuncAttributeMaxDynamicSharedMemorySize, LDS_BYTES) != hipSuccess) { fprintf(stderr, "kernel_launch: hipFuncSetAttribute(%d B LDS) failed\n", LDS_BYTES); grid = -1; return; }
        if (hipOccupancyMaxActiveBlocksPerMultiprocessor(&per_cu, (const void*)hybrid_fwd, NWAVES * 64, LDS_BYTES) != hipSuccess || per_cu < 1)
            fprintf(stderr, "kernel_launch: note: occupancy query reports %d workgroups per CU\n", per_cu);
        (void)hipGetLastError();
        grid = cus;
    }
    if (grid < 0) return;
    if (hipMemsetAsync((char*)d_ws + WS_CTL, 0, CTL_ZERO_BYTES, stream) != hipSuccess) { fprintf(stderr, "kernel_launch: hipMemsetAsync failed\n"); return; }
    Args a{};
    for (int i = 0; i < 22; ++i) a.in[i] = d_in[i];
    a.out = (float*)d_out; a.ws = (unsigned char*)d_ws;
#if MK_ONE_LAUNCH
    a.ph_lo = 0; a.ph_hi = N_PHASES;
    hipLaunchKernelGGL(hybrid_fwd, dim3(grid), dim3(NWAVES * 64), LDS_BYTES, stream, a);
#else
    for (int p = 0; p < N_PHASES; ++p) { a.ph_lo = p; a.ph_hi = p + 1; hipLaunchKernelGGL(hybrid_fwd, dim3(grid), dim3(NWAVES * 64), LDS_BYTES, stream, a); }
#endif
    const hipError_t le = hipPeekAtLastError();
    if (le != hipSuccess) fprintf(stderr, "kernel_launch: launch failed: %s (grid %d x %d threads, %d B LDS)\n", hipGetErrorName(le), grid, NWAVES * 64, LDS_BYTES);
}
```

```cpp
#include <hip/hip_runtime.h>
#include <hip/hip_bf16.h>
#include <cstdio>
#include <cstdint>
#include <cmath>
namespace pg8 {
#define PG8_LAS __attribute__((address_space(3)))
typedef unsigned short bf16_t;
typedef short bf16x8 __attribute__((ext_vector_type(8)));
typedef float f32x4 __attribute__((ext_vector_type(4)));
typedef unsigned u32x4 __attribute__((ext_vector_type(4)));
constexpr int BM = 256, BK = 64, HALF = 128, HTB = HALF * BK * 2  , STAGE_BYTES = 8 * HTB, NXCD = 8, WGM = 8;

__host__ __device__ __forceinline__ int lds_byte(int r, int c) { const int st = (r >> 4) * 2 + (c >> 5), rr = r & 15, cc = c & 31, ob = rr * 64 + cc * 2; return st * 1024 + (ob ^ (((ob >> 9) & 1) << 5)); }
__host__ __device__ __forceinline__ void stage_rc(int b, int& R, int& C) { const int st = b / 1024, sb = b % 1024, swz = sb ^ (((sb >> 9) & 1) << 5); R = (st >> 1) * 16 + swz / 64; C = (st & 1) * 32 + (swz % 64) / 2; }
__host__ __device__ __forceinline__ int perm32(int rho) { const int n = rho >> 4, i = rho & 15; return 8 * (i >> 2) + 4 * n + (i & 3); }

struct Unit { int pm, pn; };
struct Gemm { const bf16_t* A; const bf16_t* Bt; int M, N, K; };

struct StaticOrder {
    int nM, nN, nwg, G, c;
    __host__ __device__ void init(int M, int N, int G_, int c_) { nM = M / BM; nN = N / BM; nwg = nM * nN; G = G_; c = c_; }
    __host__ __device__ bool next(int i, Unit& u) const {
        const long L = (long)i * G + c; if (L >= nwg) return false;
        int wgid = (int)L; { const int q = nwg / NXCD, r = nwg % NXCD, xcd = wgid % NXCD, off = wgid / NXCD; wgid = (xcd < r ? xcd * (q + 1) : r * (q + 1) + (xcd - r) * q) + off; }
        const int nig = WGM * nN, gid = wgid / nig, fm = gid * WGM, gsz = (nM - fm) < WGM ? (nM - fm) : WGM;
        u.pm = fm + ((wgid % nig) % gsz); u.pn = (wgid % nig) / gsz; return true;
    }
    __device__ __forceinline__ void a_ready(const Unit&) const {}
    __device__ __forceinline__ void done(const Unit&) const {}
};

__device__ __forceinline__ unsigned cvt_pk_bf16(float lo, float hi) { unsigned r; asm volatile("v_cvt_pk_bf16_f32 %0, %1, %2" : "=v"(r) : "v"(lo), "v"(hi)); return r; }
typedef float f32x2 __attribute__((ext_vector_type(2)));

__device__ __forceinline__ void store8(bf16_t* p, const f32x4 a, const f32x4 b) {
    u32x4 w; w.x = cvt_pk_bf16(a[0], a[1]); w.y = cvt_pk_bf16(a[2], a[3]); w.z = cvt_pk_bf16(b[0], b[1]); w.w = cvt_pk_bf16(b[2], b[3]);
#ifdef STORE_SC1
    asm volatile("global_store_dwordx4 %0, %1, off sc1\n\ts_nop 1" :: "v"(p), "v"(w) : "memory");
#else
    *(u32x4*)p = w;
#endif

}
__device__ __forceinline__ float sigmoid_f(float g) { return __builtin_amdgcn_rcpf(1.f + __builtin_amdgcn_exp2f(-1.4426950408889634f * g)); }
__device__ __forceinline__ float silu_f(float g) { return g * sigmoid_f(g); }
__device__ __forceinline__ void rope_invf(float (&invf)[4], int wc, int fq) {
    const int j = 4 * (wc & 1) + fq;
#pragma unroll
    for (int e = 0; e < 4; ++e) invf[e] = exp2f(-(float)(4 * j + e) * 0.41524101186092029f) * 0.15915494309189535f;
}
__device__ __forceinline__ void rope_sincos(float (&sn)[4], float (&cs)[4], float p, const float (&invf)[4]) {
#pragma unroll
    for (int e = 0; e < 4; ++e) { const float r = __builtin_amdgcn_fractf(p * invf[e]); sn[e] = __builtin_amdgcn_sinf(r); cs[e] = __builtin_amdgcn_cosf(r); }
}
__device__ __forceinline__ void rope_apply(f32x4& x1, f32x4& x2, const float (&sn)[4], const float (&cs)[4]) {
    f32x4 o1, o2;
#pragma unroll
    for (int e = 0; e < 4; ++e) { o1[e] = x1[e] * cs[e] - x2[e] * sn[e]; o2[e] = x2[e] * cs[e] + x1[e] * sn[e]; }
    x1 = o1; x2 = o2;
}

struct EpiIn {
    static constexpr bool PERM = true, AFTER_DRAIN = false;
    bf16_t *CQ, *K, *V, *KI, *QM, *KM, *VM, *OM; float *SSQ, *WI, *IG, *LF; const int* pos; const float *b_ig, *b_fg;
    __device__ __forceinline__ void operator()(const f32x4 (&acc)[2][2][4][2], const Unit& u, int wr, int wc, int fr, int fq) const {
        { unsigned ones_ = ~0u; asm volatile("" : "+s"(ones_)); const int ln_ = (int)__builtin_amdgcn_mbcnt_hi(ones_, __builtin_amdgcn_mbcnt_lo(ones_, 0u)); fr = ln_ & 15; fq = ln_ >> 4; }
        const int row0 = u.pm * BM + wr * 64 + fr, ct = wc * 32 + 8 * fq, pn = u.pn;
        if (pn == 0) {
#pragma unroll
            for (int ai = 0; ai < 2; ++ai)
#pragma unroll
                for (int m = 0; m < 4; ++m) { const int row = row0 + ai * HALF + m * 16; float s = 0.f;
#pragma unroll
                    for (int bj = 0; bj < 2; ++bj) { const f32x4 v0 = acc[ai][bj][m][0], v1 = acc[ai][bj][m][1];
                        s += (v0[0] * v0[0] + v0[1] * v0[1]) + (v0[2] * v0[2] + v0[3] * v0[3]) + (v1[0] * v1[0] + v1[1] * v1[1]) + (v1[2] * v1[2] + v1[3] * v1[3]);
                        store8(CQ + (size_t)row * 256 + bj * HALF + ct, v0, v1); }
                    s += __shfl_xor(s, 16); s += __shfl_xor(s, 32);
                    if (fq == 0) SSQ[(size_t)row * 4 + wc] = s; }
        } else if (pn <= 2) {
            float invf[4]; rope_invf(invf, wc, fq);
            int psv[2][4];
#pragma unroll
            for (int ai = 0; ai < 2; ++ai)
#pragma unroll
                for (int m = 0; m < 4; ++m) psv[ai][m] = pos[row0 + ai * HALF + m * 16];
#pragma unroll
            for (int ai = 0; ai < 2; ++ai)
#pragma unroll
                for (int m = 0; m < 4; ++m) { const int row = row0 + ai * HALF + m * 16; float sn[4], cs[4]; rope_sincos(sn, cs, (float)psv[ai][m], invf);
#pragma unroll
                    for (int bj = 0; bj < 2; ++bj) { f32x4 v0 = acc[ai][bj][m][0], v1 = acc[ai][bj][m][1]; rope_apply(v0, v1, sn, cs);
                        store8(K + (size_t)row * 512 + (pn - 1) * 256 + bj * HALF + ct, v0, v1); } }
        } else if (pn <= 12) {
            const int g = (pn - 3) >> 1; bf16_t* dst = (g == 0) ? V : (g == 1) ? QM : (g == 2) ? KM : (g == 3) ? VM : OM; const int cb = ((pn - 3) & 1) * 256 + ct;
#pragma unroll
            for (int ai = 0; ai < 2; ++ai)
#pragma unroll
                for (int m = 0; m < 4; ++m) { const int row = row0 + ai * HALF + m * 16;
#pragma unroll
                    for (int bj = 0; bj < 2; ++bj) { f32x4 v0 = acc[ai][bj][m][0], v1 = acc[ai][bj][m][1];
                        if (g == 4) {
#pragma unroll
                            for (int e = 0; e < 4; ++e) { v0[e] = sigmoid_f(v0[e]); v1[e] = sigmoid_f(v1[e]); } }
                        store8(dst + (size_t)row * 512 + cb + bj * HALF, v0, v1); } }
        } else {
            if (wc < 2) {
                float invf[4]; rope_invf(invf, wc, fq);
                int psv[2][4];
#pragma unroll
                for (int ai = 0; ai < 2; ++ai)
#pragma unroll
                    for (int m = 0; m < 4; ++m) psv[ai][m] = pos[row0 + ai * HALF + m * 16];
#pragma unroll
                for (int ai = 0; ai < 2; ++ai)
#pragma unroll
                    for (int m = 0; m < 4; ++m) { const int row = row0 + ai * HALF + m * 16; float sn[4], cs[4]; rope_sincos(sn, cs, (float)psv[ai][m], invf);
                        f32x4 v0 = acc[ai][0][m][0], v1 = acc[ai][0][m][1]; rope_apply(v0, v1, sn, cs); store8(KI + (size_t)row * 64 + ct, v0, v1); }
            } else if (wc == 2 && fq == 0) {
#pragma unroll
                for (int ai = 0; ai < 2; ++ai)
#pragma unroll
                    for (int m = 0; m < 4; ++m) { const int row = row0 + ai * HALF + m * 16; const float s = 0.044194173824159216f;
                        *(f32x4*)(WI + (size_t)row * 8) = acc[ai][0][m][0] * s; *(f32x4*)(WI + (size_t)row * 8 + 4) = acc[ai][0][m][1] * s; }
            } else if (wc == 2 && fq == 1) {
                const f32x4 bi = *(const f32x4*)b_ig, bf = *(const f32x4*)b_fg;
#pragma unroll
                for (int ai = 0; ai < 2; ++ai)
#pragma unroll
                    for (int m = 0; m < 4; ++m) { const int row = row0 + ai * HALF + m * 16; const f32x4 iv = acc[ai][0][m][0] + bi, fv = acc[ai][0][m][1] + bf; f32x4 lf;
#pragma unroll
                        for (int e = 0; e < 4; ++e) lf[e] = fminf(fv[e], 0.f) - 0.6931471805599453f * __builtin_amdgcn_logf(1.f + __builtin_amdgcn_exp2f(-1.4426950408889634f * fabsf(fv[e])));
                        *(f32x4*)(IG + (size_t)row * 4) = iv; *(f32x4*)(LF + (size_t)row * 4) = lf; }
            }
        }
    }
};

struct EpiQ {
    static constexpr bool PERM = true, AFTER_DRAIN = false;
    bf16_t *Q, *QI; const float* SSQ; const int* pos; float qscale;
    __device__ __forceinline__ void operator()(const f32x4 (&acc)[2][2][4][2], const Unit& u, int wr, int wc, int fr, int fq) const {
        { unsigned ones_ = ~0u; asm volatile("" : "+s"(ones_)); const int ln_ = (int)__builtin_amdgcn_mbcnt_hi(ones_, __builtin_amdgcn_mbcnt_lo(ones_, 0u)); fr = ln_ & 15; fq = ln_ >> 4; }
        const int row0 = u.pm * BM + wr * 64 + fr, ct = wc * 32 + 8 * fq, pn = u.pn;
        float invf[4]; rope_invf(invf, wc, fq);
        bf16_t* dst = (pn < 2) ? Q + pn * 256 : QI + (pn - 2) * 256; const float sc = (pn < 2) ? qscale : 1.f;
#pragma unroll
        for (int ai = 0; ai < 2; ++ai) {
            float rsv[4]; int psv[4];
#pragma unroll
            for (int m = 0; m < 4; ++m) { const int row = row0 + ai * HALF + m * 16; const f32x4 ss = *(const f32x4*)(SSQ + (size_t)row * 4); psv[m] = pos[row]; rsv[m] = ((ss[0] + ss[1]) + (ss[2] + ss[3])) * (1.f / 256.f) + 1e-6f; }
#pragma unroll
            for (int m = 0; m < 4; ++m) { const int row = row0 + ai * HALF + m * 16;
                const float rstd = rsqrtf(rsv[m]);
                float sn[4], cs[4]; rope_sincos(sn, cs, (float)psv[m], invf);
#pragma unroll
                for (int bj = 0; bj < 2; ++bj) { f32x4 v0 = acc[ai][bj][m][0] * rstd, v1 = acc[ai][bj][m][1] * rstd; rope_apply(v0, v1, sn, cs);
                    store8(dst + (size_t)row * 512 + bj * HALF + ct, v0 * sc, v1 * sc); } } }
    }
};

struct EpiPlain {
    static constexpr bool PERM = true, AFTER_DRAIN = false;
    bf16_t* O; int ldc;
    __device__ __forceinline__ void operator()(const f32x4 (&acc)[2][2][4][2], const Unit& u, int wr, int wc, int fr, int fq) const {
        { unsigned ones_ = ~0u; asm volatile("" : "+s"(ones_)); const int ln_ = (int)__builtin_amdgcn_mbcnt_hi(ones_, __builtin_amdgcn_mbcnt_lo(ones_, 0u)); fr = ln_ & 15; fq = ln_ >> 4; }
        const int row0 = u.pm * BM + wr * 64 + fr, col0 = u.pn * BM + wc * 32 + 8 * fq;
#pragma unroll
        for (int ai = 0; ai < 2; ++ai)
#pragma unroll
            for (int m = 0; m < 4; ++m) { bf16_t* rowp = O + (size_t)(row0 + ai * HALF + m * 16) * ldc + col0;
#pragma unroll
                for (int bj = 0; bj < 2; ++bj) store8(rowp + bj * HALF, acc[ai][bj][m][0], acc[ai][bj][m][1]); }
    }
};

struct EpiSwiglu {
    static constexpr bool PERM = true, AFTER_DRAIN = false;
    bf16_t* H; int ldc;
    __device__ __forceinline__ void operator()(const f32x4 (&acc)[2][2][4][2], const Unit& u, int wr, int wc, int fr, int fq) const {
        { unsigned ones_ = ~0u; asm volatile("" : "+s"(ones_)); const int ln_ = (int)__builtin_amdgcn_mbcnt_hi(ones_, __builtin_amdgcn_mbcnt_lo(ones_, 0u)); fr = ln_ & 15; fq = ln_ >> 4; }
        const int row0 = u.pm * BM + wr * 64 + fr, col0 = u.pn * HALF + wc * 32 + 8 * fq;
#pragma unroll
        for (int ai = 0; ai < 2; ++ai)
#pragma unroll
            for (int m = 0; m < 4; ++m) { f32x4 o0, o1;
#pragma unroll
                for (int e = 0; e < 4; ++e) { o0[e] = silu_f(acc[ai][0][m][0][e]) * acc[ai][1][m][0][e]; o1[e] = silu_f(acc[ai][0][m][1][e]) * acc[ai][1][m][1][e]; }
                store8(H + (size_t)(row0 + ai * HALF + m * 16) * ldc + col0, o0, o1); }
    }
};

template <class Epi, class Sched, bool ALIGN_EPI = false, bool SP2 = false>
__device__ __forceinline__ void gemm_phase(PG8_LAS unsigned char* lds, const Gemm g, const Sched& S, const Epi& E, int tid_in  ) {
    int tid_o = tid_in; asm volatile("" : "+v"(tid_o));
    const int tid = tid_o, wid = __builtin_amdgcn_readfirstlane(tid >> 6), lane = tid & 63, wr = wid >> 2, wc = wid & 3, fr = lane & 15, fq = lane >> 4;
    const int K = g.K, nt = K / BK;
    unsigned voffA[2], voffB[2];
#pragma unroll
    for (int i = 0; i < 2; ++i) { int R, C; stage_rc(tid * 16 + i * 8192, R, C); const int Rb = Epi::PERM ? ((R & ~31) + perm32(R & 31)) : R;
        voffA[i] = (unsigned)(R * K + C) * 2u; voffB[i] = (unsigned)(Rb * K + C) * 2u; }
    const size_t kstep = (size_t)(BK * 2);
    const size_t hstep = (size_t)HALF * K * 2;
    const size_t tstep = 2 * hstep;
    const unsigned ldsw = (unsigned)wid * 1024u;
    const int aoff = lds_byte(wr * 64 + fr, fq * 8), boff = lds_byte(wc * 32 + fr, fq * 8);
#define PG8_SA(b, h) (((b) * 2 + (h)) * HTB)
#define PG8_SB(b, h) ((4 + (b) * 2 + (h)) * HTB)
#define PG8_STAGE(bufoff, gbase, voff) do { _Pragma("unroll") for (int _i = 0; _i < 2; ++_i) \
        __builtin_amdgcn_global_load_lds((const unsigned*)((const char*)(gbase) + (voff)[_i]), (PG8_LAS unsigned*)(lds + (bufoff) + ldsw + _i * 8192), 16, 0, 0); } while (0)
#define PG8_LDA(dst, b, h) do { _Pragma("unroll") for (int m = 0; m < 4; ++m) _Pragma("unroll") for (int k = 0; k < 2; ++k) dst[m][k] = *(const PG8_LAS bf16x8*)(lds + PG8_SA(b, h) + aoff + m * 2048 + k * 1024); } while (0)
#define PG8_LDB(dst, b, h) do { _Pragma("unroll") for (int n = 0; n < 2; ++n) _Pragma("unroll") for (int k = 0; k < 2; ++k) dst[n][k] = *(const PG8_LAS bf16x8*)(lds + PG8_SB(b, h) + boff + n * 2048 + k * 1024); } while (0)
#define PG8_MMA(ai, bj, At, Bt) do { __builtin_amdgcn_s_setprio(1); _Pragma("unroll") for (int m = 0; m < 4; ++m) _Pragma("unroll") for (int n = 0; n < 2; ++n) _Pragma("unroll") for (int k = 0; k < 2; ++k) \
        acc[ai][bj][m][n] = __builtin_amdgcn_mfma_f32_16x16x32_bf16(Bt[n][k], At[m][k], acc[ai][bj][m][n], 0, 0, 0); __builtin_amdgcn_s_setprio(0); } while (0)
#define PG8_WAIT_V(n) asm volatile("s_waitcnt vmcnt(" #n ")" ::: "memory")
#define PG8_WAIT_L(n) asm volatile("s_waitcnt lgkmcnt(" #n ")" ::: "memory")
#define PG8_BAR __builtin_amdgcn_s_barrier()
#define PG8_SCHED __builtin_amdgcn_sched_barrier(0)
    Unit cur, nxt; int ui = 0;
    if (!S.next(0, cur)) return;
    f32x4 acc[2][2][4][2];
#pragma unroll
    for (int a = 0; a < 2; ++a)
#pragma unroll
        for (int b = 0; b < 2; ++b)
#pragma unroll
            for (int m = 0; m < 4; ++m)
#pragma unroll
                for (int n = 0; n < 2; ++n) acc[a][b][m][n] = (f32x4){0.f, 0.f, 0.f, 0.f};
    bf16x8 At[4][2], B0[2][2], B1[2][2];
    const char* cA = (const char*)g.A + (size_t)cur.pm * tstep; const char* cB = (const char*)g.Bt + (size_t)cur.pn * tstep;
    S.a_ready(cur);
    if constexpr (SP2) {
        PG8_STAGE(PG8_SB(0, 0), cB, voffB); PG8_STAGE(PG8_SB(0, 1), cB + hstep, voffB); PG8_STAGE(PG8_SA(0, 0), cA, voffA); PG8_STAGE(PG8_SA(0, 1), cA + hstep, voffA);
        if (wr == 1) PG8_BAR;
        PG8_WAIT_V(2); PG8_BAR;
        PG8_STAGE(PG8_SB(1, 0), cB + kstep, voffB); PG8_STAGE(PG8_SA(1, 0), cA + kstep, voffA); PG8_STAGE(PG8_SB(1, 1), cB + hstep + kstep, voffB);
        PG8_WAIT_V(6); PG8_BAR;
    } else {
        PG8_STAGE(PG8_SB(0, 0), cB, voffB); PG8_STAGE(PG8_SA(0, 0), cA, voffA); PG8_STAGE(PG8_SB(0, 1), cB + hstep, voffB); PG8_STAGE(PG8_SA(0, 1), cA + hstep, voffA);
        if (wr == 1) PG8_BAR;
        PG8_WAIT_V(4); PG8_BAR;
        PG8_STAGE(PG8_SB(1, 0), cB + kstep, voffB); PG8_STAGE(PG8_SA(1, 0), cA + kstep, voffA); PG8_STAGE(PG8_SB(1, 1), cB + hstep + kstep, voffB);
        PG8_WAIT_V(6); PG8_BAR;
    }
    for (;;) {
        const bool has_next = S.next(ui + 1, nxt);
        const char* nA = has_next ? (const char*)g.A + (size_t)nxt.pm * tstep : cA; const char* nB = has_next ? (const char*)g.Bt + (size_t)nxt.pn * tstep : cB;
        for (int t = 0; t < nt; t += 2) {
            const bool last = (t == nt - 2);
            const char* a1 = cA + (size_t)(t + 1) * kstep;
            const char* a2 = last ? nA : cA + (size_t)(t + 2) * kstep; const char* b2 = last ? nB : cB + (size_t)(t + 2) * kstep;
            const char* a3 = a2 + kstep; const char* b3 = b2 + kstep;
            if (last && has_next) S.a_ready(nxt);
            if constexpr (SP2) {
            PG8_LDB(B0, 0, 0); PG8_LDB(B1, 0, 1); PG8_SCHED; PG8_LDA(At, 0, 0); PG8_STAGE(PG8_SA(1, 1), a1 + hstep, voffA);
            PG8_WAIT_V(8); PG8_WAIT_L(0); PG8_BAR; PG8_MMA(0, 0, At, B0); PG8_MMA(0, 1, At, B1); PG8_BAR; PG8_SCHED;
            PG8_LDA(At, 0, 1); PG8_STAGE(PG8_SB(0, 0), b2, voffB); PG8_STAGE(PG8_SB(0, 1), b2 + hstep, voffB); PG8_STAGE(PG8_SA(0, 0), a2, voffA);
            PG8_WAIT_V(8); PG8_WAIT_L(0); PG8_BAR; PG8_MMA(1, 0, At, B0); PG8_MMA(1, 1, At, B1); PG8_BAR; PG8_SCHED;
            PG8_LDB(B0, 1, 0); PG8_LDB(B1, 1, 1); PG8_SCHED; PG8_LDA(At, 1, 0); PG8_STAGE(PG8_SA(0, 1), a2 + hstep, voffA);
            PG8_WAIT_V(8); PG8_WAIT_L(0); PG8_BAR; PG8_MMA(0, 0, At, B0); PG8_MMA(0, 1, At, B1); PG8_BAR; PG8_SCHED;
            PG8_LDA(At, 1, 1); PG8_STAGE(PG8_SB(1, 0), b3, voffB); PG8_STAGE(PG8_SB(1, 1), b3 + hstep, voffB); PG8_STAGE(PG8_SA(1, 0), a3, voffA);
            PG8_WAIT_V(8); PG8_WAIT_L(0); PG8_BAR; PG8_MMA(1, 0, At, B0); PG8_MMA(1, 1, At, B1); PG8_BAR; PG8_SCHED;
            } else {
            PG8_LDB(B0, 0, 0); PG8_SCHED; PG8_LDA(At, 0, 0); PG8_STAGE(PG8_SA(1, 1), a1 + hstep, voffA);
            PG8_WAIT_L(8); PG8_BAR; PG8_WAIT_L(0); PG8_MMA(0, 0, At, B0); PG8_BAR; PG8_SCHED;
            PG8_LDB(B1, 0, 1); PG8_STAGE(PG8_SB(0, 0), b2, voffB);
            PG8_BAR; PG8_WAIT_L(0); PG8_MMA(0, 1, At, B1); PG8_BAR;
            PG8_LDA(At, 0, 1); PG8_STAGE(PG8_SA(0, 0), a2, voffA);
            PG8_BAR; PG8_WAIT_L(0); PG8_MMA(1, 0, At, B0); PG8_BAR; PG8_SCHED;
            PG8_STAGE(PG8_SB(0, 1), b2 + hstep, voffB);
            PG8_WAIT_V(6); PG8_BAR; PG8_MMA(1, 1, At, B1); PG8_BAR;
            PG8_LDB(B0, 1, 0); PG8_SCHED; PG8_LDA(At, 1, 0); PG8_STAGE(PG8_SA(0, 1), a2 + hstep, voffA);
            PG8_WAIT_L(8); PG8_BAR; PG8_WAIT_L(0); PG8_MMA(0, 0, At, B0); PG8_BAR; PG8_SCHED;
            PG8_LDB(B1, 1, 1); PG8_STAGE(PG8_SB(1, 0), b3, voffB);
            PG8_BAR; PG8_WAIT_L(0); PG8_MMA(0, 1, At, B1); PG8_BAR;
            PG8_LDA(At, 1, 1); PG8_STAGE(PG8_SA(1, 0), a3, voffA);
            PG8_BAR; PG8_WAIT_L(0); PG8_MMA(1, 0, At, B0); PG8_BAR; PG8_SCHED;
            PG8_STAGE(PG8_SB(1, 1), b3 + hstep, voffB);
            PG8_WAIT_V(6); PG8_BAR; PG8_MMA(1, 1, At, B1); PG8_BAR;
            }
        }
        if constexpr (ALIGN_EPI) { if (wr == 0) PG8_BAR; }
        if constexpr (!Epi::AFTER_DRAIN) { E(acc, cur, wr, wc, fr, fq); S.done(cur); }
        if (!has_next) break;
#pragma unroll
        for (int a = 0; a < 2; ++a)
#pragma unroll
            for (int b = 0; b < 2; ++b)
#pragma unroll
                for (int m = 0; m < 4; ++m)
#pragma unroll
                    for (int n = 0; n < 2; ++n) acc[a][b][m][n] = (f32x4){0.f, 0.f, 0.f, 0.f};
        cur = nxt; cA = nA; cB = nB; ++ui;
        if constexpr (ALIGN_EPI) { if (wr == 1) PG8_BAR; }
    }
    PG8_WAIT_V(0);
    if constexpr (!ALIGN_EPI) { if (wr == 0) PG8_BAR; }
    PG8_BAR;
    if constexpr (Epi::AFTER_DRAIN) { E.fused(acc, cur, wr, wc, fr, fq, lds, wid, lane); S.done(cur); }
#undef PG8_SA
#undef PG8_SB
#undef PG8_STAGE
#undef PG8_LDA
#undef PG8_LDB
#undef PG8_MMA
#undef PG8_WAIT_V
#undef PG8_WAIT_L
#undef PG8_BAR
#undef PG8_SCHED
}
}
namespace attn_body {
using bf16=__hip_bfloat16;
using bf16x8=__attribute__((ext_vector_type(8)))short;
using s16x4=__attribute__((ext_vector_type(4)))short;
using f32x16=__attribute__((ext_vector_type(16)))float;
using u32x4=__attribute__((ext_vector_type(4)))unsigned;
constexpr int BATCH=16,NHEAD=8,SEQ=2048,D=64,DM=NHEAD*D,DMO=1024;
constexpr int NW=8,QBLK=32,QB=QBLK*NW,KVBLK=64,NQB=SEQ/QB;
constexpr int ATTN_PITCH=DM, ATTN_UNIT_ROWS=QB;
__device__ __forceinline__ int crow(int r,int hi){return (r&3)+8*(r>>2)+4*hi;}
#define SBAR() __builtin_amdgcn_sched_barrier(0)
__device__ __forceinline__ void cmask(f32x16&p0,f32x16&p1,int jb,int qrel,int hi){
  const float NEG=-INFINITY; int kb=64*jb+4*hi;
  #pragma unroll
  for(int r=0;r<16;++r){int kv=kb+(r&3)+8*(r>>2); if(kv>qrel)p0[r]=NEG; if(kv+32>qrel)p1[r]=NEG;}
}

__device__ __forceinline__ void bmask(f32x16&p0,f32x16&p1,unsigned long long mw,int hi){
  const unsigned lo=(unsigned)mw>>(4*hi), up=(unsigned)(mw>>32)>>(4*hi);
  #pragma unroll
  for(int r=0;r<16;++r){ const int ps=(r&3)+8*(r>>2);
    const unsigned x0=(unsigned)__builtin_amdgcn_sbfe((int)lo,ps,1), x1=(unsigned)__builtin_amdgcn_sbfe((int)up,ps,1);
    p0[r]=__uint_as_float((__float_as_uint(p0[r])&x0)|(0xFF800000u&~x0)); p1[r]=__uint_as_float((__float_as_uint(p1[r])&x1)|(0xFF800000u&~x1)); }
}
constexpr int NSLOT=3, SLOTB=8192;
constexpr int LDS_K=0, LDS_V=NSLOT*SLOTB, LDS_WS=2*NSLOT*SLOTB, LDS_OST=LDS_WS+NW*64*4, LDS_MASK=LDS_OST+NW*4096, LDS_BYTES=LDS_MASK+32*256*8;
constexpr float C2=0.125f*1.4426950408889634f;
__device__ __forceinline__ void glds16(const void*gsrc,unsigned lds_dst){unsigned keep;
  asm volatile("s_mov_b32 %0, m0\n\ts_mov_b32 m0, %2\n\ts_nop 0\n\tglobal_load_lds_dwordx4 %1, off\n\ts_mov_b32 m0, %0":"=&s"(keep):"v"(gsrc),"s"(lds_dst):"memory");}
__device__ __forceinline__ float max3f(float a,float b,float c){float r;asm("v_max3_f32 %0, %1, %2, %3":"=v"(r):"v"(a),"v"(b),"v"(c));return r;}
__device__ __forceinline__ float max2f(float a,float b){float r;asm("v_max_f32_e32 %0, %1, %2":"=v"(r):"v"(a),"v"(b));return r;}
__device__ __forceinline__ float fadd_s(float a,float b){float r;asm("v_add_f32_e32 %0, %1, %2":"=v"(r):"v"(a),"v"(b));return r;}
__device__ __forceinline__ float fsub_s(float a,float b){float r;asm("v_sub_f32_e32 %0, %1, %2":"=v"(r):"v"(a),"v"(b));return r;}
typedef float f32x2_t __attribute__((ext_vector_type(2))); typedef __bf16 bf16x2_t __attribute__((ext_vector_type(2)));
__device__ __forceinline__ unsigned cvtpk_s(float lo,float hi){f32x2_t v={lo,hi};bf16x2_t b=__builtin_convertvector(v,bf16x2_t);return __builtin_bit_cast(unsigned,b);}
#define WAIT_BAR(N) asm volatile("s_waitcnt vmcnt(" #N ") lgkmcnt(0)\n\ts_barrier":::"memory")

__device__ __forceinline__ void qkt(f32x16&p0,f32x16&p1,const char*Kslot,const bf16x8*qr,const f32x16&negm,int r32,int hi){
  const char*kb=Kslot+hi*1024+r32*16;
  #pragma unroll
  for(int d0=0;d0<4;++d0){
    const bf16x8 b0=*reinterpret_cast<const bf16x8*>(kb+d0*2048);
    const bf16x8 b1=*reinterpret_cast<const bf16x8*>(kb+d0*2048+512);
    if(d0==0){p0=__builtin_amdgcn_mfma_f32_32x32x16_bf16(b0,qr[0],negm,0,0,0);p1=__builtin_amdgcn_mfma_f32_32x32x16_bf16(b1,qr[0],negm,0,0,0);}
    else{p0=__builtin_amdgcn_mfma_f32_32x32x16_bf16(b0,qr[d0],p0,0,0,0);p1=__builtin_amdgcn_mfma_f32_32x32x16_bf16(b1,qr[d0],p1,0,0,0);}}
}
typedef __attribute__((address_space(3))) const char* lds_cptr;
typedef short v4i16_t __attribute__((ext_vector_type(4)));
__device__ __forceinline__ void kload8(bf16x8*kf,lds_cptr kp){
  kf[0]=*(const __attribute__((address_space(3))) bf16x8*)(kp);      kf[1]=*(const __attribute__((address_space(3))) bf16x8*)(kp+512);
  kf[2]=*(const __attribute__((address_space(3))) bf16x8*)(kp+2048); kf[3]=*(const __attribute__((address_space(3))) bf16x8*)(kp+2560);
  kf[4]=*(const __attribute__((address_space(3))) bf16x8*)(kp+4096); kf[5]=*(const __attribute__((address_space(3))) bf16x8*)(kp+4608);
  kf[6]=*(const __attribute__((address_space(3))) bf16x8*)(kp+6144); kf[7]=*(const __attribute__((address_space(3))) bf16x8*)(kp+6656);
}
__device__ __forceinline__ void kload2(bf16x8*kf,lds_cptr kp,int j){ kf[2*j]=*(const __attribute__((address_space(3))) bf16x8*)(kp+j*2048); kf[2*j+1]=*(const __attribute__((address_space(3))) bf16x8*)(kp+j*2048+512); }
__device__ __forceinline__ s16x4 vtr(lds_cptr p){ return __builtin_bit_cast(s16x4,__builtin_amdgcn_ds_read_tr16_b64_v4i16((__attribute__((address_space(3))) v4i16_t*)p)); }
__device__ __forceinline__ float rowmax(const f32x16&p0,const f32x16&p1){
  float a=max3f(p0[0],p0[1],p1[0]),b=max3f(p0[2],p0[3],p1[1]);a=max3f(a,p1[2],p1[3]);
  #pragma unroll
  for(int r=4;r<16;r+=4){a=max3f(a,p0[r],p0[r+1]);b=max3f(b,p0[r+2],p0[r+3]);a=max3f(a,p1[r],p1[r+1]);b=max3f(b,p1[r+2],p1[r+3]);}
  const float m=max2f(a,b);
  auto rr=__builtin_amdgcn_permlane32_swap(__float_as_uint(m),__float_as_uint(m),false,false);
  return max2f(__uint_as_float(rr[0]),__uint_as_float(rr[1]));
}
__device__ __forceinline__ void pv(f32x16*o,int vb,bf16x8 pa0,bf16x8 pa1,bf16x8 pa2,bf16x8 pa3){
  #pragma unroll
  for(int d0=0;d0<2;++d0){s16x4 lo[4],hi[4];
    #pragma unroll
    for(int ks=0;ks<4;++ks){
      asm volatile("ds_read_b64_tr_b16 %0,%1 offset:%c2":"=&v"(lo[ks]):"v"(vb),"i"(d0*4096+ks*1024):"memory");
      asm volatile("ds_read_b64_tr_b16 %0,%1 offset:%c2":"=&v"(hi[ks]):"v"(vb),"i"(d0*4096+ks*1024+512):"memory");}
    asm volatile("s_waitcnt lgkmcnt(0)":::"memory");SBAR();
    #define PK(k) (bf16x8){lo[k][0],lo[k][1],lo[k][2],lo[k][3],hi[k][0],hi[k][1],hi[k][2],hi[k][3]}
    o[d0]=__builtin_amdgcn_mfma_f32_32x32x16_bf16(pa0,PK(0),o[d0],0,0,0);
    o[d0]=__builtin_amdgcn_mfma_f32_32x32x16_bf16(pa1,PK(1),o[d0],0,0,0);
    o[d0]=__builtin_amdgcn_mfma_f32_32x32x16_bf16(pa2,PK(2),o[d0],0,0,0);
    o[d0]=__builtin_amdgcn_mfma_f32_32x32x16_bf16(pa3,PK(3),o[d0],0,0,0);
    #undef PK
  }
}

#ifndef ATTN_STORE16
#define ATTN_STORE16(p,v) (*(u32x4*)(p)=(v))
#endif
template<int THRL> __device__ __forceinline__ void attn_unit(int b,int h,int qb,const bf16*Q,const bf16*__restrict__ K,const bf16*__restrict__ V,bf16*O,const u32x4*__restrict__ MaskG,const float*__restrict__ gain,char*shm,int tid_in){
  int tid_o=tid_in; asm volatile("":"+v"(tid_o)); const int tid=tid_o,lane=tid&63,r32=lane&31,hi=lane>>5; const int wid=__builtin_amdgcn_readfirstlane(tid>>6);
  const long rowbase=(long)b*SEQ; const int q0=qb*QB;
  const bf16*Qw=Q+(rowbase+q0+wid*QBLK)*DM+h*D;
  const bf16*Kh=K+rowbase*DM+h*D,*Vh=V+rowbase*DM+h*D;
  const unsigned lds0=(unsigned)(uintptr_t)shm;
  float*wsf=(float*)(shm+LDS_WS)+wid*64;
  const bf16*ksrc=Kh+(long)lane*DM+wid*8;
  const bf16*vsrc=Vh+(long)(16*(wid&3)+(lane>>2))*DM+(wid>>2)*32+(lane&3)*8;
  const unsigned kdst=lds0+LDS_K+wid*1024, vdst=lds0+LDS_V+wid*1024;
  #define DMA_K(t,slot) glds16(ksrc+(long)(t)*KVBLK*DM,(unsigned)__builtin_amdgcn_readfirstlane(kdst+(slot)))
  #define DMA_V(t,slot) glds16(vsrc+(long)(t)*KVBLK*DM,(unsigned)__builtin_amdgcn_readfirstlane(vdst+(slot)))
  const int vb0=(int)(lds0+LDS_V)+((lane>>4)&1)*32+(lane&3)*8+(4*hi+((lane&15)>>2))*64;
  const char*Kbase=shm+LDS_K; bf16x8 kf[8];
  const lds_cptr shm3=(lds_cptr)shm; const lds_cptr kp0=shm3+LDS_K+hi*1024+r32*16; const lds_cptr vp0=shm3+LDS_V+((lane>>4)&1)*32+(lane&3)*8+(4*hi+((lane&15)>>2))*64;
  const int NT=(q0+QB)/KVBLK;
  DMA_K(0,0);DMA_V(0,0);DMA_K(1,SLOTB);
  { const u32x4*mg=MaskG+(long)(b*NQB+qb)*32*128;
    __attribute__((address_space(3))) u32x4*ml=(__attribute__((address_space(3))) u32x4*)((__attribute__((address_space(3))) char*)shm+LDS_MASK);
    u32x4 mv[8];
    _Pragma("unroll") for(int k=0;k<8;++k){ const int i=tid+NW*64*k; mv[k]=u32x4{0u,0u,0u,0u}; if(i<NT*128)mv[k]=mg[i]; }
    _Pragma("unroll") for(int k=0;k<8;++k){ const int i=tid+NW*64*k; if(i<NT*128)ml[i]=mv[k]; }
    asm volatile("s_waitcnt vmcnt(0)":::"memory"); }
  bf16x8 qr[4];
  #pragma unroll
  for(int d0=0;d0<4;++d0)qr[d0]=*reinterpret_cast<const bf16x8*>(&Qw[(long)r32*DM+d0*16+hi*8]);
  float mhat=0.f,l_reg=0.f;f32x16 o[2];o[0]=f32x16{};o[1]=f32x16{};f32x16 negm=f32x16{};asm volatile("":"+v"(negm));
  const int qrel=wid*QBLK+r32;
  const lds_cptr mkp=(lds_cptr)shm+LDS_MASK+qrel*8;
  unsigned long long mwn=0ull;
  #define CMASK(P0,P1,t) do{ bmask(P0,P1,mwn,hi); mwn=*(const __attribute__((address_space(3))) unsigned long long*)(mkp+((t)+1)*2048); }while(0)
  bool resc=false;
  #define START(P0,P1) do{ const float rm=rowmax(P0,P1); resc=false; \
    { const float dl=max2f(rm,-256.f); mhat=fadd_s(mhat,dl); \
      _Pragma("unroll") for(int r=0;r<16;++r){P0[r]=fsub_s(P0[r],dl);P1[r]=fsub_s(P1[r],dl);} \
      _Pragma("unroll") for(int r=0;r<16;++r)negm[r]=-mhat; asm volatile("":"+v"(negm)); } \
    _Pragma("unroll") for(int r=0;r<16;++r)P0[r]=__builtin_amdgcn_exp2f(P0[r]); }while(0)
  #define RESC() do{ if(resc){ asm volatile("s_waitcnt lgkmcnt(0)":::"memory"); \
      _Pragma("unroll") for(int d_=0;d_<2;++d_) _Pragma("unroll") for(int r=0;r<16;++r)o[d_][r]*=wsf[crow(r,hi)]; } }while(0)
  f32x16 pA0,pA1,pB0,pB1;
  int sl_prev=0,sl_cur=0,sl_next=SLOTB;
  #define ROT() do{sl_prev=sl_cur;sl_cur=sl_next;sl_next=(sl_next==(NSLOT-1)*SLOTB)?0:sl_next+SLOTB;}while(0)
  DMA_K(2,2*SLOTB);
  WAIT_BAR(3);
  mwn=*(const __attribute__((address_space(3))) unsigned long long*)(mkp);
  qkt(pA0,pA1,Kbase,qr,negm,r32,hi);asm volatile("s_nop 15\n\ts_nop 7":"+v"(pA0),"+v"(pA1));CMASK(pA0,pA1,0);
  START(pA0,pA1);
  _Pragma("unroll") for(int r=0;r<16;++r)pA1[r]=__builtin_amdgcn_exp2f(pA1[r]);
  WAIT_BAR(0);
  DMA_K(3,0);DMA_V(1,SLOTB);
  ROT();
  kload8(kf,kp0+sl_cur);
  WAIT_BAR(2);
  s16x4 vlo[8],vhi[8]; u32x4 pw0,pw1,pw2,pw3;
  #define PKW(P,B) cvtpk_s(P[B],P[B+1])
  #define PAF(k) __builtin_bit_cast(bf16x8,pw##k)
  #define VFR(i) (bf16x8){vlo[i][0],vlo[i][1],vlo[i][2],vlo[i][3],vhi[i][0],vhi[i][1],vhi[i][2],vhi[i][3]}
  #define PIN(x) asm volatile("":"+v"(x))
  #define MX3(a,b,c) __builtin_fmaxf(__builtin_fmaxf((a),(b)),(c))
  #define GAPA(MF,A0,A1,A2,A3,W0,W1,PW) do{ MF; sacc+=A0; sacc+=A1; sacc+=A2; sacc+=A3; PIN(sacc); W0; W1; PIN(PW); SBAR(); }while(0)
  #define EX(v) __builtin_amdgcn_exp2f(v)
  #define GAPB(MF,X,B) do{ MF; X[B]=EX(X[B]); X[B+1]=EX(X[B+1]); X[B+2]=EX(X[B+2]); X[B+3]=EX(X[B+3]); PIN(X); SBAR(); }while(0)
  #define VRD(i) do{ vlo[i]=vtr(vp_+(((i)>>2)*4096+((i)&3)*1024)); vhi[i]=vtr(vp_+(((i)>>2)*4096+((i)&3)*1024+512)); }while(0)
  #define KRD(G,j) do{ if(G){ kload2(kf,kp0+sl_next,j); SBAR(); } }while(0)
  #define STEP(C0,C1,P0,P1,t,GK,GV,GL) do{ SBAR(); \
    const lds_cptr vp_=vp0+sl_prev; \
    VRD(0); SBAR(); float sacc=(P0[0]+P0[1]); \
    GAPA(C0=__builtin_amdgcn_mfma_f32_32x32x16_bf16(kf[0],qr[0],negm,0,0,0), P0[2],P0[3],P0[4],P0[5],     pw0[0]=PKW(P0,0), pw0[1]=PKW(P0,2), pw0); \
    VRD(4); SBAR(); GAPA(C1=__builtin_amdgcn_mfma_f32_32x32x16_bf16(kf[1],qr[0],negm,0,0,0), P0[6],P0[7],P0[8],P0[9],     pw0[2]=PKW(P0,4), pw0[3]=PKW(P0,6), pw0); \
    VRD(1); SBAR(); GAPA(C0=__builtin_amdgcn_mfma_f32_32x32x16_bf16(kf[2],qr[1],C0,0,0,0),   P0[10],P0[11],P0[12],P0[13], pw1[0]=PKW(P0,8), pw1[1]=PKW(P0,10), pw1); \
    VRD(5); SBAR(); GAPA(C1=__builtin_amdgcn_mfma_f32_32x32x16_bf16(kf[3],qr[1],C1,0,0,0),   P0[14],P0[15],P1[0],P1[1],   pw1[2]=PKW(P0,12),pw1[3]=PKW(P0,14), pw1); \
    VRD(2); SBAR(); GAPA(C0=__builtin_amdgcn_mfma_f32_32x32x16_bf16(kf[4],qr[2],C0,0,0,0),   P1[2],P1[3],P1[4],P1[5],     pw2[0]=PKW(P1,0), pw2[1]=PKW(P1,2), pw2); \
    VRD(6); SBAR(); GAPA(C1=__builtin_amdgcn_mfma_f32_32x32x16_bf16(kf[5],qr[2],C1,0,0,0),   P1[6],P1[7],P1[8],P1[9],     pw2[2]=PKW(P1,4), pw2[3]=PKW(P1,6), pw2); \
    VRD(3); SBAR(); GAPA(C0=__builtin_amdgcn_mfma_f32_32x32x16_bf16(kf[6],qr[3],C0,0,0,0),   P1[10],P1[11],P1[12],P1[13], pw3[0]=PKW(P1,8), pw3[1]=PKW(P1,10), pw3); \
    VRD(7); SBAR(); GAPA(C1=__builtin_amdgcn_mfma_f32_32x32x16_bf16(kf[7],qr[3],C1,0,0,0),   P1[14],P1[15],0.f,0.f,       pw3[2]=PKW(P1,12),pw3[3]=PKW(P1,14), pw3); \
    l_reg+=sacc; \
    if(GK){DMA_K((t)+3,sl_cur);} if(GV){DMA_V((t)+1,sl_next);} \
    CMASK(C0,C1,t); \
    { float a=MX3(C0[0],C0[1],C1[0]),b=MX3(C0[2],C0[3],C1[1]); a=MX3(a,C1[2],C1[3]); \
      _Pragma("unroll") for(int r=4;r<16;r+=4){a=MX3(a,C0[r],C0[r+1]);b=MX3(b,C0[r+2],C0[r+3]);a=MX3(a,C1[r],C1[r+1]);b=MX3(b,C1[r+2],C1[r+3]);} \
      float rm=__builtin_fmaxf(a,b); { auto rr=__builtin_amdgcn_permlane32_swap(__float_as_uint(rm),__float_as_uint(rm),false,false); rm=__builtin_fmaxf(__uint_as_float(rr[0]),__uint_as_float(rr[1])); } \
      resc=false; \
      if(__builtin_expect(__any(rm>(float)THRL),0)){ const float dl=__builtin_fmaxf(rm,0.f); mhat+=dl; \
        _Pragma("unroll") for(int r=0;r<16;++r){C0[r]-=dl;C1[r]-=dl;} \
        _Pragma("unroll") for(int r=0;r<16;++r)negm[r]=-mhat; asm volatile("":"+v"(negm)); \
        const float f=__builtin_amdgcn_exp2f(-dl); l_reg*=f; if(hi==0)wsf[r32]=f; resc=true; } } \
    SBAR(); \
    GAPB(o[0]=__builtin_amdgcn_mfma_f32_32x32x16_bf16(PAF(0),VFR(0),o[0],0,0,0), C0,0); \
    GAPB(o[1]=__builtin_amdgcn_mfma_f32_32x32x16_bf16(PAF(0),VFR(4),o[1],0,0,0), C0,4); \
    KRD(GL,0); GAPB(o[0]=__builtin_amdgcn_mfma_f32_32x32x16_bf16(PAF(1),VFR(1),o[0],0,0,0), C0,8); \
    KRD(GL,1); GAPB(o[1]=__builtin_amdgcn_mfma_f32_32x32x16_bf16(PAF(1),VFR(5),o[1],0,0,0), C0,12); \
    KRD(GL,2); GAPB(o[0]=__builtin_amdgcn_mfma_f32_32x32x16_bf16(PAF(2),VFR(2),o[0],0,0,0), C1,0); \
    KRD(GL,3); GAPB(o[1]=__builtin_amdgcn_mfma_f32_32x32x16_bf16(PAF(2),VFR(6),o[1],0,0,0), C1,4); \
    GAPB(o[0]=__builtin_amdgcn_mfma_f32_32x32x16_bf16(PAF(3),VFR(3),o[0],0,0,0), C1,8); \
    GAPB(o[1]=__builtin_amdgcn_mfma_f32_32x32x16_bf16(PAF(3),VFR(7),o[1],0,0,0), C1,12); \
    }while(0)
  int t=1;
  for(;t+5<NT;t+=2){
    STEP(pB0,pB1,pA0,pA1,t,true,true,true);     WAIT_BAR(2); RESC(); ROT();
    STEP(pA0,pA1,pB0,pB1,t+1,true,true,true);   WAIT_BAR(2); RESC(); ROT();
  }
  #define ENDW(tt) do{ if((tt)+3<NT){WAIT_BAR(2);} else if((tt)+2<NT){WAIT_BAR(1);} else {WAIT_BAR(0);} }while(0)
  for(;t+1<NT;t+=2){
    STEP(pB0,pB1,pA0,pA1,t,(t+3<NT),(t+1<NT),(t+1<NT));       ENDW(t);   RESC(); ROT();
    STEP(pA0,pA1,pB0,pB1,t+1,(t+4<NT),(t+2<NT),(t+2<NT));     ENDW(t+1); RESC(); ROT();
  }
  STEP(pB0,pB1,pA0,pA1,NT-1,false,false,false); RESC();
  { float sacc=pB0[0]+pB0[1]; _Pragma("unroll") for(int r=2;r<16;++r)sacc+=pB0[r]; _Pragma("unroll") for(int r=0;r<16;++r)sacc+=pB1[r]; l_reg+=sacc;
    pw0=(u32x4){PKW(pB0,0),PKW(pB0,2),PKW(pB0,4),PKW(pB0,6)};pw1=(u32x4){PKW(pB0,8),PKW(pB0,10),PKW(pB0,12),PKW(pB0,14)};pw2=(u32x4){PKW(pB1,0),PKW(pB1,2),PKW(pB1,4),PKW(pB1,6)};pw3=(u32x4){PKW(pB1,8),PKW(pB1,10),PKW(pB1,12),PKW(pB1,14)};
    SBAR(); pv(o,vb0+sl_cur,PAF(0),PAF(1),PAF(2),PAF(3)); }
  #undef PKW
  #undef PAF
  #undef VFR
  #undef PIN
  #undef MX3
  #undef GAPA
  #undef GAPB
  #undef EX
  #undef VRD
  #undef KRD
  #undef STEP
  #undef ENDW
  {auto rr=__builtin_amdgcn_permlane32_swap(__float_as_uint(l_reg),__float_as_uint(l_reg),false,false);l_reg=__uint_as_float(rr[0])+__uint_as_float(rr[1]);}
  if(hi==0)wsf[32+r32]=l_reg;asm volatile("s_waitcnt lgkmcnt(0)":::"memory");
  float rli[16];
  #pragma unroll
  for(int r=0;r<16;++r)rli[r]=__builtin_amdgcn_rcpf(wsf[32+crow(r,hi)]);
  bf16*Ow=O+(rowbase+q0+wid*QBLK)*DMO+h*D;
  { bf16*stg=(bf16*)(shm+LDS_OST)+wid*2048;
    #pragma unroll
    for(int r=0;r<16;++r){const int orow=crow(r,hi);
      #pragma unroll
      for(int d0=0;d0<2;++d0)stg[orow*64+d0*32+r32]=__float2bfloat16(o[d0][r]*rli[r]);}
    asm volatile("s_waitcnt lgkmcnt(0)":::"memory");
    float gn[8];
    #pragma unroll
    for(int e=0;e<8;++e)gn[e]=gain[h*D+(lane&7)*8+e];
    #pragma unroll
    for(int i=0;i<4;++i){const int row=i*8+(lane>>3),ch=lane&7; const u32x4 v=*(const u32x4*)(stg+row*64+ch*8);
      float f[8]; f[0]=__uint_as_float(v.x<<16);f[1]=__uint_as_float(v.x&0xffff0000u);f[2]=__uint_as_float(v.y<<16);f[3]=__uint_as_float(v.y&0xffff0000u);
      f[4]=__uint_as_float(v.z<<16);f[5]=__uint_as_float(v.z&0xffff0000u);f[6]=__uint_as_float(v.w<<16);f[7]=__uint_as_float(v.w&0xffff0000u);
      float ss=0.f;
      #pragma unroll
      for(int e=0;e<8;++e)ss+=f[e]*f[e];
      ss+=__shfl_xor(ss,1);ss+=__shfl_xor(ss,2);ss+=__shfl_xor(ss,4);
      const float rs=rsqrtf(ss*(1.f/64.f)+1e-6f);
      u32x4 w; w.x=cvtpk_s(f[0]*rs*gn[0],f[1]*rs*gn[1]); w.y=cvtpk_s(f[2]*rs*gn[2],f[3]*rs*gn[3]); w.z=cvtpk_s(f[4]*rs*gn[4],f[5]*rs*gn[5]); w.w=cvtpk_s(f[6]*rs*gn[6],f[7]*rs*gn[7]);
      ATTN_STORE16(Ow+(long)row*DMO+ch*8,w);} }
  asm volatile("s_waitcnt lgkmcnt(0)\n\ts_barrier":::"memory");
  #undef DMA_K
  #undef DMA_V
  #undef CMASK
  #undef START
  #undef RESC
  #undef ROT
}
constexpr int ATTN_LDS_BYTES=LDS_BYTES;
struct AttnTensors { const bf16* Q; const bf16* K; const bf16* V; bf16* O; const u32x4* Mask; const float* gain; };
struct AttnUnit { int bh; int qb; };
struct StaticOrder {
  int vcu, G;
  __device__ __forceinline__ explicit StaticOrder(int grid,int block):vcu((grid%8==0)?(block%8)*(grid/8)+block/8:block),G(grid){}
  __device__ __forceinline__ bool next(int i,AttnUnit&u)const{
    if(G==256){ if(i>=4)return false; const int s=vcu&1; u.bh=vcu>>1; u.qb=(i==0)?s:(i==1)?7-s:(i==2)?3-s:4+s; return true; }
    const int L=i*G+vcu; if(L>=BATCH*NHEAD*NQB)return false; u.bh=L/NQB; u.qb=L%NQB; return true; }
  __device__ __forceinline__ void a_ready(const AttnUnit&)const{}
  __device__ __forceinline__ void done(const AttnUnit&)const{}
};
template<class Sched,int THRL=8> __device__ __forceinline__ void attn_phase(char*lds,const AttnTensors&T,const Sched&S,int tid_in){
  AttnUnit u;
  for(int i=0;S.next(i,u);++i){ S.a_ready(u); attn_unit<THRL>(u.bh/NHEAD,u.bh%NHEAD,u.qb,T.Q,T.K,T.V,T.O,T.Mask,T.gain,lds,tid_in); S.done(u); }
}
#undef SBAR
#undef WAIT_BAR
}

constexpr int NWAVES = 8;
#ifndef MK_ONE_LAUNCH
#define MK_ONE_LAUNCH 1
#endif
constexpr int BATCH = 16, SEQ = 2048, D = 1024, M = BATCH * SEQ, DEPTH = 2;
constexpr int NIN = 3408, NINP = 3584, QRK = 256, FF = 2816, NMOD = 6 * D;
constexpr float EPS = 1e-6f;
constexpr int N_PHASES = 2 + 9 * DEPTH;

constexpr size_t MiB = 1u << 20;
constexpr size_t WS_CTL = 0, CTL_ZERO_BYTES = 64 * 1024;
constexpr size_t WS_MOD = 1 * MiB;
constexpr size_t WS_SSQ = 2 * MiB;
constexpr size_t WS_W = 3 * MiB, W_LAYER = 26 * MiB;
constexpr size_t WO_IN = 0, WO_Q = 7 * MiB, WO_OUT = 7 * MiB + 512 * 1024, WO_GU = 9 * MiB + 512 * 1024, WO_DN = 20 * MiB + 512 * 1024;
constexpr size_t WS_XN = 56 * MiB;
constexpr size_t WS_MIX = 120 * MiB;
constexpr size_t MX_CQ = 0, MX_K = 16 * MiB, MX_V = 48 * MiB, MX_KI = 80 * MiB, MX_WI = 84 * MiB, MX_IG = 85 * MiB, MX_LF = 85 * MiB + 512 * 1024, MX_QM = 86 * MiB, MX_KM = 118 * MiB, MX_VM = 150 * MiB,
                 MX_OM = 182 * MiB, MX_Q = 214 * MiB, MX_QI = 246 * MiB, MX_MASK = 278 * MiB, MX_CL = 286 * MiB, MX_KC = 352 * MiB, MX_H = 0, MX_Y = 192 * MiB, MX_END = 384 * MiB;
constexpr size_t WS_END = WS_MIX + MX_END;
static_assert(WO_DN + (size_t)D * FF * 2 <= W_LAYER && WS_W + DEPTH * W_LAYER <= WS_XN && WS_XN + (size_t)M * D * 2 <= WS_MIX && (size_t)M * FF * 2 <= MX_Y && MX_Y + (size_t)M * D * 2 <= MX_CL && MX_CL + (size_t)2048 * 129 * 128 * 2 <= MX_KC && MX_KC + (size_t)2048 * 64 * 128 * 2 <= MX_END, "d_ws map");
constexpr int CW_BAR = 4096;

constexpr int RING_BYTES = 153600;
constexpr int LDSCTL_OFF = RING_BYTES, LDS_BYTES = LDSCTL_OFF + 512;
static_assert(pg8::STAGE_BYTES <= RING_BYTES && attn_body::ATTN_LDS_BYTES <= RING_BYTES && LDS_BYTES <= 160 * 1024, "LDS map");

#define GAS __attribute__((address_space(1)))
#define LAS __attribute__((address_space(3)))
typedef unsigned short bf16;
typedef unsigned v4u __attribute__((ext_vector_type(4)));
typedef float f32x4 __attribute__((ext_vector_type(4)));
typedef short bf16x8 __attribute__((ext_vector_type(8)));
typedef GAS unsigned gu32;
typedef GAS unsigned long long gu64;
#define RLX_AGENT __ATOMIC_RELAXED, __HIP_MEMORY_SCOPE_AGENT
#define LDS_WAIT() asm volatile("s_waitcnt lgkmcnt(0)" ::: "memory")
#define VM_WAIT() asm volatile("s_waitcnt vmcnt(0)" ::: "memory")
__device__ __forceinline__ unsigned long long rt() { return __builtin_amdgcn_s_memrealtime(); }
__device__ __forceinline__ unsigned f2bf(float f) { unsigned u = __builtin_bit_cast(unsigned, f); return (u + 0x7fffu + ((u >> 16) & 1u)) >> 16; }
__device__ __forceinline__ unsigned pk2(float lo, float hi) { return f2bf(lo) | (f2bf(hi) << 16); }

#define XB_TMO      128
#define XB_XCNT(j)  (256  + 64 * (j))
#define XB_XSUB(j)  (1280 + 64 * (j))
#define XB_XGEN(j)  (2304 + 64 * (j))
#define XB_TOP      3328
#define XB_TOPGEN   3392
#define XCD_BAR_WORDS 3456
#define XB_SPIN_CAP (1u << 18)

__device__ __forceinline__ unsigned xb_ld(unsigned* p)              { return __hip_atomic_load(p, __ATOMIC_RELAXED, __HIP_MEMORY_SCOPE_AGENT); }
__device__ __forceinline__ unsigned xb_add(unsigned* p, unsigned v) { return __hip_atomic_fetch_add(p, v, __ATOMIC_RELAXED, __HIP_MEMORY_SCOPE_AGENT); }
__device__ __forceinline__ unsigned xb_xcc_id() { return (unsigned)__builtin_amdgcn_s_getreg((3 << 11) | 20) & 0xFu; }
#define XB_SPIN(cond, bar) do { unsigned _sp = 0; while (cond) { __builtin_amdgcn_s_sleep(1); \
    if ((++_sp & 255u) == 0u) { if (xb_ld(&(bar)[XB_TMO])) break; if (_sp > XB_SPIN_CAP) { atomicAdd(&(bar)[XB_TMO], 1u); break; } } } } while (0)

struct XcdBarrier {
    unsigned* bar; unsigned x;
    volatile LAS unsigned* st;
};

__device__ __forceinline__ XcdBarrier xcd_barrier_post(unsigned* bar, volatile LAS unsigned* st) {
    XcdBarrier b; b.bar = bar; b.x = xb_xcc_id(); b.st = st;
    if (threadIdx.x == 0) (void)xb_add(&bar[XB_XCNT(b.x)], 1u);
    return b;
}
__device__ __forceinline__ void xcd_barrier_complete(unsigned* bar, unsigned x, unsigned& nloc, unsigned& nx) {
    const unsigned G = gridDim.x * gridDim.y * gridDim.z;
    unsigned sum, cnt, mine, sp = 0u;
    for (;;) {
        sum = 0u; cnt = 0u; mine = 0u;
#pragma unroll
        for (unsigned j = 0; j < 16; ++j) { const unsigned c = xb_ld(&bar[XB_XCNT(j)]); sum += c; cnt += (c > 0u) ? 1u : 0u; mine = (j == x) ? c : mine; }
        if (sum == G) break;
        __builtin_amdgcn_s_sleep(1);
        if ((++sp & 255u) == 0u) { if (xb_ld(&bar[XB_TMO])) break; if (sp > XB_SPIN_CAP) { atomicAdd(&bar[XB_TMO], 1u); break; } }
    }
    nloc = mine > 0u ? mine : 1u; nx = cnt > 0u ? cnt : 1u;
}

__device__ __forceinline__ void xcd_barrier(const XcdBarrier& b) {
    asm volatile("s_waitcnt vmcnt(0)" ::: "memory");
    __syncthreads();
    if (threadIdx.x == 0) {
        unsigned* bar = b.bar;
        const unsigned bx = xb_xcc_id();
        __builtin_amdgcn_s_waitcnt(0);
        unsigned nloc = b.st[0], nx = b.st[1];
        if (nloc == 0u) { xcd_barrier_complete(bar, bx, nloc, nx); b.st[0] = nloc; b.st[1] = nx; }
        const unsigned old = xb_add(&bar[XB_XSUB(bx)], 1u);
        const unsigned gen = old / nloc;
        if (old + 1u == (gen + 1u) * nloc) {
            __builtin_amdgcn_fence(__ATOMIC_RELEASE, "agent");
            asm volatile("s_waitcnt vmcnt(0)" ::: "memory");
            const unsigned og = xb_add(&bar[XB_TOP], 1u);
            const unsigned tg = og / nx;
            if (og + 1u == (tg + 1u) * nx) xb_add(&bar[XB_TOPGEN], 1u);
            else XB_SPIN(xb_ld(&bar[XB_TOPGEN]) == tg, bar);
            __builtin_amdgcn_fence(__ATOMIC_ACQUIRE, "agent");
            xb_add(&bar[XB_XGEN(bx)], 1u);
            asm volatile("s_waitcnt vmcnt(0)" ::: "memory");
        } else {
            XB_SPIN(xb_ld(&bar[XB_XGEN(bx)]) == gen, bar);
            __builtin_amdgcn_fence(__ATOMIC_ACQUIRE, "agent");
            asm volatile("s_waitcnt vmcnt(0)" ::: "memory");
        }
    }
    __syncthreads();
}

typedef float f32x16 __attribute__((ext_vector_type(16)));
typedef unsigned u32x2 __attribute__((ext_vector_type(2)));
__device__ __forceinline__ float wave_sum(float v) {
#pragma unroll
    for (int o = 1; o < 64; o <<= 1) v += __shfl_xor(v, o);
    return v;
}
__device__ __forceinline__ float bf_lo(unsigned u) { return __uint_as_float(u << 16); }
__device__ __forceinline__ float bf_hi(unsigned u) { return __uint_as_float(u & 0xffff0000u); }
__device__ __forceinline__ float sigmoid_f(float g) { return __builtin_amdgcn_rcpf(1.f + __builtin_amdgcn_exp2f(-1.4426950408889634f * g)); }
__device__ __forceinline__ float silu_f(float g) { return g * sigmoid_f(g); }
__device__ __forceinline__ int ropeperm(int p) { const int j = p >> 3, e = p & 7; return (e < 4) ? 4 * j + e : 32 + 4 * j + (e - 4); }

__device__ __forceinline__ void conv_item(int kind, const float* W0, const float* W1, const float* gain, int K, int Nphys, bf16* WT, LAS float* scr, int item, int lane) {
    const int nblk = Nphys / 32, kb = item / nblk, nb = item % nblk, k0 = 64 * kb, n0 = 32 * nb;
    const int n = n0 + (lane & 31);
    const float* src = W0; int ld = Nphys, col = n;
    if (kind == 1) {
        ld = NIN; const int tile = n >> 8, r = n & 255;
        if (tile == 0) col = r;
        else if (tile <= 2) { const int idx = (tile - 1) * 256 + r; col = 256 + (idx >> 6) * 64 + ropeperm(idx & 63); }
        else if (tile <= 4) col = 768 + (tile - 3) * 256 + r;
        else if (tile <= 12) col = 1352 + (tile - 5) * 256 + r;
        else { if (r < 64) col = 1280 + ropeperm(r); else if (r < 72) col = 1344 + (r - 64); else if (r < 76) col = 3400 + (r - 72); else if (r < 80) col = 3404 + (r - 76); else { src = nullptr; col = 0; } }
    } else if (kind == 2) {
        ld = 512; src = (n < 512) ? W0 : W1; const int idx = n & 511; col = (idx >> 6) * 64 + ropeperm(idx & 63);
    } else if (kind == 3) {
        ld = 2 * FF; col = ((n >> 7) & 1) * FF + (n >> 8) * 128 + (n & 127);
    }
    float wv[32];
#pragma unroll
    for (int i = 0; i < 32; ++i) { const int kk = 2 * i + (lane >> 5); wv[i] = src ? src[(size_t)(k0 + kk) * ld + col] : 0.f; }
#pragma unroll
    for (int i = 0; i < 32; ++i) { const int kk = 2 * i + (lane >> 5); float v = wv[i]; if (gain) v *= gain[k0 + kk]; scr[kk * 33 + (lane & 31)] = v; }
    LDS_WAIT(); asm volatile("" ::: "memory");
    const int c = lane & 7;
#pragma unroll
    for (int j = 0; j < 4; ++j) { const int nn = (lane >> 3) + 8 * j; const LAS float* s = scr + (8 * c) * 33 + nn;
        v4u o; o.x = pk2(s[0 * 33], s[1 * 33]); o.y = pk2(s[2 * 33], s[3 * 33]); o.z = pk2(s[4 * 33], s[5 * 33]); o.w = pk2(s[6 * 33], s[7 * 33]);
        *(GAS v4u*)(WT + (size_t)(n0 + nn) * K + k0 + 8 * c) = o; }
    LDS_WAIT(); asm volatile("" ::: "memory");
}

enum { I_X = 0, I_C, I_POS, I_WMOD, I_BMOD, I_MIXPRE, I_MIXPOST, I_WIN, I_QLN, I_WQUP, I_WQIUP, I_CONVW, I_CONVB, I_BIG, I_BFG, I_ATTN, I_MLN, I_WOUT, I_FFNPRE, I_FFNPOST, I_WGU, I_WDN, I_OUT, I_WS };
__device__ __forceinline__ unsigned long long ldptr(LAS unsigned char* lds, int k) {
    const volatile LAS unsigned* p = (const volatile LAS unsigned*)(lds + LDSCTL_OFF + 64 + 8 * k);
    const unsigned lo = __builtin_amdgcn_readfirstlane(p[0]), hi = __builtin_amdgcn_readfirstlane(p[1]);
    return ((unsigned long long)hi << 32) | lo;
}
#define GPTR(T, x) ((T*)(GAS T*)(x))
#define FP(k) GPTR(const float, ldptr(lds, (k)))
#define WSP() ((unsigned char*)ldptr(lds, I_WS))
#define WSPG() GPTR(unsigned char, ldptr(lds, I_WS))

__device__ __forceinline__ void p0_prologue(LAS unsigned char* lds, int tid, int lane, int wave, int vcu, int G) {
    LAS float* scr = (LAS float*)(lds + wave * 16384);
    const int gw = vcu * NWAVES + wave, NGW = G * NWAVES;
    constexpr int I_IN = (D / 64) * (NINP / 32), I_Q = (QRK / 64) * (1024 / 32), I_O = (D / 64) * (D / 32), I_GU = (D / 64) * (2 * FF / 32), I_DN = (FF / 64) * (D / 32);
    constexpr int I_LAYER = I_IN + I_Q + I_O + I_GU + I_DN;
    for (int it = gw; it < DEPTH * I_LAYER; it += NGW) {
        const int l = it / I_LAYER; int r = it % I_LAYER; unsigned char* wl = WSP() + WS_W + (size_t)l * W_LAYER;
        if (r < I_IN) { conv_item(1, FP(I_WIN) + (size_t)l * D * NIN, nullptr, nullptr, D, NINP, (bf16*)(wl + WO_IN), scr, r, lane); continue; } r -= I_IN;
        if (r < I_Q) { conv_item(2, FP(I_WQUP) + (size_t)l * QRK * 512, FP(I_WQIUP) + (size_t)l * QRK * 512, FP(I_QLN) + (size_t)l * QRK, QRK, 1024, (bf16*)(wl + WO_Q), scr, r, lane); continue; } r -= I_Q;
        if (r < I_O) { conv_item(0, FP(I_WOUT) + (size_t)l * D * D, nullptr, nullptr, D, D, (bf16*)(wl + WO_OUT), scr, r, lane); continue; } r -= I_O;
        if (r < I_GU) { conv_item(3, FP(I_WGU) + (size_t)l * D * 2 * FF, nullptr, nullptr, D, 2 * FF, (bf16*)(wl + WO_GU), scr, r, lane); continue; } r -= I_GU;
        conv_item(0, FP(I_WDN) + (size_t)l * FF * D, nullptr, nullptr, FF, D, (bf16*)(wl + WO_DN), scr, r, lane);
    }
    __syncthreads();
    constexpr int NU = DEPTH * (NMOD / 64);
    if (vcu < NU) {
        LAS float* sc = (LAS float*)lds;
        LAS float* part = (LAS float*)(lds + 65536);
        { const float* cin = FP(I_C);
#pragma unroll
          for (int h2 = 0; h2 < 2; ++h2) { float cv[16];
#pragma unroll
              for (int q = 0; q < 16; ++q) cv[q] = cin[tid + NWAVES * 64 * (16 * h2 + q)];
#pragma unroll
              for (int q = 0; q < 16; ++q) { const int i = tid + NWAVES * 64 * (16 * h2 + q), b = i / D, k = i % D; sc[k * 16 + b] = silu_f(cv[q]); } } }
        __syncthreads();
        const float* wmod = FP(I_WMOD); const float* bmod = FP(I_BMOD); float* modo = (float*)(WSP() + WS_MOD);
        for (int u = vcu; u < NU; u += G) {
            const int l = u / (NMOD / 64), n0 = (u % (NMOD / 64)) * 64;
            const float* W = wmod + (size_t)l * D * NMOD + n0 + lane;
            float acc[16];
#pragma unroll
            for (int b = 0; b < 16; ++b) acc[b] = 0.f;
            for (int k0 = wave * 128; k0 < wave * 128 + 128; k0 += 32) { float wv[32];
#pragma unroll
                for (int kk = 0; kk < 32; ++kk) wv[kk] = W[(size_t)(k0 + kk) * NMOD];
#pragma unroll
                for (int kk = 0; kk < 32; ++kk) {
#pragma unroll
                    for (int q = 0; q < 4; ++q) { const f32x4 s4 = *(const LAS f32x4*)(sc + (k0 + kk) * 16 + 4 * q);
                        acc[4 * q + 0] += s4[0] * wv[kk]; acc[4 * q + 1] += s4[1] * wv[kk]; acc[4 * q + 2] += s4[2] * wv[kk]; acc[4 * q + 3] += s4[3] * wv[kk]; }
                    __builtin_amdgcn_sched_barrier(0); } }
#pragma unroll
            for (int b = 0; b < 16; ++b) part[(wave * 16 + b) * 64 + lane] = acc[b];
            __syncthreads();
            for (int i = tid; i < 16 * 64; i += NWAVES * 64) { const int b = i >> 6, ln = i & 63; float s = bmod[(size_t)l * NMOD + n0 + ln];
#pragma unroll
                for (int w = 0; w < 8; ++w) s += part[(w * 16 + b) * 64 + ln];
                modo[((size_t)l * BATCH + b) * NMOD + n0 + ln] = s; }
            __syncthreads();
        }
    }
}

__device__ __forceinline__ void norm_phase(const bf16* y, const float* xin, float* xout, const float* gpost, const float* gate, const float* gnext, const float* sc, const float* sh, bf16* XN,
                                           int lane, int wave, int vcu, int G) {
    const int gw = vcu * NWAVES + wave, NGW = G * NWAVES;
    for (int m0 = gw * 16; m0 < M; m0 += NGW * 16) {
        const int b = m0 / SEQ;
        f32x4 vg[4], vt[4], vn[4], vs[4], vh[4];
#pragma unroll
        for (int j = 0; j < 4; ++j) { const int e = 256 * j + 4 * lane;
            if (y) { vg[j] = *(const f32x4*)(gpost + e); vt[j] = *(const f32x4*)(gate + (size_t)b * NMOD + e); }
            if (gnext) { vn[j] = *(const f32x4*)(gnext + e); vs[j] = *(const f32x4*)(sc + (size_t)b * NMOD + e) + 1.f; vh[j] = *(const f32x4*)(sh + (size_t)b * NMOD + e); vn[j] = vn[j] * vs[j]; } }
#pragma unroll 1
        for (int r0 = 0; r0 < 16; r0 += 4) {
            f32x4 xb[4][4]; u32x2 yb[4][4];
#pragma unroll
            for (int q = 0; q < 4; ++q)
#pragma unroll
                for (int j = 0; j < 4; ++j) { const size_t row = (size_t)(m0 + r0 + q); xb[q][j] = *(const f32x4*)(xin + row * D + 256 * j + 4 * lane); yb[q][j] = (u32x2){0u, 0u}; if (y) yb[q][j] = *(const u32x2*)(y + row * D + 256 * j + 4 * lane); }
#pragma unroll
            for (int q = 0; q < 4; ++q) {
                const size_t row = (size_t)(m0 + r0 + q);
                f32x4 xv[4];
#pragma unroll
                for (int j = 0; j < 4; ++j) xv[j] = xb[q][j];
                if (y) {
                    f32x4 yv[4]; float ss = 0.f;
#pragma unroll
                    for (int j = 0; j < 4; ++j) { const u32x2 w = yb[q][j]; yv[j] = (f32x4){bf_lo(w.x), bf_hi(w.x), bf_lo(w.y), bf_hi(w.y)};
                        ss += (yv[j][0] * yv[j][0] + yv[j][1] * yv[j][1]) + (yv[j][2] * yv[j][2] + yv[j][3] * yv[j][3]); }
                    const float rstd = rsqrtf(wave_sum(ss) * (1.f / D) + EPS);
#pragma unroll
                    for (int j = 0; j < 4; ++j) { xv[j] = xv[j] + vt[j] * (yv[j] * rstd * vg[j]); *(f32x4*)(xout + row * D + 256 * j + 4 * lane) = xv[j]; }
                }
                if (gnext) {
                    float ss = 0.f;
#pragma unroll
                    for (int j = 0; j < 4; ++j) ss += (xv[j][0] * xv[j][0] + xv[j][1] * xv[j][1]) + (xv[j][2] * xv[j][2] + xv[j][3] * xv[j][3]);
                    const float rstd = rsqrtf(wave_sum(ss) * (1.f / D) + EPS);
#pragma unroll
                    for (int j = 0; j < 4; ++j) { const f32x4 o = xv[j] * rstd * vn[j] + vh[j]; u32x2 w; w.x = pk2(o[0], o[1]); w.y = pk2(o[2], o[3]); *(u32x2*)(XN + row * D + 256 * j + 4 * lane) = w; }
                }
            }
        }
    }
}

constexpr int IX_SC = 0, IX_KCH = 131072, IX_KPITCH = 144, IX_HIST = IX_KCH, IX_MSK = IX_KCH + 128 * IX_KPITCH, IX_END = IX_MSK + 4096;
static_assert(IX_END <= RING_BYTES && 8 * 576 * 4 <= 128 * IX_KPITCH, "indexer LDS");
__device__ __forceinline__ unsigned ord_key(float f) { const unsigned u = __float_as_uint(f); return u ^ ((unsigned)((int)u >> 31) | 0x80000000u); }
__device__ __forceinline__ unsigned wave_scan_add(unsigned v) {
    v += (unsigned)__builtin_amdgcn_update_dpp(0, (int)v, 0x111, 0xf, 0xf, false);
    v += (unsigned)__builtin_amdgcn_update_dpp(0, (int)v, 0x112, 0xf, 0xf, false);
    v += (unsigned)__builtin_amdgcn_update_dpp(0, (int)v, 0x114, 0xf, 0xf, false);
    v += (unsigned)__builtin_amdgcn_update_dpp(0, (int)v, 0x118, 0xf, 0xf, false);
    v += (unsigned)__builtin_amdgcn_update_dpp(0, (int)v, 0x142, 0xa, 0xf, false);
    v += (unsigned)__builtin_amdgcn_update_dpp(0, (int)v, 0x143, 0xc, 0xf, false);
    return v;
}
template <int NJ> __device__ __forceinline__ void radix_rows(const unsigned (&xa)[NJ], const unsigned (&xb)[NJ], LAS unsigned* hist, int lane,
                                                              unsigned& thrA, unsigned& needA_o, unsigned& eqA_o, unsigned& thrB, unsigned& needB_o, unsigned& eqB_o) {
    unsigned pfA = 0u, ndA = 256u, eA = 0u, pfB = 0u, ndB = 256u, eB = 0u;
    unsigned zero = 0u, one = 1u; asm volatile("" : "+v"(zero), "+v"(one));
    const int rl = 63 - lane;
#if defined(DUP) && DUP == 45
    { *(LAS v4u*)(hist + 4 * lane) = (v4u){zero, zero, zero, zero}; *(LAS v4u*)(hist + 256 + 4 * lane) = (v4u){zero, zero, zero, zero};
#pragma unroll
      for (int j = 0; j < NJ; ++j) { __hip_atomic_fetch_add(hist + ((xa[j] >> 24) & 255u), one, __ATOMIC_RELAXED, __HIP_MEMORY_SCOPE_WORKGROUP); __hip_atomic_fetch_add(hist + 256u + ((xb[j] >> 24) & 255u), one, __ATOMIC_RELAXED, __HIP_MEMORY_SCOPE_WORKGROUP);
          if ((j & 3) == 3) __builtin_amdgcn_sched_barrier(0); } }
#endif
#if defined(DUP) && DUP == 46
    { unsigned acc_ = 0u;
#pragma unroll
      for (int j = 0; j < NJ; ++j) { acc_ += (xa[j] >= one) ? 1u : 0u; acc_ += (xb[j] >= one) ? 1u : 0u; }
      acc_ = wave_scan_add(acc_); asm volatile("" :: "v"(acc_)); }
#endif
#pragma unroll 1
    for (int bit = 31; bit >= 24; --bit) {
        const unsigned cA = pfA | (1u << bit), cB = pfB | (1u << bit); unsigned nA = 0u, nB = 0u;
#pragma unroll
        for (int j = 0; j < NJ; ++j) { nA += (xa[j] >= cA) ? 1u : 0u; nB += (xb[j] >= cB) ? 1u : 0u; if ((j & 3) == 3) __builtin_amdgcn_sched_barrier(0); }
        const unsigned n = (unsigned)__builtin_amdgcn_readlane((int)wave_scan_add(nA | (nB << 16)), 63);
        if ((n & 0xffffu) >= 256u) pfA = cA;
        if ((n >> 16) >= 256u) pfB = cB;
    }
    { const unsigned uA = pfA + (1u << 24), uB = pfB + (1u << 24); unsigned nA = 0u, nB = 0u;
#pragma unroll
      for (int j = 0; j < NJ; ++j) { nA += (uA != 0u && xa[j] >= uA) ? 1u : 0u; nB += (uB != 0u && xb[j] >= uB) ? 1u : 0u; if ((j & 3) == 3) __builtin_amdgcn_sched_barrier(0); }
      const unsigned n = (unsigned)__builtin_amdgcn_readlane((int)wave_scan_add(nA | (nB << 16)), 63);
      ndA = 256u - (n & 0xffffu); ndB = 256u - (n >> 16); }
#pragma unroll
    for (int p = 1; p < 4; ++p) { const int sh = 24 - 8 * p;
        *(LAS v4u*)(hist + 4 * lane) = (v4u){zero, zero, zero, zero}; *(LAS v4u*)(hist + 256 + 4 * lane) = (v4u){zero, zero, zero, zero};
#pragma unroll
        for (int j0 = 0; j0 < NJ; j0 += 4) {
            unsigned mm = 0xffffffffu;
#pragma unroll
            for (int j = j0; j < j0 + 4; ++j) mm = min(mm, min((xa[j] ^ pfA) >> (sh + 8), (xb[j] ^ pfB) >> (sh + 8)));
            if (__any(mm == 0u)) {
#pragma unroll
                for (int j = j0; j < j0 + 4; ++j) { const unsigned va = xa[j], vb = xb[j];
                    if (((va ^ pfA) >> (sh + 8)) == 0u) __hip_atomic_fetch_add(hist + ((va >> sh) & 255u), one, __ATOMIC_RELAXED, __HIP_MEMORY_SCOPE_WORKGROUP);
                    if (((vb ^ pfB) >> (sh + 8)) == 0u) __hip_atomic_fetch_add(hist + 256u + ((vb >> sh) & 255u), one, __ATOMIC_RELAXED, __HIP_MEMORY_SCOPE_WORKGROUP); } }
        }
        const v4u ca = *(const LAS v4u*)(hist + 4 * rl), cb = *(const LAS v4u*)(hist + 256 + 4 * rl);
        const unsigned ta = (ca.x + ca.y) + (ca.z + ca.w), tb = (cb.x + cb.y) + (cb.z + cb.w);
        const unsigned sa = wave_scan_add(ta), sb = wave_scan_add(tb);
#define RADIX_PICK(c, t, sfx, need, pf, eqv) { const unsigned above = sfx - t; const bool mine = (above < need) && (need <= sfx); unsigned bsel, nn, cn, cum = above; \
          if (cum + c.w >= need) { bsel = 3u; nn = need - cum; cn = c.w; } \
          else { cum += c.w; if (cum + c.z >= need) { bsel = 2u; nn = need - cum; cn = c.z; } \
              else { cum += c.z; if (cum + c.y >= need) { bsel = 1u; nn = need - cum; cn = c.y; } else { cum += c.y; bsel = 0u; nn = need - cum; cn = c.x; } } } \
          const unsigned long long bm = __ballot(mine); const int L = (int)__builtin_ctzll(bm | (1ull << 63)); \
          const unsigned bin = (unsigned)__builtin_amdgcn_readlane((int)(4u * (unsigned)rl + bsel), L); \
          need = (unsigned)__builtin_amdgcn_readlane((int)nn, L); eqv = (unsigned)__builtin_amdgcn_readlane((int)cn, L); pf |= bin << sh; }
        RADIX_PICK(ca, ta, sa, ndA, pfA, eA)
        RADIX_PICK(cb, tb, sb, ndB, pfB, eB)
#undef RADIX_PICK
    }
    thrA = pfA; needA_o = ndA; eqA_o = eA; thrB = pfB; needB_o = ndB; eqB_o = eB;
}
template <int NJ> __device__ __forceinline__ void select_rows(const LAS unsigned* scb, LAS unsigned long long* msk, LAS unsigned* hist, int nk, int wave, int lane) {
    unsigned xa[NJ], xb[NJ];
#pragma unroll
    for (int j = 0; j < NJ; ++j) { const unsigned va = scb[(2 * wave) * 2048 + 64 * j + lane], vb = scb[(2 * wave + 1) * 2048 + 64 * j + lane]; const bool in = (64 * j + lane) < nk; xa[j] = in ? va : 0u; xb[j] = in ? vb : 0u; }
    unsigned pA, pB, needA, needB, eA, eB;
    radix_rows<NJ>(xa, xb, hist, lane, pA, needA, eA, pB, needB, eB);
    unsigned xiA = 2047u, xiB = 2047u;
    if ((eA > needA) || (eB > needB)) {
        xiA = 0u; xiB = 0u;
#pragma unroll 1
        for (int bit = 10; bit >= 0; --bit) {
            const unsigned cA = xiA | (1u << bit), cB = xiB | (1u << bit); unsigned nA = 0u, nB = 0u;
#pragma unroll
            for (int j = 0; j < NJ; ++j) { int ll = lane; asm volatile("" : "+v"(ll)); const unsigned key = 64u * j + ll;
                nA += (xa[j] == pA && key < cA) ? 1u : 0u; nB += (xb[j] == pB && key < cB) ? 1u : 0u; if (j & 1) __builtin_amdgcn_sched_barrier(0); }
            unsigned n = nA | (nB << 16);
#pragma unroll
            for (int o = 1; o < 64; o <<= 1) n += __shfl_xor(n, o);
            if ((n & 0xffffu) < needA) xiA = cA;
            if ((n >> 16) < needB) xiB = cB;
        }
    }
    unsigned a0 = 0u, a1 = 0u, b0 = 0u, b1 = 0u;
    const bool ties = (xiA != 2047u) || (xiB != 2047u);
#pragma unroll
    for (int j = 0; j < NJ; ++j) { int ll = lane; asm volatile("" : "+v"(ll)); const unsigned key = 64u * j + ll;
        bool sA = xa[j] >= pA, sB = xb[j] >= pB;
        if (ties) { sA = (xa[j] > pA) || (xa[j] == pA && key <= xiA); sB = (xb[j] > pB) || (xb[j] == pB && key <= xiB); }
        const unsigned long long ba = __ballot(sA), bb = __ballot(sB);
        asm volatile("v_writelane_b32 %0, %4, %8\n\tv_writelane_b32 %1, %5, %8\n\tv_writelane_b32 %2, %6, %8\n\tv_writelane_b32 %3, %7, %8"
                     : "+v"(a0), "+v"(a1), "+v"(b0), "+v"(b1) : "s"((unsigned)ba), "s"((unsigned)(ba >> 32)), "s"((unsigned)bb), "s"((unsigned)(bb >> 32)), "n"(j));
        __builtin_amdgcn_sched_barrier(0);
    }
    if (lane < 32) { msk[lane * 16 + 2 * wave] = (unsigned long long)a0 | ((unsigned long long)a1 << 32); msk[lane * 16 + 2 * wave + 1] = (unsigned long long)b0 | ((unsigned long long)b1 << 32); }
}
struct IxReg { bf16x8 af[4]; float wA[8], wB[8]; v4u pre[2]; };
__device__ __forceinline__ void indexer_load(IxReg& R, int b, int qb16, const bf16* QI, const bf16* KI, const float* WI, int tid, int lane, int wave) {
    if (qb16 < 16) return;
    const int r = lane & 31, hh = lane >> 5, mt = wave & 3, q0 = qb16 * 16; const size_t rowb = (size_t)b * SEQ;
    { const int g = r >> 2, ql = 2 * (g & 1) + (g >> 2), hd = 4 * ((g >> 1) & 1) + (r & 3);
      const bf16* qp = QI + (rowb + q0 + 4 * mt + ql) * 512 + hd * 64 + 8 * hh;
#pragma unroll
      for (int s = 0; s < 4; ++s) R.af[s] = *(const bf16x8*)(qp + 16 * s); }
    { const float* wp = WI + (rowb + q0 + 4 * mt + 2 * hh) * 8;
#pragma unroll
      for (int j = 0; j < 8; ++j) { R.wA[j] = wp[j]; R.wB[j] = wp[8 + j]; } }
#pragma unroll
    for (int i = 0; i < 2; ++i) { const int idx = tid + 512 * i; R.pre[i] = *(const v4u*)(KI + (rowb + (idx >> 3)) * 64 + (idx & 7) * 8); }
}
__device__ __forceinline__ void indexer_unit(LAS unsigned char* lds, int b, int qb16, int nb, int nqb16, IxReg& R, const bf16* QI, const bf16* KI, const float* WI, unsigned long long* MaskG, int tid, int lane, int wave) {
    asm volatile("" : "+v"(tid), "+v"(lane));
    LAS unsigned* scb = (LAS unsigned*)(lds + IX_SC);
    LAS unsigned long long* msk = (LAS unsigned long long*)(lds + IX_MSK);
    const int q0 = qb16 * 16, n_kt = (q0 + 47) >> 5, nk = 32 * n_kt;
    const size_t rowb = (size_t)b * SEQ;
    __syncthreads();
    if (qb16 < 16) {
        { const int T = tid >> 4, i = tid & 15, t = q0 + i;
          msk[T * 16 + i] = (64 * T + 63 <= t) ? ~0ull : (64 * T > t) ? 0ull : ((1ull << (t - 64 * T + 1)) - 1ull); }
        if (nqb16 >= 0) indexer_load(R, nb, nqb16, QI, KI, WI, tid, lane, wave);
    } else {
        const int r = lane & 31, hh = lane >> 5, mt = wave & 3, par = wave >> 2;
        bf16x8 af[4]; float wA[8], wB[8]; v4u pre[2];
#pragma unroll
        for (int s = 0; s < 4; ++s) af[s] = R.af[s];
#pragma unroll
        for (int j = 0; j < 8; ++j) { wA[j] = R.wA[j]; wB[j] = R.wB[j]; }
        pre[0] = R.pre[0]; pre[1] = R.pre[1];
        const int rowA = 4 * mt + 2 * hh, tA = q0 + rowA;
        for (int c = 0; 4 * c < n_kt; ++c) {
            if (c) __syncthreads();
#pragma unroll
            for (int i = 0; i < 2; ++i) { const int idx = tid + 512 * i; *(LAS v4u*)(lds + IX_KCH + (idx >> 3) * IX_KPITCH + (idx & 7) * 16) = pre[i]; }
            __syncthreads();
            if (4 * (c + 1) < n_kt) {
#pragma unroll
                for (int i = 0; i < 2; ++i) { const int idx = tid + 512 * i; pre[i] = *(const v4u*)(KI + (rowb + 128 * (c + 1) + (idx >> 3)) * 64 + (idx & 7) * 8); } }
#pragma unroll
            for (int k = 0; k < 2; ++k) { const int tt = par + 2 * k, tile = 4 * c + tt;
                if (tile < n_kt) {
                    f32x16 acc = {};
#pragma unroll
                    for (int s = 0; s < 4; ++s) { const bf16x8 bfr = *(const LAS bf16x8*)(lds + IX_KCH + (32 * tt + r) * IX_KPITCH + 32 * s + 16 * hh);
                        acc = __builtin_amdgcn_mfma_f32_32x32x16_bf16(af[s], bfr, acc, 0, 0, 0); }
                    float sa = 0.f, sb = 0.f;
#pragma unroll
                    for (int j = 0; j < 8; ++j) { sa += wA[j] * fmaxf(acc[j], 0.f); sb += wB[j] * fmaxf(acc[8 + j], 0.f); }
                    const int key = 32 * tile + r;
                    scb[rowA * 2048 + key] = (key <= tA) ? ord_key(sa) : 0u; scb[(rowA + 1) * 2048 + key] = (key <= tA + 1) ? ord_key(sb) : 0u;
                } }
        }
        __syncthreads();
        if (nqb16 >= 0) indexer_load(R, nb, nqb16, QI, KI, WI, tid, lane, wave);
#ifdef DUP
#pragma unroll 1
        for (int rep_ = 0; rep_ < ((DUP == 44) ? 2 : 1); ++rep_)
#endif
        { LAS unsigned* hist = (LAS unsigned*)(lds + IX_HIST) + 576 * wave;
          if (nk <= 512) select_rows<8>(scb, msk, hist, nk, wave, lane); else if (nk <= 1024) select_rows<16>(scb, msk, hist, nk, wave, lane);
          else if (nk <= 1536) select_rows<24>(scb, msk, hist, nk, wave, lane); else select_rows<32>(scb, msk, hist, nk, wave, lane); }
    }
    __syncthreads();
    asm volatile("" : "+v"(tid));
    { const int T = tid >> 4, i = tid & 15;
      MaskG[((size_t)(b * 8 + (qb16 >> 4)) * 32 + T) * 256 + (qb16 & 15) * 16 + i] = msk[T * 16 + i]; }
}

constexpr int ML_PQ = 272, ML_PV = 320, ML_PS = 144, ML_PN = 132;
constexpr int MA_VS = 0, MA_KW = 20480, MA_CT = 40960, MA_GT = 76288, ML_CW = 137216, ML_END = 142336;
constexpr int MC_QT = 0, MC_KT = 17408, MC_NUM = 0, MC_VS = 34816, MC_SS = 55296, MC_CT = 64512, MC_GT = 99840;
constexpr int ML_CLE = 129 * 128;
static_assert(ML_END <= RING_BYTES && MA_GT + 1024 <= ML_CW && MC_GT + 1024 <= ML_CW && 64 * ML_PN * 4 <= MC_VS && MC_CT + 129 * ML_PQ <= MC_GT && MA_CT + 129 * ML_PQ <= MA_GT, "mLSTM LDS");
__device__ __forceinline__ int crow16(int reg, int hh) { return (reg & 3) + 8 * (reg >> 2) + 4 * hh; }
typedef short v4i16_t __attribute__((ext_vector_type(4)));
__device__ __forceinline__ bf16x8 tr_frag(const LAS unsigned char* tb, int pitch, int c, int ks) {
    const v4i16_t lo = __builtin_amdgcn_ds_read_tr16_b64_v4i16((LAS v4i16_t*)(tb + (16 * ks) * pitch + 64 * c));
    const v4i16_t hi = __builtin_amdgcn_ds_read_tr16_b64_v4i16((LAS v4i16_t*)(tb + (16 * ks + 4) * pitch + 64 * c));
    return (bf16x8){lo[0], lo[1], lo[2], lo[3], hi[0], hi[1], hi[2], hi[3]};
}
__device__ __forceinline__ int tr_base(int lane, int pitch) { return ((lane >> 5) * 8 + ((lane & 15) >> 2)) * pitch + (((lane >> 4) & 1) * 16 + (lane & 3) * 4) * 2; }
__device__ __forceinline__ void mma_tile(f32x16& acc, const LAS unsigned char* a, int pa, const LAS unsigned char* bt, int pb, int ks, int r, int hh) {
    for (int s = 0; s < ks; ++s) { const bf16x8 av = *(const LAS bf16x8*)(a + r * pa + 32 * s + 16 * hh), bv = *(const LAS bf16x8*)(bt + r * pb + 32 * s + 16 * hh);
        acc = __builtin_amdgcn_mfma_f32_32x32x16_bf16(av, bv, acc, 0, 0, 0); }
}
__device__ __forceinline__ void ml_stage_cw(LAS unsigned char* lds, const float* conv_w, const float* conv_b, int hd, int tid) {
    LAS float* cwl = (LAS float*)(lds + ML_CW);
    float tv[3];
#pragma unroll
    for (int k = 0; k < 3; ++k) { const int i = tid + NWAVES * 64 * k; tv[k] = 0.f; if (i < 2 * 5 * 128) { const int z = i / 640, j = (i % 640) >> 7, ch = i & 127, gch = z * 512 + hd * 128 + ch; tv[k] = (j < 4) ? conv_w[j * 1024 + gch] : conv_b[gch]; } }
#pragma unroll
    for (int k = 0; k < 3; ++k) { const int i = tid + NWAVES * 64 * k; if (i < 2 * 5 * 128) cwl[i] = tv[k]; }
}
__device__ __forceinline__ void conv8(float (&y)[8], const bf16* src, int tt0, const LAS float* cw) {
    { const f32x4 b0 = *(const LAS f32x4*)(cw + 4 * 128), b1 = *(const LAS f32x4*)(cw + 4 * 128 + 4); y[0] = b0[0]; y[1] = b0[1]; y[2] = b0[2]; y[3] = b0[3]; y[4] = b1[0]; y[5] = b1[1]; y[6] = b1[2]; y[7] = b1[3]; }
#pragma unroll
    for (int j = 0; j < 4; ++j) { const int tt = tt0 - 3 + j;
        if (tt >= 0) { const v4u xw = *(const v4u*)(src + (size_t)tt * 512); const f32x4 w0 = *(const LAS f32x4*)(cw + j * 128), w1 = *(const LAS f32x4*)(cw + j * 128 + 4);
            y[0] += w0[0] * bf_lo(xw.x); y[1] += w0[1] * bf_hi(xw.x); y[2] += w0[2] * bf_lo(xw.y); y[3] += w0[3] * bf_hi(xw.y);
            y[4] += w1[0] * bf_lo(xw.z); y[5] += w1[1] * bf_hi(xw.z); y[6] += w1[2] * bf_lo(xw.w); y[7] += w1[3] * bf_hi(xw.w); } }
#pragma unroll
    for (int e = 0; e < 8; ++e) y[e] = silu_f(y[e]);
}

__device__ __forceinline__ void conv8r(float (&y)[8], const v4u (&xr)[4], const LAS float* cw) {
    { const f32x4 b0 = *(const LAS f32x4*)(cw + 4 * 128), b1 = *(const LAS f32x4*)(cw + 4 * 128 + 4); y[0] = b0[0]; y[1] = b0[1]; y[2] = b0[2]; y[3] = b0[3]; y[4] = b1[0]; y[5] = b1[1]; y[6] = b1[2]; y[7] = b1[3]; }
#pragma unroll
    for (int j = 0; j < 4; ++j) { const v4u xw = xr[j]; const f32x4 w0 = *(const LAS f32x4*)(cw + j * 128), w1 = *(const LAS f32x4*)(cw + j * 128 + 4);
        y[0] += w0[0] * bf_lo(xw.x); y[1] += w0[1] * bf_hi(xw.x); y[2] += w0[2] * bf_lo(xw.y); y[3] += w0[3] * bf_hi(xw.y);
        y[4] += w1[0] * bf_lo(xw.z); y[5] += w1[1] * bf_hi(xw.z); y[6] += w1[2] * bf_lo(xw.w); y[7] += w1[3] * bf_hi(xw.w); }
#pragma unroll
    for (int e = 0; e < 8; ++e) y[e] = silu_f(y[e]);
}
__device__ __forceinline__ void load_taps(v4u (&xr)[4], const bf16* src, int tt0) {
#pragma unroll
    for (int j = 0; j < 4; ++j) { const int tt = tt0 - 3 + j; xr[j] = (v4u){0u, 0u, 0u, 0u}; if (tt >= 0) xr[j] = *(const v4u*)(src + (size_t)tt * 512); }
}

struct AReg { v4u kx[2][4]; v4u vv[2]; float ig, lf; };
__device__ __forceinline__ void mlstm_A_load(AReg& R, int u, const bf16* KM, const bf16* VM, const float* IG, const float* LF, int tid, int lane, int wave) {
    const int c = u & 31, hd = (u >> 5) & 3, b = u >> 7; const size_t rowb = (size_t)b * SEQ, t0 = rowb + 64 * c;
#pragma unroll
    for (int it = 0; it < 2; ++it) { const int idx = tid + 512 * it, t = (idx >> 4) & 63, g = idx & 15;
        load_taps(R.kx[it], KM + rowb * 512 + hd * 128 + 8 * g, 64 * c + t); R.vv[it] = *(const v4u*)(VM + (t0 + t) * 512 + hd * 128 + 8 * g); }
    R.ig = 0.f; R.lf = 0.f; if (wave == 0) { R.ig = IG[(t0 + lane) * 4 + hd]; R.lf = LF[(t0 + lane) * 4 + hd]; }
}
__device__ __forceinline__ void mlstm_A(LAS unsigned char* lds, int u, int u_next, AReg& R, const bf16* KM, const bf16* VM, const float* IG, const float* LF, bf16* KC, bf16* CL, float* MSC,
                                        int tid, int lane, int wave) {
    asm volatile("" : "+v"(tid), "+v"(lane)); asm volatile("" : "+s"(wave));
    const int r = lane & 31, hh = lane >> 5;
    LAS float* gt = (LAS float*)(lds + MA_GT); LAS bf16* ct = (LAS bf16*)(lds + MA_CT);
    __syncthreads();
    if (wave == 0) {
        float bc = R.lf;
#pragma unroll
        for (int o = 1; o < 64; o <<= 1) { const float v = __shfl_up(bc, o); if (lane >= o) bc += v; }
        const float a = R.ig - bc; float am = a;
#pragma unroll
        for (int o = 1; o < 64; o <<= 1) am = fmaxf(am, __shfl_xor(am, o));
        gt[lane] = __expf(a - am);
        if (lane == 63) { MSC[(size_t)u * 4 + 0] = am; MSC[(size_t)u * 4 + 1] = bc; }
    }
#pragma unroll
    for (int it = 0; it < 2; ++it) { const int idx = tid + 512 * it, t = (idx >> 4) & 63, g = idx & 15;
        float y[8]; conv8r(y, R.kx[it], (const LAS float*)(lds + ML_CW) + 640 + 8 * g);
        v4u o; o.x = pk2(y[0], y[1]); o.y = pk2(y[2], y[3]); o.z = pk2(y[4], y[5]); o.w = pk2(y[6], y[7]);
        *(LAS v4u*)(lds + MA_KW + t * ML_PV + 16 * g) = o; *(v4u*)(KC + ((size_t)u * 64 + t) * 128 + 8 * g) = o;
        *(LAS v4u*)(lds + MA_VS + t * ML_PV + 16 * g) = R.vv[it]; }
    if (u_next >= 0) mlstm_A_load(R, u_next, KM, VM, IG, LF, tid, lane, wave);
    __syncthreads();
#pragma unroll
    for (int it = 0; it < 2; ++it) { const int idx = tid + 512 * it, t = (idx >> 4) & 63, g = idx & 15; const float ws = gt[t];
        LAS v4u* kp = (LAS v4u*)(lds + MA_KW + t * ML_PV + 16 * g); const v4u xw = *kp;
        v4u o; o.x = pk2(ws * bf_lo(xw.x), ws * bf_hi(xw.x)); o.y = pk2(ws * bf_lo(xw.y), ws * bf_hi(xw.y)); o.z = pk2(ws * bf_lo(xw.z), ws * bf_hi(xw.z)); o.w = pk2(ws * bf_lo(xw.w), ws * bf_hi(xw.w)); *kp = o; }
    __syncthreads();
    { const int vi = wave >> 1; const LAS unsigned char* va = lds + MA_VS + tr_base(lane, ML_PV); const LAS unsigned char* kb = lds + MA_KW + tr_base(lane, ML_PV);
      f32x16 acc0 = f32x16{}, acc1 = f32x16{};
#pragma unroll
      for (int ks = 0; ks < 4; ++ks) { const bf16x8 af = tr_frag(va, ML_PV, vi, ks), b0 = tr_frag(kb, ML_PV, 2 * (wave & 1), ks), b1 = tr_frag(kb, ML_PV, 2 * (wave & 1) + 1, ks);
          acc0 = __builtin_amdgcn_mfma_f32_32x32x16_bf16(af, b0, acc0, 0, 0, 0); acc1 = __builtin_amdgcn_mfma_f32_32x32x16_bf16(af, b1, acc1, 0, 0, 0); }
#pragma unroll
      for (int q = 0; q < 16; ++q) { LAS bf16* cp = ct + (32 * vi + crow16(q, hh)) * (ML_PQ / 2) + 64 * (wave & 1) + r; cp[0] = (bf16)f2bf(acc0[q]); cp[32] = (bf16)f2bf(acc1[q]); } }
    if (tid < 128) { float sacc = 0.f;
#pragma unroll 8
        for (int s2 = 0; s2 < 64; ++s2) sacc += __uint_as_float((unsigned)(*(const LAS bf16*)(lds + MA_KW + s2 * ML_PV + 2 * tid)) << 16);
        ct[128 * (ML_PQ / 2) + tid] = (bf16)f2bf(sacc); }
    __syncthreads();
    bf16* dst = CL + (size_t)u * ML_CLE;
    for (int i = tid; i < 129 * 16; i += NWAVES * 64) { const int row = i >> 4, pc = i & 15; *(v4u*)(dst + row * 128 + pc * 8) = *(const LAS v4u*)(lds + MA_CT + row * ML_PQ + pc * 16); }
}

__device__ __forceinline__ void mlstm_B(bf16* CL, float* MSC, int tid, int vcu, int G) {
    constexpr int PCS = ML_CLE / 8;
    for (int item = vcu * (NWAVES * 64) + tid; item < 64 * PCS; item += G * NWAVES * 64) {
        const int bh = item / PCS, pc = item % PCS;
        bf16* base = CL + (size_t)bh * 32 * ML_CLE + pc * 8; float* ms = MSC + (size_t)bh * 32 * 4;
        float cst[8];
#pragma unroll
        for (int e = 0; e < 8; ++e) cst[e] = 0.f;
        float m = 0.f;
#pragma unroll 1
        for (int k0 = 0; k0 < 32; k0 += 8) {
            v4u x[8]; float ak[8], tk[8];
#pragma unroll
            for (int k = 0; k < 8; ++k) { x[k] = *(const v4u*)(base + (size_t)(k0 + k) * ML_CLE); ak[k] = ms[(k0 + k) * 4 + 0]; tk[k] = ms[(k0 + k) * 4 + 1]; }
#pragma unroll
            for (int k = 0; k < 8; ++k) {
                const float Mx = fmaxf(m, ak[k]), dec = __expf(m - Mx), w = __expf(ak[k] - Mx);
                v4u o; o.x = pk2(cst[0], cst[1]); o.y = pk2(cst[2], cst[3]); o.z = pk2(cst[4], cst[5]); o.w = pk2(cst[6], cst[7]);
                *(v4u*)(base + (size_t)(k0 + k) * ML_CLE) = o;
                if (pc == 0) ms[(k0 + k) * 4 + 2] = m;
                cst[0] = dec * cst[0] + w * bf_lo(x[k].x); cst[1] = dec * cst[1] + w * bf_hi(x[k].x); cst[2] = dec * cst[2] + w * bf_lo(x[k].y); cst[3] = dec * cst[3] + w * bf_hi(x[k].y);
                cst[4] = dec * cst[4] + w * bf_lo(x[k].z); cst[5] = dec * cst[5] + w * bf_hi(x[k].z); cst[6] = dec * cst[6] + w * bf_lo(x[k].w); cst[7] = dec * cst[7] + w * bf_hi(x[k].w);
                m = tk[k] + Mx; }
        }
    }
}

struct CReg { v4u cl[5]; v4u kc[2]; v4u vv[2]; v4u qx[2][4]; v4u om[2]; float ig, lf, mp; };
__device__ __forceinline__ void mlstm_C_load(CReg& R, int u, const bf16* QM, const bf16* KC, const bf16* VM, const bf16* OM, const float* IG, const float* LF, const bf16* CL, const float* MSC,
                                             int tid, int lane, int wave) {
    const int c = u & 31, hd = (u >> 5) & 3, b = u >> 7; const size_t rowb = (size_t)b * SEQ, t0 = rowb + 64 * c;
    const bf16* src = CL + (size_t)u * ML_CLE;
#pragma unroll
    for (int k = 0; k < 5; ++k) { const int i = tid + 512 * k; R.cl[k] = (v4u){0u, 0u, 0u, 0u}; if (i < 129 * 16) R.cl[k] = *(const v4u*)(src + (i >> 4) * 128 + (i & 15) * 8); }
#pragma unroll
    for (int it = 0; it < 2; ++it) { const int idx = tid + 512 * it, t = (idx >> 4) & 63, g = idx & 15;
        R.kc[it] = *(const v4u*)(KC + ((size_t)u * 64 + t) * 128 + 8 * g); R.vv[it] = *(const v4u*)(VM + (t0 + t) * 512 + hd * 128 + 8 * g);
        load_taps(R.qx[it], QM + rowb * 512 + hd * 128 + 8 * g, 64 * c + t); }
    { const int ot = tid >> 3, op8 = tid & 7; R.om[0] = *(const v4u*)(OM + (t0 + ot) * 512 + hd * 128 + 16 * op8); R.om[1] = *(const v4u*)(OM + (t0 + ot) * 512 + hd * 128 + 16 * op8 + 8); }
    R.ig = 0.f; R.lf = 0.f; R.mp = 0.f; if (wave == 0) { R.ig = IG[(t0 + lane) * 4 + hd]; R.lf = LF[(t0 + lane) * 4 + hd]; R.mp = MSC[(size_t)u * 4 + 2]; }
}
__device__ __forceinline__ void mlstm_C(LAS unsigned char* lds, int u, int u_next, CReg& R, const bf16* QM, const bf16* KC, const bf16* VM, const bf16* OM, const float* IG, const float* LF,
                                        const float* gain, const bf16* CL, const float* MSC, bf16* ATT, int tid, int lane, int wave) {
    asm volatile("" : "+v"(tid), "+v"(lane)); asm volatile("" : "+s"(wave));
    const int r = lane & 31, hh = lane >> 5, c = u & 31, hd = (u >> 5) & 3, b = u >> 7;
    LAS float* gt = (LAS float*)(lds + MC_GT);
    const size_t rowb = (size_t)b * SEQ, t0 = rowb + 64 * c;
    __syncthreads();
#pragma unroll
    for (int k = 0; k < 5; ++k) { const int i = tid + 512 * k; if (i < 129 * 16) *(LAS v4u*)(lds + MC_CT + (i >> 4) * ML_PQ + (i & 15) * 16) = R.cl[k]; }
    if (wave == 0) {
        const float m_prev = R.mp;
        float bc = R.lf;
#pragma unroll
        for (int o = 1; o < 64; o <<= 1) { const float v = __shfl_up(bc, o); if (lane >= o) bc += v; }
        const float a = R.ig - bc; float pm = a;
#pragma unroll
        for (int o = 1; o < 64; o <<= 1) { const float v = __shfl_up(pm, o); if (lane >= o) pm = fmaxf(pm, v); }
        gt[lane] = a; gt[64 + lane] = fmaxf(m_prev, pm); gt[128 + lane] = bc;
        if (lane == 0) gt[194] = m_prev;
    }
    const int ot = tid >> 3, op8 = tid & 7;
    const v4u og0 = R.om[0], og1 = R.om[1];
#pragma unroll
    for (int it = 0; it < 2; ++it) { const int idx = tid + 512 * it, t = (idx >> 4) & 63, g = idx & 15;
        *(LAS v4u*)(lds + MC_KT + t * ML_PQ + 16 * g) = R.kc[it];
        *(LAS v4u*)(lds + MC_VS + t * ML_PV + 16 * g) = R.vv[it];
        float y[8]; conv8r(y, R.qx[it], (const LAS float*)(lds + ML_CW) + 8 * g);
        const float sc = 0.08838834764831845f;
        v4u o; o.x = pk2(y[0] * sc, y[1] * sc); o.y = pk2(y[2] * sc, y[3] * sc); o.z = pk2(y[4] * sc, y[5] * sc); o.w = pk2(y[6] * sc, y[7] * sc);
        *(LAS v4u*)(lds + MC_QT + t * ML_PQ + 16 * g) = o; }
    if (u_next >= 0) mlstm_C_load(R, u_next, QM, KC, VM, OM, IG, LF, CL, MSC, tid, lane, wave);
    __syncthreads();
    if (wave < 4) { const int ti = wave >> 1, si = wave & 1; f32x16 g = f32x16{};
        if (si <= ti) mma_tile(g, lds + MC_QT + 32 * ti * ML_PQ, ML_PQ, lds + MC_KT + 32 * si * ML_PQ, ML_PQ, 8, r, hh);
        const float as = gt[32 * si + r]; LAS bf16* sp = (LAS bf16*)(lds + MC_SS);
#pragma unroll
        for (int q = 0; q < 16; ++q) { const int tl = crow16(q, hh), t = 32 * ti + tl, s2 = 32 * si + r;
            const float v = g[q] * __expf(fminf(as - gt[64 + t], 0.f)); sp[t * (ML_PS / 2) + s2] = (bf16)f2bf((s2 <= t) ? v : 0.f); } }
    __syncthreads();
    f32x16 nm = f32x16{};
    { const int ti = wave >> 2, vi = wave & 3;
      mma_tile(nm, lds + MC_QT + 32 * ti * ML_PQ, ML_PQ, lds + MC_CT + 32 * vi * ML_PQ, ML_PQ, 8, r, hh);
      const float mp = gt[194];
#pragma unroll
      for (int q = 0; q < 16; ++q) nm[q] *= __expf(mp - gt[64 + 32 * ti + crow16(q, hh)]);
      const LAS unsigned char* vb = lds + MC_VS + tr_base(lane, ML_PV);
#pragma unroll
      for (int ks = 0; ks < 4; ++ks) { const bf16x8 av = *(const LAS bf16x8*)(lds + MC_SS + (32 * ti + r) * ML_PS + 32 * ks + 16 * hh), bv = tr_frag(vb, ML_PV, vi, ks);
          nm = __builtin_amdgcn_mfma_f32_32x32x16_bf16(av, bv, nm, 0, 0, 0); } }
    float den;
    { const v4u sw = *(const LAS v4u*)(lds + MC_SS + ot * ML_PS + 16 * op8);
      float d1 = (bf_lo(sw.x) + bf_hi(sw.x)) + (bf_lo(sw.y) + bf_hi(sw.y)) + (bf_lo(sw.z) + bf_hi(sw.z)) + (bf_lo(sw.w) + bf_hi(sw.w)), d2 = 0.f;
#pragma unroll
      for (int k = 0; k < 2; ++k) { const v4u qw = *(const LAS v4u*)(lds + MC_QT + ot * ML_PQ + 32 * op8 + 16 * k), nw = *(const LAS v4u*)(lds + MC_CT + 128 * ML_PQ + 32 * op8 + 16 * k);
          d2 += bf_lo(qw.x) * bf_lo(nw.x) + bf_hi(qw.x) * bf_hi(nw.x) + bf_lo(qw.y) * bf_lo(nw.y) + bf_hi(qw.y) * bf_hi(nw.y) + bf_lo(qw.z) * bf_lo(nw.z) + bf_hi(qw.z) * bf_hi(nw.z) + bf_lo(qw.w) * bf_lo(nw.w) + bf_hi(qw.w) * bf_hi(nw.w); }
      den = d1 + __expf(gt[194] - gt[64 + ot]) * d2;
      den += __shfl_xor(den, 1); den += __shfl_xor(den, 2); den += __shfl_xor(den, 4); }
    __syncthreads();
    { const int ti = wave >> 2, vi = wave & 3; LAS float* np = (LAS float*)(lds + MC_NUM);
#pragma unroll
      for (int q = 0; q < 16; ++q) np[(32 * ti + crow16(q, hh)) * ML_PN + 32 * vi + r] = nm[q]; }
    __syncthreads();
    { const int t = ot, p = op8; const LAS float* np = (const LAS float*)(lds + MC_NUM) + t * ML_PN;
      const float mrow = gt[128 + t] + gt[64 + t], scl = 1.f / fmaxf(fabsf(den), __expf(-mrow));
      float hv[16]; float ss = 0.f;
#pragma unroll
      for (int e = 0; e < 16; ++e) { hv[e] = np[16 * p + e] * scl; ss += hv[e] * hv[e]; }
      ss += __shfl_xor(ss, 1); ss += __shfl_xor(ss, 2); ss += __shfl_xor(ss, 4);
      const float rs = rsqrtf(ss * (1.f / 128.f) + EPS);
      const v4u o0 = og0, o1 = og1;
      const float og[16] = {bf_lo(o0.x), bf_hi(o0.x), bf_lo(o0.y), bf_hi(o0.y), bf_lo(o0.z), bf_hi(o0.z), bf_lo(o0.w), bf_hi(o0.w), bf_lo(o1.x), bf_hi(o1.x), bf_lo(o1.y), bf_hi(o1.y), bf_lo(o1.z), bf_hi(o1.z), bf_lo(o1.w), bf_hi(o1.w)};
      const float* gp = gain + hd * 128 + 16 * p;
#pragma unroll
      for (int e = 0; e < 16; ++e) hv[e] = hv[e] * rs * gp[e] * og[e];
      v4u w0, w1; w0.x = pk2(hv[0], hv[1]); w0.y = pk2(hv[2], hv[3]); w0.z = pk2(hv[4], hv[5]); w0.w = pk2(hv[6], hv[7]); w1.x = pk2(hv[8], hv[9]); w1.y = pk2(hv[10], hv[11]); w1.z = pk2(hv[12], hv[13]); w1.w = pk2(hv[14], hv[15]);
      bf16* op = ATT + (t0 + t) * 1024 + 512 + hd * 128 + 16 * p; *(v4u*)op = w0; *(v4u*)(op + 8) = w1; }
}

struct Args { const void* in[22]; float* out; unsigned char* ws; int ph_lo, ph_hi; };
__global__ void __launch_bounds__(NWAVES * 64, 2) hybrid_fwd(Args args) {
    extern __shared__ __attribute__((aligned(16))) unsigned char lds_raw[];
    LAS unsigned char* lds = (LAS unsigned char*)lds_raw;
    volatile LAS unsigned* MISC = (volatile LAS unsigned*)(lds + LDSCTL_OFF);
    const int G0 = gridDim.x, bid0 = blockIdx.x; const int vcu0 = (G0 % 8 == 0) ? (bid0 % 8) * (G0 / 8) + bid0 / 8 : bid0;
#define PHASE_BEGIN() unsigned ones_ = ~0u; asm volatile("" : "+s"(ones_)); int lane = (int)__builtin_amdgcn_mbcnt_hi(ones_, __builtin_amdgcn_mbcnt_lo(ones_, 0u)), tid = wave0 * 64 + lane; asm volatile("" : "+v"(tid), "+v"(lane)); const int wave = __builtin_amdgcn_readfirstlane(tid >> 6); \
    int G = G0, vcu = vcu0, bid = bid0; asm volatile("" : "+s"(G), "+s"(vcu), "+s"(bid)); (void)wave; (void)lane; (void)vcu; (void)bid; (void)G
    const int wave0 = __builtin_amdgcn_readfirstlane((int)threadIdx.x >> 6);
    { const int tid = threadIdx.x;
    for (int u = tid; u < (LDS_BYTES - LDSCTL_OFF) / 4; u += NWAVES * 64) ((LAS unsigned*)(lds + LDSCTL_OFF))[u] = 0u;
    __syncthreads();
    if (tid == 0) { LAS unsigned long long* pb = (LAS unsigned long long*)(lds + LDSCTL_OFF + 64);
#pragma unroll
        for (int k = 0; k < 22; ++k) pb[k] = (unsigned long long)args.in[k];
        pb[I_OUT] = (unsigned long long)args.out; pb[I_WS] = (unsigned long long)args.ws; }
    __syncthreads(); }
    const int lo = args.ph_lo, hi = args.ph_hi;
    XcdBarrier bar; bar.bar = (unsigned*)(args.ws + WS_CTL) + CW_BAR; bar.x = 0; bar.st = nullptr;
    if (hi - lo > 1) bar = xcd_barrier_post((unsigned*)(args.ws + WS_CTL) + CW_BAR, MISC + 8);
#ifndef ONLY
#define ONLY -1
#endif
#define PH_ON(c) (ONLY < 0 || ONLY == (c))
#ifndef DUP
#define DUP -1
#endif
#define REPS(c) _Pragma("unroll 1") for (int rep_ = 0; rep_ < ((DUP == (c)) ? 2 : 1); ++rep_)
#define IN(k) (lo <= (k) && (k) < hi)
#define OPAQUE_GEMM(g) asm volatile("" : "+s"(g.A), "+s"(g.Bt))
#define SEAM(k) do { if (IN(k) && IN((k) + 1)) { bar.bar = (unsigned*)(WSP() + WS_CTL) + CW_BAR; xcd_barrier(bar); } } while (0)
#define XNB   ((bf16*)(WSPG() + WS_XN))
#define MXB(o) (WSPG() + WS_MIX + (o))
#define MODB  ((float*)(WSPG() + WS_MOD))
#define SSQB  ((float*)(WSPG() + WS_SSQ))

    REPS(0) { PHASE_BEGIN(); if (PH_ON(0) && IN(0)) p0_prologue(lds, tid, lane, wave, vcu, G); }
    SEAM(0);
#if defined(DUP) && DUP == 50
    for (int xb_ = 0; xb_ < 20; ++xb_) SEAM(0);
#endif
    { PHASE_BEGIN(); if (PH_ON(1) && IN(1)) norm_phase(nullptr, FP(I_X), nullptr, nullptr, nullptr, FP(I_MIXPRE), MODB + 1 * D, MODB + 0 * D, XNB, lane, wave, vcu, G); }
    SEAM(1);

    for (int l = 0; l < DEPTH; ++l) {
        const int pb = 2 + 9 * l;
        if (PH_ON(2) && IN(pb + 0)) REPS(2) { PHASE_BEGIN();
            unsigned char* wl = WSP() + WS_W + (size_t)l * W_LAYER;
            pg8::Gemm g{XNB, (const bf16*)(wl + WO_IN), M, NINP, D}; OPAQUE_GEMM(g); pg8::StaticOrder S; S.init(M, NINP, G, bid);
            pg8::EpiIn E{(bf16*)MXB(MX_CQ), (bf16*)MXB(MX_K), (bf16*)MXB(MX_V), (bf16*)MXB(MX_KI), (bf16*)MXB(MX_QM), (bf16*)MXB(MX_KM), (bf16*)MXB(MX_VM), (bf16*)MXB(MX_OM), SSQB, (float*)MXB(MX_WI), (float*)MXB(MX_IG), (float*)MXB(MX_LF),
                         GPTR(const int, ldptr(lds, I_POS)), FP(I_BIG) + l * 4, FP(I_BFG) + l * 4};
            pg8::gemm_phase<pg8::EpiIn, pg8::StaticOrder, true, true>(lds, g, S, E, tid);
        }
        SEAM(pb + 0);
#ifndef SUB
#define SUB 0
#endif
#define MSCB ((float*)(WSPG() + WS_SSQ + 512 * 1024))
#define MLSTM_A_BLOCK() do { PHASE_BEGIN(); int cur_hd = -1; \
            if (SUB != 1 && vcu < 2048) { AReg RA; mlstm_A_load(RA, vcu, (const bf16*)MXB(MX_KM), (const bf16*)MXB(MX_VM), (const float*)MXB(MX_IG), (const float*)MXB(MX_LF), tid, lane, wave); \
              for (int u = vcu; u < 2048; u += G) { const int hd = (u >> 5) & 3; \
                if (hd != cur_hd) { __syncthreads(); ml_stage_cw(lds, FP(I_CONVW) + (size_t)l * 4 * 1024, FP(I_CONVB) + (size_t)l * 1024, hd, tid); cur_hd = hd; }       \
                mlstm_A(lds, u, (u + G < 2048) ? u + G : -1, RA, (const bf16*)MXB(MX_KM), (const bf16*)MXB(MX_VM), (const float*)MXB(MX_IG), (const float*)MXB(MX_LF), (bf16*)MXB(MX_KC), (bf16*)MXB(MX_CL), MSCB, tid, lane, wave); } } \
            __syncthreads(); } while (0)
        if (PH_ON(3) && IN(pb + 1)) REPS(3) { PHASE_BEGIN();
            unsigned char* wl = WSP() + WS_W + (size_t)l * W_LAYER;
            pg8::Gemm g{(const bf16*)MXB(MX_CQ), (const bf16*)(wl + WO_Q), M, 1024, QRK}; OPAQUE_GEMM(g); pg8::StaticOrder S; S.init(M, 1024, G, bid);
            pg8::EpiQ E{(bf16*)MXB(MX_Q), (bf16*)MXB(MX_QI), SSQB, GPTR(const int, ldptr(lds, I_POS)), attn_body::C2};
            pg8::gemm_phase<pg8::EpiQ, pg8::StaticOrder, true, true>(lds, g, S, E, tid);
        }
        if (PH_ON(4) && IN(pb + 1)) REPS(41) MLSTM_A_BLOCK();
        SEAM(pb + 1);
        if (PH_ON(4) && IN(pb + 2)) { PHASE_BEGIN();
            if (SUB != 1) REPS(42) mlstm_B((bf16*)MXB(MX_CL), MSCB, tid, vcu, G);
            if (SUB != 2) REPS(40) { IxReg RI = {};
#define IX_L(i) ((i) * G + (((i) & 1) ? G - 1 - vcu : vcu))
                if (IX_L(0) < BATCH * 128) indexer_load(RI, IX_L(0) & 15, 127 - (IX_L(0) >> 4), (const bf16*)MXB(MX_QI), (const bf16*)MXB(MX_KI), (const float*)MXB(MX_WI), tid, lane, wave);
                for (int i = 0; i * G < BATCH * 128; ++i) { const int L = IX_L(i), Ln = IX_L(i + 1); const bool hn = ((i + 1) * G < BATCH * 128) && (Ln < BATCH * 128);
                    if (L < BATCH * 128) indexer_unit(lds, L & 15, 127 - (L >> 4), hn ? (Ln & 15) : 0, hn ? 127 - (Ln >> 4) : -1, RI, (const bf16*)MXB(MX_QI), (const bf16*)MXB(MX_KI), (const float*)MXB(MX_WI), (unsigned long long*)MXB(MX_MASK), tid, lane, wave); }
#undef IX_L
            }
        }
        SEAM(pb + 2);
#define MLSTM_C_BLOCK() do { PHASE_BEGIN(); int cur_hd = -1; \
            if (SUB != 1 && vcu < 2048) { CReg RC; mlstm_C_load(RC, vcu, (const bf16*)MXB(MX_QM), (const bf16*)MXB(MX_KC), (const bf16*)MXB(MX_VM), (const bf16*)MXB(MX_OM), (const float*)MXB(MX_IG), (const float*)MXB(MX_LF), (const bf16*)MXB(MX_CL), MSCB, tid, lane, wave); \
              for (int u = vcu; u < 2048; u += G) { const int hd = (u >> 5) & 3; \
                if (hd != cur_hd) { __syncthreads(); ml_stage_cw(lds, FP(I_CONVW) + (size_t)l * 4 * 1024, FP(I_CONVB) + (size_t)l * 1024, hd, tid); cur_hd = hd; } \
                mlstm_C(lds, u, (u + G < 2048) ? u + G : -1, RC, (const bf16*)MXB(MX_QM), (const bf16*)MXB(MX_KC), (const bf16*)MXB(MX_VM), (const bf16*)MXB(MX_OM), (const float*)MXB(MX_IG), (const float*)MXB(MX_LF), \
                        FP(I_MLN) + (size_t)l * 512, (const bf16*)MXB(MX_CL), MSCB, XNB, tid, lane, wave); } } \
            __syncthreads(); } while (0)
        if (PH_ON(4) && IN(pb + 3)) REPS(43) MLSTM_C_BLOCK();
        if (PH_ON(5) && IN(pb + 3)) REPS(5) { PHASE_BEGIN();
            const attn_body::AttnTensors AT{(const attn_body::bf16*)MXB(MX_Q), (const attn_body::bf16*)MXB(MX_K), (const attn_body::bf16*)MXB(MX_V), (attn_body::bf16*)XNB, (const attn_body::u32x4*)MXB(MX_MASK), FP(I_ATTN) + (size_t)l * 512};
            const attn_body::StaticOrder S(G, bid);
            attn_body::attn_phase<attn_body::StaticOrder>((char*)lds_raw, AT, S, tid);
        }
        SEAM(pb + 3);
        if (PH_ON(6) && IN(pb + 4)) REPS(6) { PHASE_BEGIN();
            unsigned char* wl = WSP() + WS_W + (size_t)l * W_LAYER;
            pg8::Gemm g{XNB, (const bf16*)(wl + WO_OUT), M, D, D}; OPAQUE_GEMM(g); pg8::StaticOrder S; S.init(M, D, G, bid);
            pg8::EpiPlain E{(bf16*)MXB(MX_Y), D};
            pg8::gemm_phase<pg8::EpiPlain, pg8::StaticOrder, true, true>(lds, g, S, E, tid);
        }
        SEAM(pb + 4);
        if (PH_ON(1) && IN(pb + 5)) { PHASE_BEGIN(); const float* modl = MODB + (size_t)l * BATCH * NMOD; float* outp = GPTR(float, ldptr(lds, I_OUT));
            norm_phase((const bf16*)MXB(MX_Y), l == 0 ? FP(I_X) : (const float*)outp, outp, FP(I_MIXPOST) + (size_t)l * D, modl + 2 * D, FP(I_FFNPRE) + (size_t)l * D, modl + 4 * D, modl + 3 * D, XNB, lane, wave, vcu, G); }
        SEAM(pb + 5);
        if (PH_ON(7) && IN(pb + 6)) REPS(7) { PHASE_BEGIN();
            unsigned char* wl = WSP() + WS_W + (size_t)l * W_LAYER;
            pg8::Gemm g{XNB, (const bf16*)(wl + WO_GU), M, 2 * FF, D}; OPAQUE_GEMM(g); pg8::StaticOrder S; S.init(M, 2 * FF, G, bid);
            pg8::EpiSwiglu E{(bf16*)MXB(MX_H), FF};
            pg8::gemm_phase<pg8::EpiSwiglu, pg8::StaticOrder, true, true>(lds, g, S, E, tid);
        }
        SEAM(pb + 6);
        if (PH_ON(6) && IN(pb + 7)) REPS(8) { PHASE_BEGIN();
            unsigned char* wl = WSP() + WS_W + (size_t)l * W_LAYER;
            pg8::Gemm g{(const bf16*)MXB(MX_H), (const bf16*)(wl + WO_DN), M, D, FF}; OPAQUE_GEMM(g); pg8::StaticOrder S; S.init(M, D, G, bid);
            pg8::EpiPlain E{(bf16*)MXB(MX_Y), D};
            pg8::gemm_phase<pg8::EpiPlain, pg8::StaticOrder, true, true>(lds, g, S, E, tid);
        }
        SEAM(pb + 7);
        if (PH_ON(1) && IN(pb + 8)) { PHASE_BEGIN();
            const bool last = (l == DEPTH - 1); const float* modl = MODB + (size_t)l * BATCH * NMOD; const float* modn = MODB + (size_t)(l + 1) * BATCH * NMOD; float* outp = GPTR(float, ldptr(lds, I_OUT));
            norm_phase((const bf16*)MXB(MX_Y), outp, outp, FP(I_FFNPOST) + (size_t)l * D, modl + 5 * D, last ? nullptr : FP(I_MIXPRE) + (size_t)(l + 1) * D, modn + 1 * D, modn + 0 * D, XNB, lane, wave, vcu, G);
        }
        SEAM(pb + 8);
    }
#undef IN
#undef SEAM
}

extern "C" void kernel_launch(void* const* d_in, const int* in_sizes, int n_in, void* d_out, int out_size, void* d_ws, size_t ws_size, hipStream_t stream) {
    static int grid = 0;
    if (grid == 0) {
        if (n_in != 22 || in_sizes[0] != M * D || out_size != M * D || ws_size < WS_END) { fprintf(stderr, "kernel_launch: built for 22 inputs, x/out of %d floats, >= %zu bytes of workspace; got n_in %d, in0 %d, out %d, ws %zu; nothing launched\n", M * D, (size_t)WS_END, n_in, n_in > 0 ? in_sizes[0] : -1, out_size, ws_size); grid = -1; return; }
        int dev = 0, cus = 0, per_cu = 0;
        if (hipGetDevice(&dev) != hipSuccess || hipDeviceGetAttribute(&cus, hipDeviceAttributeMultiprocessorCount, dev) != hipSuccess) { fprintf(stderr, "kernel_launch: device query failed\n"); grid = -1; return; }
        if (hipFuncSetAttribute((const void*)hybrid_fwd, hipFuncAttributeMaxDynamicSharedMemorySize, LDS_BYTES) != hipSuccess) { fprintf(stderr, "kernel_launch: hipFuncSetAttribute(%d B LDS) failed\n", LDS_BYTES); grid = -1; return; }
        if (hipOccupancyMaxActiveBlocksPerMultiprocessor(&per_cu, (const void*)hybrid_fwd, NWAVES * 64, LDS_BYTES) != hipSuccess || per_cu < 1)
            fprintf(stderr, "kernel_launch: note: occupancy query reports %d workgroups per CU\n", per_cu);
        (void)hipGetLastError();
        grid = cus;
    }
    if (grid < 0) return;
    if (hipMemsetAsync((char*)d_ws + WS_CTL, 0, CTL_ZERO_BYTES, stream) != hipSuccess) { fprintf(stderr, "kernel_launch: hipMemsetAsync failed\n"); return; }
    Args a{};
    for (int i = 0; i < 22; ++i) a.in[i] = d_in[i];
    a.out = (float*)d_out; a.ws = (unsigned char*)d_ws;
#if MK_ONE_LAUNCH
    a.ph_lo = 0; a.ph_hi = N_PHASES;
    hipLaunchKernelGGL(hybrid_fwd, dim3(grid), dim3(NWAVES * 64), LDS_BYTES, stream, a);
#else
    for (int p = 0; p < N_PHASES; ++p) { a.ph_lo = p; a.ph_hi = p + 1; hipLaunchKernelGGL(hybrid_fwd, dim3(grid), dim3(NWAVES * 64), LDS_BYTES, stream, a); }
#endif
    const hipError_t le = hipPeekAtLastError();
    if (le != hipSuccess) fprintf(stderr, "kernel_launch: launch failed: %s (grid %d x %d threads, %d B LDS)\n", hipGetErrorName(le), grid, NWAVES * 64, LDS_BYTES);
}
```

```cpp
#include <hip/hip_runtime.h>
#include <hip/hip_bf16.h>
#include <cstdio>
#include <cstdint>
#include <cmath>
namespace pg8 {
#define PG8_LAS __attribute__((address_space(3)))
typedef unsigned short bf16_t;
typedef short bf16x8 __attribute__((ext_vector_type(8)));
typedef float f32x4 __attribute__((ext_vector_type(4)));
typedef unsigned u32x4 __attribute__((ext_vector_type(4)));
constexpr int BM = 256, BK = 64, HALF = 128, HTB = HALF * BK * 2  , STAGE_BYTES = 8 * HTB, NXCD = 8, WGM = 8;

__host__ __device__ __forceinline__ int lds_byte(int r, int c) { const int st = (r >> 4) * 2 + (c >> 5), rr = r & 15, cc = c & 31, ob = rr * 64 + cc * 2; return st * 1024 + (ob ^ (((ob >> 9) & 1) << 5)); }
__host__ __device__ __forceinline__ void stage_rc(int b, int& R, int& C) { const int st = b / 1024, sb = b % 1024, swz = sb ^ (((sb >> 9) & 1) << 5); R = (st >> 1) * 16 + swz / 64; C = (st & 1) * 32 + (swz % 64) / 2; }
__host__ __device__ __forceinline__ int perm32(int rho) { const int n = rho >> 4, i = rho & 15; return 8 * (i >> 2) + 4 * n + (i & 3); }

struct Unit { int pm, pn; };
struct Gemm { const bf16_t* A; const bf16_t* Bt; int M, N, K; };

struct StaticOrder {
    int nM, nN, nwg, G, c;
    __host__ __device__ void init(int M, int N, int G_, int c_) { nM = M / BM; nN = N / BM; nwg = nM * nN; G = G_; c = c_; }
    __host__ __device__ bool next(int i, Unit& u) const {
        const long L = (long)i * G + c; if (L >= nwg) return false;
        int wgid = (int)L; { const int q = nwg / NXCD, r = nwg % NXCD, xcd = wgid % NXCD, off = wgid / NXCD; wgid = (xcd < r ? xcd * (q + 1) : r * (q + 1) + (xcd - r) * q) + off; }
        const int nig = WGM * nN, gid = wgid / nig, fm = gid * WGM, gsz = (nM - fm) < WGM ? (nM - fm) : WGM;
        u.pm = fm + ((wgid % nig) % gsz); u.pn = (wgid % nig) / gsz; return true;
    }
    __device__ __forceinline__ void a_ready(const Unit&) const {}
    __device__ __forceinline__ void done(const Unit&) const {}
};

__device__ __forceinline__ unsigned cvt_pk_bf16(float lo, float hi) { unsigned r; asm volatile("v_cvt_pk_bf16_f32 %0, %1, %2" : "=v"(r) : "v"(lo), "v"(hi)); return r; }
typedef float f32x2 __attribute__((ext_vector_type(2)));

__device__ __forceinline__ void store8(bf16_t* p, const f32x4 a, const f32x4 b) {
    u32x4 w; w.x = cvt_pk_bf16(a[0], a[1]); w.y = cvt_pk_bf16(a[2], a[3]); w.z = cvt_pk_bf16(b[0], b[1]); w.w = cvt_pk_bf16(b[2], b[3]);
#ifdef STORE_SC1
    asm volatile("global_store_dwordx4 %0, %1, off sc1\n\ts_nop 1" :: "v"(p), "v"(w) : "memory");
#else
    *(u32x4*)p = w;
#endif

}
__device__ __forceinline__ float sigmoid_f(float g) { return __builtin_amdgcn_rcpf(1.f + __builtin_amdgcn_exp2f(-1.4426950408889634f * g)); }
__device__ __forceinline__ float silu_f(float g) { return g * sigmoid_f(g); }
__device__ __forceinline__ void rope_invf(float (&invf)[4], int wc, int fq) {
    const int j = 4 * (wc & 1) + fq;
#pragma unroll
    for (int e = 0; e < 4; ++e) invf[e] = exp2f(-(float)(4 * j + e) * 0.41524101186092029f) * 0.15915494309189535f;
}
__device__ __forceinline__ void rope_sincos(float (&sn)[4], float (&cs)[4], float p, const float (&invf)[4]) {
#pragma unroll
    for (int e = 0; e < 4; ++e) { const float r = __builtin_amdgcn_fractf(p * invf[e]); sn[e] = __builtin_amdgcn_sinf(r); cs[e] = __builtin_amdgcn_cosf(r); }
}
__device__ __forceinline__ void rope_apply(f32x4& x1, f32x4& x2, const float (&sn)[4], const float (&cs)[4]) {
    f32x4 o1, o2;
#pragma unroll
    for (int e = 0; e < 4; ++e) { o1[e] = x1[e] * cs[e] - x2[e] * sn[e]; o2[e] = x2[e] * cs[e] + x1[e] * sn[e]; }
    x1 = o1; x2 = o2;
}

struct EpiIn {
    static constexpr bool PERM = true, AFTER_DRAIN = false;
    bf16_t *CQ, *K, *V, *KI, *QM, *KM, *VM, *OM; float *SSQ, *WI, *IG, *LF; const int* pos; const float *b_ig, *b_fg;
    __device__ __forceinline__ void operator()(const f32x4 (&acc)[2][2][4][2], const Unit& u, int wr, int wc, int fr, int fq) const {
        { unsigned ones_ = ~0u; asm volatile("" : "+s"(ones_)); const int ln_ = (int)__builtin_amdgcn_mbcnt_hi(ones_, __builtin_amdgcn_mbcnt_lo(ones_, 0u)); fr = ln_ & 15; fq = ln_ >> 4; }
        const int row0 = u.pm * BM + wr * 64 + fr, ct = wc * 32 + 8 * fq, pn = u.pn;
        if (pn == 0) {
#pragma unroll
            for (int ai = 0; ai < 2; ++ai)
#pragma unroll
                for (int m = 0; m < 4; ++m) { const int row = row0 + ai * HALF + m * 16; float s = 0.f;
#pragma unroll
                    for (int bj = 0; bj < 2; ++bj) { const f32x4 v0 = acc[ai][bj][m][0], v1 = acc[ai][bj][m][1];
                        s += (v0[0] * v0[0] + v0[1] * v0[1]) + (v0[2] * v0[2] + v0[3] * v0[3]) + (v1[0] * v1[0] + v1[1] * v1[1]) + (v1[2] * v1[2] + v1[3] * v1[3]);
                        store8(CQ + (size_t)row * 256 + bj * HALF + ct, v0, v1); }
                    s += __shfl_xor(s, 16); s += __shfl_xor(s, 32);
                    if (fq == 0) SSQ[(size_t)row * 4 + wc] = s; }
        } else if (pn <= 2) {
            float invf[4]; rope_invf(invf, wc, fq);
            int psv[2][4];
#pragma unroll
            for (int ai = 0; ai < 2; ++ai)
#pragma unroll
                for (int m = 0; m < 4; ++m) psv[ai][m] = pos[row0 + ai * HALF + m * 16];
#pragma unroll
            for (int ai = 0; ai < 2; ++ai)
#pragma unroll
                for (int m = 0; m < 4; ++m) { const int row = row0 + ai * HALF + m * 16; float sn[4], cs[4]; rope_sincos(sn, cs, (float)psv[ai][m], invf);
#pragma unroll
                    for (int bj = 0; bj < 2; ++bj) { f32x4 v0 = acc[ai][bj][m][0], v1 = acc[ai][bj][m][1]; rope_apply(v0, v1, sn, cs);
                        store8(K + (size_t)row * 512 + (pn - 1) * 256 + bj * HALF + ct, v0, v1); } }
        } else if (pn <= 12) {
            const int g = (pn - 3) >> 1; bf16_t* dst = (g == 0) ? V : (g == 1) ? QM : (g == 2) ? KM : (g == 3) ? VM : OM; const int cb = ((pn - 3) & 1) * 256 + ct;
#pragma unroll
            for (int ai = 0; ai < 2; ++ai)
#pragma unroll
                for (int m = 0; m < 4; ++m) { const int row = row0 + ai * HALF + m * 16;
#pragma unroll
                    for (int bj = 0; bj < 2; ++bj) { f32x4 v0 = acc[ai][bj][m][0], v1 = acc[ai][bj][m][1];
                        if (g == 4) {
#pragma unroll
                            for (int e = 0; e < 4; ++e) { v0[e] = sigmoid_f(v0[e]); v1[e] = sigmoid_f(v1[e]); } }
                        store8(dst + (size_t)row * 512 + cb + bj * HALF, v0, v1); } }
        } else {
            if (wc < 2) {
                float invf[4]; rope_invf(invf, wc, fq);
                int psv[2][4];
#pragma unroll
                for (int ai = 0; ai < 2; ++ai)
#pragma unroll
                    for (int m = 0; m < 4; ++m) psv[ai][m] = pos[row0 + ai * HALF + m * 16];
#pragma unroll
                for (int ai = 0; ai < 2; ++ai)
#pragma unroll
                    for (int m = 0; m < 4; ++m) { const int row = row0 + ai * HALF + m * 16; float sn[4], cs[4]; rope_sincos(sn, cs, (float)psv[ai][m], invf);
                        f32x4 v0 = acc[ai][0][m][0], v1 = acc[ai][0][m][1]; rope_apply(v0, v1, sn, cs); store8(KI + (size_t)row * 64 + ct, v0, v1); }
            } else if (wc == 2 && fq == 0) {
#pragma unroll
                for (int ai = 0; ai < 2; ++ai)
#pragma unroll
                    for (int m = 0; m < 4; ++m) { const int row = row0 + ai * HALF + m * 16; const float s = 0.044194173824159216f;
                        *(f32x4*)(WI + (size_t)row * 8) = acc[ai][0][m][0] * s; *(f32x4*)(WI + (size_t)row * 8 + 4) = acc[ai][0][m][1] * s; }
            } else if (wc == 2 && fq == 1) {
                const f32x4 bi = *(const f32x4*)b_ig, bf = *(const f32x4*)b_fg;
#pragma unroll
                for (int ai = 0; ai < 2; ++ai)
#pragma unroll
                    for (int m = 0; m < 4; ++m) { const int row = row0 + ai * HALF + m * 16; const f32x4 iv = acc[ai][0][m][0] + bi, fv = acc[ai][0][m][1] + bf; f32x4 lf;
#pragma unroll
                        for (int e = 0; e < 4; ++e) lf[e] = fminf(fv[e], 0.f) - 0.6931471805599453f * __builtin_amdgcn_logf(1.f + __builtin_amdgcn_exp2f(-1.4426950408889634f * fabsf(fv[e])));
                        *(f32x4*)(IG + (size_t)row * 4) = iv; *(f32x4*)(LF + (size_t)row * 4) = lf; }
            }
        }
    }
};

struct EpiQ {
    static constexpr bool PERM = true, AFTER_DRAIN = false;
    bf16_t *Q, *QI; const float* SSQ; const int* pos; float qscale;
    __device__ __forceinline__ void operator()(const f32x4 (&acc)[2][2][4][2], const Unit& u, int wr, int wc, int fr, int fq) const {
        { unsigned ones_ = ~0u; asm volatile("" : "+s"(ones_)); const int ln_ = (int)__builtin_amdgcn_mbcnt_hi(ones_, __builtin_amdgcn_mbcnt_lo(ones_, 0u)); fr = ln_ & 15; fq = ln_ >> 4; }
        const int row0 = u.pm * BM + wr * 64 + fr, ct = wc * 32 + 8 * fq, pn = u.pn;
        float invf[4]; rope_invf(invf, wc, fq);
        bf16_t* dst = (pn < 2) ? Q + pn * 256 : QI + (pn - 2) * 256; const float sc = (pn < 2) ? qscale : 1.f;
#pragma unroll
        for (int ai = 0; ai < 2; ++ai) {
            float rsv[4]; int psv[4];
#pragma unroll
            for (int m = 0; m < 4; ++m) { const int row = row0 + ai * HALF + m * 16; const f32x4 ss = *(const f32x4*)(SSQ + (size_t)row * 4); psv[m] = pos[row]; rsv[m] = ((ss[0] + ss[1]) + (ss[2] + ss[3])) * (1.f / 256.f) + 1e-6f; }
#pragma unroll
            for (int m = 0; m < 4; ++m) { const int row = row0 + ai * HALF + m * 16;
                const float rstd = rsqrtf(rsv[m]);
                float sn[4], cs[4]; rope_sincos(sn, cs, (float)psv[m], invf);
#pragma unroll
                for (int bj = 0; bj < 2; ++bj) { f32x4 v0 = acc[ai][bj][m][0] * rstd, v1 = acc[ai][bj][m][1] * rstd; rope_apply(v0, v1, sn, cs);
                    store8(dst + (size_t)row * 512 + bj * HALF + ct, v0 * sc, v1 * sc); } } }
    }
};

struct EpiPlain {
    static constexpr bool PERM = true, AFTER_DRAIN = false;
    bf16_t* O; int ldc;
    __device__ __forceinline__ void operator()(const f32x4 (&acc)[2][2][4][2], const Unit& u, int wr, int wc, int fr, int fq) const {
        { unsigned ones_ = ~0u; asm volatile("" : "+s"(ones_)); const int ln_ = (int)__builtin_amdgcn_mbcnt_hi(ones_, __builtin_amdgcn_mbcnt_lo(ones_, 0u)); fr = ln_ & 15; fq = ln_ >> 4; }
        const int row0 = u.pm * BM + wr * 64 + fr, col0 = u.pn * BM + wc * 32 + 8 * fq;
#pragma unroll
        for (int ai = 0; ai < 2; ++ai)
#pragma unroll
            for (int m = 0; m < 4; ++m) { bf16_t* rowp = O + (size_t)(row0 + ai * HALF + m * 16) * ldc + col0;
#pragma unroll
                for (int bj = 0; bj < 2; ++bj) store8(rowp + bj * HALF, acc[ai][bj][m][0], acc[ai][bj][m][1]); }
    }
};

struct EpiSwiglu {
    static constexpr bool PERM = true, AFTER_DRAIN = false;
    bf16_t* H; int ldc;
    __device__ __forceinline__ void operator()(const f32x4 (&acc)[2][2][4][2], const Unit& u, int wr, int wc, int fr, int fq) const {
        { unsigned ones_ = ~0u; asm volatile("" : "+s"(ones_)); const int ln_ = (int)__builtin_amdgcn_mbcnt_hi(ones_, __builtin_amdgcn_mbcnt_lo(ones_, 0u)); fr = ln_ & 15; fq = ln_ >> 4; }
        const int row0 = u.pm * BM + wr * 64 + fr, col0 = u.pn * HALF + wc * 32 + 8 * fq;
#pragma unroll
        for (int ai = 0; ai < 2; ++ai)
#pragma unroll
            for (int m = 0; m < 4; ++m) { f32x4 o0, o1;
#pragma unroll
                for (int e = 0; e < 4; ++e) { o0[e] = silu_f(acc[ai][0][m][0][e]) * acc[ai][1][m][0][e]; o1[e] = silu_f(acc[ai][0][m][1][e]) * acc[ai][1][m][1][e]; }
                store8(H + (size_t)(row0 + ai * HALF + m * 16) * ldc + col0, o0, o1); }
    }
};

template <class Epi, class Sched, bool ALIGN_EPI = false, bool SP2 = false>
__device__ __forceinline__ void gemm_phase(PG8_LAS unsigned char* lds, const Gemm g, const Sched& S, const Epi& E, int tid_in  ) {
    int tid_o = tid_in; asm volatile("" : "+v"(tid_o));
    const int tid = tid_o, wid = __builtin_amdgcn_readfirstlane(tid >> 6), lane = tid & 63, wr = wid >> 2, wc = wid & 3, fr = lane & 15, fq = lane >> 4;
    const int K = g.K, nt = K / BK;
    unsigned voffA[2], voffB[2];
#pragma unroll
    for (int i = 0; i < 2; ++i) { int R, C; stage_rc(tid * 16 + i * 8192, R, C); const int Rb = Epi::PERM ? ((R & ~31) + perm32(R & 31)) : R;
        voffA[i] = (unsigned)(R * K + C) * 2u; voffB[i] = (unsigned)(Rb * K + C) * 2u; }
    const size_t kstep = (size_t)(BK * 2);
    const size_t hstep = (size_t)HALF * K * 2;
    const size_t tstep = 2 * hstep;
    const unsigned ldsw = (unsigned)wid * 1024u;
    const int aoff = lds_byte(wr * 64 + fr, fq * 8), boff = lds_byte(wc * 32 + fr, fq * 8);
#define PG8_SA(b, h) (((b) * 2 + (h)) * HTB)
#define PG8_SB(b, h) ((4 + (b) * 2 + (h)) * HTB)
#define PG8_STAGE(bufoff, gbase, voff) do { _Pragma("unroll") for (int _i = 0; _i < 2; ++_i) \
        __builtin_amdgcn_global_load_lds((const unsigned*)((const char*)(gbase) + (voff)[_i]), (PG8_LAS unsigned*)(lds + (bufoff) + ldsw + _i * 8192), 16, 0, 0); } while (0)
#define PG8_LDA(dst, b, h) do { _Pragma("unroll") for (int m = 0; m < 4; ++m) _Pragma("unroll") for (int k = 0; k < 2; ++k) dst[m][k] = *(const PG8_LAS bf16x8*)(lds + PG8_SA(b, h) + aoff + m * 2048 + k * 1024); } while (0)
#define PG8_LDB(dst, b, h) do { _Pragma("unroll") for (int n = 0; n < 2; ++n) _Pragma("unroll") for (int k = 0; k < 2; ++k) dst[n][k] = *(const PG8_LAS bf16x8*)(lds + PG8_SB(b, h) + boff + n * 2048 + k * 1024); } while (0)
#define PG8_MMA(ai, bj, At, Bt) do { __builtin_amdgcn_s_setprio(1); _Pragma("unroll") for (int m = 0; m < 4; ++m) _Pragma("unroll") for (int n = 0; n < 2; ++n) _Pragma("unroll") for (int k = 0; k < 2; ++k) \
        acc[ai][bj][m][n] = __builtin_amdgcn_mfma_f32_16x16x32_bf16(Bt[n][k], At[m][k], acc[ai][bj][m][n], 0, 0, 0); __builtin_amdgcn_s_setprio(0); } while (0)
#define PG8_WAIT_V(n) asm volatile("s_waitcnt vmcnt(" #n ")" ::: "memory")
#define PG8_WAIT_L(n) asm volatile("s_waitcnt lgkmcnt(" #n ")" ::: "memory")
#define PG8_BAR __builtin_amdgcn_s_barrier()
#define PG8_SCHED __builtin_amdgcn_sched_barrier(0)
    Unit cur, nxt; int ui = 0;
    if (!S.next(0, cur)) return;
    f32x4 acc[2][2][4][2];
#pragma unroll
    for (int a = 0; a < 2; ++a)
#pragma unroll
        for (int b = 0; b < 2; ++b)
#pragma unroll
            for (int m = 0; m < 4; ++m)
#pragma unroll
                for (int n = 0; n < 2; ++n) acc[a][b][m][n] = (f32x4){0.f, 0.f, 0.f, 0.f};
    bf16x8 At[4][2], B0[2][2], B1[2][2];
    const char* cA = (const char*)g.A + (size_t)cur.pm * tstep; const char* cB = (const char*)g.Bt + (size_t)cur.pn * tstep;
    S.a_ready(cur);
    if constexpr (SP2) {
        PG8_STAGE(PG8_SB(0, 0), cB, voffB); PG8_STAGE(PG8_SB(0, 1), cB + hstep, voffB); PG8_STAGE(PG8_SA(0, 0), cA, voffA); PG8_STAGE(PG8_SA(0, 1), cA + hstep, voffA);
        if (wr == 1) PG8_BAR;
        PG8_WAIT_V(2); PG8_BAR;
        PG8_STAGE(PG8_SB(1, 0), cB + kstep, voffB); PG8_STAGE(PG8_SA(1, 0), cA + kstep, voffA); PG8_STAGE(PG8_SB(1, 1), cB + hstep + kstep, voffB);
        PG8_WAIT_V(6); PG8_BAR;
    } else {
        PG8_STAGE(PG8_SB(0, 0), cB, voffB); PG8_STAGE(PG8_SA(0, 0), cA, voffA); PG8_STAGE(PG8_SB(0, 1), cB + hstep, voffB); PG8_STAGE(PG8_SA(0, 1), cA + hstep, voffA);
        if (wr == 1) PG8_BAR;
        PG8_WAIT_V(4); PG8_BAR;
        PG8_STAGE(PG8_SB(1, 0), cB + kstep, voffB); PG8_STAGE(PG8_SA(1, 0), cA + kstep, voffA); PG8_STAGE(PG8_SB(1, 1), cB + hstep + kstep, voffB);
        PG8_WAIT_V(6); PG8_BAR;
    }
    for (;;) {
        const bool has_next = S.next(ui + 1, nxt);
        const char* nA = has_next ? (const char*)g.A + (size_t)nxt.pm * tstep : cA; const char* nB = has_next ? (const char*)g.Bt + (size_t)nxt.pn * tstep : cB;
        for (int t = 0; t < nt; t += 2) {
            const bool last = (t == nt - 2);
            const char* a1 = cA + (size_t)(t + 1) * kstep;
            const char* a2 = last ? nA : cA + (size_t)(t + 2) * kstep; const char* b2 = last ? nB : cB + (size_t)(t + 2) * kstep;
            const char* a3 = a2 + kstep; const char* b3 = b2 + kstep;
            if (last && has_next) S.a_ready(nxt);
            if constexpr (SP2) {
            PG8_LDB(B0, 0, 0); PG8_LDB(B1, 0, 1); PG8_SCHED; PG8_LDA(At, 0, 0); PG8_STAGE(PG8_SA(1, 1), a1 + hstep, voffA);
            PG8_WAIT_V(8); PG8_WAIT_L(0); PG8_BAR; PG8_MMA(0, 0, At, B0); PG8_MMA(0, 1, At, B1); PG8_BAR; PG8_SCHED;
            PG8_LDA(At, 0, 1); PG8_STAGE(PG8_SB(0, 0), b2, voffB); PG8_STAGE(PG8_SB(0, 1), b2 + hstep, voffB); PG8_STAGE(PG8_SA(0, 0), a2, voffA);
            PG8_WAIT_V(8); PG8_WAIT_L(0); PG8_BAR; PG8_MMA(1, 0, At, B0); PG8_MMA(1, 1, At, B1); PG8_BAR; PG8_SCHED;
            PG8_LDB(B0, 1, 0); PG8_LDB(B1, 1, 1); PG8_SCHED; PG8_LDA(At, 1, 0); PG8_STAGE(PG8_SA(0, 1), a2 + hstep, voffA);
            PG8_WAIT_V(8); PG8_WAIT_L(0); PG8_BAR; PG8_MMA(0, 0, At, B0); PG8_MMA(0, 1, At, B1); PG8_BAR; PG8_SCHED;
            PG8_LDA(At, 1, 1); PG8_STAGE(PG8_SB(1, 0), b3, voffB); PG8_STAGE(PG8_SB(1, 1), b3 + hstep, voffB); PG8_STAGE(PG8_SA(1, 0), a3, voffA);
            PG8_WAIT_V(8); PG8_WAIT_L(0); PG8_BAR; PG8_MMA(1, 0, At, B0); PG8_MMA(1, 1, At, B1); PG8_BAR; PG8_SCHED;
            } else {
            PG8_LDB(B0, 0, 0); PG8_SCHED; PG8_LDA(At, 0, 0); PG8_STAGE(PG8_SA(1, 1), a1 + hstep, voffA);
            PG8_WAIT_L(8); PG8_BAR; PG8_WAIT_L(0); PG8_MMA(0, 0, At, B0); PG8_BAR; PG8_SCHED;
            PG8_LDB(B1, 0, 1); PG8_STAGE(PG8_SB(0, 0), b2, voffB);
            PG8_BAR; PG8_WAIT_L(0); PG8_MMA(0, 1, At, B1); PG8_BAR;
            PG8_LDA(At, 0, 1); PG8_STAGE(PG8_SA(0, 0), a2, voffA);
            PG8_BAR; PG8_WAIT_L(0); PG8_MMA(1, 0, At, B0); PG8_BAR; PG8_SCHED;
            PG8_STAGE(PG8_SB(0, 1), b2 + hstep, voffB);
            PG8_WAIT_V(6); PG8_BAR; PG8_MMA(1, 1, At, B1); PG8_BAR;
            PG8_LDB(B0, 1, 0); PG8_SCHED; PG8_LDA(At, 1, 0); PG8_STAGE(PG8_SA(0, 1), a2 + hstep, voffA);
            PG8_WAIT_L(8); PG8_BAR; PG8_WAIT_L(0); PG8_MMA(0, 0, At, B0); PG8_BAR; PG8_SCHED;
            PG8_LDB(B1, 1, 1); PG8_STAGE(PG8_SB(1, 0), b3, voffB);
            PG8_BAR; PG8_WAIT_L(0); PG8_MMA(0, 1, At, B1); PG8_BAR;
            PG8_LDA(At, 1, 1); PG8_STAGE(PG8_SA(1, 0), a3, voffA);
            PG8_BAR; PG8_WAIT_L(0); PG8_MMA(1, 0, At, B0); PG8_BAR; PG8_SCHED;
            PG8_STAGE(PG8_SB(1, 1), b3 + hstep, voffB);
            PG8_WAIT_V(6); PG8_BAR; PG8_MMA(1, 1, At, B1); PG8_BAR;
            }
        }
        if constexpr (ALIGN_EPI) { if (wr == 0) PG8_BAR; }
        if constexpr (!Epi::AFTER_DRAIN) { E(acc, cur, wr, wc, fr, fq); S.done(cur); }
        if (!has_next) break;
#pragma unroll
        for (int a = 0; a < 2; ++a)
#pragma unroll
            for (int b = 0; b < 2; ++b)
#pragma unroll
                for (int m = 0; m < 4; ++m)
#pragma unroll
                    for (int n = 0; n < 2; ++n) acc[a][b][m][n] = (f32x4){0.f, 0.f, 0.f, 0.f};
        cur = nxt; cA = nA; cB = nB; ++ui;
        if constexpr (ALIGN_EPI) { if (wr == 1) PG8_BAR; }
    }
    PG8_WAIT_V(0);
    if constexpr (!ALIGN_EPI) { if (wr == 0) PG8_BAR; }
    PG8_BAR;
    if constexpr (Epi::AFTER_DRAIN) { E.fused(acc, cur, wr, wc, fr, fq, lds, wid, lane); S.done(cur); }
#undef PG8_SA
#undef PG8_SB
#undef PG8_STAGE
#undef PG8_LDA
#undef PG8_LDB
#undef PG8_MMA
#undef PG8_WAIT_V
#undef PG8_WAIT_L
#undef PG8_BAR
#undef PG8_SCHED
}
}
namespace attn_body {
using bf16=__hip_bfloat16;
using bf16x8=__attribute__((ext_vector_type(8)))short;
using s16x4=__attribute__((ext_vector_type(4)))short;
using f32x16=__attribute__((ext_vector_type(16)))float;
using u32x4=__attribute__((ext_vector_type(4)))unsigned;
constexpr int BATCH=16,NHEAD=8,SEQ=2048,D=64,DM=NHEAD*D,DMO=1024;
constexpr int NW=8,QBLK=32,QB=QBLK*NW,KVBLK=64,NQB=SEQ/QB;
constexpr int ATTN_PITCH=DM, ATTN_UNIT_ROWS=QB;
__device__ __forceinline__ int crow(int r,int hi){return (r&3)+8*(r>>2)+4*hi;}
#define SBAR() __builtin_amdgcn_sched_barrier(0)
__device__ __forceinline__ void cmask(f32x16&p0,f32x16&p1,int jb,int qrel,int hi){
  const float NEG=-INFINITY; int kb=64*jb+4*hi;
  #pragma unroll
  for(int r=0;r<16;++r){int kv=kb+(r&3)+8*(r>>2); if(kv>qrel)p0[r]=NEG; if(kv+32>qrel)p1[r]=NEG;}
}

__device__ __forceinline__ void bmask(f32x16&p0,f32x16&p1,unsigned long long mw,int hi){
  const unsigned lo=(unsigned)mw>>(4*hi), up=(unsigned)(mw>>32)>>(4*hi);
  #pragma unroll
  for(int r=0;r<16;++r){ const int ps=(r&3)+8*(r>>2);
    const unsigned x0=(unsigned)__builtin_amdgcn_sbfe((int)lo,ps,1), x1=(unsigned)__builtin_amdgcn_sbfe((int)up,ps,1);
    p0[r]=__uint_as_float((__float_as_uint(p0[r])&x0)|(0xFF800000u&~x0)); p1[r]=__uint_as_float((__float_as_uint(p1[r])&x1)|(0xFF800000u&~x1)); }
}
constexpr int NSLOT=3, SLOTB=8192;
constexpr int LDS_K=0, LDS_V=NSLOT*SLOTB, LDS_WS=2*NSLOT*SLOTB, LDS_OST=LDS_WS+NW*64*4, LDS_MASK=LDS_OST+NW*4096, LDS_BYTES=LDS_MASK+32*256*8;
constexpr float C2=0.125f*1.4426950408889634f;
__device__ __forceinline__ void glds16(const void*gsrc,unsigned lds_dst){unsigned keep;
  asm volatile("s_mov_b32 %0, m0\n\ts_mov_b32 m0, %2\n\ts_nop 0\n\tglobal_load_lds_dwordx4 %1, off\n\ts_mov_b32 m0, %0":"=&s"(keep):"v"(gsrc),"s"(lds_dst):"memory");}
__device__ __forceinline__ float max3f(float a,float b,float c){float r;asm("v_max3_f32 %0, %1, %2, %3":"=v"(r):"v"(a),"v"(b),"v"(c));return r;}
__device__ __forceinline__ float max2f(float a,float b){float r;asm("v_max_f32_e32 %0, %1, %2":"=v"(r):"v"(a),"v"(b));return r;}
__device__ __forceinline__ float fadd_s(float a,float b){float r;asm("v_add_f32_e32 %0, %1, %2":"=v"(r):"v"(a),"v"(b));return r;}
__device__ __forceinline__ float fsub_s(float a,float b){float r;asm("v_sub_f32_e32 %0, %1, %2":"=v"(r):"v"(a),"v"(b));return r;}
typedef float f32x2_t __attribute__((ext_vector_type(2))); typedef __bf16 bf16x2_t __attribute__((ext_vector_type(2)));
__device__ __forceinline__ unsigned cvtpk_s(float lo,float hi){f32x2_t v={lo,hi};bf16x2_t b=__builtin_convertvector(v,bf16x2_t);return __builtin_bit_cast(unsigned,b);}
#define WAIT_BAR(N) asm volatile("s_waitcnt vmcnt(" #N ") lgkmcnt(0)\n\ts_barrier":::"memory")

__device__ __forceinline__ void qkt(f32x16&p0,f32x16&p1,const char*Kslot,const bf16x8*qr,const f32x16&negm,int r32,int hi){
  const char*kb=Kslot+hi*1024+r32*16;
  #pragma unroll
  for(int d0=0;d0<4;++d0){
    const bf16x8 b0=*reinterpret_cast<const bf16x8*>(kb+d0*2048);
    const bf16x8 b1=*reinterpret_cast<const bf16x8*>(kb+d0*2048+512);
    if(d0==0){p0=__builtin_amdgcn_mfma_f32_32x32x16_bf16(b0,qr[0],negm,0,0,0);p1=__builtin_amdgcn_mfma_f32_32x32x16_bf16(b1,qr[0],negm,0,0,0);}
    else{p0=__builtin_amdgcn_mfma_f32_32x32x16_bf16(b0,qr[d0],p0,0,0,0);p1=__builtin_amdgcn_mfma_f32_32x32x16_bf16(b1,qr[d0],p1,0,0,0);}}
}
typedef __attribute__((address_space(3))) const char* lds_cptr;
typedef short v4i16_t __attribute__((ext_vector_type(4)));
__device__ __forceinline__ void kload8(bf16x8*kf,lds_cptr kp){
  kf[0]=*(const __attribute__((address_space(3))) bf16x8*)(kp);      kf[1]=*(const __attribute__((address_space(3))) bf16x8*)(kp+512);
  kf[2]=*(const __attribute__((address_space(3))) bf16x8*)(kp+2048); kf[3]=*(const __attribute__((address_space(3))) bf16x8*)(kp+2560);
  kf[4]=*(const __attribute__((address_space(3))) bf16x8*)(kp+4096); kf[5]=*(const __attribute__((address_space(3))) bf16x8*)(kp+4608);
  kf[6]=*(const __attribute__((address_space(3))) bf16x8*)(kp+6144); kf[7]=*(const __attribute__((address_space(3))) bf16x8*)(kp+6656);
}
__device__ __forceinline__ void kload2(bf16x8*kf,lds_cptr kp,int j){ kf[2*j]=*(const __attribute__((address_space(3))) bf16x8*)(kp+j*2048); kf[2*j+1]=*(const __attribute__((address_space(3))) bf16x8*)(kp+j*2048+512); }
__device__ __forceinline__ s16x4 vtr(lds_cptr p){ return __builtin_bit_cast(s16x4,__builtin_amdgcn_ds_read_tr16_b64_v4i16((__attribute__((address_space(3))) v4i16_t*)p)); }
__device__ __forceinline__ float rowmax(const f32x16&p0,const f32x16&p1){
  float a=max3f(p0[0],p0[1],p1[0]),b=max3f(p0[2],p0[3],p1[1]);a=max3f(a,p1[2],p1[3]);
  #pragma unroll
  for(int r=4;r<16;r+=4){a=max3f(a,p0[r],p0[r+1]);b=max3f(b,p0[r+2],p0[r+3]);a=max3f(a,p1[r],p1[r+1]);b=max3f(b,p1[r+2],p1[r+3]);}
  const float m=max2f(a,b);
  auto rr=__builtin_amdgcn_permlane32_swap(__float_as_uint(m),__float_as_uint(m),false,false);
  return max2f(__uint_as_float(rr[0]),__uint_as_float(rr[1]));
}
__device__ __forceinline__ void pv(f32x16*o,int vb,bf16x8 pa0,bf16x8 pa1,bf16x8 pa2,bf16x8 pa3){
  #pragma unroll
  for(int d0=0;d0<2;++d0){s16x4 lo[4],hi[4];
    #pragma unroll
    for(int ks=0;ks<4;++ks){
      asm volatile("ds_read_b64_tr_b16 %0,%1 offset:%c2":"=&v"(lo[ks]):"v"(vb),"i"(d0*4096+ks*1024):"memory");
      asm volatile("ds_read_b64_tr_b16 %0,%1 offset:%c2":"=&v"(hi[ks]):"v"(vb),"i"(d0*4096+ks*1024+512):"memory");}
    asm volatile("s_waitcnt lgkmcnt(0)":::"memory");SBAR();
    #define PK(k) (bf16x8){lo[k][0],lo[k][1],lo[k][2],lo[k][3],hi[k][0],hi[k][1],hi[k][2],hi[k][3]}
    o[d0]=__builtin_amdgcn_mfma_f32_32x32x16_bf16(pa0,PK(0),o[d0],0,0,0);
    o[d0]=__builtin_amdgcn_mfma_f32_32x32x16_bf16(pa1,PK(1),o[d0],0,0,0);
    o[d0]=__builtin_amdgcn_mfma_f32_32x32x16_bf16(pa2,PK(2),o[d0],0,0,0);
    o[d0]=__builtin_amdgcn_mfma_f32_32x32x16_bf16(pa3,PK(3),o[d0],0,0,0);
    #undef PK
  }
}

#ifndef ATTN_STORE16
#define ATTN_STORE16(p,v) (*(u32x4*)(p)=(v))
#endif
template<int THRL> __device__ __forceinline__ void attn_unit(int b,int h,int qb,const bf16*Q,const bf16*__restrict__ K,const bf16*__restrict__ V,bf16*O,const u32x4*__restrict__ MaskG,const float*__restrict__ gain,char*shm,int tid_in){
  int tid_o=tid_in; asm volatile("":"+v"(tid_o)); const int tid=tid_o,lane=tid&63,r32=lane&31,hi=lane>>5; const int wid=__builtin_amdgcn_readfirstlane(tid>>6);
  const long rowbase=(long)b*SEQ; const int q0=qb*QB;
  const bf16*Qw=Q+(rowbase+q0+wid*QBLK)*DM+h*D;
  const bf16*Kh=K+rowbase*DM+h*D,*Vh=V+rowbase*DM+h*D;
  const unsigned lds0=(unsigned)(uintptr_t)shm;
  float*wsf=(float*)(shm+LDS_WS)+wid*64;
  const bf16*ksrc=Kh+(long)lane*DM+wid*8;
  const bf16*vsrc=Vh+(long)(16*(wid&3)+(lane>>2))*DM+(wid>>2)*32+(lane&3)*8;
  const unsigned kdst=lds0+LDS_K+wid*1024, vdst=lds0+LDS_V+wid*1024;
  #define DMA_K(t,slot) glds16(ksrc+(long)(t)*KVBLK*DM,(unsigned)__builtin_amdgcn_readfirstlane(kdst+(slot)))
  #define DMA_V(t,slot) glds16(vsrc+(long)(t)*KVBLK*DM,(unsigned)__builtin_amdgcn_readfirstlane(vdst+(slot)))
  const int vb0=(int)(lds0+LDS_V)+((lane>>4)&1)*32+(lane&3)*8+(4*hi+((lane&15)>>2))*64;
  const char*Kbase=shm+LDS_K; bf16x8 kf[8];
  const lds_cptr shm3=(lds_cptr)shm; const lds_cptr kp0=shm3+LDS_K+hi*1024+r32*16; const lds_cptr vp0=shm3+LDS_V+((lane>>4)&1)*32+(lane&3)*8+(4*hi+((lane&15)>>2))*64;
  const int NT=(q0+QB)/KVBLK;
  DMA_K(0,0);DMA_V(0,0);DMA_K(1,SLOTB);
  { const u32x4*mg=MaskG+(long)(b*NQB+qb)*32*128;
    __attribute__((address_space(3))) u32x4*ml=(__attribute__((address_space(3))) u32x4*)((__attribute__((address_space(3))) char*)shm+LDS_MASK);
    u32x4 mv[8];
    _Pragma("unroll") for(int k=0;k<8;++k){ const int i=tid+NW*64*k; mv[k]=u32x4{0u,0u,0u,0u}; if(i<NT*128)mv[k]=mg[i]; }
    _Pragma("unroll") for(int k=0;k<8;++k){ const int i=tid+NW*64*k; if(i<NT*128)ml[i]=mv[k]; }
    asm volatile("s_waitcnt vmcnt(0)":::"memory"); }
  bf16x8 qr[4];
  #pragma unroll
  for(int d0=0;d0<4;++d0)qr[d0]=*reinterpret_cast<const bf16x8*>(&Qw[(long)r32*DM+d0*16+hi*8]);
  float mhat=0.f,l_reg=0.f;f32x16 o[2];o[0]=f32x16{};o[1]=f32x16{};f32x16 negm=f32x16{};asm volatile("":"+v"(negm));
  const int qrel=wid*QBLK+r32;
  const lds_cptr mkp=(lds_cptr)shm+LDS_MASK+qrel*8;
  unsigned long long mwn=0ull;
  #define CMASK(P0,P1,t) do{ bmask(P0,P1,mwn,hi); mwn=*(const __attribute__((address_space(3))) unsigned long long*)(mkp+((t)+1)*2048); }while(0)
  bool resc=false;
  #define START(P0,P1) do{ const float rm=rowmax(P0,P1); resc=false; \
    { const float dl=max2f(rm,-256.f); mhat=fadd_s(mhat,dl); \
      _Pragma("unroll") for(int r=0;r<16;++r){P0[r]=fsub_s(P0[r],dl);P1[r]=fsub_s(P1[r],dl);} \
      _Pragma("unroll") for(int r=0;r<16;++r)negm[r]=-mhat; asm volatile("":"+v"(negm)); } \
    _Pragma("unroll") for(int r=0;r<16;++r)P0[r]=__builtin_amdgcn_exp2f(P0[r]); }while(0)
  #define RESC() do{ if(resc){ asm volatile("s_waitcnt lgkmcnt(0)":::"memory"); \
      _Pragma("unroll") for(int d_=0;d_<2;++d_) _Pragma("unroll") for(int r=0;r<16;++r)o[d_][r]*=wsf[crow(r,hi)]; } }while(0)
  f32x16 pA0,pA1,pB0,pB1;
  if(wid>=4)__builtin_amdgcn_s_setprio(1);
  int sl_prev=0,sl_cur=0,sl_next=SLOTB;
  #define ROT() do{sl_prev=sl_cur;sl_cur=sl_next;sl_next=(sl_next==(NSLOT-1)*SLOTB)?0:sl_next+SLOTB;}while(0)
  DMA_K(2,2*SLOTB);
  WAIT_BAR(3);
  mwn=*(const __attribute__((address_space(3))) unsigned long long*)(mkp);
  qkt(pA0,pA1,Kbase,qr,negm,r32,hi);asm volatile("s_nop 15\n\ts_nop 7":"+v"(pA0),"+v"(pA1));CMASK(pA0,pA1,0);
  START(pA0,pA1);
  _Pragma("unroll") for(int r=0;r<16;++r)pA1[r]=__builtin_amdgcn_exp2f(pA1[r]);
  WAIT_BAR(0);
  DMA_K(3,0);DMA_V(1,SLOTB);
  ROT();
  kload8(kf,kp0+sl_cur);
  WAIT_BAR(2);
  s16x4 vlo[8],vhi[8]; u32x4 pw0,pw1,pw2,pw3;
  #define PKW(P,B) cvtpk_s(P[B],P[B+1])
  #define PAF(k) __builtin_bit_cast(bf16x8,pw##k)
  #define VFR(i) (bf16x8){vlo[i][0],vlo[i][1],vlo[i][2],vlo[i][3],vhi[i][0],vhi[i][1],vhi[i][2],vhi[i][3]}
  #define PIN(x) asm volatile("":"+v"(x))
  #define MX3(a,b,c) __builtin_fmaxf(__builtin_fmaxf((a),(b)),(c))
  #define GAPA(MF,A0,A1,A2,A3,W0,W1,PW) do{ MF; sacc+=A0; sacc+=A1; sacc+=A2; sacc+=A3; PIN(sacc); W0; W1; PIN(PW); SBAR(); }while(0)
  #define EX(v) __builtin_amdgcn_exp2f(v)
  #define GAPB(MF,X,B) do{ MF; X[B]=EX(X[B]); X[B+1]=EX(X[B+1]); X[B+2]=EX(X[B+2]); X[B+3]=EX(X[B+3]); PIN(X); SBAR(); }while(0)
  #define VRD(i) do{ vlo[i]=vtr(vp_+(((i)>>2)*4096+((i)&3)*1024)); vhi[i]=vtr(vp_+(((i)>>2)*4096+((i)&3)*1024+512)); }while(0)
  #define KRD(G,j) do{ if(G){ kload2(kf,kp0+sl_next,j); SBAR(); } }while(0)
  #define STEP(C0,C1,P0,P1,t,GK,GV,GL) do{ SBAR(); \
    const lds_cptr vp_=vp0+sl_prev; \
    VRD(0); SBAR(); float sacc=(P0[0]+P0[1]); \
    GAPA(C0=__builtin_amdgcn_mfma_f32_32x32x16_bf16(kf[0],qr[0],negm,0,0,0), P0[2],P0[3],P0[4],P0[5],     pw0[0]=PKW(P0,0), pw0[1]=PKW(P0,2), pw0); \
    VRD(4); SBAR(); GAPA(C1=__builtin_amdgcn_mfma_f32_32x32x16_bf16(kf[1],qr[0],negm,0,0,0), P0[6],P0[7],P0[8],P0[9],     pw0[2]=PKW(P0,4), pw0[3]=PKW(P0,6), pw0); \
    VRD(1); SBAR(); GAPA(C0=__builtin_amdgcn_mfma_f32_32x32x16_bf16(kf[2],qr[1],C0,0,0,0),   P0[10],P0[11],P0[12],P0[13], pw1[0]=PKW(P0,8), pw1[1]=PKW(P0,10), pw1); \
    VRD(5); SBAR(); GAPA(C1=__builtin_amdgcn_mfma_f32_32x32x16_bf16(kf[3],qr[1],C1,0,0,0),   P0[14],P0[15],P1[0],P1[1],   pw1[2]=PKW(P0,12),pw1[3]=PKW(P0,14), pw1); \
    VRD(2); SBAR(); GAPA(C0=__builtin_amdgcn_mfma_f32_32x32x16_bf16(kf[4],qr[2],C0,0,0,0),   P1[2],P1[3],P1[4],P1[5],     pw2[0]=PKW(P1,0), pw2[1]=PKW(P1,2), pw2); \
    VRD(6); SBAR(); GAPA(C1=__builtin_amdgcn_mfma_f32_32x32x16_bf16(kf[5],qr[2],C1,0,0,0),   P1[6],P1[7],P1[8],P1[9],     pw2[2]=PKW(P1,4), pw2[3]=PKW(P1,6), pw2); \
    VRD(3); SBAR(); GAPA(C0=__builtin_amdgcn_mfma_f32_32x32x16_bf16(kf[6],qr[3],C0,0,0,0),   P1[10],P1[11],P1[12],P1[13], pw3[0]=PKW(P1,8), pw3[1]=PKW(P1,10), pw3); \
    VRD(7); SBAR(); GAPA(C1=__builtin_amdgcn_mfma_f32_32x32x16_bf16(kf[7],qr[3],C1,0,0,0),   P1[14],P1[15],0.f,0.f,       pw3[2]=PKW(P1,12),pw3[3]=PKW(P1,14), pw3); \
    l_reg+=sacc; \
    if(GK){DMA_K((t)+3,sl_cur);} if(GV){DMA_V((t)+1,sl_next);} \
    CMASK(C0,C1,t); \
    { float a=MX3(C0[0],C0[1],C1[0]),b=MX3(C0[2],C0[3],C1[1]); a=MX3(a,C1[2],C1[3]); \
      _Pragma("unroll") for(int r=4;r<16;r+=4){a=MX3(a,C0[r],C0[r+1]);b=MX3(b,C0[r+2],C0[r+3]);a=MX3(a,C1[r],C1[r+1]);b=MX3(b,C1[r+2],C1[r+3]);} \
      float rm=__builtin_fmaxf(a,b); { auto rr=__builtin_amdgcn_permlane32_swap(__float_as_uint(rm),__float_as_uint(rm),false,false); rm=__builtin_fmaxf(__uint_as_float(rr[0]),__uint_as_float(rr[1])); } \
      resc=false; \
      if(__builtin_expect(__any(rm>(float)THRL),0)){ const float dl=__builtin_fmaxf(rm,0.f); mhat+=dl; \
        _Pragma("unroll") for(int r=0;r<16;++r){C0[r]-=dl;C1[r]-=dl;} \
        _Pragma("unroll") for(int r=0;r<16;++r)negm[r]=-mhat; asm volatile("":"+v"(negm)); \
        const float f=__builtin_amdgcn_exp2f(-dl); l_reg*=f; if(hi==0)wsf[r32]=f; resc=true; } } \
    SBAR(); \
    GAPB(o[0]=__builtin_amdgcn_mfma_f32_32x32x16_bf16(PAF(0),VFR(0),o[0],0,0,0), C0,0); \
    GAPB(o[1]=__builtin_amdgcn_mfma_f32_32x32x16_bf16(PAF(0),VFR(4),o[1],0,0,0), C0,4); \
    KRD(GL,0); GAPB(o[0]=__builtin_amdgcn_mfma_f32_32x32x16_bf16(PAF(1),VFR(1),o[0],0,0,0), C0,8); \
    KRD(GL,1); GAPB(o[1]=__builtin_amdgcn_mfma_f32_32x32x16_bf16(PAF(1),VFR(5),o[1],0,0,0), C0,12); \
    KRD(GL,2); GAPB(o[0]=__builtin_amdgcn_mfma_f32_32x32x16_bf16(PAF(2),VFR(2),o[0],0,0,0), C1,0); \
    KRD(GL,3); GAPB(o[1]=__builtin_amdgcn_mfma_f32_32x32x16_bf16(PAF(2),VFR(6),o[1],0,0,0), C1,4); \
    GAPB(o[0]=__builtin_amdgcn_mfma_f32_32x32x16_bf16(PAF(3),VFR(3),o[0],0,0,0), C1,8); \
    GAPB(o[1]=__builtin_amdgcn_mfma_f32_32x32x16_bf16(PAF(3),VFR(7),o[1],0,0,0), C1,12); \
    }while(0)
  int t=1;
  for(;t+5<NT;t+=2){
    STEP(pB0,pB1,pA0,pA1,t,true,true,true);     WAIT_BAR(2); RESC(); ROT();
    STEP(pA0,pA1,pB0,pB1,t+1,true,true,true);   WAIT_BAR(2); RESC(); ROT();
  }
  #define ENDW(tt) do{ if((tt)+3<NT){WAIT_BAR(2);} else if((tt)+2<NT){WAIT_BAR(1);} else {WAIT_BAR(0);} }while(0)
  for(;t+1<NT;t+=2){
    STEP(pB0,pB1,pA0,pA1,t,(t+3<NT),(t+1<NT),(t+1<NT));       ENDW(t);   RESC(); ROT();
    STEP(pA0,pA1,pB0,pB1,t+1,(t+4<NT),(t+2<NT),(t+2<NT));     ENDW(t+1); RESC(); ROT();
  }
  STEP(pB0,pB1,pA0,pA1,NT-1,false,false,false); RESC();
  { float sacc=pB0[0]+pB0[1]; _Pragma("unroll") for(int r=2;r<16;++r)sacc+=pB0[r]; _Pragma("unroll") for(int r=0;r<16;++r)sacc+=pB1[r]; l_reg+=sacc;
    pw0=(u32x4){PKW(pB0,0),PKW(pB0,2),PKW(pB0,4),PKW(pB0,6)};pw1=(u32x4){PKW(pB0,8),PKW(pB0,10),PKW(pB0,12),PKW(pB0,14)};pw2=(u32x4){PKW(pB1,0),PKW(pB1,2),PKW(pB1,4),PKW(pB1,6)};pw3=(u32x4){PKW(pB1,8),PKW(pB1,10),PKW(pB1,12),PKW(pB1,14)};
    SBAR(); pv(o,vb0+sl_cur,PAF(0),PAF(1),PAF(2),PAF(3)); }
  #undef PKW
  #undef PAF
  #undef VFR
  #undef PIN
  #undef MX3
  #undef GAPA
  #undef GAPB
  #undef EX
  #undef VRD
  #undef KRD
  #undef STEP
  #undef ENDW
  __builtin_amdgcn_s_setprio(0);
  {auto rr=__builtin_amdgcn_permlane32_swap(__float_as_uint(l_reg),__float_as_uint(l_reg),false,false);l_reg=__uint_as_float(rr[0])+__uint_as_float(rr[1]);}
  if(hi==0)wsf[32+r32]=l_reg;asm volatile("s_waitcnt lgkmcnt(0)":::"memory");
  float rli[16];
  #pragma unroll
  for(int r=0;r<16;++r)rli[r]=__builtin_amdgcn_rcpf(wsf[32+crow(r,hi)]);
  bf16*Ow=O+(rowbase+q0+wid*QBLK)*DMO+h*D;
  { bf16*stg=(bf16*)(shm+LDS_OST)+wid*2048;
    #pragma unroll
    for(int r=0;r<16;++r){const int orow=crow(r,hi);
      #pragma unroll
      for(int d0=0;d0<2;++d0)stg[orow*64+d0*32+r32]=__float2bfloat16(o[d0][r]*rli[r]);}
    asm volatile("s_waitcnt lgkmcnt(0)":::"memory");
    float gn[8];
    #pragma unroll
    for(int e=0;e<8;++e)gn[e]=gain[h*D+(lane&7)*8+e];
    #pragma unroll
    for(int i=0;i<4;++i){const int row=i*8+(lane>>3),ch=lane&7; const u32x4 v=*(const u32x4*)(stg+row*64+ch*8);
      float f[8]; f[0]=__uint_as_float(v.x<<16);f[1]=__uint_as_float(v.x&0xffff0000u);f[2]=__uint_as_float(v.y<<16);f[3]=__uint_as_float(v.y&0xffff0000u);
      f[4]=__uint_as_float(v.z<<16);f[5]=__uint_as_float(v.z&0xffff0000u);f[6]=__uint_as_float(v.w<<16);f[7]=__uint_as_float(v.w&0xffff0000u);
      float ss=0.f;
      #pragma unroll
      for(int e=0;e<8;++e)ss+=f[e]*f[e];
      ss+=__shfl_xor(ss,1);ss+=__shfl_xor(ss,2);ss+=__shfl_xor(ss,4);
      const float rs=rsqrtf(ss*(1.f/64.f)+1e-6f);
      u32x4 w; w.x=cvtpk_s(f[0]*rs*gn[0],f[1]*rs*gn[1]); w.y=cvtpk_s(f[2]*rs*gn[2],f[3]*rs*gn[3]); w.z=cvtpk_s(f[4]*rs*gn[4],f[5]*rs*gn[5]); w.w=cvtpk_s(f[6]*rs*gn[6],f[7]*rs*gn[7]);
      ATTN_STORE16(Ow+(long)row*DMO+ch*8,w);} }
  asm volatile("s_waitcnt lgkmcnt(0)\n\ts_barrier":::"memory");
  #undef DMA_K
  #undef DMA_V
  #undef CMASK
  #undef START
  #undef RESC
  #undef ROT
}
constexpr int ATTN_LDS_BYTES=LDS_BYTES;
struct AttnTensors { const bf16* Q; const bf16* K; const bf16* V; bf16* O; const u32x4* Mask; const float* gain; };
struct AttnUnit { int bh; int qb; };
struct StaticOrder {
  int vcu, G;
  __device__ __forceinline__ explicit StaticOrder(int grid,int block):vcu((grid%8==0)?(block%8)*(grid/8)+block/8:block),G(grid){}
  __device__ __forceinline__ bool next(int i,AttnUnit&u)const{
    if(G==256){ if(i>=4)return false; const int s=vcu&1; u.bh=vcu>>1; u.qb=(i==0)?s:(i==1)?7-s:(i==2)?3-s:4+s; return true; }
    const int L=i*G+vcu; if(L>=BATCH*NHEAD*NQB)return false; u.bh=L/NQB; u.qb=L%NQB; return true; }
  __device__ __forceinline__ void a_ready(const AttnUnit&)const{}
  __device__ __forceinline__ void done(const AttnUnit&)const{}
};
template<class Sched,int THRL=8> __device__ __forceinline__ void attn_phase(char*lds,const AttnTensors&T,const Sched&S,int tid_in){
  AttnUnit u;
  for(int i=0;S.next(i,u);++i){ S.a_ready(u); attn_unit<THRL>(u.bh/NHEAD,u.bh%NHEAD,u.qb,T.Q,T.K,T.V,T.O,T.Mask,T.gain,lds,tid_in); S.done(u); }
}
#undef SBAR
#undef WAIT_BAR
}

constexpr int NWAVES = 8;
#ifndef MK_ONE_LAUNCH
#define MK_ONE_LAUNCH 1
#endif
constexpr int BATCH = 16, SEQ = 2048, D = 1024, M = BATCH * SEQ, DEPTH = 2;
constexpr int NIN = 3408, NINP = 3584, QRK = 256, FF = 2816, NMOD = 6 * D;
constexpr float EPS = 1e-6f;
constexpr int N_PHASES = 2 + 9 * DEPTH;

constexpr size_t MiB = 1u << 20;
constexpr size_t WS_CTL = 0, CTL_ZERO_BYTES = 64 * 1024;
constexpr size_t WS_MOD = 1 * MiB;
constexpr size_t WS_SSQ = 2 * MiB;
constexpr size_t WS_W = 3 * MiB, W_LAYER = 26 * MiB;
constexpr size_t WO_IN = 0, WO_Q = 7 * MiB, WO_OUT = 7 * MiB + 512 * 1024, WO_GU = 9 * MiB + 512 * 1024, WO_DN = 20 * MiB + 512 * 1024;
constexpr size_t WS_XN = 56 * MiB;
constexpr size_t WS_MIX = 120 * MiB;
constexpr size_t MX_CQ = 0, MX_K = 16 * MiB, MX_V = 48 * MiB, MX_KI = 80 * MiB, MX_WI = 84 * MiB, MX_IG = 85 * MiB, MX_LF = 85 * MiB + 512 * 1024, MX_QM = 86 * MiB, MX_KM = 118 * MiB, MX_VM = 150 * MiB,
                 MX_OM = 182 * MiB, MX_Q = 214 * MiB, MX_QI = 246 * MiB, MX_MASK = 278 * MiB, MX_CL = 286 * MiB, MX_KC = 352 * MiB, MX_H = 0, MX_Y = 192 * MiB, MX_END = 384 * MiB;
constexpr size_t WS_END = WS_MIX + MX_END;
static_assert(WO_DN + (size_t)D * FF * 2 <= W_LAYER && WS_W + DEPTH * W_LAYER <= WS_XN && WS_XN + (size_t)M * D * 2 <= WS_MIX && (size_t)M * FF * 2 <= MX_Y && MX_Y + (size_t)M * D * 2 <= MX_CL && MX_CL + (size_t)2048 * 129 * 128 * 2 <= MX_KC && MX_KC + (size_t)2048 * 64 * 128 * 2 <= MX_END, "d_ws map");
constexpr int CW_BAR = 4096;

constexpr int RING_BYTES = 153600;
constexpr int LDSCTL_OFF = RING_BYTES, LDS_BYTES = LDSCTL_OFF + 512;
static_assert(pg8::STAGE_BYTES <= RING_BYTES && attn_body::ATTN_LDS_BYTES <= RING_BYTES && LDS_BYTES <= 160 * 1024, "LDS map");

#define GAS __attribute__((address_space(1)))
#define LAS __attribute__((address_space(3)))
typedef unsigned short bf16;
typedef unsigned v4u __attribute__((ext_vector_type(4)));
typedef float f32x4 __attribute__((ext_vector_type(4)));
typedef short bf16x8 __attribute__((ext_vector_type(8)));
typedef GAS unsigned gu32;
typedef GAS unsigned long long gu64;
#define RLX_AGENT __ATOMIC_RELAXED, __HIP_MEMORY_SCOPE_AGENT
#define LDS_WAIT() asm volatile("s_waitcnt lgkmcnt(0)" ::: "memory")
#define VM_WAIT() asm volatile("s_waitcnt vmcnt(0)" ::: "memory")
__device__ __forceinline__ unsigned long long rt() { return __builtin_amdgcn_s_memrealtime(); }
__device__ __forceinline__ unsigned f2bf(float f) { unsigned u = __builtin_bit_cast(unsigned, f); return (u + 0x7fffu + ((u >> 16) & 1u)) >> 16; }
__device__ __forceinline__ unsigned pk2(float lo, float hi) { return f2bf(lo) | (f2bf(hi) << 16); }

#define XB_TMO      128
#define XB_XCNT(j)  (256  + 64 * (j))
#define XB_XSUB(j)  (1280 + 64 * (j))
#define XB_XGEN(j)  (2304 + 64 * (j))
#define XB_TOP      3328
#define XB_TOPGEN   3392
#define XCD_BAR_WORDS 3456
#define XB_SPIN_CAP (1u << 18)

__device__ __forceinline__ unsigned xb_ld(unsigned* p)              { return __hip_atomic_load(p, __ATOMIC_RELAXED, __HIP_MEMORY_SCOPE_AGENT); }
__device__ __forceinline__ unsigned xb_add(unsigned* p, unsigned v) { return __hip_atomic_fetch_add(p, v, __ATOMIC_RELAXED, __HIP_MEMORY_SCOPE_AGENT); }
__device__ __forceinline__ unsigned xb_xcc_id() { return (unsigned)__builtin_amdgcn_s_getreg((3 << 11) | 20) & 0xFu; }
#define XB_SPIN(cond, bar) do { unsigned _sp = 0; while (cond) { __builtin_amdgcn_s_sleep(1); \
    if ((++_sp & 255u) == 0u) { if (xb_ld(&(bar)[XB_TMO])) break; if (_sp > XB_SPIN_CAP) { atomicAdd(&(bar)[XB_TMO], 1u); break; } } } } while (0)

struct XcdBarrier {
    unsigned* bar; unsigned x;
    volatile LAS unsigned* st;
};

__device__ __forceinline__ XcdBarrier xcd_barrier_post(unsigned* bar, volatile LAS unsigned* st) {
    XcdBarrier b; b.bar = bar; b.x = xb_xcc_id(); b.st = st;
    if (threadIdx.x == 0) (void)xb_add(&bar[XB_XCNT(b.x)], 1u);
    return b;
}
__device__ __forceinline__ void xcd_barrier_complete(unsigned* bar, unsigned x, unsigned& nloc, unsigned& nx) {
    const unsigned G = gridDim.x * gridDim.y * gridDim.z;
    unsigned sum, cnt, mine, sp = 0u;
    for (;;) {
        sum = 0u; cnt = 0u; mine = 0u;
#pragma unroll
        for (unsigned j = 0; j < 16; ++j) { const unsigned c = xb_ld(&bar[XB_XCNT(j)]); sum += c; cnt += (c > 0u) ? 1u : 0u; mine = (j == x) ? c : mine; }
        if (sum == G) break;
        __builtin_amdgcn_s_sleep(1);
        if ((++sp & 255u) == 0u) { if (xb_ld(&bar[XB_TMO])) break; if (sp > XB_SPIN_CAP) { atomicAdd(&bar[XB_TMO], 1u); break; } }
    }
    nloc = mine > 0u ? mine : 1u; nx = cnt > 0u ? cnt : 1u;
}

__device__ __forceinline__ void xcd_barrier(const XcdBarrier& b) {
    asm volatile("s_waitcnt vmcnt(0)" ::: "memory");
    __syncthreads();
    if (threadIdx.x == 0) {
        unsigned* bar = b.bar;
        const unsigned bx = xb_xcc_id();
        __builtin_amdgcn_s_waitcnt(0);
        unsigned nloc = b.st[0], nx = b.st[1];
        if (nloc == 0u) { xcd_barrier_complete(bar, bx, nloc, nx); b.st[0] = nloc; b.st[1] = nx; }
        const unsigned old = xb_add(&bar[XB_XSUB(bx)], 1u);
        const unsigned gen = old / nloc;
        if (old + 1u == (gen + 1u) * nloc) {
            __builtin_amdgcn_fence(__ATOMIC_RELEASE, "agent");
            asm volatile("s_waitcnt vmcnt(0)" ::: "memory");
            const unsigned og = xb_add(&bar[XB_TOP], 1u);
            const unsigned tg = og / nx;
            if (og + 1u == (tg + 1u) * nx) xb_add(&bar[XB_TOPGEN], 1u);
            else XB_SPIN(xb_ld(&bar[XB_TOPGEN]) == tg, bar);
            __builtin_amdgcn_fence(__ATOMIC_ACQUIRE, "agent");
            xb_add(&bar[XB_XGEN(bx)], 1u);
            asm volatile("s_waitcnt vmcnt(0)" ::: "memory");
        } else {
            XB_SPIN(xb_ld(&bar[XB_XGEN(bx)]) == gen, bar);
            __builtin_amdgcn_fence(__ATOMIC_ACQUIRE, "agent");
            asm volatile("s_waitcnt vmcnt(0)" ::: "memory");
        }
    }
    __syncthreads();
}

typedef float f32x16 __attribute__((ext_vector_type(16)));
typedef unsigned u32x2 __attribute__((ext_vector_type(2)));
__device__ __forceinline__ float wave_sum(float v) {
#pragma unroll
    for (int o = 1; o < 64; o <<= 1) v += __shfl_xor(v, o);
    return v;
}
__device__ __forceinline__ float bf_lo(unsigned u) { return __uint_as_float(u << 16); }
__device__ __forceinline__ float bf_hi(unsigned u) { return __uint_as_float(u & 0xffff0000u); }
__device__ __forceinline__ float sigmoid_f(float g) { return __builtin_amdgcn_rcpf(1.f + __builtin_amdgcn_exp2f(-1.4426950408889634f * g)); }
__device__ __forceinline__ float silu_f(float g) { return g * sigmoid_f(g); }
__device__ __forceinline__ int ropeperm(int p) { const int j = p >> 3, e = p & 7; return (e < 4) ? 4 * j + e : 32 + 4 * j + (e - 4); }

__device__ __forceinline__ void conv_item(int kind, const float* W0, const float* W1, const float* gain, int K, int Nphys, bf16* WT, LAS float* scr, int item, int lane) {
    const int nblk = Nphys / 32, kb = item / nblk, nb = item % nblk, k0 = 64 * kb, n0 = 32 * nb;
    const int n = n0 + (lane & 31);
    const float* src = W0; int ld = Nphys, col = n;
    if (kind == 1) {
        ld = NIN; const int tile = n >> 8, r = n & 255;
        if (tile == 0) col = r;
        else if (tile <= 2) { const int idx = (tile - 1) * 256 + r; col = 256 + (idx >> 6) * 64 + ropeperm(idx & 63); }
        else if (tile <= 4) col = 768 + (tile - 3) * 256 + r;
        else if (tile <= 12) col = 1352 + (tile - 5) * 256 + r;
        else { if (r < 64) col = 1280 + ropeperm(r); else if (r < 72) col = 1344 + (r - 64); else if (r < 76) col = 3400 + (r - 72); else if (r < 80) col = 3404 + (r - 76); else { src = nullptr; col = 0; } }
    } else if (kind == 2) {
        ld = 512; src = (n < 512) ? W0 : W1; const int idx = n & 511; col = (idx >> 6) * 64 + ropeperm(idx & 63);
    } else if (kind == 3) {
        ld = 2 * FF; col = ((n >> 7) & 1) * FF + (n >> 8) * 128 + (n & 127);
    }
    float wv[32];
#pragma unroll
    for (int i = 0; i < 32; ++i) { const int kk = 2 * i + (lane >> 5); wv[i] = src ? src[(size_t)(k0 + kk) * ld + col] : 0.f; }
#pragma unroll
    for (int i = 0; i < 32; ++i) { const int kk = 2 * i + (lane >> 5); float v = wv[i]; if (gain) v *= gain[k0 + kk]; scr[kk * 33 + (lane & 31)] = v; }
    LDS_WAIT(); asm volatile("" ::: "memory");
    const int c = lane & 7;
#pragma unroll
    for (int j = 0; j < 4; ++j) { const int nn = (lane >> 3) + 8 * j; const LAS float* s = scr + (8 * c) * 33 + nn;
        v4u o; o.x = pk2(s[0 * 33], s[1 * 33]); o.y = pk2(s[2 * 33], s[3 * 33]); o.z = pk2(s[4 * 33], s[5 * 33]); o.w = pk2(s[6 * 33], s[7 * 33]);
        *(GAS v4u*)(WT + (size_t)(n0 + nn) * K + k0 + 8 * c) = o; }
    LDS_WAIT(); asm volatile("" ::: "memory");
}

enum { I_X = 0, I_C, I_POS, I_WMOD, I_BMOD, I_MIXPRE, I_MIXPOST, I_WIN, I_QLN, I_WQUP, I_WQIUP, I_CONVW, I_CONVB, I_BIG, I_BFG, I_ATTN, I_MLN, I_WOUT, I_FFNPRE, I_FFNPOST, I_WGU, I_WDN, I_OUT, I_WS };
__device__ __forceinline__ unsigned long long ldptr(LAS unsigned char* lds, int k) {
    const volatile LAS unsigned* p = (const volatile LAS unsigned*)(lds + LDSCTL_OFF + 64 + 8 * k);
    const unsigned lo = __builtin_amdgcn_readfirstlane(p[0]), hi = __builtin_amdgcn_readfirstlane(p[1]);
    return ((unsigned long long)hi << 32) | lo;
}
#define GPTR(T, x) ((T*)(GAS T*)(x))
#define FP(k) GPTR(const float, ldptr(lds, (k)))
#define WSP() ((unsigned char*)ldptr(lds, I_WS))
#define WSPG() GPTR(unsigned char, ldptr(lds, I_WS))

__device__ __forceinline__ void p0_prologue(LAS unsigned char* lds, int tid, int lane, int wave, int vcu, int G) {
    LAS float* scr = (LAS float*)(lds + wave * 16384);
    const int gw = vcu * NWAVES + wave, NGW = G * NWAVES;
    constexpr int I_IN = (D / 64) * (NINP / 32), I_Q = (QRK / 64) * (1024 / 32), I_O = (D / 64) * (D / 32), I_GU = (D / 64) * (2 * FF / 32), I_DN = (FF / 64) * (D / 32);
    constexpr int I_LAYER = I_IN + I_Q + I_O + I_GU + I_DN;
    for (int it = gw; it < DEPTH * I_LAYER; it += NGW) {
        const int l = it / I_LAYER; int r = it % I_LAYER; unsigned char* wl = WSP() + WS_W + (size_t)l * W_LAYER;
        if (r < I_IN) { conv_item(1, FP(I_WIN) + (size_t)l * D * NIN, nullptr, nullptr, D, NINP, (bf16*)(wl + WO_IN), scr, r, lane); continue; } r -= I_IN;
        if (r < I_Q) { conv_item(2, FP(I_WQUP) + (size_t)l * QRK * 512, FP(I_WQIUP) + (size_t)l * QRK * 512, FP(I_QLN) + (size_t)l * QRK, QRK, 1024, (bf16*)(wl + WO_Q), scr, r, lane); continue; } r -= I_Q;
        if (r < I_O) { conv_item(0, FP(I_WOUT) + (size_t)l * D * D, nullptr, nullptr, D, D, (bf16*)(wl + WO_OUT), scr, r, lane); continue; } r -= I_O;
        if (r < I_GU) { conv_item(3, FP(I_WGU) + (size_t)l * D * 2 * FF, nullptr, nullptr, D, 2 * FF, (bf16*)(wl + WO_GU), scr, r, lane); continue; } r -= I_GU;
        conv_item(0, FP(I_WDN) + (size_t)l * FF * D, nullptr, nullptr, FF, D, (bf16*)(wl + WO_DN), scr, r, lane);
    }
    __syncthreads();
    constexpr int NU = DEPTH * (NMOD / 64);
    if (vcu < NU) {
        LAS float* sc = (LAS float*)lds;
        LAS float* part = (LAS float*)(lds + 65536);
        { const float* cin = FP(I_C);
#pragma unroll
          for (int h2 = 0; h2 < 2; ++h2) { float cv[16];
#pragma unroll
              for (int q = 0; q < 16; ++q) cv[q] = cin[tid + NWAVES * 64 * (16 * h2 + q)];
#pragma unroll
              for (int q = 0; q < 16; ++q) { const int i = tid + NWAVES * 64 * (16 * h2 + q), b = i / D, k = i % D; sc[k * 16 + b] = silu_f(cv[q]); } } }
        __syncthreads();
        const float* wmod = FP(I_WMOD); const float* bmod = FP(I_BMOD); float* modo = (float*)(WSP() + WS_MOD);
        for (int u = vcu; u < NU; u += G) {
            const int l = u / (NMOD / 64), n0 = (u % (NMOD / 64)) * 64;
            const float* W = wmod + (size_t)l * D * NMOD + n0 + lane;
            float acc[16];
#pragma unroll
            for (int b = 0; b < 16; ++b) acc[b] = 0.f;
            for (int k0 = wave * 128; k0 < wave * 128 + 128; k0 += 32) { float wv[32];
#pragma unroll
                for (int kk = 0; kk < 32; ++kk) wv[kk] = W[(size_t)(k0 + kk) * NMOD];
#pragma unroll
                for (int kk = 0; kk < 32; ++kk) {
#pragma unroll
                    for (int q = 0; q < 4; ++q) { const f32x4 s4 = *(const LAS f32x4*)(sc + (k0 + kk) * 16 + 4 * q);
                        acc[4 * q + 0] += s4[0] * wv[kk]; acc[4 * q + 1] += s4[1] * wv[kk]; acc[4 * q + 2] += s4[2] * wv[kk]; acc[4 * q + 3] += s4[3] * wv[kk]; }
                    __builtin_amdgcn_sched_barrier(0); } }
#pragma unroll
            for (int b = 0; b < 16; ++b) part[(wave * 16 + b) * 64 + lane] = acc[b];
            __syncthreads();
            for (int i = tid; i < 16 * 64; i += NWAVES * 64) { const int b = i >> 6, ln = i & 63; float s = bmod[(size_t)l * NMOD + n0 + ln];
#pragma unroll
                for (int w = 0; w < 8; ++w) s += part[(w * 16 + b) * 64 + ln];
                modo[((size_t)l * BATCH + b) * NMOD + n0 + ln] = s; }
            __syncthreads();
        }
    }
}

__device__ __forceinline__ void norm_phase(const bf16* y, const float* xin, float* xout, const float* gpost, const float* gate, const float* gnext, const float* sc, const float* sh, bf16* XN,
                                           int lane, int wave, int vcu, int G) {
    const int gw = vcu * NWAVES + wave, NGW = G * NWAVES;
    for (int m0 = gw * 16; m0 < M; m0 += NGW * 16) {
        const int b = m0 / SEQ;
        f32x4 vg[4], vt[4], vn[4], vs[4], vh[4];
#pragma unroll
        for (int j = 0; j < 4; ++j) { const int e = 256 * j + 4 * lane;
            if (y) { vg[j] = *(const f32x4*)(gpost + e); vt[j] = *(const f32x4*)(gate + (size_t)b * NMOD + e); }
            if (gnext) { vn[j] = *(const f32x4*)(gnext + e); vs[j] = *(const f32x4*)(sc + (size_t)b * NMOD + e) + 1.f; vh[j] = *(const f32x4*)(sh + (size_t)b * NMOD + e); vn[j] = vn[j] * vs[j]; } }
        for (int r = 0; r < 16; ++r) {
            const size_t row = (size_t)(m0 + r);
            f32x4 xv[4];
#pragma unroll
            for (int j = 0; j < 4; ++j) xv[j] = *(const f32x4*)(xin + row * D + 256 * j + 4 * lane);
            if (y) {
                f32x4 yv[4]; float ss = 0.f;
#pragma unroll
                for (int j = 0; j < 4; ++j) { const u32x2 w = *(const u32x2*)(y + row * D + 256 * j + 4 * lane); yv[j] = (f32x4){bf_lo(w.x), bf_hi(w.x), bf_lo(w.y), bf_hi(w.y)};
                    ss += (yv[j][0] * yv[j][0] + yv[j][1] * yv[j][1]) + (yv[j][2] * yv[j][2] + yv[j][3] * yv[j][3]); }
                const float rstd = rsqrtf(wave_sum(ss) * (1.f / D) + EPS);
#pragma unroll
                for (int j = 0; j < 4; ++j) { xv[j] = xv[j] + vt[j] * (yv[j] * rstd * vg[j]); *(f32x4*)(xout + row * D + 256 * j + 4 * lane) = xv[j]; }
            }
            if (gnext) {
                float ss = 0.f;
#pragma unroll
                for (int j = 0; j < 4; ++j) ss += (xv[j][0] * xv[j][0] + xv[j][1] * xv[j][1]) + (xv[j][2] * xv[j][2] + xv[j][3] * xv[j][3]);
                const float rstd = rsqrtf(wave_sum(ss) * (1.f / D) + EPS);
#pragma unroll
                for (int j = 0; j < 4; ++j) { const f32x4 o = xv[j] * rstd * vn[j] + vh[j]; u32x2 w; w.x = pk2(o[0], o[1]); w.y = pk2(o[2], o[3]); *(u32x2*)(XN + row * D + 256 * j + 4 * lane) = w; }
            }
        }
    }
}

constexpr int IX_SC = 0, IX_KCH = 131072, IX_KPITCH = 144, IX_HIST = IX_KCH, IX_MSK = IX_KCH + 128 * IX_KPITCH, IX_END = IX_MSK + 4096;
static_assert(IX_END <= RING_BYTES && 8 * 576 * 4 <= 128 * IX_KPITCH, "indexer LDS");
__device__ __forceinline__ unsigned ord_key(float f) { const unsigned u = __float_as_uint(f); return u ^ ((unsigned)((int)u >> 31) | 0x80000000u); }
__device__ __forceinline__ unsigned wave_scan_add(unsigned v) {
    v += (unsigned)__builtin_amdgcn_update_dpp(0, (int)v, 0x111, 0xf, 0xf, false);
    v += (unsigned)__builtin_amdgcn_update_dpp(0, (int)v, 0x112, 0xf, 0xf, false);
    v += (unsigned)__builtin_amdgcn_update_dpp(0, (int)v, 0x114, 0xf, 0xf, false);
    v += (unsigned)__builtin_amdgcn_update_dpp(0, (int)v, 0x118, 0xf, 0xf, false);
    v += (unsigned)__builtin_amdgcn_update_dpp(0, (int)v, 0x142, 0xa, 0xf, false);
    v += (unsigned)__builtin_amdgcn_update_dpp(0, (int)v, 0x143, 0xc, 0xf, false);
    return v;
}
template <int NJ> __device__ __forceinline__ void radix_rows(const unsigned (&xa)[NJ], const unsigned (&xb)[NJ], LAS unsigned* hist, int lane,
                                                              unsigned& thrA, unsigned& needA_o, unsigned& eqA_o, unsigned& thrB, unsigned& needB_o, unsigned& eqB_o) {
    unsigned pfA = 0u, ndA = 256u, eA = 0u, pfB = 0u, ndB = 256u, eB = 0u;
    unsigned zero = 0u, one = 1u; asm volatile("" : "+v"(zero), "+v"(one));
    const int rl = 63 - lane;
#if defined(DUP) && DUP == 45
    { *(LAS v4u*)(hist + 4 * lane) = (v4u){zero, zero, zero, zero}; *(LAS v4u*)(hist + 256 + 4 * lane) = (v4u){zero, zero, zero, zero};
#pragma unroll
      for (int j = 0; j < NJ; ++j) { __hip_atomic_fetch_add(hist + ((xa[j] >> 24) & 255u), one, __ATOMIC_RELAXED, __HIP_MEMORY_SCOPE_WORKGROUP); __hip_atomic_fetch_add(hist + 256u + ((xb[j] >> 24) & 255u), one, __ATOMIC_RELAXED, __HIP_MEMORY_SCOPE_WORKGROUP);
          if ((j & 3) == 3) __builtin_amdgcn_sched_barrier(0); } }
#endif
#if defined(DUP) && DUP == 46
    { unsigned acc_ = 0u;
#pragma unroll
      for (int j = 0; j < NJ; ++j) { acc_ += (xa[j] >= one) ? 1u : 0u; acc_ += (xb[j] >= one) ? 1u : 0u; }
      acc_ = wave_scan_add(acc_); asm volatile("" :: "v"(acc_)); }
#endif
#pragma unroll 1
    for (int bit = 31; bit >= 24; --bit) {
        const unsigned cA = pfA | (1u << bit), cB = pfB | (1u << bit); unsigned nA = 0u, nB = 0u;
#pragma unroll
        for (int j = 0; j < NJ; ++j) { nA += (xa[j] >= cA) ? 1u : 0u; nB += (xb[j] >= cB) ? 1u : 0u; if ((j & 3) == 3) __builtin_amdgcn_sched_barrier(0); }
        const unsigned n = (unsigned)__builtin_amdgcn_readlane((int)wave_scan_add(nA | (nB << 16)), 63);
        if ((n & 0xffffu) >= 256u) pfA = cA;
        if ((n >> 16) >= 256u) pfB = cB;
    }
    { const unsigned uA = pfA + (1u << 24), uB = pfB + (1u << 24); unsigned nA = 0u, nB = 0u;
#pragma unroll
      for (int j = 0; j < NJ; ++j) { nA += (uA != 0u && xa[j] >= uA) ? 1u : 0u; nB += (uB != 0u && xb[j] >= uB) ? 1u : 0u; if ((j & 3) == 3) __builtin_amdgcn_sched_barrier(0); }
      const unsigned n = (unsigned)__builtin_amdgcn_readlane((int)wave_scan_add(nA | (nB << 16)), 63);
      ndA = 256u - (n & 0xffffu); ndB = 256u - (n >> 16); }
#pragma unroll
    for (int p = 1; p < 4; ++p) { const int sh = 24 - 8 * p;
        *(LAS v4u*)(hist + 4 * lane) = (v4u){zero, zero, zero, zero}; *(LAS v4u*)(hist + 256 + 4 * lane) = (v4u){zero, zero, zero, zero};
#pragma unroll
        for (int j0 = 0; j0 < NJ; j0 += 4) {
            unsigned mm = 0xffffffffu;
#pragma unroll
            for (int j = j0; j < j0 + 4; ++j) mm = min(mm, min((xa[j] ^ pfA) >> (sh + 8), (xb[j] ^ pfB) >> (sh + 8)));
            if (__any(mm == 0u)) {
#pragma unroll
                for (int j = j0; j < j0 + 4; ++j) { const unsigned va = xa[j], vb = xb[j];
                    if (((va ^ pfA) >> (sh + 8)) == 0u) __hip_atomic_fetch_add(hist + ((va >> sh) & 255u), one, __ATOMIC_RELAXED, __HIP_MEMORY_SCOPE_WORKGROUP);
                    if (((vb ^ pfB) >> (sh + 8)) == 0u) __hip_atomic_fetch_add(hist + 256u + ((vb >> sh) & 255u), one, __ATOMIC_RELAXED, __HIP_MEMORY_SCOPE_WORKGROUP); } }
        }
        const v4u ca = *(const LAS v4u*)(hist + 4 * rl), cb = *(const LAS v4u*)(hist + 256 + 4 * rl);
        const unsigned ta = (ca.x + ca.y) + (ca.z + ca.w), tb = (cb.x + cb.y) + (cb.z + cb.w);
        const unsigned sa = wave_scan_add(ta), sb = wave_scan_add(tb);
#define RADIX_PICK(c, t, sfx, need, pf, eqv) { const unsigned above = sfx - t; const bool mine = (above < need) && (need <= sfx); unsigned bsel, nn, cn, cum = above; \
          if (cum + c.w >= need) { bsel = 3u; nn = need - cum; cn = c.w; } \
          else { cum += c.w; if (cum + c.z >= need) { bsel = 2u; nn = need - cum; cn = c.z; } \
              else { cum += c.z; if (cum + c.y >= need) { bsel = 1u; nn = need - cum; cn = c.y; } else { cum += c.y; bsel = 0u; nn = need - cum; cn = c.x; } } } \
          const unsigned long long bm = __ballot(mine); const int L = (int)__builtin_ctzll(bm | (1ull << 63)); \
          const unsigned bin = (unsigned)__builtin_amdgcn_readlane((int)(4u * (unsigned)rl + bsel), L); \
          need = (unsigned)__builtin_amdgcn_readlane((int)nn, L); eqv = (unsigned)__builtin_amdgcn_readlane((int)cn, L); pf |= bin << sh; }
        RADIX_PICK(ca, ta, sa, ndA, pfA, eA)
        RADIX_PICK(cb, tb, sb, ndB, pfB, eB)
#undef RADIX_PICK
    }
    thrA = pfA; needA_o = ndA; eqA_o = eA; thrB = pfB; needB_o = ndB; eqB_o = eB;
}
template <int NJ> __device__ __forceinline__ void select_rows(const LAS unsigned* scb, LAS unsigned long long* msk, LAS unsigned* hist, int nk, int wave, int lane) {
    unsigned xa[NJ], xb[NJ];
#pragma unroll
    for (int j = 0; j < NJ; ++j) { const unsigned va = scb[(2 * wave) * 2048 + 64 * j + lane], vb = scb[(2 * wave + 1) * 2048 + 64 * j + lane]; const bool in = (64 * j + lane) < nk; xa[j] = in ? va : 0u; xb[j] = in ? vb : 0u; }
    unsigned pA, pB, needA, needB, eA, eB;
    radix_rows<NJ>(xa, xb, hist, lane, pA, needA, eA, pB, needB, eB);
    unsigned xiA = 2047u, xiB = 2047u;
    if ((eA > needA) || (eB > needB)) {
        xiA = 0u; xiB = 0u;
#pragma unroll 1
        for (int bit = 10; bit >= 0; --bit) {
            const unsigned cA = xiA | (1u << bit), cB = xiB | (1u << bit); unsigned nA = 0u, nB = 0u;
#pragma unroll
            for (int j = 0; j < NJ; ++j) { int ll = lane; asm volatile("" : "+v"(ll)); const unsigned key = 64u * j + ll;
                nA += (xa[j] == pA && key < cA) ? 1u : 0u; nB += (xb[j] == pB && key < cB) ? 1u : 0u; if (j & 1) __builtin_amdgcn_sched_barrier(0); }
            unsigned n = nA | (nB << 16);
#pragma unroll
            for (int o = 1; o < 64; o <<= 1) n += __shfl_xor(n, o);
            if ((n & 0xffffu) < needA) xiA = cA;
            if ((n >> 16) < needB) xiB = cB;
        }
    }
    unsigned a0 = 0u, a1 = 0u, b0 = 0u, b1 = 0u;
    const bool ties = (xiA != 2047u) || (xiB != 2047u);
#pragma unroll
    for (int j = 0; j < NJ; ++j) { int ll = lane; asm volatile("" : "+v"(ll)); const unsigned key = 64u * j + ll;
        bool sA = xa[j] >= pA, sB = xb[j] >= pB;
        if (ties) { sA = (xa[j] > pA) || (xa[j] == pA && key <= xiA); sB = (xb[j] > pB) || (xb[j] == pB && key <= xiB); }
        const unsigned long long ba = __ballot(sA), bb = __ballot(sB);
        asm volatile("v_writelane_b32 %0, %4, %8\n\tv_writelane_b32 %1, %5, %8\n\tv_writelane_b32 %2, %6, %8\n\tv_writelane_b32 %3, %7, %8"
                     : "+v"(a0), "+v"(a1), "+v"(b0), "+v"(b1) : "s"((unsigned)ba), "s"((unsigned)(ba >> 32)), "s"((unsigned)bb), "s"((unsigned)(bb >> 32)), "n"(j));
        __builtin_amdgcn_sched_barrier(0);
    }
    if (lane < 32) { msk[lane * 16 + 2 * wave] = (unsigned long long)a0 | ((unsigned long long)a1 << 32); msk[lane * 16 + 2 * wave + 1] = (unsigned long long)b0 | ((unsigned long long)b1 << 32); }
}
struct IxReg { bf16x8 af[4]; float wA[8], wB[8]; v4u pre[2]; };
__device__ __forceinline__ void indexer_load(IxReg& R, int b, int qb16, const bf16* QI, const bf16* KI, const float* WI, int tid, int lane, int wave) {
    if (qb16 < 16) return;
    const int r = lane & 31, hh = lane >> 5, mt = wave & 3, q0 = qb16 * 16; const size_t rowb = (size_t)b * SEQ;
    { const int g = r >> 2, ql = 2 * (g & 1) + (g >> 2), hd = 4 * ((g >> 1) & 1) + (r & 3);
      const bf16* qp = QI + (rowb + q0 + 4 * mt + ql) * 512 + hd * 64 + 8 * hh;
#pragma unroll
      for (int s = 0; s < 4; ++s) R.af[s] = *(const bf16x8*)(qp + 16 * s); }
    { const float* wp = WI + (rowb + q0 + 4 * mt + 2 * hh) * 8;
#pragma unroll
      for (int j = 0; j < 8; ++j) { R.wA[j] = wp[j]; R.wB[j] = wp[8 + j]; } }
#pragma unroll
    for (int i = 0; i < 2; ++i) { const int idx = tid + 512 * i; R.pre[i] = *(const v4u*)(KI + (rowb + (idx >> 3)) * 64 + (idx & 7) * 8); }
}
__device__ __forceinline__ void indexer_unit(LAS unsigned char* lds, int b, int qb16, int nb, int nqb16, IxReg& R, const bf16* QI, const bf16* KI, const float* WI, unsigned long long* MaskG, int tid, int lane, int wave) {
    asm volatile("" : "+v"(tid), "+v"(lane));
    LAS unsigned* scb = (LAS unsigned*)(lds + IX_SC);
    LAS unsigned long long* msk = (LAS unsigned long long*)(lds + IX_MSK);
    const int q0 = qb16 * 16, n_kt = (q0 + 47) >> 5, nk = 32 * n_kt;
    const size_t rowb = (size_t)b * SEQ;
    __syncthreads();
    if (qb16 < 16) {
        { const int T = tid >> 4, i = tid & 15, t = q0 + i;
          msk[T * 16 + i] = (64 * T + 63 <= t) ? ~0ull : (64 * T > t) ? 0ull : ((1ull << (t - 64 * T + 1)) - 1ull); }
        if (nqb16 >= 0) indexer_load(R, nb, nqb16, QI, KI, WI, tid, lane, wave);
    } else {
        const int r = lane & 31, hh = lane >> 5, mt = wave & 3, par = wave >> 2;
        bf16x8 af[4]; float wA[8], wB[8]; v4u pre[2];
#pragma unroll
        for (int s = 0; s < 4; ++s) af[s] = R.af[s];
#pragma unroll
        for (int j = 0; j < 8; ++j) { wA[j] = R.wA[j]; wB[j] = R.wB[j]; }
        pre[0] = R.pre[0]; pre[1] = R.pre[1];
        const int rowA = 4 * mt + 2 * hh, tA = q0 + rowA;
        for (int c = 0; 4 * c < n_kt; ++c) {
            if (c) __syncthreads();
#pragma unroll
            for (int i = 0; i < 2; ++i) { const int idx = tid + 512 * i; *(LAS v4u*)(lds + IX_KCH + (idx >> 3) * IX_KPITCH + (idx & 7) * 16) = pre[i]; }
            __syncthreads();
            if (4 * (c + 1) < n_kt) {
#pragma unroll
                for (int i = 0; i < 2; ++i) { const int idx = tid + 512 * i; pre[i] = *(const v4u*)(KI + (rowb + 128 * (c + 1) + (idx >> 3)) * 64 + (idx & 7) * 8); } }
#pragma unroll
            for (int k = 0; k < 2; ++k) { const int tt = par + 2 * k, tile = 4 * c + tt;
                if (tile < n_kt) {
                    f32x16 acc = {};
#pragma unroll
                    for (int s = 0; s < 4; ++s) { const bf16x8 bfr = *(const LAS bf16x8*)(lds + IX_KCH + (32 * tt + r) * IX_KPITCH + 32 * s + 16 * hh);
                        acc = __builtin_amdgcn_mfma_f32_32x32x16_bf16(af[s], bfr, acc, 0, 0, 0); }
                    float sa = 0.f, sb = 0.f;
#pragma unroll
                    for (int j = 0; j < 8; ++j) { sa += wA[j] * fmaxf(acc[j], 0.f); sb += wB[j] * fmaxf(acc[8 + j], 0.f); }
                    const int key = 32 * tile + r;
                    scb[rowA * 2048 + key] = (key <= tA) ? ord_key(sa) : 0u; scb[(rowA + 1) * 2048 + key] = (key <= tA + 1) ? ord_key(sb) : 0u;
                } }
        }
        __syncthreads();
        if (nqb16 >= 0) indexer_load(R, nb, nqb16, QI, KI, WI, tid, lane, wave);
#ifdef DUP
#pragma unroll 1
        for (int rep_ = 0; rep_ < ((DUP == 44) ? 2 : 1); ++rep_)
#endif
        { LAS unsigned* hist = (LAS unsigned*)(lds + IX_HIST) + 576 * wave;
          if (nk <= 512) select_rows<8>(scb, msk, hist, nk, wave, lane); else if (nk <= 1024) select_rows<16>(scb, msk, hist, nk, wave, lane);
          else if (nk <= 1536) select_rows<24>(scb, msk, hist, nk, wave, lane); else select_rows<32>(scb, msk, hist, nk, wave, lane); }
    }
    __syncthreads();
    asm volatile("" : "+v"(tid));
    { const int T = tid >> 4, i = tid & 15;
      MaskG[((size_t)(b * 8 + (qb16 >> 4)) * 32 + T) * 256 + (qb16 & 15) * 16 + i] = msk[T * 16 + i]; }
}

constexpr int ML_PQ = 272, ML_PV = 320, ML_PS = 144, ML_PN = 132;
constexpr int MA_VS = 0, MA_KW = 20480, MA_CT = 40960, MA_GT = 76288, ML_CW = 137216, ML_END = 142336;
constexpr int MC_QT = 0, MC_KT = 17408, MC_NUM = 0, MC_VS = 34816, MC_SS = 55296, MC_CT = 64512, MC_GT = 99840;
constexpr int ML_CLE = 129 * 128;
static_assert(ML_END <= RING_BYTES && MA_GT + 1024 <= ML_CW && MC_GT + 1024 <= ML_CW && 64 * ML_PN * 4 <= MC_VS && MC_CT + 129 * ML_PQ <= MC_GT && MA_CT + 129 * ML_PQ <= MA_GT, "mLSTM LDS");
__device__ __forceinline__ int crow16(int reg, int hh) { return (reg & 3) + 8 * (reg >> 2) + 4 * hh; }
typedef short v4i16_t __attribute__((ext_vector_type(4)));
__device__ __forceinline__ bf16x8 tr_frag(const LAS unsigned char* tb, int pitch, int c, int ks) {
    const v4i16_t lo = __builtin_amdgcn_ds_read_tr16_b64_v4i16((LAS v4i16_t*)(tb + (16 * ks) * pitch + 64 * c));
    const v4i16_t hi = __builtin_amdgcn_ds_read_tr16_b64_v4i16((LAS v4i16_t*)(tb + (16 * ks + 4) * pitch + 64 * c));
    return (bf16x8){lo[0], lo[1], lo[2], lo[3], hi[0], hi[1], hi[2], hi[3]};
}
__device__ __forceinline__ int tr_base(int lane, int pitch) { return ((lane >> 5) * 8 + ((lane & 15) >> 2)) * pitch + (((lane >> 4) & 1) * 16 + (lane & 3) * 4) * 2; }
__device__ __forceinline__ void mma_tile(f32x16& acc, const LAS unsigned char* a, int pa, const LAS unsigned char* bt, int pb, int ks, int r, int hh) {
    for (int s = 0; s < ks; ++s) { const bf16x8 av = *(const LAS bf16x8*)(a + r * pa + 32 * s + 16 * hh), bv = *(const LAS bf16x8*)(bt + r * pb + 32 * s + 16 * hh);
        acc = __builtin_amdgcn_mfma_f32_32x32x16_bf16(av, bv, acc, 0, 0, 0); }
}
__device__ __forceinline__ void ml_stage_cw(LAS unsigned char* lds, const float* conv_w, const float* conv_b, int hd, int tid) {
    LAS float* cwl = (LAS float*)(lds + ML_CW);
    float tv[3];
#pragma unroll
    for (int k = 0; k < 3; ++k) { const int i = tid + NWAVES * 64 * k; tv[k] = 0.f; if (i < 2 * 5 * 128) { const int z = i / 640, j = (i % 640) >> 7, ch = i & 127, gch = z * 512 + hd * 128 + ch; tv[k] = (j < 4) ? conv_w[j * 1024 + gch] : conv_b[gch]; } }
#pragma unroll
    for (int k = 0; k < 3; ++k) { const int i = tid + NWAVES * 64 * k; if (i < 2 * 5 * 128) cwl[i] = tv[k]; }
}
__device__ __forceinline__ void conv8(float (&y)[8], const bf16* src, int tt0, const LAS float* cw) {
    { const f32x4 b0 = *(const LAS f32x4*)(cw + 4 * 128), b1 = *(const LAS f32x4*)(cw + 4 * 128 + 4); y[0] = b0[0]; y[1] = b0[1]; y[2] = b0[2]; y[3] = b0[3]; y[4] = b1[0]; y[5] = b1[1]; y[6] = b1[2]; y[7] = b1[3]; }
#pragma unroll
    for (int j = 0; j < 4; ++j) { const int tt = tt0 - 3 + j;
        if (tt >= 0) { const v4u xw = *(const v4u*)(src + (size_t)tt * 512); const f32x4 w0 = *(const LAS f32x4*)(cw + j * 128), w1 = *(const LAS f32x4*)(cw + j * 128 + 4);
            y[0] += w0[0] * bf_lo(xw.x); y[1] += w0[1] * bf_hi(xw.x); y[2] += w0[2] * bf_lo(xw.y); y[3] += w0[3] * bf_hi(xw.y);
            y[4] += w1[0] * bf_lo(xw.z); y[5] += w1[1] * bf_hi(xw.z); y[6] += w1[2] * bf_lo(xw.w); y[7] += w1[3] * bf_hi(xw.w); } }
#pragma unroll
    for (int e = 0; e < 8; ++e) y[e] = silu_f(y[e]);
}

__device__ __forceinline__ void conv8r(float (&y)[8], const v4u (&xr)[4], const LAS float* cw) {
    { const f32x4 b0 = *(const LAS f32x4*)(cw + 4 * 128), b1 = *(const LAS f32x4*)(cw + 4 * 128 + 4); y[0] = b0[0]; y[1] = b0[1]; y[2] = b0[2]; y[3] = b0[3]; y[4] = b1[0]; y[5] = b1[1]; y[6] = b1[2]; y[7] = b1[3]; }
#pragma unroll
    for (int j = 0; j < 4; ++j) { const v4u xw = xr[j]; const f32x4 w0 = *(const LAS f32x4*)(cw + j * 128), w1 = *(const LAS f32x4*)(cw + j * 128 + 4);
        y[0] += w0[0] * bf_lo(xw.x); y[1] += w0[1] * bf_hi(xw.x); y[2] += w0[2] * bf_lo(xw.y); y[3] += w0[3] * bf_hi(xw.y);
        y[4] += w1[0] * bf_lo(xw.z); y[5] += w1[1] * bf_hi(xw.z); y[6] += w1[2] * bf_lo(xw.w); y[7] += w1[3] * bf_hi(xw.w); }
#pragma unroll
    for (int e = 0; e < 8; ++e) y[e] = silu_f(y[e]);
}
__device__ __forceinline__ void load_taps(v4u (&xr)[4], const bf16* src, int tt0) {
#pragma unroll
    for (int j = 0; j < 4; ++j) { const int tt = tt0 - 3 + j; xr[j] = (v4u){0u, 0u, 0u, 0u}; if (tt >= 0) xr[j] = *(const v4u*)(src + (size_t)tt * 512); }
}

struct AReg { v4u kx[2][4]; v4u vv[2]; float ig, lf; };
__device__ __forceinline__ void mlstm_A_load(AReg& R, int u, const bf16* KM, const bf16* VM, const float* IG, const float* LF, int tid, int lane, int wave) {
    const int c = u & 31, hd = (u >> 5) & 3, b = u >> 7; const size_t rowb = (size_t)b * SEQ, t0 = rowb + 64 * c;
#pragma unroll
    for (int it = 0; it < 2; ++it) { const int idx = tid + 512 * it, t = (idx >> 4) & 63, g = idx & 15;
        load_taps(R.kx[it], KM + rowb * 512 + hd * 128 + 8 * g, 64 * c + t); R.vv[it] = *(const v4u*)(VM + (t0 + t) * 512 + hd * 128 + 8 * g); }
    R.ig = 0.f; R.lf = 0.f; if (wave == 0) { R.ig = IG[(t0 + lane) * 4 + hd]; R.lf = LF[(t0 + lane) * 4 + hd]; }
}
__device__ __forceinline__ void mlstm_A(LAS unsigned char* lds, int u, int u_next, AReg& R, const bf16* KM, const bf16* VM, const float* IG, const float* LF, bf16* KC, bf16* CL, float* MSC,
                                        int tid, int lane, int wave) {
    asm volatile("" : "+v"(tid), "+v"(lane)); asm volatile("" : "+s"(wave));
    const int r = lane & 31, hh = lane >> 5;
    LAS float* gt = (LAS float*)(lds + MA_GT); LAS bf16* ct = (LAS bf16*)(lds + MA_CT);
    __syncthreads();
    if (wave == 0) {
        float bc = R.lf;
#pragma unroll
        for (int o = 1; o < 64; o <<= 1) { const float v = __shfl_up(bc, o); if (lane >= o) bc += v; }
        const float a = R.ig - bc; float am = a;
#pragma unroll
        for (int o = 1; o < 64; o <<= 1) am = fmaxf(am, __shfl_xor(am, o));
        gt[lane] = __expf(a - am);
        if (lane == 63) { MSC[(size_t)u * 4 + 0] = am; MSC[(size_t)u * 4 + 1] = bc; }
    }
#pragma unroll
    for (int it = 0; it < 2; ++it) { const int idx = tid + 512 * it, t = (idx >> 4) & 63, g = idx & 15;
        float y[8]; conv8r(y, R.kx[it], (const LAS float*)(lds + ML_CW) + 640 + 8 * g);
        v4u o; o.x = pk2(y[0], y[1]); o.y = pk2(y[2], y[3]); o.z = pk2(y[4], y[5]); o.w = pk2(y[6], y[7]);
        *(LAS v4u*)(lds + MA_KW + t * ML_PV + 16 * g) = o; *(v4u*)(KC + ((size_t)u * 64 + t) * 128 + 8 * g) = o;
        *(LAS v4u*)(lds + MA_VS + t * ML_PV + 16 * g) = R.vv[it]; }
    if (u_next >= 0) mlstm_A_load(R, u_next, KM, VM, IG, LF, tid, lane, wave);
    __syncthreads();
#pragma unroll
    for (int it = 0; it < 2; ++it) { const int idx = tid + 512 * it, t = (idx >> 4) & 63, g = idx & 15; const float ws = gt[t];
        LAS v4u* kp = (LAS v4u*)(lds + MA_KW + t * ML_PV + 16 * g); const v4u xw = *kp;
        v4u o; o.x = pk2(ws * bf_lo(xw.x), ws * bf_hi(xw.x)); o.y = pk2(ws * bf_lo(xw.y), ws * bf_hi(xw.y)); o.z = pk2(ws * bf_lo(xw.z), ws * bf_hi(xw.z)); o.w = pk2(ws * bf_lo(xw.w), ws * bf_hi(xw.w)); *kp = o; }
    __syncthreads();
    { const int vi = wave >> 1; const LAS unsigned char* va = lds + MA_VS + tr_base(lane, ML_PV); const LAS unsigned char* kb = lds + MA_KW + tr_base(lane, ML_PV);
      f32x16 acc0 = f32x16{}, acc1 = f32x16{};
#pragma unroll
      for (int ks = 0; ks < 4; ++ks) { const bf16x8 af = tr_frag(va, ML_PV, vi, ks), b0 = tr_frag(kb, ML_PV, 2 * (wave & 1), ks), b1 = tr_frag(kb, ML_PV, 2 * (wave & 1) + 1, ks);
          acc0 = __builtin_amdgcn_mfma_f32_32x32x16_bf16(af, b0, acc0, 0, 0, 0); acc1 = __builtin_amdgcn_mfma_f32_32x32x16_bf16(af, b1, acc1, 0, 0, 0); }
#pragma unroll
      for (int q = 0; q < 16; ++q) { LAS bf16* cp = ct + (32 * vi + crow16(q, hh)) * (ML_PQ / 2) + 64 * (wave & 1) + r; cp[0] = (bf16)f2bf(acc0[q]); cp[32] = (bf16)f2bf(acc1[q]); } }
    if (tid < 128) { float sacc = 0.f;
#pragma unroll 8
        for (int s2 = 0; s2 < 64; ++s2) sacc += __uint_as_float((unsigned)(*(const LAS bf16*)(lds + MA_KW + s2 * ML_PV + 2 * tid)) << 16);
        ct[128 * (ML_PQ / 2) + tid] = (bf16)f2bf(sacc); }
    __syncthreads();
    bf16* dst = CL + (size_t)u * ML_CLE;
    for (int i = tid; i < 129 * 16; i += NWAVES * 64) { const int row = i >> 4, pc = i & 15; *(v4u*)(dst + row * 128 + pc * 8) = *(const LAS v4u*)(lds + MA_CT + row * ML_PQ + pc * 16); }
}

__device__ __forceinline__ void mlstm_B(bf16* CL, float* MSC, int tid, int vcu, int G) {
    constexpr int PCS = ML_CLE / 8;
    for (int item = vcu * (NWAVES * 64) + tid; item < 64 * PCS; item += G * NWAVES * 64) {
        const int bh = item / PCS, pc = item % PCS;
        bf16* base = CL + (size_t)bh * 32 * ML_CLE + pc * 8; float* ms = MSC + (size_t)bh * 32 * 4;
        float cst[8];
#pragma unroll
        for (int e = 0; e < 8; ++e) cst[e] = 0.f;
        float m = 0.f;
#pragma unroll 1
        for (int k0 = 0; k0 < 32; k0 += 8) {
            v4u x[8]; float ak[8], tk[8];
#pragma unroll
            for (int k = 0; k < 8; ++k) { x[k] = *(const v4u*)(base + (size_t)(k0 + k) * ML_CLE); ak[k] = ms[(k0 + k) * 4 + 0]; tk[k] = ms[(k0 + k) * 4 + 1]; }
#pragma unroll
            for (int k = 0; k < 8; ++k) {
                const float Mx = fmaxf(m, ak[k]), dec = __expf(m - Mx), w = __expf(ak[k] - Mx);
                v4u o; o.x = pk2(cst[0], cst[1]); o.y = pk2(cst[2], cst[3]); o.z = pk2(cst[4], cst[5]); o.w = pk2(cst[6], cst[7]);
                *(v4u*)(base + (size_t)(k0 + k) * ML_CLE) = o;
                if (pc == 0) ms[(k0 + k) * 4 + 2] = m;
                cst[0] = dec * cst[0] + w * bf_lo(x[k].x); cst[1] = dec * cst[1] + w * bf_hi(x[k].x); cst[2] = dec * cst[2] + w * bf_lo(x[k].y); cst[3] = dec * cst[3] + w * bf_hi(x[k].y);
                cst[4] = dec * cst[4] + w * bf_lo(x[k].z); cst[5] = dec * cst[5] + w * bf_hi(x[k].z); cst[6] = dec * cst[6] + w * bf_lo(x[k].w); cst[7] = dec * cst[7] + w * bf_hi(x[k].w);
                m = tk[k] + Mx; }
        }
    }
}

struct CReg { v4u cl[5]; v4u kc[2]; v4u vv[2]; v4u qx[2][4]; v4u om[2]; float ig, lf, mp; };
__device__ __forceinline__ void mlstm_C_load(CReg& R, int u, const bf16* QM, const bf16* KC, const bf16* VM, const bf16* OM, const float* IG, const float* LF, const bf16* CL, const float* MSC,
                                             int tid, int lane, int wave) {
    const int c = u & 31, hd = (u >> 5) & 3, b = u >> 7; const size_t rowb = (size_t)b * SEQ, t0 = rowb + 64 * c;
    const bf16* src = CL + (size_t)u * ML_CLE;
#pragma unroll
    for (int k = 0; k < 5; ++k) { const int i = tid + 512 * k; R.cl[k] = (v4u){0u, 0u, 0u, 0u}; if (i < 129 * 16) R.cl[k] = *(const v4u*)(src + (i >> 4) * 128 + (i & 15) * 8); }
#pragma unroll
    for (int it = 0; it < 2; ++it) { const int idx = tid + 512 * it, t = (idx >> 4) & 63, g = idx & 15;
        R.kc[it] = *(const v4u*)(KC + ((size_t)u * 64 + t) * 128 + 8 * g); R.vv[it] = *(const v4u*)(VM + (t0 + t) * 512 + hd * 128 + 8 * g);
        load_taps(R.qx[it], QM + rowb * 512 + hd * 128 + 8 * g, 64 * c + t); }
    { const int ot = tid >> 3, op8 = tid & 7; R.om[0] = *(const v4u*)(OM + (t0 + ot) * 512 + hd * 128 + 16 * op8); R.om[1] = *(const v4u*)(OM + (t0 + ot) * 512 + hd * 128 + 16 * op8 + 8); }
    R.ig = 0.f; R.lf = 0.f; R.mp = 0.f; if (wave == 0) { R.ig = IG[(t0 + lane) * 4 + hd]; R.lf = LF[(t0 + lane) * 4 + hd]; R.mp = MSC[(size_t)u * 4 + 2]; }
}
__device__ __forceinline__ void mlstm_C(LAS unsigned char* lds, int u, int u_next, CReg& R, const bf16* QM, const bf16* KC, const bf16* VM, const bf16* OM, const float* IG, const float* LF,
                                        const float* gain, const bf16* CL, const float* MSC, bf16* ATT, int tid, int lane, int wave) {
    asm volatile("" : "+v"(tid), "+v"(lane)); asm volatile("" : "+s"(wave));
    const int r = lane & 31, hh = lane >> 5, c = u & 31, hd = (u >> 5) & 3, b = u >> 7;
    LAS float* gt = (LAS float*)(lds + MC_GT);
    const size_t rowb = (size_t)b * SEQ, t0 = rowb + 64 * c;
    __syncthreads();
#pragma unroll
    for (int k = 0; k < 5; ++k) { const int i = tid + 512 * k; if (i < 129 * 16) *(LAS v4u*)(lds + MC_CT + (i >> 4) * ML_PQ + (i & 15) * 16) = R.cl[k]; }
    if (wave == 0) {
        const float m_prev = R.mp;
        float bc = R.lf;
#pragma unroll
        for (int o = 1; o < 64; o <<= 1) { const float v = __shfl_up(bc, o); if (lane >= o) bc += v; }
        const float a = R.ig - bc; float pm = a;
#pragma unroll
        for (int o = 1; o < 64; o <<= 1) { const float v = __shfl_up(pm, o); if (lane >= o) pm = fmaxf(pm, v); }
        gt[lane] = a; gt[64 + lane] = fmaxf(m_prev, pm); gt[128 + lane] = bc;
        if (lane == 0) gt[194] = m_prev;
    }
    const int ot = tid >> 3, op8 = tid & 7;
    const v4u og0 = R.om[0], og1 = R.om[1];
#pragma unroll
    for (int it = 0; it < 2; ++it) { const int idx = tid + 512 * it, t = (idx >> 4) & 63, g = idx & 15;
        *(LAS v4u*)(lds + MC_KT + t * ML_PQ + 16 * g) = R.kc[it];
        *(LAS v4u*)(lds + MC_VS + t * ML_PV + 16 * g) = R.vv[it];
        float y[8]; conv8r(y, R.qx[it], (const LAS float*)(lds + ML_CW) + 8 * g);
        const float sc = 0.08838834764831845f;
        v4u o; o.x = pk2(y[0] * sc, y[1] * sc); o.y = pk2(y[2] * sc, y[3] * sc); o.z = pk2(y[4] * sc, y[5] * sc); o.w = pk2(y[6] * sc, y[7] * sc);
        *(LAS v4u*)(lds + MC_QT + t * ML_PQ + 16 * g) = o; }
    if (u_next >= 0) mlstm_C_load(R, u_next, QM, KC, VM, OM, IG, LF, CL, MSC, tid, lane, wave);
    __syncthreads();
    if (wave < 4) { const int ti = wave >> 1, si = wave & 1; f32x16 g = f32x16{};
        if (si <= ti) mma_tile(g, lds + MC_QT + 32 * ti * ML_PQ, ML_PQ, lds + MC_KT + 32 * si * ML_PQ, ML_PQ, 8, r, hh);
        const float as = gt[32 * si + r]; LAS bf16* sp = (LAS bf16*)(lds + MC_SS);
#pragma unroll
        for (int q = 0; q < 16; ++q) { const int tl = crow16(q, hh), t = 32 * ti + tl, s2 = 32 * si + r;
            const float v = g[q] * __expf(fminf(as - gt[64 + t], 0.f)); sp[t * (ML_PS / 2) + s2] = (bf16)f2bf((s2 <= t) ? v : 0.f); } }
    __syncthreads();
    f32x16 nm = f32x16{};
    { const int ti = wave >> 2, vi = wave & 3;
      mma_tile(nm, lds + MC_QT + 32 * ti * ML_PQ, ML_PQ, lds + MC_CT + 32 * vi * ML_PQ, ML_PQ, 8, r, hh);
      const float mp = gt[194];
#pragma unroll
      for (int q = 0; q < 16; ++q) nm[q] *= __expf(mp - gt[64 + 32 * ti + crow16(q, hh)]);
      const LAS unsigned char* vb = lds + MC_VS + tr_base(lane, ML_PV);
#pragma unroll
      for (int ks = 0; ks < 4; ++ks) { const bf16x8 av = *(const LAS bf16x8*)(lds + MC_SS + (32 * ti + r) * ML_PS + 32 * ks + 16 * hh), bv = tr_frag(vb, ML_PV, vi, ks);
          nm = __builtin_amdgcn_mfma_f32_32x32x16_bf16(av, bv, nm, 0, 0, 0); } }
    float den;
    { const v4u sw = *(const LAS v4u*)(lds + MC_SS + ot * ML_PS + 16 * op8);
      float d1 = (bf_lo(sw.x) + bf_hi(sw.x)) + (bf_lo(sw.y) + bf_hi(sw.y)) + (bf_lo(sw.z) + bf_hi(sw.z)) + (bf_lo(sw.w) + bf_hi(sw.w)), d2 = 0.f;
#pragma unroll
      for (int k = 0; k < 2; ++k) { const v4u qw = *(const LAS v4u*)(lds + MC_QT + ot * ML_PQ + 32 * op8 + 16 * k), nw = *(const LAS v4u*)(lds + MC_CT + 128 * ML_PQ + 32 * op8 + 16 * k);
          d2 += bf_lo(qw.x) * bf_lo(nw.x) + bf_hi(qw.x) * bf_hi(nw.x) + bf_lo(qw.y) * bf_lo(nw.y) + bf_hi(qw.y) * bf_hi(nw.y) + bf_lo(qw.z) * bf_lo(nw.z) + bf_hi(qw.z) * bf_hi(nw.z) + bf_lo(qw.w) * bf_lo(nw.w) + bf_hi(qw.w) * bf_hi(nw.w); }
      den = d1 + __expf(gt[194] - gt[64 + ot]) * d2;
      den += __shfl_xor(den, 1); den += __shfl_xor(den, 2); den += __shfl_xor(den, 4); }
    __syncthreads();
    { const int ti = wave >> 2, vi = wave & 3; LAS float* np = (LAS float*)(lds + MC_NUM);
#pragma unroll
      for (int q = 0; q < 16; ++q) np[(32 * ti + crow16(q, hh)) * ML_PN + 32 * vi + r] = nm[q]; }
    __syncthreads();
    { const int t = ot, p = op8; const LAS float* np = (const LAS float*)(lds + MC_NUM) + t * ML_PN;
      const float mrow = gt[128 + t] + gt[64 + t], scl = 1.f / fmaxf(fabsf(den), __expf(-mrow));
      float hv[16]; float ss = 0.f;
#pragma unroll
      for (int e = 0; e < 16; ++e) { hv[e] = np[16 * p + e] * scl; ss += hv[e] * hv[e]; }
      ss += __shfl_xor(ss, 1); ss += __shfl_xor(ss, 2); ss += __shfl_xor(ss, 4);
      const float rs = rsqrtf(ss * (1.f / 128.f) + EPS);
      const v4u o0 = og0, o1 = og1;
      const float og[16] = {bf_lo(o0.x), bf_hi(o0.x), bf_lo(o0.y), bf_hi(o0.y), bf_lo(o0.z), bf_hi(o0.z), bf_lo(o0.w), bf_hi(o0.w), bf_lo(o1.x), bf_hi(o1.x), bf_lo(o1.y), bf_hi(o1.y), bf_lo(o1.z), bf_hi(o1.z), bf_lo(o1.w), bf_hi(o1.w)};
      const float* gp = gain + hd * 128 + 16 * p;
#pragma unroll
      for (int e = 0; e < 16; ++e) hv[e] = hv[e] * rs * gp[e] * og[e];
      v4u w0, w1; w0.x = pk2(hv[0], hv[1]); w0.y = pk2(hv[2], hv[3]); w0.z = pk2(hv[4], hv[5]); w0.w = pk2(hv[6], hv[7]); w1.x = pk2(hv[8], hv[9]); w1.y = pk2(hv[10], hv[11]); w1.z = pk2(hv[12], hv[13]); w1.w = pk2(hv[14], hv[15]);
      bf16* op = ATT + (t0 + t) * 1024 + 512 + hd * 128 + 16 * p; *(v4u*)op = w0; *(v4u*)(op + 8) = w1; }
}

struct Args { const void* in[22]; float* out; unsigned char* ws; int ph_lo, ph_hi; };
__global__ void __launch_bounds__(NWAVES * 64, 2) hybrid_fwd(Args args) {
    extern __shared__ __attribute__((aligned(16))) unsigned char lds_raw[];
    LAS unsigned char* lds = (LAS unsigned char*)lds_raw;
    volatile LAS unsigned* MISC = (volatile LAS unsigned*)(lds + LDSCTL_OFF);
    const int G0 = gridDim.x, bid0 = blockIdx.x; const int vcu0 = (G0 % 8 == 0) ? (bid0 % 8) * (G0 / 8) + bid0 / 8 : bid0;
#define PHASE_BEGIN() unsigned ones_ = ~0u; asm volatile("" : "+s"(ones_)); int lane = (int)__builtin_amdgcn_mbcnt_hi(ones_, __builtin_amdgcn_mbcnt_lo(ones_, 0u)), tid = wave0 * 64 + lane; asm volatile("" : "+v"(tid), "+v"(lane)); const int wave = __builtin_amdgcn_readfirstlane(tid >> 6); \
    int G = G0, vcu = vcu0, bid = bid0; asm volatile("" : "+s"(G), "+s"(vcu), "+s"(bid)); (void)wave; (void)lane; (void)vcu; (void)bid; (void)G
    const int wave0 = __builtin_amdgcn_readfirstlane((int)threadIdx.x >> 6);
    { const int tid = threadIdx.x;
    for (int u = tid; u < (LDS_BYTES - LDSCTL_OFF) / 4; u += NWAVES * 64) ((LAS unsigned*)(lds + LDSCTL_OFF))[u] = 0u;
    __syncthreads();
    if (tid == 0) { LAS unsigned long long* pb = (LAS unsigned long long*)(lds + LDSCTL_OFF + 64);
#pragma unroll
        for (int k = 0; k < 22; ++k) pb[k] = (unsigned long long)args.in[k];
        pb[I_OUT] = (unsigned long long)args.out; pb[I_WS] = (unsigned long long)args.ws; }
    __syncthreads(); }
    const int lo = args.ph_lo, hi = args.ph_hi;
    XcdBarrier bar; bar.bar = (unsigned*)(args.ws + WS_CTL) + CW_BAR; bar.x = 0; bar.st = nullptr;
    if (hi - lo > 1) bar = xcd_barrier_post((unsigned*)(args.ws + WS_CTL) + CW_BAR, MISC + 8);
#ifndef ONLY
#define ONLY -1
#endif
#define PH_ON(c) (ONLY < 0 || ONLY == (c))
#ifndef DUP
#define DUP -1
#endif
#define REPS(c) _Pragma("unroll 1") for (int rep_ = 0; rep_ < ((DUP == (c)) ? 2 : 1); ++rep_)
#define IN(k) (lo <= (k) && (k) < hi)
#define OPAQUE_GEMM(g) asm volatile("" : "+s"(g.A), "+s"(g.Bt))
#define SEAM(k) do { if (IN(k) && IN((k) + 1)) { bar.bar = (unsigned*)(WSP() + WS_CTL) + CW_BAR; xcd_barrier(bar); } } while (0)
#define XNB   ((bf16*)(WSPG() + WS_XN))
#define MXB(o) (WSPG() + WS_MIX + (o))
#define MODB  ((float*)(WSPG() + WS_MOD))
#define SSQB  ((float*)(WSPG() + WS_SSQ))

    REPS(0) { PHASE_BEGIN(); if (PH_ON(0) && IN(0)) p0_prologue(lds, tid, lane, wave, vcu, G); }
    SEAM(0);
#if defined(DUP) && DUP == 50
    for (int xb_ = 0; xb_ < 20; ++xb_) SEAM(0);
#endif
    { PHASE_BEGIN(); if (PH_ON(1) && IN(1)) norm_phase(nullptr, FP(I_X), nullptr, nullptr, nullptr, FP(I_MIXPRE), MODB + 1 * D, MODB + 0 * D, XNB, lane, wave, vcu, G); }
    SEAM(1);

    for (int l = 0; l < DEPTH; ++l) {
        const int pb = 2 + 9 * l;
        if (PH_ON(2) && IN(pb + 0)) REPS(2) { PHASE_BEGIN();
            unsigned char* wl = WSP() + WS_W + (size_t)l * W_LAYER;
            pg8::Gemm g{XNB, (const bf16*)(wl + WO_IN), M, NINP, D}; OPAQUE_GEMM(g); pg8::StaticOrder S; S.init(M, NINP, G, bid);
            pg8::EpiIn E{(bf16*)MXB(MX_CQ), (bf16*)MXB(MX_K), (bf16*)MXB(MX_V), (bf16*)MXB(MX_KI), (bf16*)MXB(MX_QM), (bf16*)MXB(MX_KM), (bf16*)MXB(MX_VM), (bf16*)MXB(MX_OM), SSQB, (float*)MXB(MX_WI), (float*)MXB(MX_IG), (float*)MXB(MX_LF),
                         GPTR(const int, ldptr(lds, I_POS)), FP(I_BIG) + l * 4, FP(I_BFG) + l * 4};
            pg8::gemm_phase<pg8::EpiIn, pg8::StaticOrder, true, true>(lds, g, S, E, tid);
        }
        SEAM(pb + 0);
#ifndef SUB
#define SUB 0
#endif
#define MSCB ((float*)(WSPG() + WS_SSQ + 512 * 1024))
#define MLSTM_A_BLOCK() do { PHASE_BEGIN(); int cur_hd = -1; \
            if (SUB != 1 && vcu < 2048) { AReg RA; mlstm_A_load(RA, vcu, (const bf16*)MXB(MX_KM), (const bf16*)MXB(MX_VM), (const float*)MXB(MX_IG), (const float*)MXB(MX_LF), tid, lane, wave); \
              for (int u = vcu; u < 2048; u += G) { const int hd = (u >> 5) & 3; \
                if (hd != cur_hd) { __syncthreads(); ml_stage_cw(lds, FP(I_CONVW) + (size_t)l * 4 * 1024, FP(I_CONVB) + (size_t)l * 1024, hd, tid); cur_hd = hd; }       \
                mlstm_A(lds, u, (u + G < 2048) ? u + G : -1, RA, (const bf16*)MXB(MX_KM), (const bf16*)MXB(MX_VM), (const float*)MXB(MX_IG), (const float*)MXB(MX_LF), (bf16*)MXB(MX_KC), (bf16*)MXB(MX_CL), MSCB, tid, lane, wave); } } \
            __syncthreads(); } while (0)
        if (PH_ON(3) && IN(pb + 1)) REPS(3) { PHASE_BEGIN();
            unsigned char* wl = WSP() + WS_W + (size_t)l * W_LAYER;
            pg8::Gemm g{(const bf16*)MXB(MX_CQ), (const bf16*)(wl + WO_Q), M, 1024, QRK}; OPAQUE_GEMM(g); pg8::StaticOrder S; S.init(M, 1024, G, bid);
            pg8::EpiQ E{(bf16*)MXB(MX_Q), (bf16*)MXB(MX_QI), SSQB, GPTR(const int, ldptr(lds, I_POS)), attn_body::C2};
            pg8::gemm_phase<pg8::EpiQ, pg8::StaticOrder, true, true>(lds, g, S, E, tid);
        }
        if (PH_ON(4) && IN(pb + 1)) REPS(41) MLSTM_A_BLOCK();
        SEAM(pb + 1);
        if (PH_ON(4) && IN(pb + 2)) { PHASE_BEGIN();
            if (SUB != 1) REPS(42) mlstm_B((bf16*)MXB(MX_CL), MSCB, tid, vcu, G);
            if (SUB != 2) REPS(40) { IxReg RI = {};
#define IX_L(i) ((i) * G + (((i) & 1) ? G - 1 - vcu : vcu))
                if (IX_L(0) < BATCH * 128) indexer_load(RI, IX_L(0) & 15, 127 - (IX_L(0) >> 4), (const bf16*)MXB(MX_QI), (const bf16*)MXB(MX_KI), (const float*)MXB(MX_WI), tid, lane, wave);
                for (int i = 0; i * G < BATCH * 128; ++i) { const int L = IX_L(i), Ln = IX_L(i + 1); const bool hn = ((i + 1) * G < BATCH * 128) && (Ln < BATCH * 128);
                    if (L < BATCH * 128) indexer_unit(lds, L & 15, 127 - (L >> 4), hn ? (Ln & 15) : 0, hn ? 127 - (Ln >> 4) : -1, RI, (const bf16*)MXB(MX_QI), (const bf16*)MXB(MX_KI), (const float*)MXB(MX_WI), (unsigned long long*)MXB(MX_MASK), tid, lane, wave); }
#undef IX_L
            }
        }
        SEAM(pb + 2);
#define MLSTM_C_BLOCK() do { PHASE_BEGIN(); int cur_hd = -1; \
            if (SUB != 1 && vcu < 2048) { CReg RC; mlstm_C_load(RC, vcu, (const bf16*)MXB(MX_QM), (const bf16*)MXB(MX_KC), (const bf16*)MXB(MX_VM), (const bf16*)MXB(MX_OM), (const float*)MXB(MX_IG), (const float*)MXB(MX_LF), (const bf16*)MXB(MX_CL), MSCB, tid, lane, wave); \
              for (int u = vcu; u < 2048; u += G) { const int hd = (u >> 5) & 3; \
                if (hd != cur_hd) { __syncthreads(); ml_stage_cw(lds, FP(I_CONVW) + (size_t)l * 4 * 1024, FP(I_CONVB) + (size_t)l * 1024, hd, tid); cur_hd = hd; } \
                mlstm_C(lds, u, (u + G < 2048) ? u + G : -1, RC, (const bf16*)MXB(MX_QM), (const bf16*)MXB(MX_KC), (const bf16*)MXB(MX_VM), (const bf16*)MXB(MX_OM), (const float*)MXB(MX_IG), (const float*)MXB(MX_LF), \
                        FP(I_MLN) + (size_t)l * 512, (const bf16*)MXB(MX_CL), MSCB, XNB, tid, lane, wave); } } \
            __syncthreads(); } while (0)
        if (PH_ON(4) && IN(pb + 3)) REPS(43) MLSTM_C_BLOCK();
        if (PH_ON(5) && IN(pb + 3)) REPS(5) { PHASE_BEGIN();
            const attn_body::AttnTensors AT{(const attn_body::bf16*)MXB(MX_Q), (const attn_body::bf16*)MXB(MX_K), (const attn_body::bf16*)MXB(MX_V), (attn_body::bf16*)XNB, (const attn_body::u32x4*)MXB(MX_MASK), FP(I_ATTN) + (size_t)l * 512};
            const attn_body::StaticOrder S(G, bid);
            attn_body::attn_phase<attn_body::StaticOrder>((char*)lds_raw, AT, S, tid);
        }
        SEAM(pb + 3);
        if (PH_ON(6) && IN(pb + 4)) REPS(6) { PHASE_BEGIN();
            unsigned char* wl = WSP() + WS_W + (size_t)l * W_LAYER;
            pg8::Gemm g{XNB, (const bf16*)(wl + WO_OUT), M, D, D}; OPAQUE_GEMM(g); pg8::StaticOrder S; S.init(M, D, G, bid);
            pg8::EpiPlain E{(bf16*)MXB(MX_Y), D};
            pg8::gemm_phase<pg8::EpiPlain, pg8::StaticOrder, true, true>(lds, g, S, E, tid);
        }
        SEAM(pb + 4);
        if (PH_ON(1) && IN(pb + 5)) { PHASE_BEGIN(); const float* modl = MODB + (size_t)l * BATCH * NMOD; float* outp = GPTR(float, ldptr(lds, I_OUT));
            norm_phase((const bf16*)MXB(MX_Y), l == 0 ? FP(I_X) : (const float*)outp, outp, FP(I_MIXPOST) + (size_t)l * D, modl + 2 * D, FP(I_FFNPRE) + (size_t)l * D, modl + 4 * D, modl + 3 * D, XNB, lane, wave, vcu, G); }
        SEAM(pb + 5);
        if (PH_ON(7) && IN(pb + 6)) REPS(7) { PHASE_BEGIN();
            unsigned char* wl = WSP() + WS_W + (size_t)l * W_LAYER;
            pg8::Gemm g{XNB, (const bf16*)(wl + WO_GU), M, 2 * FF, D}; OPAQUE_GEMM(g); pg8::StaticOrder S; S.init(M, 2 * FF, G, bid);
            pg8::EpiSwiglu E{(bf16*)MXB(MX_H), FF};
            pg8::gemm_phase<pg8::EpiSwiglu, pg8::StaticOrder, true, true>(lds, g, S, E, tid);
        }
        SEAM(pb + 6);
        if (PH_ON(6) && IN(pb + 7)) REPS(8) { PHASE_BEGIN();
            unsigned char* wl = WSP() + WS_W + (size_t)l * W_LAYER;
            pg8::Gemm g{(const bf16*)MXB(MX_H), (const bf16*)(wl + WO_DN), M, D, FF}; OPAQUE_GEMM(g); pg8::StaticOrder S; S.init(M, D, G, bid);
            pg8::EpiPlain E{(bf16*)MXB(MX_Y), D};
            pg8::gemm_phase<pg8::EpiPlain, pg8::StaticOrder, true, true>(lds, g, S, E, tid);
        }
        SEAM(pb + 7);
        if (PH_ON(1) && IN(pb + 8)) { PHASE_BEGIN();
            const bool last = (l == DEPTH - 1); const float* modl = MODB + (size_t)l * BATCH * NMOD; const float* modn = MODB + (size_t)(l + 1) * BATCH * NMOD; float* outp = GPTR(float, ldptr(lds, I_OUT));
            norm_phase((const bf16*)MXB(MX_Y), outp, outp, FP(I_FFNPOST) + (size_t)l * D, modl + 5 * D, last ? nullptr : FP(I_MIXPRE) + (size_t)(l + 1) * D, modn + 1 * D, modn + 0 * D, XNB, lane, wave, vcu, G);
        }
        SEAM(pb + 8);
    }
#undef IN
#undef SEAM
}

extern "C" void kernel_launch(void* const* d_in, const int* in_sizes, int n_in, void* d_out, int out_size, void* d_ws, size_t ws_size, hipStream_t stream) {
    static int grid = 0;
    if (grid == 0) {
        if (n_in != 22 || in_sizes[0] != M * D || out_size != M * D || ws_size < WS_END) { fprintf(stderr, "kernel_launch: built for 22 inputs, x/out of %d floats, >= %zu bytes of workspace; got n_in %d, in0 %d, out %d, ws %zu; nothing launched\n", M * D, (size_t)WS_END, n_in, n_in > 0 ? in_sizes[0] : -1, out_size, ws_size); grid = -1; return; }
        int dev = 0, cus = 0, per_cu = 0;
        if (hipGetDevice(&dev) != hipSuccess || hipDeviceGetAttribute(&cus, hipDeviceAttributeMultiprocessorCount, dev) != hipSuccess) { fprintf(stderr, "kernel_launch: device query failed\n"); grid = -1; return; }
        if (hipFuncSetAttribute((const void*)hybrid_fwd, hipFuncAttributeMaxDynamicSharedMemorySize, LDS_BYTES) != hipSuccess) { fprintf(stderr, "kernel_launch: hipFuncSetAttribute(%d B LDS) failed\n", LDS_BYTES); grid = -1; return; }
        if (hipOccupancyMaxActiveBlocksPerMultiprocessor(&per_cu, (const void*)hybrid_fwd, NWAVES * 64, LDS_BYTES) != hipSuccess || per_cu < 1)
            fprintf(stderr, "kernel_launch: note: occupancy query reports %d workgroups per CU\n", per_cu);
        (void)hipGetLastError();
        grid = cus;
    }
    if (grid < 0) return;
    if (hipMemsetAsync((char*)d_ws + WS_CTL, 0, CTL_ZERO_BYTES, stream) != hipSuccess) { fprintf(stderr, "kernel_launch: hipMemsetAsync failed\n"); return; }
    Args a{};
    for (int i = 0; i < 22; ++i) a.in[i] = d_in[i];
    a.out = (float*)d_out; a.ws = (unsigned char*)d_ws;
#if MK_ONE_LAUNCH
    a.ph_lo = 0; a.ph_hi = N_PHASES;
    hipLaunchKernelGGL(hybrid_fwd, dim3(grid), dim3(NWAVES * 64), LDS_BYTES, stream, a);
#else
    for (int p = 0; p < N_PHASES; ++p) { a.ph_lo = p; a.ph_hi = p + 1; hipLaunchKernelGGL(hybrid_fwd, dim3(grid), dim3(NWAVES * 64), LDS_BYTES, stream, a); }
#endif
    const hipError_t le = hipPeekAtLastError();
    if (le != hipSuccess) fprintf(stderr, "kernel_launch: launch failed: %s (grid %d x %d threads, %d B LDS)\n", hipGetErrorName(le), grid, NWAVES * 64, LDS_BYTES);
}
```

```cpp
#include <hip/hip_runtime.h>
#include <hip/hip_bf16.h>
#include <cstdio>
#include <cstdint>
#include <cmath>
namespace pg8 {
#define PG8_LAS __attribute__((address_space(3)))
typedef unsigned short bf16_t;
typedef short bf16x8 __attribute__((ext_vector_type(8)));
typedef float f32x4 __attribute__((ext_vector_type(4)));
typedef unsigned u32x4 __attribute__((ext_vector_type(4)));
constexpr int PROBE_LDS_OFF = 153600 + 448 - 16;
constexpr int BM = 256, BK = 64, HALF = 128, HTB = HALF * BK * 2  , STAGE_BYTES = 8 * HTB, NXCD = 8, WGM = 8;

__host__ __device__ __forceinline__ int lds_byte(int r, int c) { const int st = (r >> 4) * 2 + (c >> 5), rr = r & 15, cc = c & 31, ob = rr * 64 + cc * 2; return st * 1024 + (ob ^ (((ob >> 9) & 1) << 5)); }
__host__ __device__ __forceinline__ void stage_rc(int b, int& R, int& C) { const int st = b / 1024, sb = b % 1024, swz = sb ^ (((sb >> 9) & 1) << 5); R = (st >> 1) * 16 + swz / 64; C = (st & 1) * 32 + (swz % 64) / 2; }
__host__ __device__ __forceinline__ int perm32(int rho) { const int n = rho >> 4, i = rho & 15; return 8 * (i >> 2) + 4 * n + (i & 3); }

struct Unit { int pm, pn; };
struct Gemm { const bf16_t* A; const bf16_t* Bt; int M, N, K; };

struct StaticOrder {
    int nM, nN, nwg, G, c;
    __host__ __device__ void init(int M, int N, int G_, int c_) { nM = M / BM; nN = N / BM; nwg = nM * nN; G = G_; c = c_; }
    __host__ __device__ bool next(int i, Unit& u) const {
        const long L = (long)i * G + c; if (L >= nwg) return false;
        int wgid = (int)L; { const int q = nwg / NXCD, r = nwg % NXCD, xcd = wgid % NXCD, off = wgid / NXCD; wgid = (xcd < r ? xcd * (q + 1) : r * (q + 1) + (xcd - r) * q) + off; }
        const int nig = WGM * nN, gid = wgid / nig, fm = gid * WGM, gsz = (nM - fm) < WGM ? (nM - fm) : WGM;
        u.pm = fm + ((wgid % nig) % gsz); u.pn = (wgid % nig) / gsz; return true;
    }
    __device__ __forceinline__ void a_ready(const Unit&) const {}
    __device__ __forceinline__ void done(const Unit&) const {}
};

__device__ __forceinline__ unsigned cvt_pk_bf16(float lo, float hi) { unsigned r; asm volatile("v_cvt_pk_bf16_f32 %0, %1, %2" : "=v"(r) : "v"(lo), "v"(hi)); return r; }
typedef float f32x2 __attribute__((ext_vector_type(2)));

__device__ __forceinline__ void store8(bf16_t* p, const f32x4 a, const f32x4 b) {
    u32x4 w; w.x = cvt_pk_bf16(a[0], a[1]); w.y = cvt_pk_bf16(a[2], a[3]); w.z = cvt_pk_bf16(b[0], b[1]); w.w = cvt_pk_bf16(b[2], b[3]);
#ifdef STORE_SC1
    asm volatile("global_store_dwordx4 %0, %1, off sc1\n\ts_nop 1" :: "v"(p), "v"(w) : "memory");
#else
    *(u32x4*)p = w;
#endif

}
__device__ __forceinline__ float sigmoid_f(float g) { return __builtin_amdgcn_rcpf(1.f + __builtin_amdgcn_exp2f(-1.4426950408889634f * g)); }
__device__ __forceinline__ float silu_f(float g) { return g * sigmoid_f(g); }
__device__ __forceinline__ void rope_invf(float (&invf)[4], int wc, int fq) {
    const int j = 4 * (wc & 1) + fq;
#pragma unroll
    for (int e = 0; e < 4; ++e) invf[e] = exp2f(-(float)(4 * j + e) * 0.41524101186092029f) * 0.15915494309189535f;
}
__device__ __forceinline__ void rope_sincos(float (&sn)[4], float (&cs)[4], float p, const float (&invf)[4]) {
#pragma unroll
    for (int e = 0; e < 4; ++e) { const float r = __builtin_amdgcn_fractf(p * invf[e]); sn[e] = __builtin_amdgcn_sinf(r); cs[e] = __builtin_amdgcn_cosf(r); }
}
__device__ __forceinline__ void rope_apply(f32x4& x1, f32x4& x2, const float (&sn)[4], const float (&cs)[4]) {
    f32x4 o1, o2;
#pragma unroll
    for (int e = 0; e < 4; ++e) { o1[e] = x1[e] * cs[e] - x2[e] * sn[e]; o2[e] = x2[e] * cs[e] + x1[e] * sn[e]; }
    x1 = o1; x2 = o2;
}

struct EpiIn {
    static constexpr bool PERM = true, AFTER_DRAIN = false; static constexpr int PROBE = 2;
    bf16_t *CQ, *K, *V, *KI, *QM, *KM, *VM, *OM; float *SSQ, *WI, *IG, *LF; const int* pos; const float *b_ig, *b_fg;
    __device__ __forceinline__ void operator()(const f32x4 (&acc)[2][2][4][2], const Unit& u, int wr, int wc, int fr, int fq) const {
        { unsigned ones_ = ~0u; asm volatile("" : "+s"(ones_)); const int ln_ = (int)__builtin_amdgcn_mbcnt_hi(ones_, __builtin_amdgcn_mbcnt_lo(ones_, 0u)); fr = ln_ & 15; fq = ln_ >> 4; }
        const int row0 = u.pm * BM + wr * 64 + fr, ct = wc * 32 + 8 * fq, pn = u.pn;
        if (pn == 0) {
#pragma unroll
            for (int ai = 0; ai < 2; ++ai)
#pragma unroll
                for (int m = 0; m < 4; ++m) { const int row = row0 + ai * HALF + m * 16; float s = 0.f;
#pragma unroll
                    for (int bj = 0; bj < 2; ++bj) { const f32x4 v0 = acc[ai][bj][m][0], v1 = acc[ai][bj][m][1];
                        s += (v0[0] * v0[0] + v0[1] * v0[1]) + (v0[2] * v0[2] + v0[3] * v0[3]) + (v1[0] * v1[0] + v1[1] * v1[1]) + (v1[2] * v1[2] + v1[3] * v1[3]);
                        store8(CQ + (size_t)row * 256 + bj * HALF + ct, v0, v1); }
                    s += __shfl_xor(s, 16); s += __shfl_xor(s, 32);
                    if (fq == 0) SSQ[(size_t)row * 4 + wc] = s; }
        } else if (pn <= 2) {
            float invf[4]; rope_invf(invf, wc, fq);
            int psv[2][4];
#pragma unroll
            for (int ai = 0; ai < 2; ++ai)
#pragma unroll
                for (int m = 0; m < 4; ++m) psv[ai][m] = pos[row0 + ai * HALF + m * 16];
#pragma unroll
            for (int ai = 0; ai < 2; ++ai)
#pragma unroll
                for (int m = 0; m < 4; ++m) { const int row = row0 + ai * HALF + m * 16; float sn[4], cs[4]; rope_sincos(sn, cs, (float)psv[ai][m], invf);
#pragma unroll
                    for (int bj = 0; bj < 2; ++bj) { f32x4 v0 = acc[ai][bj][m][0], v1 = acc[ai][bj][m][1]; rope_apply(v0, v1, sn, cs);
                        store8(K + (size_t)row * 512 + (pn - 1) * 256 + bj * HALF + ct, v0, v1); } }
        } else if (pn <= 12) {
            const int g = (pn - 3) >> 1; bf16_t* dst = (g == 0) ? V : (g == 1) ? QM : (g == 2) ? KM : (g == 3) ? VM : OM; const int cb = ((pn - 3) & 1) * 256 + ct;
#pragma unroll
            for (int ai = 0; ai < 2; ++ai)
#pragma unroll
                for (int m = 0; m < 4; ++m) { const int row = row0 + ai * HALF + m * 16;
#pragma unroll
                    for (int bj = 0; bj < 2; ++bj) { f32x4 v0 = acc[ai][bj][m][0], v1 = acc[ai][bj][m][1];
                        if (g == 4) {
#pragma unroll
                            for (int e = 0; e < 4; ++e) { v0[e] = sigmoid_f(v0[e]); v1[e] = sigmoid_f(v1[e]); } }
                        store8(dst + (size_t)row * 512 + cb + bj * HALF, v0, v1); } }
        } else {
            if (wc < 2) {
                float invf[4]; rope_invf(invf, wc, fq);
                int psv[2][4];
#pragma unroll
                for (int ai = 0; ai < 2; ++ai)
#pragma unroll
                    for (int m = 0; m < 4; ++m) psv[ai][m] = pos[row0 + ai * HALF + m * 16];
#pragma unroll
                for (int ai = 0; ai < 2; ++ai)
#pragma unroll
                    for (int m = 0; m < 4; ++m) { const int row = row0 + ai * HALF + m * 16; float sn[4], cs[4]; rope_sincos(sn, cs, (float)psv[ai][m], invf);
                        f32x4 v0 = acc[ai][0][m][0], v1 = acc[ai][0][m][1]; rope_apply(v0, v1, sn, cs); store8(KI + (size_t)row * 64 + ct, v0, v1); }
            } else if (wc == 2 && fq == 0) {
#pragma unroll
                for (int ai = 0; ai < 2; ++ai)
#pragma unroll
                    for (int m = 0; m < 4; ++m) { const int row = row0 + ai * HALF + m * 16; const float s = 0.044194173824159216f;
                        *(f32x4*)(WI + (size_t)row * 8) = acc[ai][0][m][0] * s; *(f32x4*)(WI + (size_t)row * 8 + 4) = acc[ai][0][m][1] * s; }
            } else if (wc == 2 && fq == 1) {
                const f32x4 bi = *(const f32x4*)b_ig, bf = *(const f32x4*)b_fg;
#pragma unroll
                for (int ai = 0; ai < 2; ++ai)
#pragma unroll
                    for (int m = 0; m < 4; ++m) { const int row = row0 + ai * HALF + m * 16; const f32x4 iv = acc[ai][0][m][0] + bi, fv = acc[ai][0][m][1] + bf; f32x4 lf;
#pragma unroll
                        for (int e = 0; e < 4; ++e) lf[e] = fminf(fv[e], 0.f) - 0.6931471805599453f * __builtin_amdgcn_logf(1.f + __builtin_amdgcn_exp2f(-1.4426950408889634f * fabsf(fv[e])));
                        *(f32x4*)(IG + (size_t)row * 4) = iv; *(f32x4*)(LF + (size_t)row * 4) = lf; }
            }
        }
    }
};

struct EpiQ {
    static constexpr bool PERM = true, AFTER_DRAIN = false; static constexpr int PROBE = 3;
    bf16_t *Q, *QI; const float* SSQ; const int* pos; float qscale;
    __device__ __forceinline__ void operator()(const f32x4 (&acc)[2][2][4][2], const Unit& u, int wr, int wc, int fr, int fq) const {
        { unsigned ones_ = ~0u; asm volatile("" : "+s"(ones_)); const int ln_ = (int)__builtin_amdgcn_mbcnt_hi(ones_, __builtin_amdgcn_mbcnt_lo(ones_, 0u)); fr = ln_ & 15; fq = ln_ >> 4; }
        const int row0 = u.pm * BM + wr * 64 + fr, ct = wc * 32 + 8 * fq, pn = u.pn;
        float invf[4]; rope_invf(invf, wc, fq);
        bf16_t* dst = (pn < 2) ? Q + pn * 256 : QI + (pn - 2) * 256; const float sc = (pn < 2) ? qscale : 1.f;
#pragma unroll
        for (int ai = 0; ai < 2; ++ai) {
            float rsv[4]; int psv[4];
#pragma unroll
            for (int m = 0; m < 4; ++m) { const int row = row0 + ai * HALF + m * 16; const f32x4 ss = *(const f32x4*)(SSQ + (size_t)row * 4); psv[m] = pos[row]; rsv[m] = ((ss[0] + ss[1]) + (ss[2] + ss[3])) * (1.f / 256.f) + 1e-6f; }
#pragma unroll
            for (int m = 0; m < 4; ++m) { const int row = row0 + ai * HALF + m * 16;
                const float rstd = rsqrtf(rsv[m]);
                float sn[4], cs[4]; rope_sincos(sn, cs, (float)psv[m], invf);
#pragma unroll
                for (int bj = 0; bj < 2; ++bj) { f32x4 v0 = acc[ai][bj][m][0] * rstd, v1 = acc[ai][bj][m][1] * rstd; rope_apply(v0, v1, sn, cs);
                    store8(dst + (size_t)row * 512 + bj * HALF + ct, v0 * sc, v1 * sc); } } }
    }
};

struct EpiPlain {
    static constexpr bool PERM = true, AFTER_DRAIN = false; static constexpr int PROBE = 6;
    bf16_t* O; int ldc;
    __device__ __forceinline__ void operator()(const f32x4 (&acc)[2][2][4][2], const Unit& u, int wr, int wc, int fr, int fq) const {
        { unsigned ones_ = ~0u; asm volatile("" : "+s"(ones_)); const int ln_ = (int)__builtin_amdgcn_mbcnt_hi(ones_, __builtin_amdgcn_mbcnt_lo(ones_, 0u)); fr = ln_ & 15; fq = ln_ >> 4; }
        const int row0 = u.pm * BM + wr * 64 + fr, col0 = u.pn * BM + wc * 32 + 8 * fq;
#pragma unroll
        for (int ai = 0; ai < 2; ++ai)
#pragma unroll
            for (int m = 0; m < 4; ++m) { bf16_t* rowp = O + (size_t)(row0 + ai * HALF + m * 16) * ldc + col0;
#pragma unroll
                for (int bj = 0; bj < 2; ++bj) store8(rowp + bj * HALF, acc[ai][bj][m][0], acc[ai][bj][m][1]); }
    }
};

struct EpiSwiglu {
    static constexpr bool PERM = true, AFTER_DRAIN = false; static constexpr int PROBE = 7;
    bf16_t* H; int ldc;
    __device__ __forceinline__ void operator()(const f32x4 (&acc)[2][2][4][2], const Unit& u, int wr, int wc, int fr, int fq) const {
        { unsigned ones_ = ~0u; asm volatile("" : "+s"(ones_)); const int ln_ = (int)__builtin_amdgcn_mbcnt_hi(ones_, __builtin_amdgcn_mbcnt_lo(ones_, 0u)); fr = ln_ & 15; fq = ln_ >> 4; }
        const int row0 = u.pm * BM + wr * 64 + fr, col0 = u.pn * HALF + wc * 32 + 8 * fq;
#pragma unroll
        for (int ai = 0; ai < 2; ++ai)
#pragma unroll
            for (int m = 0; m < 4; ++m) { f32x4 o0, o1;
#pragma unroll
                for (int e = 0; e < 4; ++e) { o0[e] = silu_f(acc[ai][0][m][0][e]) * acc[ai][1][m][0][e]; o1[e] = silu_f(acc[ai][0][m][1][e]) * acc[ai][1][m][1][e]; }
                store8(H + (size_t)(row0 + ai * HALF + m * 16) * ldc + col0, o0, o1); }
    }
};

template <class Epi, class Sched, bool ALIGN_EPI = false, bool SP2 = false>
__device__ __forceinline__ void gemm_phase(PG8_LAS unsigned char* lds, const Gemm g, const Sched& S, const Epi& E, int tid_in  ) {
    int tid_o = tid_in; asm volatile("" : "+v"(tid_o));
    const int tid = tid_o, wid = __builtin_amdgcn_readfirstlane(tid >> 6), lane = tid & 63, wr = wid >> 2, wc = wid & 3, fr = lane & 15, fq = lane >> 4;
    const int K = g.K, nt = K / BK;
    unsigned voffA[2], voffB[2];
#pragma unroll
    for (int i = 0; i < 2; ++i) { int R, C; stage_rc(tid * 16 + i * 8192, R, C); const int Rb = Epi::PERM ? ((R & ~31) + perm32(R & 31)) : R;
        voffA[i] = (unsigned)(R * K + C) * 2u; voffB[i] = (unsigned)(Rb * K + C) * 2u; }
    const size_t kstep = (size_t)(BK * 2);
    const size_t hstep = (size_t)HALF * K * 2;
    const size_t tstep = 2 * hstep;
    const unsigned ldsw = (unsigned)wid * 1024u;
    const int aoff = lds_byte(wr * 64 + fr, fq * 8), boff = lds_byte(wc * 32 + fr, fq * 8);
#define PG8_SA(b, h) (((b) * 2 + (h)) * HTB)
#define PG8_SB(b, h) ((4 + (b) * 2 + (h)) * HTB)
#define PG8_STAGE(bufoff, gbase, voff) do { _Pragma("unroll") for (int _i = 0; _i < 2; ++_i) \
        __builtin_amdgcn_global_load_lds((const unsigned*)((const char*)(gbase) + (voff)[_i]), (PG8_LAS unsigned*)(lds + (bufoff) + ldsw + _i * 8192), 16, 0, 0); } while (0)
#define PG8_LDA(dst, b, h) do { _Pragma("unroll") for (int m = 0; m < 4; ++m) _Pragma("unroll") for (int k = 0; k < 2; ++k) dst[m][k] = *(const PG8_LAS bf16x8*)(lds + PG8_SA(b, h) + aoff + m * 2048 + k * 1024); } while (0)
#define PG8_LDB(dst, b, h) do { _Pragma("unroll") for (int n = 0; n < 2; ++n) _Pragma("unroll") for (int k = 0; k < 2; ++k) dst[n][k] = *(const PG8_LAS bf16x8*)(lds + PG8_SB(b, h) + boff + n * 2048 + k * 1024); } while (0)
#define PG8_MMA(ai, bj, At, Bt) do { __builtin_amdgcn_s_setprio(1); _Pragma("unroll") for (int m = 0; m < 4; ++m) _Pragma("unroll") for (int n = 0; n < 2; ++n) _Pragma("unroll") for (int k = 0; k < 2; ++k) \
        acc[ai][bj][m][n] = __builtin_amdgcn_mfma_f32_16x16x32_bf16(Bt[n][k], At[m][k], acc[ai][bj][m][n], 0, 0, 0); __builtin_amdgcn_s_setprio(0); } while (0)
#define PG8_WAIT_V(n) asm volatile("s_waitcnt vmcnt(" #n ")" ::: "memory")
#define PG8_WAIT_L(n) asm volatile("s_waitcnt lgkmcnt(" #n ")" ::: "memory")
#define PG8_BAR __builtin_amdgcn_s_barrier()
#define PG8_SCHED __builtin_amdgcn_sched_barrier(0)
#ifdef GPROBE
    volatile PG8_LAS unsigned long long* pw_ = (volatile PG8_LAS unsigned long long*)(lds + PROBE_LDS_OFF);
#define PG8_NOW() __builtin_amdgcn_s_memrealtime()
#define PG8_PROBE_ON (Epi::PROBE == GPROBE_PHASE && wid == 0 && (tid & 63) == 0)
#endif
    Unit cur, nxt; int ui = 0;
    if (!S.next(0, cur)) return;
    f32x4 acc[2][2][4][2];
#pragma unroll
    for (int a = 0; a < 2; ++a)
#pragma unroll
        for (int b = 0; b < 2; ++b)
#pragma unroll
            for (int m = 0; m < 4; ++m)
#pragma unroll
                for (int n = 0; n < 2; ++n) acc[a][b][m][n] = (f32x4){0.f, 0.f, 0.f, 0.f};
    bf16x8 At[4][2], B0[2][2], B1[2][2];
    const char* cA = (const char*)g.A + (size_t)cur.pm * tstep; const char* cB = (const char*)g.Bt + (size_t)cur.pn * tstep;
    S.a_ready(cur);
    if constexpr (SP2) {
        PG8_STAGE(PG8_SB(0, 0), cB, voffB); PG8_STAGE(PG8_SB(0, 1), cB + hstep, voffB); PG8_STAGE(PG8_SA(0, 0), cA, voffA); PG8_STAGE(PG8_SA(0, 1), cA + hstep, voffA);
        if (wr == 1) PG8_BAR;
        PG8_WAIT_V(2); PG8_BAR;
        PG8_STAGE(PG8_SB(1, 0), cB + kstep, voffB); PG8_STAGE(PG8_SA(1, 0), cA + kstep, voffA); PG8_STAGE(PG8_SB(1, 1), cB + hstep + kstep, voffB);
        PG8_WAIT_V(6); PG8_BAR;
    } else {
        PG8_STAGE(PG8_SB(0, 0), cB, voffB); PG8_STAGE(PG8_SA(0, 0), cA, voffA); PG8_STAGE(PG8_SB(0, 1), cB + hstep, voffB); PG8_STAGE(PG8_SA(0, 1), cA + hstep, voffA);
        if (wr == 1) PG8_BAR;
        PG8_WAIT_V(4); PG8_BAR;
        PG8_STAGE(PG8_SB(1, 0), cB + kstep, voffB); PG8_STAGE(PG8_SA(1, 0), cA + kstep, voffA); PG8_STAGE(PG8_SB(1, 1), cB + hstep + kstep, voffB);
        PG8_WAIT_V(6); PG8_BAR;
    }
    for (;;) {
        const bool has_next = S.next(ui + 1, nxt);
        const char* nA = has_next ? (const char*)g.A + (size_t)nxt.pm * tstep : cA; const char* nB = has_next ? (const char*)g.Bt + (size_t)nxt.pn * tstep : cB;
#ifdef GPROBE
        if (PG8_PROBE_ON) { const unsigned long long n_ = PG8_NOW(); pw_[1] = n_; if (GPROBE == 4 && ui > 0) pw_[0] += n_ - pw_[2]; }
#endif
        for (int t = 0; t < nt; t += 2) {
            const bool last = (t == nt - 2);
            const char* a1 = cA + (size_t)(t + 1) * kstep;
            const char* a2 = last ? nA : cA + (size_t)(t + 2) * kstep; const char* b2 = last ? nB : cB + (size_t)(t + 2) * kstep;
            const char* a3 = a2 + kstep; const char* b3 = b2 + kstep;
            if (last && has_next) S.a_ready(nxt);
            if constexpr (SP2) {
            PG8_LDB(B0, 0, 0); PG8_LDB(B1, 0, 1); PG8_SCHED; PG8_LDA(At, 0, 0); PG8_STAGE(PG8_SA(1, 1), a1 + hstep, voffA);
            PG8_WAIT_V(8); PG8_WAIT_L(0); PG8_BAR; PG8_MMA(0, 0, At, B0); PG8_MMA(0, 1, At, B1); PG8_BAR; PG8_SCHED;
#ifdef GPROBE
            if (GPROBE == 3 && t == 0 && PG8_PROBE_ON) pw_[0] += PG8_NOW() - pw_[1];
#endif
            PG8_LDA(At, 0, 1); PG8_STAGE(PG8_SB(0, 0), b2, voffB); PG8_STAGE(PG8_SB(0, 1), b2 + hstep, voffB); PG8_STAGE(PG8_SA(0, 0), a2, voffA);
            PG8_WAIT_V(8); PG8_WAIT_L(0); PG8_BAR; PG8_MMA(1, 0, At, B0); PG8_MMA(1, 1, At, B1); PG8_BAR; PG8_SCHED;
            PG8_LDB(B0, 1, 0); PG8_LDB(B1, 1, 1); PG8_SCHED; PG8_LDA(At, 1, 0); PG8_STAGE(PG8_SA(0, 1), a2 + hstep, voffA);
            PG8_WAIT_V(8); PG8_WAIT_L(0); PG8_BAR; PG8_MMA(0, 0, At, B0); PG8_MMA(0, 1, At, B1); PG8_BAR; PG8_SCHED;
            PG8_LDA(At, 1, 1); PG8_STAGE(PG8_SB(1, 0), b3, voffB); PG8_STAGE(PG8_SB(1, 1), b3 + hstep, voffB); PG8_STAGE(PG8_SA(1, 0), a3, voffA);
            PG8_WAIT_V(8); PG8_WAIT_L(0); PG8_BAR; PG8_MMA(1, 0, At, B0); PG8_MMA(1, 1, At, B1); PG8_BAR; PG8_SCHED;
            } else {
            PG8_LDB(B0, 0, 0); PG8_SCHED; PG8_LDA(At, 0, 0); PG8_STAGE(PG8_SA(1, 1), a1 + hstep, voffA);
            PG8_WAIT_L(8); PG8_BAR; PG8_WAIT_L(0); PG8_MMA(0, 0, At, B0); PG8_BAR; PG8_SCHED;
            PG8_LDB(B1, 0, 1); PG8_STAGE(PG8_SB(0, 0), b2, voffB);
            PG8_BAR; PG8_WAIT_L(0); PG8_MMA(0, 1, At, B1); PG8_BAR;
            PG8_LDA(At, 0, 1); PG8_STAGE(PG8_SA(0, 0), a2, voffA);
            PG8_BAR; PG8_WAIT_L(0); PG8_MMA(1, 0, At, B0); PG8_BAR; PG8_SCHED;
            PG8_STAGE(PG8_SB(0, 1), b2 + hstep, voffB);
            PG8_WAIT_V(6); PG8_BAR; PG8_MMA(1, 1, At, B1); PG8_BAR;
            PG8_LDB(B0, 1, 0); PG8_SCHED; PG8_LDA(At, 1, 0); PG8_STAGE(PG8_SA(0, 1), a2 + hstep, voffA);
            PG8_WAIT_L(8); PG8_BAR; PG8_WAIT_L(0); PG8_MMA(0, 0, At, B0); PG8_BAR; PG8_SCHED;
            PG8_LDB(B1, 1, 1); PG8_STAGE(PG8_SB(1, 0), b3, voffB);
            PG8_BAR; PG8_WAIT_L(0); PG8_MMA(0, 1, At, B1); PG8_BAR;
            PG8_LDA(At, 1, 1); PG8_STAGE(PG8_SA(1, 0), a3, voffA);
            PG8_BAR; PG8_WAIT_L(0); PG8_MMA(1, 0, At, B0); PG8_BAR; PG8_SCHED;
            PG8_STAGE(PG8_SB(1, 1), b3 + hstep, voffB);
            PG8_WAIT_V(6); PG8_BAR; PG8_MMA(1, 1, At, B1); PG8_BAR;
            }
        }
#ifdef GPROBE
        if ((GPROBE == 0 || GPROBE == 1) && PG8_PROBE_ON) { const unsigned long long n_ = PG8_NOW(); if (GPROBE == 0) pw_[0] += n_ - pw_[1]; pw_[2] = n_; }
#endif
        if constexpr (ALIGN_EPI) { if (wr == 0) PG8_BAR; }
#ifdef GPROBE
        if ((GPROBE == 1 || GPROBE == 2) && PG8_PROBE_ON) { const unsigned long long n_ = PG8_NOW(); if (GPROBE == 1) pw_[0] += n_ - pw_[2]; pw_[2] = n_; }
#endif
        if constexpr (!Epi::AFTER_DRAIN) { E(acc, cur, wr, wc, fr, fq); S.done(cur); }
#ifdef GPROBE
        if ((GPROBE == 2 || GPROBE == 4) && PG8_PROBE_ON) { const unsigned long long n_ = PG8_NOW(); if (GPROBE == 2) pw_[0] += n_ - pw_[2]; pw_[2] = n_; }
#endif
        if (!has_next) break;
#pragma unroll
        for (int a = 0; a < 2; ++a)
#pragma unroll
            for (int b = 0; b < 2; ++b)
#pragma unroll
                for (int m = 0; m < 4; ++m)
#pragma unroll
                    for (int n = 0; n < 2; ++n) acc[a][b][m][n] = (f32x4){0.f, 0.f, 0.f, 0.f};
        cur = nxt; cA = nA; cB = nB; ++ui;
        if constexpr (ALIGN_EPI) { if (wr == 1) PG8_BAR; }
    }
    PG8_WAIT_V(0);
    if constexpr (!ALIGN_EPI) { if (wr == 0) PG8_BAR; }
    PG8_BAR;
    if constexpr (Epi::AFTER_DRAIN) { E.fused(acc, cur, wr, wc, fr, fq, lds, wid, lane); S.done(cur); }
#undef PG8_SA
#undef PG8_SB
#undef PG8_STAGE
#undef PG8_LDA
#undef PG8_LDB
#undef PG8_MMA
#undef PG8_WAIT_V
#undef PG8_WAIT_L
#undef PG8_BAR
#undef PG8_SCHED
}
}
namespace attn_body {
using bf16=__hip_bfloat16;
using bf16x8=__attribute__((ext_vector_type(8)))short;
using s16x4=__attribute__((ext_vector_type(4)))short;
using f32x16=__attribute__((ext_vector_type(16)))float;
using u32x4=__attribute__((ext_vector_type(4)))unsigned;
constexpr int BATCH=16,NHEAD=8,SEQ=2048,D=64,DM=NHEAD*D,DMO=1024;
constexpr int NW=8,QBLK=32,QB=QBLK*NW,KVBLK=64,NQB=SEQ/QB;
constexpr int ATTN_PITCH=DM, ATTN_UNIT_ROWS=QB;
__device__ __forceinline__ int crow(int r,int hi){return (r&3)+8*(r>>2)+4*hi;}
#define SBAR() __builtin_amdgcn_sched_barrier(0)
__device__ __forceinline__ void cmask(f32x16&p0,f32x16&p1,int jb,int qrel,int hi){
  const float NEG=-INFINITY; int kb=64*jb+4*hi;
  #pragma unroll
  for(int r=0;r<16;++r){int kv=kb+(r&3)+8*(r>>2); if(kv>qrel)p0[r]=NEG; if(kv+32>qrel)p1[r]=NEG;}
}

__device__ __forceinline__ void bmask(f32x16&p0,f32x16&p1,unsigned long long mw,int hi){
  const unsigned lo=(unsigned)mw>>(4*hi), up=(unsigned)(mw>>32)>>(4*hi);
  #pragma unroll
  for(int r=0;r<16;++r){ const int ps=(r&3)+8*(r>>2);
    const unsigned x0=(unsigned)__builtin_amdgcn_sbfe((int)lo,ps,1), x1=(unsigned)__builtin_amdgcn_sbfe((int)up,ps,1);
    p0[r]=__uint_as_float((__float_as_uint(p0[r])&x0)|(0xFF800000u&~x0)); p1[r]=__uint_as_float((__float_as_uint(p1[r])&x1)|(0xFF800000u&~x1)); }
}
constexpr int ATTN_PROBE_OFF=153600+448-16;
constexpr int NSLOT=3, SLOTB=8192;
constexpr int LDS_K=0, LDS_V=NSLOT*SLOTB, LDS_WS=2*NSLOT*SLOTB, LDS_OST=LDS_WS+NW*64*4, LDS_MASK=LDS_OST+NW*4096, LDS_BYTES=LDS_MASK+32*256*8;
constexpr float C2=0.125f*1.4426950408889634f;
__device__ __forceinline__ void glds16(const void*gsrc,unsigned lds_dst){unsigned keep;
  asm volatile("s_mov_b32 %0, m0\n\ts_mov_b32 m0, %2\n\ts_nop 0\n\tglobal_load_lds_dwordx4 %1, off\n\ts_mov_b32 m0, %0":"=&s"(keep):"v"(gsrc),"s"(lds_dst):"memory");}
__device__ __forceinline__ float max3f(float a,float b,float c){float r;asm("v_max3_f32 %0, %1, %2, %3":"=v"(r):"v"(a),"v"(b),"v"(c));return r;}
__device__ __forceinline__ float max2f(float a,float b){float r;asm("v_max_f32_e32 %0, %1, %2":"=v"(r):"v"(a),"v"(b));return r;}
__device__ __forceinline__ float fadd_s(float a,float b){float r;asm("v_add_f32_e32 %0, %1, %2":"=v"(r):"v"(a),"v"(b));return r;}
__device__ __forceinline__ float fsub_s(float a,float b){float r;asm("v_sub_f32_e32 %0, %1, %2":"=v"(r):"v"(a),"v"(b));return r;}
typedef float f32x2_t __attribute__((ext_vector_type(2))); typedef __bf16 bf16x2_t __attribute__((ext_vector_type(2)));
__device__ __forceinline__ unsigned cvtpk_s(float lo,float hi){f32x2_t v={lo,hi};bf16x2_t b=__builtin_convertvector(v,bf16x2_t);return __builtin_bit_cast(unsigned,b);}
#define WAIT_BAR(N) asm volatile("s_waitcnt vmcnt(" #N ") lgkmcnt(0)\n\ts_barrier":::"memory")

__device__ __forceinline__ void qkt(f32x16&p0,f32x16&p1,const char*Kslot,const bf16x8*qr,const f32x16&negm,int r32,int hi){
  const char*kb=Kslot+hi*1024+r32*16;
  #pragma unroll
  for(int d0=0;d0<4;++d0){
    const bf16x8 b0=*reinterpret_cast<const bf16x8*>(kb+d0*2048);
    const bf16x8 b1=*reinterpret_cast<const bf16x8*>(kb+d0*2048+512);
    if(d0==0){p0=__builtin_amdgcn_mfma_f32_32x32x16_bf16(b0,qr[0],negm,0,0,0);p1=__builtin_amdgcn_mfma_f32_32x32x16_bf16(b1,qr[0],negm,0,0,0);}
    else{p0=__builtin_amdgcn_mfma_f32_32x32x16_bf16(b0,qr[d0],p0,0,0,0);p1=__builtin_amdgcn_mfma_f32_32x32x16_bf16(b1,qr[d0],p1,0,0,0);}}
}
typedef __attribute__((address_space(3))) const char* lds_cptr;
typedef short v4i16_t __attribute__((ext_vector_type(4)));
__device__ __forceinline__ void kload8(bf16x8*kf,lds_cptr kp){
  kf[0]=*(const __attribute__((address_space(3))) bf16x8*)(kp);      kf[1]=*(const __attribute__((address_space(3))) bf16x8*)(kp+512);
  kf[2]=*(const __attribute__((address_space(3))) bf16x8*)(kp+2048); kf[3]=*(const __attribute__((address_space(3))) bf16x8*)(kp+2560);
  kf[4]=*(const __attribute__((address_space(3))) bf16x8*)(kp+4096); kf[5]=*(const __attribute__((address_space(3))) bf16x8*)(kp+4608);
  kf[6]=*(const __attribute__((address_space(3))) bf16x8*)(kp+6144); kf[7]=*(const __attribute__((address_space(3))) bf16x8*)(kp+6656);
}
__device__ __forceinline__ void kload2(bf16x8*kf,lds_cptr kp,int j){ kf[2*j]=*(const __attribute__((address_space(3))) bf16x8*)(kp+j*2048); kf[2*j+1]=*(const __attribute__((address_space(3))) bf16x8*)(kp+j*2048+512); }
__device__ __forceinline__ s16x4 vtr(lds_cptr p){ return __builtin_bit_cast(s16x4,__builtin_amdgcn_ds_read_tr16_b64_v4i16((__attribute__((address_space(3))) v4i16_t*)p)); }
__device__ __forceinline__ float rowmax(const f32x16&p0,const f32x16&p1){
  float a=max3f(p0[0],p0[1],p1[0]),b=max3f(p0[2],p0[3],p1[1]);a=max3f(a,p1[2],p1[3]);
  #pragma unroll
  for(int r=4;r<16;r+=4){a=max3f(a,p0[r],p0[r+1]);b=max3f(b,p0[r+2],p0[r+3]);a=max3f(a,p1[r],p1[r+1]);b=max3f(b,p1[r+2],p1[r+3]);}
  const float m=max2f(a,b);
  auto rr=__builtin_amdgcn_permlane32_swap(__float_as_uint(m),__float_as_uint(m),false,false);
  return max2f(__uint_as_float(rr[0]),__uint_as_float(rr[1]));
}
__device__ __forceinline__ void pv(f32x16*o,int vb,bf16x8 pa0,bf16x8 pa1,bf16x8 pa2,bf16x8 pa3){
  #pragma unroll
  for(int d0=0;d0<2;++d0){s16x4 lo[4],hi[4];
    #pragma unroll
    for(int ks=0;ks<4;++ks){
      asm volatile("ds_read_b64_tr_b16 %0,%1 offset:%c2":"=&v"(lo[ks]):"v"(vb),"i"(d0*4096+ks*1024):"memory");
      asm volatile("ds_read_b64_tr_b16 %0,%1 offset:%c2":"=&v"(hi[ks]):"v"(vb),"i"(d0*4096+ks*1024+512):"memory");}
    asm volatile("s_waitcnt lgkmcnt(0)":::"memory");SBAR();
    #define PK(k) (bf16x8){lo[k][0],lo[k][1],lo[k][2],lo[k][3],hi[k][0],hi[k][1],hi[k][2],hi[k][3]}
    o[d0]=__builtin_amdgcn_mfma_f32_32x32x16_bf16(pa0,PK(0),o[d0],0,0,0);
    o[d0]=__builtin_amdgcn_mfma_f32_32x32x16_bf16(pa1,PK(1),o[d0],0,0,0);
    o[d0]=__builtin_amdgcn_mfma_f32_32x32x16_bf16(pa2,PK(2),o[d0],0,0,0);
    o[d0]=__builtin_amdgcn_mfma_f32_32x32x16_bf16(pa3,PK(3),o[d0],0,0,0);
    #undef PK
  }
}

#ifndef ATTN_STORE16
#define ATTN_STORE16(p,v) (*(u32x4*)(p)=(v))
#endif
template<int THRL> __device__ __forceinline__ void attn_unit(int b,int h,int qb,const bf16*Q,const bf16*__restrict__ K,const bf16*__restrict__ V,bf16*O,const u32x4*__restrict__ MaskG,const float*__restrict__ gain,char*shm,int tid_in){
  int tid_o=tid_in; asm volatile("":"+v"(tid_o)); const int tid=tid_o,lane=tid&63,r32=lane&31,hi=lane>>5; const int wid=__builtin_amdgcn_readfirstlane(tid>>6);
  const long rowbase=(long)b*SEQ; const int q0=qb*QB;
#ifdef GPROBE
  volatile __attribute__((address_space(3))) unsigned long long* apw_=(volatile __attribute__((address_space(3))) unsigned long long*)((__attribute__((address_space(3))) char*)shm+ATTN_PROBE_OFF);
  const bool apon_=(blockIdx.x==0&&wid==0&&lane==0);
  if(apon_)apw_[1]=__builtin_amdgcn_s_memrealtime();
#endif
  const bf16*Qw=Q+(rowbase+q0+wid*QBLK)*DM+h*D;
  const bf16*Kh=K+rowbase*DM+h*D,*Vh=V+rowbase*DM+h*D;
  const unsigned lds0=(unsigned)(uintptr_t)shm;
  float*wsf=(float*)(shm+LDS_WS)+wid*64;
  const bf16*ksrc=Kh+(long)lane*DM+wid*8;
  const bf16*vsrc=Vh+(long)(16*(wid&3)+(lane>>2))*DM+(wid>>2)*32+(lane&3)*8;
  const unsigned kdst=lds0+LDS_K+wid*1024, vdst=lds0+LDS_V+wid*1024;
  #define DMA_K(t,slot) glds16(ksrc+(long)(t)*KVBLK*DM,(unsigned)__builtin_amdgcn_readfirstlane(kdst+(slot)))
  #define DMA_V(t,slot) glds16(vsrc+(long)(t)*KVBLK*DM,(unsigned)__builtin_amdgcn_readfirstlane(vdst+(slot)))
  const int vb0=(int)(lds0+LDS_V)+((lane>>4)&1)*32+(lane&3)*8+(4*hi+((lane&15)>>2))*64;
  const char*Kbase=shm+LDS_K; bf16x8 kf[8];
  const lds_cptr shm3=(lds_cptr)shm; const lds_cptr kp0=shm3+LDS_K+hi*1024+r32*16; const lds_cptr vp0=shm3+LDS_V+((lane>>4)&1)*32+(lane&3)*8+(4*hi+((lane&15)>>2))*64;
  const int NT=(q0+QB)/KVBLK;
  DMA_K(0,0);DMA_V(0,0);DMA_K(1,SLOTB);
  { const u32x4*mg=MaskG+(long)(b*NQB+qb)*32*128;
    __attribute__((address_space(3))) u32x4*ml=(__attribute__((address_space(3))) u32x4*)((__attribute__((address_space(3))) char*)shm+LDS_MASK);
    u32x4 mv[8];
    _Pragma("unroll") for(int k=0;k<8;++k){ const int i=tid+NW*64*k; mv[k]=u32x4{0u,0u,0u,0u}; if(i<NT*128)mv[k]=mg[i]; }
    _Pragma("unroll") for(int k=0;k<8;++k){ const int i=tid+NW*64*k; if(i<NT*128)ml[i]=mv[k]; }
    asm volatile("s_waitcnt vmcnt(0)":::"memory"); }
  bf16x8 qr[4];
  #pragma unroll
  for(int d0=0;d0<4;++d0)qr[d0]=*reinterpret_cast<const bf16x8*>(&Qw[(long)r32*DM+d0*16+hi*8]);
  float mhat=0.f,l_reg=0.f;f32x16 o[2];o[0]=f32x16{};o[1]=f32x16{};f32x16 negm=f32x16{};asm volatile("":"+v"(negm));
  const int qrel=wid*QBLK+r32;
  const lds_cptr mkp=(lds_cptr)shm+LDS_MASK+qrel*8;
  unsigned long long mwn=0ull;
  #define CMASK(P0,P1,t) do{ bmask(P0,P1,mwn,hi); mwn=*(const __attribute__((address_space(3))) unsigned long long*)(mkp+((t)+1)*2048); }while(0)
  bool resc=false;
  #define START(P0,P1) do{ const float rm=rowmax(P0,P1); resc=false; \
    { const float dl=max2f(rm,-256.f); mhat=fadd_s(mhat,dl); \
      _Pragma("unroll") for(int r=0;r<16;++r){P0[r]=fsub_s(P0[r],dl);P1[r]=fsub_s(P1[r],dl);} \
      _Pragma("unroll") for(int r=0;r<16;++r)negm[r]=-mhat; asm volatile("":"+v"(negm)); } \
    _Pragma("unroll") for(int r=0;r<16;++r)P0[r]=__builtin_amdgcn_exp2f(P0[r]); }while(0)
  #define RESC() do{ if(resc){ asm volatile("s_waitcnt lgkmcnt(0)":::"memory"); \
      _Pragma("unroll") for(int d_=0;d_<2;++d_) _Pragma("unroll") for(int r=0;r<16;++r)o[d_][r]*=wsf[crow(r,hi)]; } }while(0)
  f32x16 pA0,pA1,pB0,pB1;
  if(wid>=4)__builtin_amdgcn_s_setprio(1);
  int sl_prev=0,sl_cur=0,sl_next=SLOTB;
  #define ROT() do{sl_prev=sl_cur;sl_cur=sl_next;sl_next=(sl_next==(NSLOT-1)*SLOTB)?0:sl_next+SLOTB;}while(0)
  DMA_K(2,2*SLOTB);
  WAIT_BAR(3);
#ifdef GPROBE
  if(apon_){const unsigned long long n_=__builtin_amdgcn_s_memrealtime(); if(GPROBE==10)apw_[0]+=n_-apw_[1]; apw_[1]=n_;}
#endif
  mwn=*(const __attribute__((address_space(3))) unsigned long long*)(mkp);
  qkt(pA0,pA1,Kbase,qr,negm,r32,hi);asm volatile("s_nop 15\n\ts_nop 7":"+v"(pA0),"+v"(pA1));CMASK(pA0,pA1,0);
  START(pA0,pA1);
  _Pragma("unroll") for(int r=0;r<16;++r)pA1[r]=__builtin_amdgcn_exp2f(pA1[r]);
  WAIT_BAR(0);
  DMA_K(3,0);DMA_V(1,SLOTB);
  ROT();
  kload8(kf,kp0+sl_cur);
  WAIT_BAR(2);
  s16x4 vlo[8],vhi[8]; u32x4 pw0,pw1,pw2,pw3;
  #define PKW(P,B) cvtpk_s(P[B],P[B+1])
  #define PAF(k) __builtin_bit_cast(bf16x8,pw##k)
  #define VFR(i) (bf16x8){vlo[i][0],vlo[i][1],vlo[i][2],vlo[i][3],vhi[i][0],vhi[i][1],vhi[i][2],vhi[i][3]}
  #define PIN(x) asm volatile("":"+v"(x))
  #define MX3(a,b,c) __builtin_fmaxf(__builtin_fmaxf((a),(b)),(c))
  #define GAPA(MF,A0,A1,A2,A3,W0,W1,PW) do{ MF; sacc+=A0; sacc+=A1; sacc+=A2; sacc+=A3; PIN(sacc); W0; W1; PIN(PW); SBAR(); }while(0)
  #define EX(v) __builtin_amdgcn_exp2f(v)
  #define GAPB(MF,X,B) do{ MF; X[B]=EX(X[B]); X[B+1]=EX(X[B+1]); X[B+2]=EX(X[B+2]); X[B+3]=EX(X[B+3]); PIN(X); SBAR(); }while(0)
  #define VRD(i) do{ vlo[i]=vtr(vp_+(((i)>>2)*4096+((i)&3)*1024)); vhi[i]=vtr(vp_+(((i)>>2)*4096+((i)&3)*1024+512)); }while(0)
  #define KRD(G,j) do{ if(G){ kload2(kf,kp0+sl_next,j); SBAR(); } }while(0)
  #define STEP(C0,C1,P0,P1,t,GK,GV,GL) do{ SBAR(); \
    const lds_cptr vp_=vp0+sl_prev; \
    VRD(0); SBAR(); float sacc=(P0[0]+P0[1]); \
    GAPA(C0=__builtin_amdgcn_mfma_f32_32x32x16_bf16(kf[0],qr[0],negm,0,0,0), P0[2],P0[3],P0[4],P0[5],     pw0[0]=PKW(P0,0), pw0[1]=PKW(P0,2), pw0); \
    VRD(4); SBAR(); GAPA(C1=__builtin_amdgcn_mfma_f32_32x32x16_bf16(kf[1],qr[0],negm,0,0,0), P0[6],P0[7],P0[8],P0[9],     pw0[2]=PKW(P0,4), pw0[3]=PKW(P0,6), pw0); \
    VRD(1); SBAR(); GAPA(C0=__builtin_amdgcn_mfma_f32_32x32x16_bf16(kf[2],qr[1],C0,0,0,0),   P0[10],P0[11],P0[12],P0[13], pw1[0]=PKW(P0,8), pw1[1]=PKW(P0,10), pw1); \
    VRD(5); SBAR(); GAPA(C1=__builtin_amdgcn_mfma_f32_32x32x16_bf16(kf[3],qr[1],C1,0,0,0),   P0[14],P0[15],P1[0],P1[1],   pw1[2]=PKW(P0,12),pw1[3]=PKW(P0,14), pw1); \
    VRD(2); SBAR(); GAPA(C0=__builtin_amdgcn_mfma_f32_32x32x16_bf16(kf[4],qr[2],C0,0,0,0),   P1[2],P1[3],P1[4],P1[5],     pw2[0]=PKW(P1,0), pw2[1]=PKW(P1,2), pw2); \
    VRD(6); SBAR(); GAPA(C1=__builtin_amdgcn_mfma_f32_32x32x16_bf16(kf[5],qr[2],C1,0,0,0),   P1[6],P1[7],P1[8],P1[9],     pw2[2]=PKW(P1,4), pw2[3]=PKW(P1,6), pw2); \
    VRD(3); SBAR(); GAPA(C0=__builtin_amdgcn_mfma_f32_32x32x16_bf16(kf[6],qr[3],C0,0,0,0),   P1[10],P1[11],P1[12],P1[13], pw3[0]=PKW(P1,8), pw3[1]=PKW(P1,10), pw3); \
    VRD(7); SBAR(); GAPA(C1=__builtin_amdgcn_mfma_f32_32x32x16_bf16(kf[7],qr[3],C1,0,0,0),   P1[14],P1[15],0.f,0.f,       pw3[2]=PKW(P1,12),pw3[3]=PKW(P1,14), pw3); \
    l_reg+=sacc; \
    if(GK){DMA_K((t)+3,sl_cur);} if(GV){DMA_V((t)+1,sl_next);} \
    CMASK(C0,C1,t); \
    { float a=MX3(C0[0],C0[1],C1[0]),b=MX3(C0[2],C0[3],C1[1]); a=MX3(a,C1[2],C1[3]); \
      _Pragma("unroll") for(int r=4;r<16;r+=4){a=MX3(a,C0[r],C0[r+1]);b=MX3(b,C0[r+2],C0[r+3]);a=MX3(a,C1[r],C1[r+1]);b=MX3(b,C1[r+2],C1[r+3]);} \
      float rm=__builtin_fmaxf(a,b); { auto rr=__builtin_amdgcn_permlane32_swap(__float_as_uint(rm),__float_as_uint(rm),false,false); rm=__builtin_fmaxf(__uint_as_float(rr[0]),__uint_as_float(rr[1])); } \
      resc=false; \
      if(__builtin_expect(__any(rm>(float)THRL),0)){ const float dl=__builtin_fmaxf(rm,0.f); mhat+=dl; \
        _Pragma("unroll") for(int r=0;r<16;++r){C0[r]-=dl;C1[r]-=dl;} \
        _Pragma("unroll") for(int r=0;r<16;++r)negm[r]=-mhat; asm volatile("":"+v"(negm)); \
        const float f=__builtin_amdgcn_exp2f(-dl); l_reg*=f; if(hi==0)wsf[r32]=f; resc=true; } } \
    SBAR(); \
    GAPB(o[0]=__builtin_amdgcn_mfma_f32_32x32x16_bf16(PAF(0),VFR(0),o[0],0,0,0), C0,0); \
    GAPB(o[1]=__builtin_amdgcn_mfma_f32_32x32x16_bf16(PAF(0),VFR(4),o[1],0,0,0), C0,4); \
    KRD(GL,0); GAPB(o[0]=__builtin_amdgcn_mfma_f32_32x32x16_bf16(PAF(1),VFR(1),o[0],0,0,0), C0,8); \
    KRD(GL,1); GAPB(o[1]=__builtin_amdgcn_mfma_f32_32x32x16_bf16(PAF(1),VFR(5),o[1],0,0,0), C0,12); \
    KRD(GL,2); GAPB(o[0]=__builtin_amdgcn_mfma_f32_32x32x16_bf16(PAF(2),VFR(2),o[0],0,0,0), C1,0); \
    KRD(GL,3); GAPB(o[1]=__builtin_amdgcn_mfma_f32_32x32x16_bf16(PAF(2),VFR(6),o[1],0,0,0), C1,4); \
    GAPB(o[0]=__builtin_amdgcn_mfma_f32_32x32x16_bf16(PAF(3),VFR(3),o[0],0,0,0), C1,8); \
    GAPB(o[1]=__builtin_amdgcn_mfma_f32_32x32x16_bf16(PAF(3),VFR(7),o[1],0,0,0), C1,12); \
    }while(0)
  int t=1;
  for(;t+5<NT;t+=2){
    STEP(pB0,pB1,pA0,pA1,t,true,true,true);     WAIT_BAR(2); RESC(); ROT();
    STEP(pA0,pA1,pB0,pB1,t+1,true,true,true);   WAIT_BAR(2); RESC(); ROT();
  }
  #define ENDW(tt) do{ if((tt)+3<NT){WAIT_BAR(2);} else if((tt)+2<NT){WAIT_BAR(1);} else {WAIT_BAR(0);} }while(0)
  for(;t+1<NT;t+=2){
    STEP(pB0,pB1,pA0,pA1,t,(t+3<NT),(t+1<NT),(t+1<NT));       ENDW(t);   RESC(); ROT();
    STEP(pA0,pA1,pB0,pB1,t+1,(t+4<NT),(t+2<NT),(t+2<NT));     ENDW(t+1); RESC(); ROT();
  }
  STEP(pB0,pB1,pA0,pA1,NT-1,false,false,false); RESC();
  { float sacc=pB0[0]+pB0[1]; _Pragma("unroll") for(int r=2;r<16;++r)sacc+=pB0[r]; _Pragma("unroll") for(int r=0;r<16;++r)sacc+=pB1[r]; l_reg+=sacc;
    pw0=(u32x4){PKW(pB0,0),PKW(pB0,2),PKW(pB0,4),PKW(pB0,6)};pw1=(u32x4){PKW(pB0,8),PKW(pB0,10),PKW(pB0,12),PKW(pB0,14)};pw2=(u32x4){PKW(pB1,0),PKW(pB1,2),PKW(pB1,4),PKW(pB1,6)};pw3=(u32x4){PKW(pB1,8),PKW(pB1,10),PKW(pB1,12),PKW(pB1,14)};
    SBAR(); pv(o,vb0+sl_cur,PAF(0),PAF(1),PAF(2),PAF(3)); }
  #undef PKW
  #undef PAF
  #undef VFR
  #undef PIN
  #undef MX3
  #undef GAPA
  #undef GAPB
  #undef EX
  #undef VRD
  #undef KRD
  #undef STEP
  #undef ENDW
  __builtin_amdgcn_s_setprio(0);
#ifdef GPROBE
  if(apon_){const unsigned long long n_=__builtin_amdgcn_s_memrealtime(); if(GPROBE==11)apw_[0]+=n_-apw_[1]; apw_[1]=n_;}
#endif
  {auto rr=__builtin_amdgcn_permlane32_swap(__float_as_uint(l_reg),__float_as_uint(l_reg),false,false);l_reg=__uint_as_float(rr[0])+__uint_as_float(rr[1]);}
  if(hi==0)wsf[32+r32]=l_reg;asm volatile("s_waitcnt lgkmcnt(0)":::"memory");
  float rli[16];
  #pragma unroll
  for(int r=0;r<16;++r)rli[r]=__builtin_amdgcn_rcpf(wsf[32+crow(r,hi)]);
  bf16*Ow=O+(rowbase+q0+wid*QBLK)*DMO+h*D;
  { bf16*stg=(bf16*)(shm+LDS_OST)+wid*2048;
    #pragma unroll
    for(int r=0;r<16;++r){const int orow=crow(r,hi);
      #pragma unroll
      for(int d0=0;d0<2;++d0)stg[orow*64+d0*32+r32]=__float2bfloat16(o[d0][r]*rli[r]);}
    asm volatile("s_waitcnt lgkmcnt(0)":::"memory");
    float gn[8];
    #pragma unroll
    for(int e=0;e<8;++e)gn[e]=gain[h*D+(lane&7)*8+e];
    #pragma unroll
    for(int i=0;i<4;++i){const int row=i*8+(lane>>3),ch=lane&7; const u32x4 v=*(const u32x4*)(stg+row*64+ch*8);
      float f[8]; f[0]=__uint_as_float(v.x<<16);f[1]=__uint_as_float(v.x&0xffff0000u);f[2]=__uint_as_float(v.y<<16);f[3]=__uint_as_float(v.y&0xffff0000u);
      f[4]=__uint_as_float(v.z<<16);f[5]=__uint_as_float(v.z&0xffff0000u);f[6]=__uint_as_float(v.w<<16);f[7]=__uint_as_float(v.w&0xffff0000u);
      float ss=0.f;
      #pragma unroll
      for(int e=0;e<8;++e)ss+=f[e]*f[e];
      ss+=__shfl_xor(ss,1);ss+=__shfl_xor(ss,2);ss+=__shfl_xor(ss,4);
      const float rs=rsqrtf(ss*(1.f/64.f)+1e-6f);
      u32x4 w; w.x=cvtpk_s(f[0]*rs*gn[0],f[1]*rs*gn[1]); w.y=cvtpk_s(f[2]*rs*gn[2],f[3]*rs*gn[3]); w.z=cvtpk_s(f[4]*rs*gn[4],f[5]*rs*gn[5]); w.w=cvtpk_s(f[6]*rs*gn[6],f[7]*rs*gn[7]);
      ATTN_STORE16(Ow+(long)row*DMO+ch*8,w);} }
  asm volatile("s_waitcnt lgkmcnt(0)\n\ts_barrier":::"memory");
#ifdef GPROBE
  if(apon_){const unsigned long long n_=__builtin_amdgcn_s_memrealtime(); if(GPROBE==12)apw_[0]+=n_-apw_[1];}
#endif
  #undef DMA_K
  #undef DMA_V
  #undef CMASK
  #undef START
  #undef RESC
  #undef ROT
}
constexpr int ATTN_LDS_BYTES=LDS_BYTES;
struct AttnTensors { const bf16* Q; const bf16* K; const bf16* V; bf16* O; const u32x4* Mask; const float* gain; };
struct AttnUnit { int bh; int qb; };
struct StaticOrder {
  int vcu, G;
  __device__ __forceinline__ explicit StaticOrder(int grid,int block):vcu((grid%8==0)?(block%8)*(grid/8)+block/8:block),G(grid){}
  __device__ __forceinline__ bool next(int i,AttnUnit&u)const{
    if(G==256){ if(i>=4)return false; const int s=vcu&1; u.bh=vcu>>1; u.qb=(i==0)?s:(i==1)?7-s:(i==2)?3-s:4+s; return true; }
    const int L=i*G+vcu; if(L>=BATCH*NHEAD*NQB)return false; u.bh=L/NQB; u.qb=L%NQB; return true; }
  __device__ __forceinline__ void a_ready(const AttnUnit&)const{}
  __device__ __forceinline__ void done(const AttnUnit&)const{}
};
template<class Sched,int THRL=8> __device__ __forceinline__ void attn_phase(char*lds,const AttnTensors&T,const Sched&S,int tid_in){
  AttnUnit u;
  for(int i=0;S.next(i,u);++i){ S.a_ready(u); attn_unit<THRL>(u.bh/NHEAD,u.bh%NHEAD,u.qb,T.Q,T.K,T.V,T.O,T.Mask,T.gain,lds,tid_in); S.done(u); }
}
#undef SBAR
#undef WAIT_BAR
}

constexpr int NWAVES = 8;
#ifndef MK_ONE_LAUNCH
#define MK_ONE_LAUNCH 1
#endif
constexpr int BATCH = 16, SEQ = 2048, D = 1024, M = BATCH * SEQ, DEPTH = 2;
constexpr int NIN = 3408, NINP = 3584, QRK = 256, FF = 2816, NMOD = 6 * D;
constexpr float EPS = 1e-6f;
constexpr int N_PHASES = 2 + 9 * DEPTH;

constexpr size_t MiB = 1u << 20;
constexpr size_t WS_CTL = 0, CTL_ZERO_BYTES = 64 * 1024;
constexpr size_t WS_MOD = 1 * MiB;
constexpr size_t WS_SSQ = 2 * MiB;
constexpr size_t WS_W = 3 * MiB, W_LAYER = 26 * MiB;
constexpr size_t WO_IN = 0, WO_Q = 7 * MiB, WO_OUT = 7 * MiB + 512 * 1024, WO_GU = 9 * MiB + 512 * 1024, WO_DN = 20 * MiB + 512 * 1024;
constexpr size_t WS_XN = 56 * MiB;
constexpr size_t WS_MIX = 120 * MiB;
constexpr size_t MX_CQ = 0, MX_K = 16 * MiB, MX_V = 48 * MiB, MX_KI = 80 * MiB, MX_WI = 84 * MiB, MX_IG = 85 * MiB, MX_LF = 85 * MiB + 512 * 1024, MX_QM = 86 * MiB, MX_KM = 118 * MiB, MX_VM = 150 * MiB,
                 MX_OM = 182 * MiB, MX_Q = 214 * MiB, MX_QI = 246 * MiB, MX_MASK = 278 * MiB, MX_CL = 286 * MiB, MX_KC = 352 * MiB, MX_H = 0, MX_Y = 192 * MiB, MX_END = 384 * MiB;
constexpr size_t WS_END = WS_MIX + MX_END;
static_assert(WO_DN + (size_t)D * FF * 2 <= W_LAYER && WS_W + DEPTH * W_LAYER <= WS_XN && WS_XN + (size_t)M * D * 2 <= WS_MIX && (size_t)M * FF * 2 <= MX_Y && MX_Y + (size_t)M * D * 2 <= MX_CL && MX_CL + (size_t)2048 * 129 * 128 * 2 <= MX_KC && MX_KC + (size_t)2048 * 64 * 128 * 2 <= MX_END, "d_ws map");
constexpr int CW_BAR = 4096;

constexpr int RING_BYTES = 153600;
constexpr int LDSCTL_OFF = RING_BYTES, LDS_BYTES = LDSCTL_OFF + 512;
static_assert(pg8::STAGE_BYTES <= RING_BYTES && attn_body::ATTN_LDS_BYTES <= RING_BYTES && LDS_BYTES <= 160 * 1024, "LDS map");

#define GAS __attribute__((address_space(1)))
#define LAS __attribute__((address_space(3)))
typedef unsigned short bf16;
typedef unsigned v4u __attribute__((ext_vector_type(4)));
typedef float f32x4 __attribute__((ext_vector_type(4)));
typedef short bf16x8 __attribute__((ext_vector_type(8)));
typedef GAS unsigned gu32;
typedef GAS unsigned long long gu64;
#define RLX_AGENT __ATOMIC_RELAXED, __HIP_MEMORY_SCOPE_AGENT
#define LDS_WAIT() asm volatile("s_waitcnt lgkmcnt(0)" ::: "memory")
#define VM_WAIT() asm volatile("s_waitcnt vmcnt(0)" ::: "memory")
__device__ __forceinline__ unsigned long long rt() { return __builtin_amdgcn_s_memrealtime(); }
__device__ __forceinline__ unsigned f2bf(float f) { unsigned u = __builtin_bit_cast(unsigned, f); return (u + 0x7fffu + ((u >> 16) & 1u)) >> 16; }
__device__ __forceinline__ unsigned pk2(float lo, float hi) { return f2bf(lo) | (f2bf(hi) << 16); }

#define XB_TMO      128
#define XB_XCNT(j)  (256  + 64 * (j))
#define XB_XSUB(j)  (1280 + 64 * (j))
#define XB_XGEN(j)  (2304 + 64 * (j))
#define XB_TOP      3328
#define XB_TOPGEN   3392
#define XCD_BAR_WORDS 3456
#define XB_SPIN_CAP (1u << 18)

__device__ __forceinline__ unsigned xb_ld(unsigned* p)              { return __hip_atomic_load(p, __ATOMIC_RELAXED, __HIP_MEMORY_SCOPE_AGENT); }
__device__ __forceinline__ unsigned xb_add(unsigned* p, unsigned v) { return __hip_atomic_fetch_add(p, v, __ATOMIC_RELAXED, __HIP_MEMORY_SCOPE_AGENT); }
__device__ __forceinline__ unsigned xb_xcc_id() { return (unsigned)__builtin_amdgcn_s_getreg((3 << 11) | 20) & 0xFu; }
#define XB_SPIN(cond, bar) do { unsigned _sp = 0; while (cond) { __builtin_amdgcn_s_sleep(1); \
    if ((++_sp & 255u) == 0u) { if (xb_ld(&(bar)[XB_TMO])) break; if (_sp > XB_SPIN_CAP) { atomicAdd(&(bar)[XB_TMO], 1u); break; } } } } while (0)

struct XcdBarrier {
    unsigned* bar; unsigned x;
    volatile LAS unsigned* st;
};

__device__ __forceinline__ XcdBarrier xcd_barrier_post(unsigned* bar, volatile LAS unsigned* st) {
    XcdBarrier b; b.bar = bar; b.x = xb_xcc_id(); b.st = st;
    if (threadIdx.x == 0) (void)xb_add(&bar[XB_XCNT(b.x)], 1u);
    return b;
}
__device__ __forceinline__ void xcd_barrier_complete(unsigned* bar, unsigned x, unsigned& nloc, unsigned& nx) {
    const unsigned G = gridDim.x * gridDim.y * gridDim.z;
    unsigned sum, cnt, mine, sp = 0u;
    for (;;) {
        sum = 0u; cnt = 0u; mine = 0u;
#pragma unroll
        for (unsigned j = 0; j < 16; ++j) { const unsigned c = xb_ld(&bar[XB_XCNT(j)]); sum += c; cnt += (c > 0u) ? 1u : 0u; mine = (j == x) ? c : mine; }
        if (sum == G) break;
        __builtin_amdgcn_s_sleep(1);
        if ((++sp & 255u) == 0u) { if (xb_ld(&bar[XB_TMO])) break; if (sp > XB_SPIN_CAP) { atomicAdd(&bar[XB_TMO], 1u); break; } }
    }
    nloc = mine > 0u ? mine : 1u; nx = cnt > 0u ? cnt : 1u;
}

__device__ __forceinline__ void xcd_barrier(const XcdBarrier& b) {
    asm volatile("s_waitcnt vmcnt(0)" ::: "memory");
    __syncthreads();
    if (threadIdx.x == 0) {
        unsigned* bar = b.bar;
        const unsigned bx = xb_xcc_id();
        __builtin_amdgcn_s_waitcnt(0);
        unsigned nloc = b.st[0], nx = b.st[1];
        if (nloc == 0u) { xcd_barrier_complete(bar, bx, nloc, nx); b.st[0] = nloc; b.st[1] = nx; }
        const unsigned old = xb_add(&bar[XB_XSUB(bx)], 1u);
        const unsigned gen = old / nloc;
        if (old + 1u == (gen + 1u) * nloc) {
            __builtin_amdgcn_fence(__ATOMIC_RELEASE, "agent");
            asm volatile("s_waitcnt vmcnt(0)" ::: "memory");
            const unsigned og = xb_add(&bar[XB_TOP], 1u);
            const unsigned tg = og / nx;
            if (og + 1u == (tg + 1u) * nx) xb_add(&bar[XB_TOPGEN], 1u);
            else XB_SPIN(xb_ld(&bar[XB_TOPGEN]) == tg, bar);
            __builtin_amdgcn_fence(__ATOMIC_ACQUIRE, "agent");
            xb_add(&bar[XB_XGEN(bx)], 1u);
            asm volatile("s_waitcnt vmcnt(0)" ::: "memory");
        } else {
            XB_SPIN(xb_ld(&bar[XB_XGEN(bx)]) == gen, bar);
            __builtin_amdgcn_fence(__ATOMIC_ACQUIRE, "agent");
            asm volatile("s_waitcnt vmcnt(0)" ::: "memory");
        }
    }
    __syncthreads();
}

typedef float f32x16 __attribute__((ext_vector_type(16)));
typedef unsigned u32x2 __attribute__((ext_vector_type(2)));
__device__ __forceinline__ float wave_sum(float v) {
#pragma unroll
    for (int o = 1; o < 64; o <<= 1) v += __shfl_xor(v, o);
    return v;
}
__device__ __forceinline__ float bf_lo(unsigned u) { return __uint_as_float(u << 16); }
__device__ __forceinline__ float bf_hi(unsigned u) { return __uint_as_float(u & 0xffff0000u); }
__device__ __forceinline__ float sigmoid_f(float g) { return __builtin_amdgcn_rcpf(1.f + __builtin_amdgcn_exp2f(-1.4426950408889634f * g)); }
__device__ __forceinline__ float silu_f(float g) { return g * sigmoid_f(g); }
__device__ __forceinline__ int ropeperm(int p) { const int j = p >> 3, e = p & 7; return (e < 4) ? 4 * j + e : 32 + 4 * j + (e - 4); }

__device__ __forceinline__ void conv_item(int kind, const float* W0, const float* W1, const float* gain, int K, int Nphys, bf16* WT, LAS float* scr, int item, int lane) {
    const int nblk = Nphys / 32, kb = item / nblk, nb = item % nblk, k0 = 64 * kb, n0 = 32 * nb;
    const int n = n0 + (lane & 31);
    const float* src = W0; int ld = Nphys, col = n;
    if (kind == 1) {
        ld = NIN; const int tile = n >> 8, r = n & 255;
        if (tile == 0) col = r;
        else if (tile <= 2) { const int idx = (tile - 1) * 256 + r; col = 256 + (idx >> 6) * 64 + ropeperm(idx & 63); }
        else if (tile <= 4) col = 768 + (tile - 3) * 256 + r;
        else if (tile <= 12) col = 1352 + (tile - 5) * 256 + r;
        else { if (r < 64) col = 1280 + ropeperm(r); else if (r < 72) col = 1344 + (r - 64); else if (r < 76) col = 3400 + (r - 72); else if (r < 80) col = 3404 + (r - 76); else { src = nullptr; col = 0; } }
    } else if (kind == 2) {
        ld = 512; src = (n < 512) ? W0 : W1; const int idx = n & 511; col = (idx >> 6) * 64 + ropeperm(idx & 63);
    } else if (kind == 3) {
        ld = 2 * FF; col = ((n >> 7) & 1) * FF + (n >> 8) * 128 + (n & 127);
    }
    float wv[32];
#pragma unroll
    for (int i = 0; i < 32; ++i) { const int kk = 2 * i + (lane >> 5); wv[i] = src ? src[(size_t)(k0 + kk) * ld + col] : 0.f; }
#pragma unroll
    for (int i = 0; i < 32; ++i) { const int kk = 2 * i + (lane >> 5); float v = wv[i]; if (gain) v *= gain[k0 + kk]; scr[kk * 33 + (lane & 31)] = v; }
    LDS_WAIT(); asm volatile("" ::: "memory");
    const int c = lane & 7;
#pragma unroll
    for (int j = 0; j < 4; ++j) { const int nn = (lane >> 3) + 8 * j; const LAS float* s = scr + (8 * c) * 33 + nn;
        v4u o; o.x = pk2(s[0 * 33], s[1 * 33]); o.y = pk2(s[2 * 33], s[3 * 33]); o.z = pk2(s[4 * 33], s[5 * 33]); o.w = pk2(s[6 * 33], s[7 * 33]);
        *(GAS v4u*)(WT + (size_t)(n0 + nn) * K + k0 + 8 * c) = o; }
    LDS_WAIT(); asm volatile("" ::: "memory");
}

enum { I_X = 0, I_C, I_POS, I_WMOD, I_BMOD, I_MIXPRE, I_MIXPOST, I_WIN, I_QLN, I_WQUP, I_WQIUP, I_CONVW, I_CONVB, I_BIG, I_BFG, I_ATTN, I_MLN, I_WOUT, I_FFNPRE, I_FFNPOST, I_WGU, I_WDN, I_OUT, I_WS };
__device__ __forceinline__ unsigned long long ldptr(LAS unsigned char* lds, int k) {
    const volatile LAS unsigned* p = (const volatile LAS unsigned*)(lds + LDSCTL_OFF + 64 + 8 * k);
    const unsigned lo = __builtin_amdgcn_readfirstlane(p[0]), hi = __builtin_amdgcn_readfirstlane(p[1]);
    return ((unsigned long long)hi << 32) | lo;
}
#define GPTR(T, x) ((T*)(GAS T*)(x))
#define FP(k) GPTR(const float, ldptr(lds, (k)))
#define WSP() ((unsigned char*)ldptr(lds, I_WS))
#define WSPG() GPTR(unsigned char, ldptr(lds, I_WS))

__device__ __forceinline__ void p0_prologue(LAS unsigned char* lds, int tid, int lane, int wave, int vcu, int G) {
    LAS float* scr = (LAS float*)(lds + wave * 16384);
    const int gw = vcu * NWAVES + wave, NGW = G * NWAVES;
    constexpr int I_IN = (D / 64) * (NINP / 32), I_Q = (QRK / 64) * (1024 / 32), I_O = (D / 64) * (D / 32), I_GU = (D / 64) * (2 * FF / 32), I_DN = (FF / 64) * (D / 32);
    constexpr int I_LAYER = I_IN + I_Q + I_O + I_GU + I_DN;
    for (int it = gw; it < DEPTH * I_LAYER; it += NGW) {
        const int l = it / I_LAYER; int r = it % I_LAYER; unsigned char* wl = WSP() + WS_W + (size_t)l * W_LAYER;
        if (r < I_IN) { conv_item(1, FP(I_WIN) + (size_t)l * D * NIN, nullptr, nullptr, D, NINP, (bf16*)(wl + WO_IN), scr, r, lane); continue; } r -= I_IN;
        if (r < I_Q) { conv_item(2, FP(I_WQUP) + (size_t)l * QRK * 512, FP(I_WQIUP) + (size_t)l * QRK * 512, FP(I_QLN) + (size_t)l * QRK, QRK, 1024, (bf16*)(wl + WO_Q), scr, r, lane); continue; } r -= I_Q;
        if (r < I_O) { conv_item(0, FP(I_WOUT) + (size_t)l * D * D, nullptr, nullptr, D, D, (bf16*)(wl + WO_OUT), scr, r, lane); continue; } r -= I_O;
        if (r < I_GU) { conv_item(3, FP(I_WGU) + (size_t)l * D * 2 * FF, nullptr, nullptr, D, 2 * FF, (bf16*)(wl + WO_GU), scr, r, lane); continue; } r -= I_GU;
        conv_item(0, FP(I_WDN) + (size_t)l * FF * D, nullptr, nullptr, FF, D, (bf16*)(wl + WO_DN), scr, r, lane);
    }
    __syncthreads();
    constexpr int NU = DEPTH * (NMOD / 64);
    if (vcu < NU) {
        LAS float* sc = (LAS float*)lds;
        LAS float* part = (LAS float*)(lds + 65536);
        { const float* cin = FP(I_C);
#pragma unroll
          for (int h2 = 0; h2 < 2; ++h2) { float cv[16];
#pragma unroll
              for (int q = 0; q < 16; ++q) cv[q] = cin[tid + NWAVES * 64 * (16 * h2 + q)];
#pragma unroll
              for (int q = 0; q < 16; ++q) { const int i = tid + NWAVES * 64 * (16 * h2 + q), b = i / D, k = i % D; sc[k * 16 + b] = silu_f(cv[q]); } } }
        __syncthreads();
        const float* wmod = FP(I_WMOD); const float* bmod = FP(I_BMOD); float* modo = (float*)(WSP() + WS_MOD);
        for (int u = vcu; u < NU; u += G) {
            const int l = u / (NMOD / 64), n0 = (u % (NMOD / 64)) * 64;
            const float* W = wmod + (size_t)l * D * NMOD + n0 + lane;
            float acc[16];
#pragma unroll
            for (int b = 0; b < 16; ++b) acc[b] = 0.f;
            for (int k0 = wave * 128; k0 < wave * 128 + 128; k0 += 32) { float wv[32];
#pragma unroll
                for (int kk = 0; kk < 32; ++kk) wv[kk] = W[(size_t)(k0 + kk) * NMOD];
#pragma unroll
                for (int kk = 0; kk < 32; ++kk) {
#pragma unroll
                    for (int q = 0; q < 4; ++q) { const f32x4 s4 = *(const LAS f32x4*)(sc + (k0 + kk) * 16 + 4 * q);
                        acc[4 * q + 0] += s4[0] * wv[kk]; acc[4 * q + 1] += s4[1] * wv[kk]; acc[4 * q + 2] += s4[2] * wv[kk]; acc[4 * q + 3] += s4[3] * wv[kk]; }
                    __builtin_amdgcn_sched_barrier(0); } }
#pragma unroll
            for (int b = 0; b < 16; ++b) part[(wave * 16 + b) * 64 + lane] = acc[b];
            __syncthreads();
            for (int i = tid; i < 16 * 64; i += NWAVES * 64) { const int b = i >> 6, ln = i & 63; float s = bmod[(size_t)l * NMOD + n0 + ln];
#pragma unroll
                for (int w = 0; w < 8; ++w) s += part[(w * 16 + b) * 64 + ln];
                modo[((size_t)l * BATCH + b) * NMOD + n0 + ln] = s; }
            __syncthreads();
        }
    }
}

__device__ __forceinline__ void norm_phase(const bf16* y, const float* xin, float* xout, const float* gpost, const float* gate, const float* gnext, const float* sc, const float* sh, bf16* XN,
                                           int lane, int wave, int vcu, int G) {
    const int gw = vcu * NWAVES + wave, NGW = G * NWAVES;
    for (int m0 = gw * 16; m0 < M; m0 += NGW * 16) {
        const int b = m0 / SEQ;
        f32x4 vg[4], vt[4], vn[4], vs[4], vh[4];
#pragma unroll
        for (int j = 0; j < 4; ++j) { const int e = 256 * j + 4 * lane;
            if (y) { vg[j] = *(const f32x4*)(gpost + e); vt[j] = *(const f32x4*)(gate + (size_t)b * NMOD + e); }
            if (gnext) { vn[j] = *(const f32x4*)(gnext + e); vs[j] = *(const f32x4*)(sc + (size_t)b * NMOD + e) + 1.f; vh[j] = *(const f32x4*)(sh + (size_t)b * NMOD + e); vn[j] = vn[j] * vs[j]; } }
        for (int r = 0; r < 16; ++r) {
            const size_t row = (size_t)(m0 + r);
            f32x4 xv[4];
#pragma unroll
            for (int j = 0; j < 4; ++j) xv[j] = *(const f32x4*)(xin + row * D + 256 * j + 4 * lane);
            if (y) {
                f32x4 yv[4]; float ss = 0.f;
#pragma unroll
                for (int j = 0; j < 4; ++j) { const u32x2 w = *(const u32x2*)(y + row * D + 256 * j + 4 * lane); yv[j] = (f32x4){bf_lo(w.x), bf_hi(w.x), bf_lo(w.y), bf_hi(w.y)};
                    ss += (yv[j][0] * yv[j][0] + yv[j][1] * yv[j][1]) + (yv[j][2] * yv[j][2] + yv[j][3] * yv[j][3]); }
                const float rstd = rsqrtf(wave_sum(ss) * (1.f / D) + EPS);
#pragma unroll
                for (int j = 0; j < 4; ++j) { xv[j] = xv[j] + vt[j] * (yv[j] * rstd * vg[j]); *(f32x4*)(xout + row * D + 256 * j + 4 * lane) = xv[j]; }
            }
            if (gnext) {
                float ss = 0.f;
#pragma unroll
                for (int j = 0; j < 4; ++j) ss += (xv[j][0] * xv[j][0] + xv[j][1] * xv[j][1]) + (xv[j][2] * xv[j][2] + xv[j][3] * xv[j][3]);
                const float rstd = rsqrtf(wave_sum(ss) * (1.f / D) + EPS);
#pragma unroll
                for (int j = 0; j < 4; ++j) { const f32x4 o = xv[j] * rstd * vn[j] + vh[j]; u32x2 w; w.x = pk2(o[0], o[1]); w.y = pk2(o[2], o[3]); *(u32x2*)(XN + row * D + 256 * j + 4 * lane) = w; }
            }
        }
    }
}

constexpr int IX_SC = 0, IX_KCH = 131072, IX_KPITCH = 144, IX_HIST = IX_KCH, IX_MSK = IX_KCH + 128 * IX_KPITCH, IX_END = IX_MSK + 4096;
static_assert(IX_END <= RING_BYTES && 8 * 576 * 4 <= 128 * IX_KPITCH, "indexer LDS");
__device__ __forceinline__ unsigned ord_key(float f) { const unsigned u = __float_as_uint(f); return u ^ ((unsigned)((int)u >> 31) | 0x80000000u); }
__device__ __forceinline__ unsigned wave_scan_add(unsigned v) {
    v += (unsigned)__builtin_amdgcn_update_dpp(0, (int)v, 0x111, 0xf, 0xf, false);
    v += (unsigned)__builtin_amdgcn_update_dpp(0, (int)v, 0x112, 0xf, 0xf, false);
    v += (unsigned)__builtin_amdgcn_update_dpp(0, (int)v, 0x114, 0xf, 0xf, false);
    v += (unsigned)__builtin_amdgcn_update_dpp(0, (int)v, 0x118, 0xf, 0xf, false);
    v += (unsigned)__builtin_amdgcn_update_dpp(0, (int)v, 0x142, 0xa, 0xf, false);
    v += (unsigned)__builtin_amdgcn_update_dpp(0, (int)v, 0x143, 0xc, 0xf, false);
    return v;
}
template <int NJ> __device__ __forceinline__ void radix_rows(const unsigned (&xa)[NJ], const unsigned (&xb)[NJ],
                                                              unsigned& thrA, unsigned& needA_o, unsigned& eqA_o, unsigned& thrB, unsigned& needB_o, unsigned& eqB_o) {
    constexpr int G = NJ / 4;
    unsigned pfA = 0u, ndA = 256u, pfB = 0u, ndB = 256u, candA = ~0u, candB = ~0u;
#pragma unroll
    for (int k = 3; k >= 0; --k) {
        unsigned wa[8], wb[8];
        const unsigned s01 = (unsigned)k | ((unsigned)(4 + k) << 8) | 0x0c0c0000u, s23 = 0x00000c0cu | ((unsigned)k << 16) | ((unsigned)(4 + k) << 24);
#pragma unroll
        for (int g = 0; g < 8; ++g) {
            if (g < G) { wa[g] = __builtin_amdgcn_perm(xa[4 * g + 1], xa[4 * g], s01) | __builtin_amdgcn_perm(xa[4 * g + 3], xa[4 * g + 2], s23);
                         wb[g] = __builtin_amdgcn_perm(xb[4 * g + 1], xb[4 * g], s01) | __builtin_amdgcn_perm(xb[4 * g + 3], xb[4 * g + 2], s23); }
            else { wa[g] = 0u; wb[g] = 0u; } }
#pragma unroll
        for (int st = 0; st < 3; ++st) { const int sh = 1 << st; const unsigned mk = (st == 0) ? 0x55555555u : (st == 1) ? 0x33333333u : 0x0f0f0f0fu;
#pragma unroll
            for (int g = 0; g < 8; ++g) if (!(g & sh)) { const int h = g | sh;
                { const unsigned A = wa[g], B = wa[h]; wa[g] = (A & mk) | ((B << sh) & ~mk); wa[h] = ((A >> sh) & mk) | (B & ~mk); }
                { const unsigned A = wb[g], B = wb[h]; wb[g] = (A & mk) | ((B << sh) & ~mk); wb[h] = ((A >> sh) & mk) | (B & ~mk); } } }
#pragma unroll
        for (int bb = 7; bb >= 0; --bb) { const unsigned bit = 1u << (8 * k + bb);
            const unsigned oA = candA & wa[bb], oB = candB & wb[bb];
            const unsigned n = (unsigned)__builtin_amdgcn_readlane((int)wave_scan_add((unsigned)__builtin_popcount(oA) | ((unsigned)__builtin_popcount(oB) << 16)), 63);
            const unsigned nA = n & 0xffffu, nB = n >> 16;
            if (nA >= ndA) { pfA |= bit; candA = oA; } else { ndA -= nA; candA ^= oA; }
            if (nB >= ndB) { pfB |= bit; candB = oB; } else { ndB -= nB; candB ^= oB; }
        }
    }
    const unsigned ne = (unsigned)__builtin_amdgcn_readlane((int)wave_scan_add((unsigned)__builtin_popcount(candA) | ((unsigned)__builtin_popcount(candB) << 16)), 63);
    thrA = pfA; needA_o = ndA; eqA_o = ne & 0xffffu; thrB = pfB; needB_o = ndB; eqB_o = ne >> 16;
}
template <int NJ> __device__ __forceinline__ void select_rows(const LAS unsigned* scb, LAS unsigned long long* msk, LAS unsigned* hist, int nk, int wave, int lane) {
    unsigned xa[NJ], xb[NJ];
#pragma unroll
    for (int j = 0; j < NJ; ++j) { const unsigned va = scb[(2 * wave) * 2048 + 64 * j + lane], vb = scb[(2 * wave + 1) * 2048 + 64 * j + lane]; const bool in = (64 * j + lane) < nk; xa[j] = in ? va : 0u; xb[j] = in ? vb : 0u; }
    unsigned pA, pB, needA, needB, eA, eB;
    radix_rows<NJ>(xa, xb, pA, needA, eA, pB, needB, eB);
    unsigned xiA = 2047u, xiB = 2047u;
    if ((eA > needA) || (eB > needB)) {
        xiA = 0u; xiB = 0u;
#pragma unroll 1
        for (int bit = 10; bit >= 0; --bit) {
            const unsigned cA = xiA | (1u << bit), cB = xiB | (1u << bit); unsigned nA = 0u, nB = 0u;
#pragma unroll
            for (int j = 0; j < NJ; ++j) { int ll = lane; asm volatile("" : "+v"(ll)); const unsigned key = 64u * j + ll;
                nA += (xa[j] == pA && key < cA) ? 1u : 0u; nB += (xb[j] == pB && key < cB) ? 1u : 0u; if (j & 1) __builtin_amdgcn_sched_barrier(0); }
            unsigned n = nA | (nB << 16);
#pragma unroll
            for (int o = 1; o < 64; o <<= 1) n += __shfl_xor(n, o);
            if ((n & 0xffffu) < needA) xiA = cA;
            if ((n >> 16) < needB) xiB = cB;
        }
    }
    unsigned a0 = 0u, a1 = 0u, b0 = 0u, b1 = 0u;
    const bool ties = (xiA != 2047u) || (xiB != 2047u);
#pragma unroll
    for (int j = 0; j < NJ; ++j) { int ll = lane; asm volatile("" : "+v"(ll)); const unsigned key = 64u * j + ll;
        bool sA = xa[j] >= pA, sB = xb[j] >= pB;
        if (ties) { sA = (xa[j] > pA) || (xa[j] == pA && key <= xiA); sB = (xb[j] > pB) || (xb[j] == pB && key <= xiB); }
        const unsigned long long ba = __ballot(sA), bb = __ballot(sB);
        asm volatile("v_writelane_b32 %0, %4, %8\n\tv_writelane_b32 %1, %5, %8\n\tv_writelane_b32 %2, %6, %8\n\tv_writelane_b32 %3, %7, %8"
                     : "+v"(a0), "+v"(a1), "+v"(b0), "+v"(b1) : "s"((unsigned)ba), "s"((unsigned)(ba >> 32)), "s"((unsigned)bb), "s"((unsigned)(bb >> 32)), "n"(j));
        __builtin_amdgcn_sched_barrier(0);
    }
    if (lane < 32) { msk[lane * 16 + 2 * wave] = (unsigned long long)a0 | ((unsigned long long)a1 << 32); msk[lane * 16 + 2 * wave + 1] = (unsigned long long)b0 | ((unsigned long long)b1 << 32); }
}
struct IxReg { bf16x8 af[4]; float wA[8], wB[8]; v4u pre[2]; };
__device__ __forceinline__ void indexer_load(IxReg& R, int b, int qb16, const bf16* QI, const bf16* KI, const float* WI, int tid, int lane, int wave) {
    if (qb16 < 16) return;
    const int r = lane & 31, hh = lane >> 5, mt = wave & 3, q0 = qb16 * 16; const size_t rowb = (size_t)b * SEQ;
    { const int g = r >> 2, ql = 2 * (g & 1) + (g >> 2), hd = 4 * ((g >> 1) & 1) + (r & 3);
      const bf16* qp = QI + (rowb + q0 + 4 * mt + ql) * 512 + hd * 64 + 8 * hh;
#pragma unroll
      for (int s = 0; s < 4; ++s) R.af[s] = *(const bf16x8*)(qp + 16 * s); }
    { const float* wp = WI + (rowb + q0 + 4 * mt + 2 * hh) * 8;
#pragma unroll
      for (int j = 0; j < 8; ++j) { R.wA[j] = wp[j]; R.wB[j] = wp[8 + j]; } }
#pragma unroll
    for (int i = 0; i < 2; ++i) { const int idx = tid + 512 * i; R.pre[i] = *(const v4u*)(KI + (rowb + (idx >> 3)) * 64 + (idx & 7) * 8); }
}
__device__ __forceinline__ void indexer_unit(LAS unsigned char* lds, int b, int qb16, int nb, int nqb16, IxReg& R, const bf16* QI, const bf16* KI, const float* WI, unsigned long long* MaskG, int tid, int lane, int wave) {
    asm volatile("" : "+v"(tid), "+v"(lane));
    LAS unsigned* scb = (LAS unsigned*)(lds + IX_SC);
    LAS unsigned long long* msk = (LAS unsigned long long*)(lds + IX_MSK);
    const int q0 = qb16 * 16, n_kt = (q0 + 47) >> 5, nk = 32 * n_kt;
    const size_t rowb = (size_t)b * SEQ;
    __syncthreads();
    if (qb16 < 16) {
        { const int T = tid >> 4, i = tid & 15, t = q0 + i;
          msk[T * 16 + i] = (64 * T + 63 <= t) ? ~0ull : (64 * T > t) ? 0ull : ((1ull << (t - 64 * T + 1)) - 1ull); }
        if (nqb16 >= 0) indexer_load(R, nb, nqb16, QI, KI, WI, tid, lane, wave);
    } else {
        const int r = lane & 31, hh = lane >> 5, mt = wave & 3, par = wave >> 2;
#ifdef GPROBE
        volatile LAS unsigned long long* ipw_ = (volatile LAS unsigned long long*)(lds + LDSCTL_OFF + 432);
        const bool ipon_ = (blockIdx.x == 0 && wave == 0 && lane == 0);
        if (ipon_) ipw_[1] = __builtin_amdgcn_s_memrealtime();
#endif
        bf16x8 af[4]; float wA[8], wB[8]; v4u pre[2];
#pragma unroll
        for (int s = 0; s < 4; ++s) af[s] = R.af[s];
#pragma unroll
        for (int j = 0; j < 8; ++j) { wA[j] = R.wA[j]; wB[j] = R.wB[j]; }
        pre[0] = R.pre[0]; pre[1] = R.pre[1];
        const int rowA = 4 * mt + 2 * hh, tA = q0 + rowA;
        for (int c = 0; 4 * c < n_kt; ++c) {
            if (c) __syncthreads();
#pragma unroll
            for (int i = 0; i < 2; ++i) { const int idx = tid + 512 * i; *(LAS v4u*)(lds + IX_KCH + (idx >> 3) * IX_KPITCH + (idx & 7) * 16) = pre[i]; }
            __syncthreads();
            if (4 * (c + 1) < n_kt) {
#pragma unroll
                for (int i = 0; i < 2; ++i) { const int idx = tid + 512 * i; pre[i] = *(const v4u*)(KI + (rowb + 128 * (c + 1) + (idx >> 3)) * 64 + (idx & 7) * 8); } }
#pragma unroll
            for (int k = 0; k < 2; ++k) { const int tt = par + 2 * k, tile = 4 * c + tt;
                if (tile < n_kt) {
                    f32x16 acc = {};
#pragma unroll
                    for (int s = 0; s < 4; ++s) { const bf16x8 bfr = *(const LAS bf16x8*)(lds + IX_KCH + (32 * tt + r) * IX_KPITCH + 32 * s + 16 * hh);
                        acc = __builtin_amdgcn_mfma_f32_32x32x16_bf16(af[s], bfr, acc, 0, 0, 0); }
                    float sa = 0.f, sb = 0.f;
#pragma unroll
                    for (int j = 0; j < 8; ++j) { sa += wA[j] * fmaxf(acc[j], 0.f); sb += wB[j] * fmaxf(acc[8 + j], 0.f); }
                    const int key = 32 * tile + r;
                    scb[rowA * 2048 + key] = (key <= tA) ? ord_key(sa) : 0u; scb[(rowA + 1) * 2048 + key] = (key <= tA + 1) ? ord_key(sb) : 0u;
                } }
        }
        __syncthreads();
#ifdef GPROBE
        if (ipon_) { const unsigned long long n_ = __builtin_amdgcn_s_memrealtime(); if (GPROBE == 20) ipw_[0] += n_ - ipw_[1]; ipw_[1] = n_; }
#endif
        if (nqb16 >= 0) indexer_load(R, nb, nqb16, QI, KI, WI, tid, lane, wave);
#ifdef DUP
#pragma unroll 1
        for (int rep_ = 0; rep_ < ((DUP == 44) ? 2 : 1); ++rep_)
#endif
        { LAS unsigned* hist = (LAS unsigned*)(lds + IX_HIST) + 576 * wave;
          if (nk <= 512) select_rows<8>(scb, msk, hist, nk, wave, lane); else if (nk <= 1024) select_rows<16>(scb, msk, hist, nk, wave, lane);
          else if (nk <= 1536) select_rows<24>(scb, msk, hist, nk, wave, lane); else select_rows<32>(scb, msk, hist, nk, wave, lane); }
#ifdef GPROBE
        if (ipon_) { const unsigned long long n_ = __builtin_amdgcn_s_memrealtime(); if (GPROBE == 21) ipw_[0] += n_ - ipw_[1]; ipw_[1] = n_; }
#endif
    }
    __syncthreads();
    asm volatile("" : "+v"(tid));
    { const int T = tid >> 4, i = tid & 15;
      MaskG[((size_t)(b * 8 + (qb16 >> 4)) * 32 + T) * 256 + (qb16 & 15) * 16 + i] = msk[T * 16 + i]; }
}

constexpr int ML_PQ = 272, ML_PV = 320, ML_PS = 144, ML_PN = 132;
constexpr int MA_VS = 0, MA_KW = 20480, MA_CT = 40960, MA_GT = 76288, ML_CW = 137216, ML_END = 142336;
constexpr int MC_QT = 0, MC_KT = 17408, MC_NUM = 0, MC_VS = 34816, MC_SS = 55296, MC_CT = 64512, MC_GT = 99840;
constexpr int ML_CLE = 129 * 128;
static_assert(ML_END <= RING_BYTES && MA_GT + 1024 <= ML_CW && MC_GT + 1024 <= ML_CW && 64 * ML_PN * 4 <= MC_VS && MC_CT + 129 * ML_PQ <= MC_GT && MA_CT + 129 * ML_PQ <= MA_GT, "mLSTM LDS");
__device__ __forceinline__ int crow16(int reg, int hh) { return (reg & 3) + 8 * (reg >> 2) + 4 * hh; }
typedef short v4i16_t __attribute__((ext_vector_type(4)));
__device__ __forceinline__ bf16x8 tr_frag(const LAS unsigned char* tb, int pitch, int c, int ks) {
    const v4i16_t lo = __builtin_amdgcn_ds_read_tr16_b64_v4i16((LAS v4i16_t*)(tb + (16 * ks) * pitch + 64 * c));
    const v4i16_t hi = __builtin_amdgcn_ds_read_tr16_b64_v4i16((LAS v4i16_t*)(tb + (16 * ks + 4) * pitch + 64 * c));
    return (bf16x8){lo[0], lo[1], lo[2], lo[3], hi[0], hi[1], hi[2], hi[3]};
}
__device__ __forceinline__ int tr_base(int lane, int pitch) { return ((lane >> 5) * 8 + ((lane & 15) >> 2)) * pitch + (((lane >> 4) & 1) * 16 + (lane & 3) * 4) * 2; }
__device__ __forceinline__ void mma_tile(f32x16& acc, const LAS unsigned char* a, int pa, const LAS unsigned char* bt, int pb, int ks, int r, int hh) {
    for (int s = 0; s < ks; ++s) { const bf16x8 av = *(const LAS bf16x8*)(a + r * pa + 32 * s + 16 * hh), bv = *(const LAS bf16x8*)(bt + r * pb + 32 * s + 16 * hh);
        acc = __builtin_amdgcn_mfma_f32_32x32x16_bf16(av, bv, acc, 0, 0, 0); }
}
__device__ __forceinline__ void ml_stage_cw(LAS unsigned char* lds, const float* conv_w, const float* conv_b, int hd, int tid) {
    LAS float* cwl = (LAS float*)(lds + ML_CW);
    float tv[3];
#pragma unroll
    for (int k = 0; k < 3; ++k) { const int i = tid + NWAVES * 64 * k; tv[k] = 0.f; if (i < 2 * 5 * 128) { const int z = i / 640, j = (i % 640) >> 7, ch = i & 127, gch = z * 512 + hd * 128 + ch; tv[k] = (j < 4) ? conv_w[j * 1024 + gch] : conv_b[gch]; } }
#pragma unroll
    for (int k = 0; k < 3; ++k) { const int i = tid + NWAVES * 64 * k; if (i < 2 * 5 * 128) cwl[i] = tv[k]; }
}
__device__ __forceinline__ void conv8(float (&y)[8], const bf16* src, int tt0, const LAS float* cw) {
    { const f32x4 b0 = *(const LAS f32x4*)(cw + 4 * 128), b1 = *(const LAS f32x4*)(cw + 4 * 128 + 4); y[0] = b0[0]; y[1] = b0[1]; y[2] = b0[2]; y[3] = b0[3]; y[4] = b1[0]; y[5] = b1[1]; y[6] = b1[2]; y[7] = b1[3]; }
#pragma unroll
    for (int j = 0; j < 4; ++j) { const int tt = tt0 - 3 + j;
        if (tt >= 0) { const v4u xw = *(const v4u*)(src + (size_t)tt * 512); const f32x4 w0 = *(const LAS f32x4*)(cw + j * 128), w1 = *(const LAS f32x4*)(cw + j * 128 + 4);
            y[0] += w0[0] * bf_lo(xw.x); y[1] += w0[1] * bf_hi(xw.x); y[2] += w0[2] * bf_lo(xw.y); y[3] += w0[3] * bf_hi(xw.y);
            y[4] += w1[0] * bf_lo(xw.z); y[5] += w1[1] * bf_hi(xw.z); y[6] += w1[2] * bf_lo(xw.w); y[7] += w1[3] * bf_hi(xw.w); } }
#pragma unroll
    for (int e = 0; e < 8; ++e) y[e] = silu_f(y[e]);
}

__device__ __forceinline__ void conv8r(float (&y)[8], const v4u (&xr)[4], const LAS float* cw) {
    { const f32x4 b0 = *(const LAS f32x4*)(cw + 4 * 128), b1 = *(const LAS f32x4*)(cw + 4 * 128 + 4); y[0] = b0[0]; y[1] = b0[1]; y[2] = b0[2]; y[3] = b0[3]; y[4] = b1[0]; y[5] = b1[1]; y[6] = b1[2]; y[7] = b1[3]; }
#pragma unroll
    for (int j = 0; j < 4; ++j) { const v4u xw = xr[j]; const f32x4 w0 = *(const LAS f32x4*)(cw + j * 128), w1 = *(const LAS f32x4*)(cw + j * 128 + 4);
        y[0] += w0[0] * bf_lo(xw.x); y[1] += w0[1] * bf_hi(xw.x); y[2] += w0[2] * bf_lo(xw.y); y[3] += w0[3] * bf_hi(xw.y);
        y[4] += w1[0] * bf_lo(xw.z); y[5] += w1[1] * bf_hi(xw.z); y[6] += w1[2] * bf_lo(xw.w); y[7] += w1[3] * bf_hi(xw.w); }
#pragma unroll
    for (int e = 0; e < 8; ++e) y[e] = silu_f(y[e]);
}
__device__ __forceinline__ void load_taps(v4u (&xr)[4], const bf16* src, int tt0) {
#pragma unroll
    for (int j = 0; j < 4; ++j) { const int tt = tt0 - 3 + j; xr[j] = (v4u){0u, 0u, 0u, 0u}; if (tt >= 0) xr[j] = *(const v4u*)(src + (size_t)tt * 512); }
}

struct AReg { v4u kx[2][4]; v4u vv[2]; float ig, lf; };
__device__ __forceinline__ void mlstm_A_load(AReg& R, int u, const bf16* KM, const bf16* VM, const float* IG, const float* LF, int tid, int lane, int wave) {
    const int c = u & 31, hd = (u >> 5) & 3, b = u >> 7; const size_t rowb = (size_t)b * SEQ, t0 = rowb + 64 * c;
#pragma unroll
    for (int it = 0; it < 2; ++it) { const int idx = tid + 512 * it, t = (idx >> 4) & 63, g = idx & 15;
        load_taps(R.kx[it], KM + rowb * 512 + hd * 128 + 8 * g, 64 * c + t); R.vv[it] = *(const v4u*)(VM + (t0 + t) * 512 + hd * 128 + 8 * g); }
    R.ig = 0.f; R.lf = 0.f; if (wave == 0) { R.ig = IG[(t0 + lane) * 4 + hd]; R.lf = LF[(t0 + lane) * 4 + hd]; }
}
__device__ __forceinline__ void mlstm_A(LAS unsigned char* lds, int u, int u_next, AReg& R, const bf16* KM, const bf16* VM, const float* IG, const float* LF, bf16* KC, bf16* CL, float* MSC,
                                        int tid, int lane, int wave) {
    asm volatile("" : "+v"(tid), "+v"(lane)); asm volatile("" : "+s"(wave));
    const int r = lane & 31, hh = lane >> 5;
    LAS float* gt = (LAS float*)(lds + MA_GT); LAS bf16* ct = (LAS bf16*)(lds + MA_CT);
    __syncthreads();
    if (wave == 0) {
        float bc = R.lf;
#pragma unroll
        for (int o = 1; o < 64; o <<= 1) { const float v = __shfl_up(bc, o); if (lane >= o) bc += v; }
        const float a = R.ig - bc; float am = a;
#pragma unroll
        for (int o = 1; o < 64; o <<= 1) am = fmaxf(am, __shfl_xor(am, o));
        gt[lane] = __expf(a - am);
        if (lane == 63) { MSC[(size_t)u * 4 + 0] = am; MSC[(size_t)u * 4 + 1] = bc; }
    }
#pragma unroll
    for (int it = 0; it < 2; ++it) { const int idx = tid + 512 * it, t = (idx >> 4) & 63, g = idx & 15;
        float y[8]; conv8r(y, R.kx[it], (const LAS float*)(lds + ML_CW) + 640 + 8 * g);
        v4u o; o.x = pk2(y[0], y[1]); o.y = pk2(y[2], y[3]); o.z = pk2(y[4], y[5]); o.w = pk2(y[6], y[7]);
        *(LAS v4u*)(lds + MA_KW + t * ML_PV + 16 * g) = o; *(v4u*)(KC + ((size_t)u * 64 + t) * 128 + 8 * g) = o;
        *(LAS v4u*)(lds + MA_VS + t * ML_PV + 16 * g) = R.vv[it]; }
    if (u_next >= 0) mlstm_A_load(R, u_next, KM, VM, IG, LF, tid, lane, wave);
    __syncthreads();
#pragma unroll
    for (int it = 0; it < 2; ++it) { const int idx = tid + 512 * it, t = (idx >> 4) & 63, g = idx & 15; const float ws = gt[t];
        LAS v4u* kp = (LAS v4u*)(lds + MA_KW + t * ML_PV + 16 * g); const v4u xw = *kp;
        v4u o; o.x = pk2(ws * bf_lo(xw.x), ws * bf_hi(xw.x)); o.y = pk2(ws * bf_lo(xw.y), ws * bf_hi(xw.y)); o.z = pk2(ws * bf_lo(xw.z), ws * bf_hi(xw.z)); o.w = pk2(ws * bf_lo(xw.w), ws * bf_hi(xw.w)); *kp = o; }
    __syncthreads();
    { const int vi = wave >> 1; const LAS unsigned char* va = lds + MA_VS + tr_base(lane, ML_PV); const LAS unsigned char* kb = lds + MA_KW + tr_base(lane, ML_PV);
      f32x16 acc0 = f32x16{}, acc1 = f32x16{};
#pragma unroll
      for (int ks = 0; ks < 4; ++ks) { const bf16x8 af = tr_frag(va, ML_PV, vi, ks), b0 = tr_frag(kb, ML_PV, 2 * (wave & 1), ks), b1 = tr_frag(kb, ML_PV, 2 * (wave & 1) + 1, ks);
          acc0 = __builtin_amdgcn_mfma_f32_32x32x16_bf16(af, b0, acc0, 0, 0, 0); acc1 = __builtin_amdgcn_mfma_f32_32x32x16_bf16(af, b1, acc1, 0, 0, 0); }
#pragma unroll
      for (int q = 0; q < 16; ++q) { LAS bf16* cp = ct + (32 * vi + crow16(q, hh)) * (ML_PQ / 2) + 64 * (wave & 1) + r; cp[0] = (bf16)f2bf(acc0[q]); cp[32] = (bf16)f2bf(acc1[q]); } }
    if (tid < 128) { float sacc = 0.f;
#pragma unroll 8
        for (int s2 = 0; s2 < 64; ++s2) sacc += __uint_as_float((unsigned)(*(const LAS bf16*)(lds + MA_KW + s2 * ML_PV + 2 * tid)) << 16);
        ct[128 * (ML_PQ / 2) + tid] = (bf16)f2bf(sacc); }
    __syncthreads();
    bf16* dst = CL + (size_t)u * ML_CLE;
    for (int i = tid; i < 129 * 16; i += NWAVES * 64) { const int row = i >> 4, pc = i & 15; *(v4u*)(dst + row * 128 + pc * 8) = *(const LAS v4u*)(lds + MA_CT + row * ML_PQ + pc * 16); }
}

__device__ __forceinline__ void mlstm_B(bf16* CL, float* MSC, int tid, int vcu, int G) {
    constexpr int PCS = ML_CLE / 8;
    for (int item = vcu * (NWAVES * 64) + tid; item < 64 * PCS; item += G * NWAVES * 64) {
        const int bh = item / PCS, pc = item % PCS;
        bf16* base = CL + (size_t)bh * 32 * ML_CLE + pc * 8; float* ms = MSC + (size_t)bh * 32 * 4;
        float cst[8];
#pragma unroll
        for (int e = 0; e < 8; ++e) cst[e] = 0.f;
        float m = 0.f;
#pragma unroll 1
        for (int k0 = 0; k0 < 32; k0 += 8) {
            v4u x[8]; float ak[8], tk[8];
#pragma unroll
            for (int k = 0; k < 8; ++k) { x[k] = *(const v4u*)(base + (size_t)(k0 + k) * ML_CLE); ak[k] = ms[(k0 + k) * 4 + 0]; tk[k] = ms[(k0 + k) * 4 + 1]; }
#pragma unroll
            for (int k = 0; k < 8; ++k) {
                const float Mx = fmaxf(m, ak[k]), dec = __expf(m - Mx), w = __expf(ak[k] - Mx);
                v4u o; o.x = pk2(cst[0], cst[1]); o.y = pk2(cst[2], cst[3]); o.z = pk2(cst[4], cst[5]); o.w = pk2(cst[6], cst[7]);
                *(v4u*)(base + (size_t)(k0 + k) * ML_CLE) = o;
                if (pc == 0) ms[(k0 + k) * 4 + 2] = m;
                cst[0] = dec * cst[0] + w * bf_lo(x[k].x); cst[1] = dec * cst[1] + w * bf_hi(x[k].x); cst[2] = dec * cst[2] + w * bf_lo(x[k].y); cst[3] = dec * cst[3] + w * bf_hi(x[k].y);
                cst[4] = dec * cst[4] + w * bf_lo(x[k].z); cst[5] = dec * cst[5] + w * bf_hi(x[k].z); cst[6] = dec * cst[6] + w * bf_lo(x[k].w); cst[7] = dec * cst[7] + w * bf_hi(x[k].w);
                m = tk[k] + Mx; }
        }
    }
}

struct CReg { v4u cl[5]; v4u kc[2]; v4u vv[2]; v4u qx[2][4]; v4u om[2]; float ig, lf, mp; };
__device__ __forceinline__ void mlstm_C_load(CReg& R, int u, const bf16* QM, const bf16* KC, const bf16* VM, const bf16* OM, const float* IG, const float* LF, const bf16* CL, const float* MSC,
                                             int tid, int lane, int wave) {
    const int c = u & 31, hd = (u >> 5) & 3, b = u >> 7; const size_t rowb = (size_t)b * SEQ, t0 = rowb + 64 * c;
    const bf16* src = CL + (size_t)u * ML_CLE;
#pragma unroll
    for (int k = 0; k < 5; ++k) { const int i = tid + 512 * k; R.cl[k] = (v4u){0u, 0u, 0u, 0u}; if (i < 129 * 16) R.cl[k] = *(const v4u*)(src + (i >> 4) * 128 + (i & 15) * 8); }
#pragma unroll
    for (int it = 0; it < 2; ++it) { const int idx = tid + 512 * it, t = (idx >> 4) & 63, g = idx & 15;
        R.kc[it] = *(const v4u*)(KC + ((size_t)u * 64 + t) * 128 + 8 * g); R.vv[it] = *(const v4u*)(VM + (t0 + t) * 512 + hd * 128 + 8 * g);
        load_taps(R.qx[it], QM + rowb * 512 + hd * 128 + 8 * g, 64 * c + t); }
    { const int ot = tid >> 3, op8 = tid & 7; R.om[0] = *(const v4u*)(OM + (t0 + ot) * 512 + hd * 128 + 16 * op8); R.om[1] = *(const v4u*)(OM + (t0 + ot) * 512 + hd * 128 + 16 * op8 + 8); }
    R.ig = 0.f; R.lf = 0.f; R.mp = 0.f; if (wave == 0) { R.ig = IG[(t0 + lane) * 4 + hd]; R.lf = LF[(t0 + lane) * 4 + hd]; R.mp = MSC[(size_t)u * 4 + 2]; }
}
__device__ __forceinline__ void mlstm_C(LAS unsigned char* lds, int u, int u_next, CReg& R, const bf16* QM, const bf16* KC, const bf16* VM, const bf16* OM, const float* IG, const float* LF,
                                        const float* gain, const bf16* CL, const float* MSC, bf16* ATT, int tid, int lane, int wave) {
    asm volatile("" : "+v"(tid), "+v"(lane)); asm volatile("" : "+s"(wave));
    const int r = lane & 31, hh = lane >> 5, c = u & 31, hd = (u >> 5) & 3, b = u >> 7;
    LAS float* gt = (LAS float*)(lds + MC_GT);
    const size_t rowb = (size_t)b * SEQ, t0 = rowb + 64 * c;
    __syncthreads();
#pragma unroll
    for (int k = 0; k < 5; ++k) { const int i = tid + 512 * k; if (i < 129 * 16) *(LAS v4u*)(lds + MC_CT + (i >> 4) * ML_PQ + (i & 15) * 16) = R.cl[k]; }
    if (wave == 0) {
        const float m_prev = R.mp;
        float bc = R.lf;
#pragma unroll
        for (int o = 1; o < 64; o <<= 1) { const float v = __shfl_up(bc, o); if (lane >= o) bc += v; }
        const float a = R.ig - bc; float pm = a;
#pragma unroll
        for (int o = 1; o < 64; o <<= 1) { const float v = __shfl_up(pm, o); if (lane >= o) pm = fmaxf(pm, v); }
        gt[lane] = a; gt[64 + lane] = fmaxf(m_prev, pm); gt[128 + lane] = bc;
        if (lane == 0) gt[194] = m_prev;
    }
    const int ot = tid >> 3, op8 = tid & 7;
    const v4u og0 = R.om[0], og1 = R.om[1];
#pragma unroll
    for (int it = 0; it < 2; ++it) { const int idx = tid + 512 * it, t = (idx >> 4) & 63, g = idx & 15;
        *(LAS v4u*)(lds + MC_KT + t * ML_PQ + 16 * g) = R.kc[it];
        *(LAS v4u*)(lds + MC_VS + t * ML_PV + 16 * g) = R.vv[it];
        float y[8]; conv8r(y, R.qx[it], (const LAS float*)(lds + ML_CW) + 8 * g);
        const float sc = 0.08838834764831845f;
        v4u o; o.x = pk2(y[0] * sc, y[1] * sc); o.y = pk2(y[2] * sc, y[3] * sc); o.z = pk2(y[4] * sc, y[5] * sc); o.w = pk2(y[6] * sc, y[7] * sc);
        *(LAS v4u*)(lds + MC_QT + t * ML_PQ + 16 * g) = o; }
    if (u_next >= 0) mlstm_C_load(R, u_next, QM, KC, VM, OM, IG, LF, CL, MSC, tid, lane, wave);
    __syncthreads();
    if (wave < 4) { const int ti = wave >> 1, si = wave & 1; f32x16 g = f32x16{};
        if (si <= ti) mma_tile(g, lds + MC_QT + 32 * ti * ML_PQ, ML_PQ, lds + MC_KT + 32 * si * ML_PQ, ML_PQ, 8, r, hh);
        const float as = gt[32 * si + r]; LAS bf16* sp = (LAS bf16*)(lds + MC_SS);
#pragma unroll
        for (int q = 0; q < 16; ++q) { const int tl = crow16(q, hh), t = 32 * ti + tl, s2 = 32 * si + r;
            const float v = g[q] * __expf(fminf(as - gt[64 + t], 0.f)); sp[t * (ML_PS / 2) + s2] = (bf16)f2bf((s2 <= t) ? v : 0.f); } }
    __syncthreads();
    f32x16 nm = f32x16{};
    { const int ti = wave >> 2, vi = wave & 3;
      mma_tile(nm, lds + MC_QT + 32 * ti * ML_PQ, ML_PQ, lds + MC_CT + 32 * vi * ML_PQ, ML_PQ, 8, r, hh);
      const float mp = gt[194];
#pragma unroll
      for (int q = 0; q < 16; ++q) nm[q] *= __expf(mp - gt[64 + 32 * ti + crow16(q, hh)]);
      const LAS unsigned char* vb = lds + MC_VS + tr_base(lane, ML_PV);
#pragma unroll
      for (int ks = 0; ks < 4; ++ks) { const bf16x8 av = *(const LAS bf16x8*)(lds + MC_SS + (32 * ti + r) * ML_PS + 32 * ks + 16 * hh), bv = tr_frag(vb, ML_PV, vi, ks);
          nm = __builtin_amdgcn_mfma_f32_32x32x16_bf16(av, bv, nm, 0, 0, 0); } }
    float den;
    { const v4u sw = *(const LAS v4u*)(lds + MC_SS + ot * ML_PS + 16 * op8);
      float d1 = (bf_lo(sw.x) + bf_hi(sw.x)) + (bf_lo(sw.y) + bf_hi(sw.y)) + (bf_lo(sw.z) + bf_hi(sw.z)) + (bf_lo(sw.w) + bf_hi(sw.w)), d2 = 0.f;
#pragma unroll
      for (int k = 0; k < 2; ++k) { const v4u qw = *(const LAS v4u*)(lds + MC_QT + ot * ML_PQ + 32 * op8 + 16 * k), nw = *(const LAS v4u*)(lds + MC_CT + 128 * ML_PQ + 32 * op8 + 16 * k);
          d2 += bf_lo(qw.x) * bf_lo(nw.x) + bf_hi(qw.x) * bf_hi(nw.x) + bf_lo(qw.y) * bf_lo(nw.y) + bf_hi(qw.y) * bf_hi(nw.y) + bf_lo(qw.z) * bf_lo(nw.z) + bf_hi(qw.z) * bf_hi(nw.z) + bf_lo(qw.w) * bf_lo(nw.w) + bf_hi(qw.w) * bf_hi(nw.w); }
      den = d1 + __expf(gt[194] - gt[64 + ot]) * d2;
      den += __shfl_xor(den, 1); den += __shfl_xor(den, 2); den += __shfl_xor(den, 4); }
    __syncthreads();
    { const int ti = wave >> 2, vi = wave & 3; LAS float* np = (LAS float*)(lds + MC_NUM);
#pragma unroll
      for (int q = 0; q < 16; ++q) np[(32 * ti + crow16(q, hh)) * ML_PN + 32 * vi + r] = nm[q]; }
    __syncthreads();
    { const int t = ot, p = op8; const LAS float* np = (const LAS float*)(lds + MC_NUM) + t * ML_PN;
      const float mrow = gt[128 + t] + gt[64 + t], scl = 1.f / fmaxf(fabsf(den), __expf(-mrow));
      float hv[16]; float ss = 0.f;
#pragma unroll
      for (int e = 0; e < 16; ++e) { hv[e] = np[16 * p + e] * scl; ss += hv[e] * hv[e]; }
      ss += __shfl_xor(ss, 1); ss += __shfl_xor(ss, 2); ss += __shfl_xor(ss, 4);
      const float rs = rsqrtf(ss * (1.f / 128.f) + EPS);
      const v4u o0 = og0, o1 = og1;
      const float og[16] = {bf_lo(o0.x), bf_hi(o0.x), bf_lo(o0.y), bf_hi(o0.y), bf_lo(o0.z), bf_hi(o0.z), bf_lo(o0.w), bf_hi(o0.w), bf_lo(o1.x), bf_hi(o1.x), bf_lo(o1.y), bf_hi(o1.y), bf_lo(o1.z), bf_hi(o1.z), bf_lo(o1.w), bf_hi(o1.w)};
      const float* gp = gain + hd * 128 + 16 * p;
#pragma unroll
      for (int e = 0; e < 16; ++e) hv[e] = hv[e] * rs * gp[e] * og[e];
      v4u w0, w1; w0.x = pk2(hv[0], hv[1]); w0.y = pk2(hv[2], hv[3]); w0.z = pk2(hv[4], hv[5]); w0.w = pk2(hv[6], hv[7]); w1.x = pk2(hv[8], hv[9]); w1.y = pk2(hv[10], hv[11]); w1.z = pk2(hv[12], hv[13]); w1.w = pk2(hv[14], hv[15]);
      bf16* op = ATT + (t0 + t) * 1024 + 512 + hd * 128 + 16 * p; *(v4u*)op = w0; *(v4u*)(op + 8) = w1; }
}

struct Args { const void* in[22]; float* out; unsigned char* ws; int ph_lo, ph_hi; };
__global__ void __launch_bounds__(NWAVES * 64, 2) hybrid_fwd(Args args) {
    extern __shared__ __attribute__((aligned(16))) unsigned char lds_raw[];
    LAS unsigned char* lds = (LAS unsigned char*)lds_raw;
    volatile LAS unsigned* MISC = (volatile LAS unsigned*)(lds + LDSCTL_OFF);
    const int G0 = gridDim.x, bid0 = blockIdx.x; const int vcu0 = (G0 % 8 == 0) ? (bid0 % 8) * (G0 / 8) + bid0 / 8 : bid0;
#define PHASE_BEGIN() unsigned ones_ = ~0u; asm volatile("" : "+s"(ones_)); int lane = (int)__builtin_amdgcn_mbcnt_hi(ones_, __builtin_amdgcn_mbcnt_lo(ones_, 0u)), tid = wave0 * 64 + lane; asm volatile("" : "+v"(tid), "+v"(lane)); const int wave = __builtin_amdgcn_readfirstlane(tid >> 6); \
    int G = G0, vcu = vcu0, bid = bid0; asm volatile("" : "+s"(G), "+s"(vcu), "+s"(bid)); (void)wave; (void)lane; (void)vcu; (void)bid; (void)G
    const int wave0 = __builtin_amdgcn_readfirstlane((int)threadIdx.x >> 6);
    { const int tid = threadIdx.x;
    for (int u = tid; u < (LDS_BYTES - LDSCTL_OFF) / 4; u += NWAVES * 64) ((LAS unsigned*)(lds + LDSCTL_OFF))[u] = 0u;
    __syncthreads();
    if (tid == 0) { LAS unsigned long long* pb = (LAS unsigned long long*)(lds + LDSCTL_OFF + 64);
#pragma unroll
        for (int k = 0; k < 22; ++k) pb[k] = (unsigned long long)args.in[k];
        pb[I_OUT] = (unsigned long long)args.out; pb[I_WS] = (unsigned long long)args.ws; }
    __syncthreads(); }
    const int lo = args.ph_lo, hi = args.ph_hi;
    XcdBarrier bar; bar.bar = (unsigned*)(args.ws + WS_CTL) + CW_BAR; bar.x = 0; bar.st = nullptr;
    if (hi - lo > 1) bar = xcd_barrier_post((unsigned*)(args.ws + WS_CTL) + CW_BAR, MISC + 8);
#ifndef ONLY
#define ONLY -1
#endif
#define PH_ON(c) (ONLY < 0 || ONLY == (c))
#ifndef DUP
#define DUP -1
#endif
#define REPS(c) _Pragma("unroll 1") for (int rep_ = 0; rep_ < ((DUP == (c)) ? 2 : 1); ++rep_)
#define IN(k) (lo <= (k) && (k) < hi)
#define OPAQUE_GEMM(g) asm volatile("" : "+s"(g.A), "+s"(g.Bt))
#define SEAM(k) do { if (IN(k) && IN((k) + 1)) { bar.bar = (unsigned*)(WSP() + WS_CTL) + CW_BAR; xcd_barrier(bar); } } while (0)
#define XNB   ((bf16*)(WSPG() + WS_XN))
#define MXB(o) (WSPG() + WS_MIX + (o))
#define MODB  ((float*)(WSPG() + WS_MOD))
#define SSQB  ((float*)(WSPG() + WS_SSQ))

    REPS(0) { PHASE_BEGIN(); if (PH_ON(0) && IN(0)) p0_prologue(lds, tid, lane, wave, vcu, G); }
    SEAM(0);
#if defined(DUP) && DUP == 50
    for (int xb_ = 0; xb_ < 20; ++xb_) SEAM(0);
#endif
    { PHASE_BEGIN(); if (PH_ON(1) && IN(1)) norm_phase(nullptr, FP(I_X), nullptr, nullptr, nullptr, FP(I_MIXPRE), MODB + 1 * D, MODB + 0 * D, XNB, lane, wave, vcu, G); }
    SEAM(1);

    for (int l = 0; l < DEPTH; ++l) {
        const int pb = 2 + 9 * l;
        if (PH_ON(2) && IN(pb + 0)) REPS(2) { PHASE_BEGIN();
            unsigned char* wl = WSP() + WS_W + (size_t)l * W_LAYER;
            pg8::Gemm g{XNB, (const bf16*)(wl + WO_IN), M, NINP, D}; OPAQUE_GEMM(g); pg8::StaticOrder S; S.init(M, NINP, G, bid);
            pg8::EpiIn E{(bf16*)MXB(MX_CQ), (bf16*)MXB(MX_K), (bf16*)MXB(MX_V), (bf16*)MXB(MX_KI), (bf16*)MXB(MX_QM), (bf16*)MXB(MX_KM), (bf16*)MXB(MX_VM), (bf16*)MXB(MX_OM), SSQB, (float*)MXB(MX_WI), (float*)MXB(MX_IG), (float*)MXB(MX_LF),
                         GPTR(const int, ldptr(lds, I_POS)), FP(I_BIG) + l * 4, FP(I_BFG) + l * 4};
            pg8::gemm_phase<pg8::EpiIn, pg8::StaticOrder, true, true>(lds, g, S, E, tid);
        }
        SEAM(pb + 0);
#ifndef SUB
#define SUB 0
#endif
#define MSCB ((float*)(WSPG() + WS_SSQ + 512 * 1024))
#define MLSTM_A_BLOCK() do { PHASE_BEGIN(); int cur_hd = -1; \
            if (SUB != 1 && vcu < 2048) { AReg RA; mlstm_A_load(RA, vcu, (const bf16*)MXB(MX_KM), (const bf16*)MXB(MX_VM), (const float*)MXB(MX_IG), (const float*)MXB(MX_LF), tid, lane, wave); \
              for (int u = vcu; u < 2048; u += G) { const int hd = (u >> 5) & 3; \
                if (hd != cur_hd) { __syncthreads(); ml_stage_cw(lds, FP(I_CONVW) + (size_t)l * 4 * 1024, FP(I_CONVB) + (size_t)l * 1024, hd, tid); cur_hd = hd; }       \
                mlstm_A(lds, u, (u + G < 2048) ? u + G : -1, RA, (const bf16*)MXB(MX_KM), (const bf16*)MXB(MX_VM), (const float*)MXB(MX_IG), (const float*)MXB(MX_LF), (bf16*)MXB(MX_KC), (bf16*)MXB(MX_CL), MSCB, tid, lane, wave); } } \
            __syncthreads(); } while (0)
        if (PH_ON(3) && IN(pb + 1)) REPS(3) { PHASE_BEGIN();
            unsigned char* wl = WSP() + WS_W + (size_t)l * W_LAYER;
            pg8::Gemm g{(const bf16*)MXB(MX_CQ), (const bf16*)(wl + WO_Q), M, 1024, QRK}; OPAQUE_GEMM(g); pg8::StaticOrder S; S.init(M, 1024, G, bid);
            pg8::EpiQ E{(bf16*)MXB(MX_Q), (bf16*)MXB(MX_QI), SSQB, GPTR(const int, ldptr(lds, I_POS)), attn_body::C2};
            pg8::gemm_phase<pg8::EpiQ, pg8::StaticOrder, true, true>(lds, g, S, E, tid);
        }
        if (PH_ON(4) && IN(pb + 1)) REPS(41) MLSTM_A_BLOCK();
        SEAM(pb + 1);
        if (PH_ON(4) && IN(pb + 2)) { PHASE_BEGIN();
            if (SUB != 1) REPS(42) mlstm_B((bf16*)MXB(MX_CL), MSCB, tid, vcu, G);
            if (SUB != 2) REPS(40) { IxReg RI = {};
#define IX_L(i) ((i) * G + (((i) & 1) ? G - 1 - vcu : vcu))
                if (IX_L(0) < BATCH * 128) indexer_load(RI, IX_L(0) & 15, 127 - (IX_L(0) >> 4), (const bf16*)MXB(MX_QI), (const bf16*)MXB(MX_KI), (const float*)MXB(MX_WI), tid, lane, wave);
                for (int i = 0; i * G < BATCH * 128; ++i) { const int L = IX_L(i), Ln = IX_L(i + 1); const bool hn = ((i + 1) * G < BATCH * 128) && (Ln < BATCH * 128);
                    if (L < BATCH * 128) indexer_unit(lds, L & 15, 127 - (L >> 4), hn ? (Ln & 15) : 0, hn ? 127 - (Ln >> 4) : -1, RI, (const bf16*)MXB(MX_QI), (const bf16*)MXB(MX_KI), (const float*)MXB(MX_WI), (unsigned long long*)MXB(MX_MASK), tid, lane, wave); }
#undef IX_L
            }
        }
        SEAM(pb + 2);
#define MLSTM_C_BLOCK() do { PHASE_BEGIN(); int cur_hd = -1; \
            if (SUB != 1 && vcu < 2048) { CReg RC; mlstm_C_load(RC, vcu, (const bf16*)MXB(MX_QM), (const bf16*)MXB(MX_KC), (const bf16*)MXB(MX_VM), (const bf16*)MXB(MX_OM), (const float*)MXB(MX_IG), (const float*)MXB(MX_LF), (const bf16*)MXB(MX_CL), MSCB, tid, lane, wave); \
              for (int u = vcu; u < 2048; u += G) { const int hd = (u >> 5) & 3; \
                if (hd != cur_hd) { __syncthreads(); ml_stage_cw(lds, FP(I_CONVW) + (size_t)l * 4 * 1024, FP(I_CONVB) + (size_t)l * 1024, hd, tid); cur_hd = hd; } \
                mlstm_C(lds, u, (u + G < 2048) ? u + G : -1, RC, (const bf16*)MXB(MX_QM), (const bf16*)MXB(MX_KC), (const bf16*)MXB(MX_VM), (const bf16*)MXB(MX_OM), (const float*)MXB(MX_IG), (const float*)MXB(MX_LF), \
                        FP(I_MLN) + (size_t)l * 512, (const bf16*)MXB(MX_CL), MSCB, XNB, tid, lane, wave); } } \
            __syncthreads(); } while (0)
        if (PH_ON(4) && IN(pb + 3)) REPS(43) MLSTM_C_BLOCK();
        if (PH_ON(5) && IN(pb + 3)) REPS(5) { PHASE_BEGIN();
            const attn_body::AttnTensors AT{(const attn_body::bf16*)MXB(MX_Q), (const attn_body::bf16*)MXB(MX_K), (const attn_body::bf16*)MXB(MX_V), (attn_body::bf16*)XNB, (const attn_body::u32x4*)MXB(MX_MASK), FP(I_ATTN) + (size_t)l * 512};
            const attn_body::StaticOrder S(G, bid);
            attn_body::attn_phase<attn_body::StaticOrder>((char*)lds_raw, AT, S, tid);
        }
        SEAM(pb + 3);
        if (PH_ON(6) && IN(pb + 4)) REPS(6) { PHASE_BEGIN();
            unsigned char* wl = WSP() + WS_W + (size_t)l * W_LAYER;
            pg8::Gemm g{XNB, (const bf16*)(wl + WO_OUT), M, D, D}; OPAQUE_GEMM(g); pg8::StaticOrder S; S.init(M, D, G, bid);
            pg8::EpiPlain E{(bf16*)MXB(MX_Y), D};
            pg8::gemm_phase<pg8::EpiPlain, pg8::StaticOrder, true, true>(lds, g, S, E, tid);
        }
        SEAM(pb + 4);
        if (PH_ON(1) && IN(pb + 5)) { PHASE_BEGIN(); const float* modl = MODB + (size_t)l * BATCH * NMOD; float* outp = GPTR(float, ldptr(lds, I_OUT));
            norm_phase((const bf16*)MXB(MX_Y), l == 0 ? FP(I_X) : (const float*)outp, outp, FP(I_MIXPOST) + (size_t)l * D, modl + 2 * D, FP(I_FFNPRE) + (size_t)l * D, modl + 4 * D, modl + 3 * D, XNB, lane, wave, vcu, G); }
        SEAM(pb + 5);
        if (PH_ON(7) && IN(pb + 6)) REPS(7) { PHASE_BEGIN();
            unsigned char* wl = WSP() + WS_W + (size_t)l * W_LAYER;
            pg8::Gemm g{XNB, (const bf16*)(wl + WO_GU), M, 2 * FF, D}; OPAQUE_GEMM(g); pg8::StaticOrder S; S.init(M, 2 * FF, G, bid);
            pg8::EpiSwiglu E{(bf16*)MXB(MX_H), FF};
            pg8::gemm_phase<pg8::EpiSwiglu, pg8::StaticOrder, true, true>(lds, g, S, E, tid);
        }
        SEAM(pb + 6);
        if (PH_ON(6) && IN(pb + 7)) REPS(8) { PHASE_BEGIN();
            unsigned char* wl = WSP() + WS_W + (size_t)l * W_LAYER;
            pg8::Gemm g{(const bf16*)MXB(MX_H), (const bf16*)(wl + WO_DN), M, D, FF}; OPAQUE_GEMM(g); pg8::StaticOrder S; S.init(M, D, G, bid);
            pg8::EpiPlain E{(bf16*)MXB(MX_Y), D};
            pg8::gemm_phase<pg8::EpiPlain, pg8::StaticOrder, true, true>(lds, g, S, E, tid);
        }
        SEAM(pb + 7);
        if (PH_ON(1) && IN(pb + 8)) { PHASE_BEGIN();
            const bool last = (l == DEPTH - 1); const float* modl = MODB + (size_t)l * BATCH * NMOD; const float* modn = MODB + (size_t)(l + 1) * BATCH * NMOD; float* outp = GPTR(float, ldptr(lds, I_OUT));
            norm_phase((const bf16*)MXB(MX_Y), outp, outp, FP(I_FFNPOST) + (size_t)l * D, modl + 5 * D, last ? nullptr : FP(I_MIXPRE) + (size_t)(l + 1) * D, modn + 1 * D, modn + 0 * D, XNB, lane, wave, vcu, G);
        }
        SEAM(pb + 8);
    }
#ifdef GPROBE
    if (bid0 == 0 && wave0 == 0 && __builtin_amdgcn_mbcnt_hi(~0u, __builtin_amdgcn_mbcnt_lo(~0u, 0u)) == 0u) { const unsigned long long tot_ = *(volatile LAS unsigned long long*)(lds + pg8::PROBE_LDS_OFF) * (unsigned long long)(GPROBE_FACTOR);
        const unsigned long long t0_ = __builtin_amdgcn_s_memrealtime(); while (__builtin_amdgcn_s_memrealtime() - t0_ < tot_) __builtin_amdgcn_s_sleep(16); }
#endif
#undef IN
#undef SEAM
}

extern "C" void kernel_launch(void* const* d_in, const int* in_sizes, int n_in, void* d_out, int out_size, void* d_ws, size_t ws_size, hipStream_t stream) {
    static int grid = 0;
    if (grid == 0) {
        if (n_in != 22 || in_sizes[0] != M * D || out_size != M * D || ws_size < WS_END) { fprintf(stderr, "kernel_launch: built for 22 inputs, x/out of %d floats, >= %zu bytes of workspace; got n_in %d, in0 %d, out %d, ws %zu; nothing launched\n", M * D, (size_t)WS_END, n_in, n_in > 0 ? in_sizes[0] : -1, out_size, ws_size); grid = -1; return; }
        int dev = 0, cus = 0, per_cu = 0;
        if (hipGetDevice(&dev) != hipSuccess || hipDeviceGetAttribute(&cus, hipDeviceAttributeMultiprocessorCount, dev) != hipSuccess) { fprintf(stderr, "kernel_launch: device query failed\n"); grid = -1; return; }
        if (hipFuncSetAttribute((const void*)hybrid_fwd, hipFuncAttributeMaxDynamicSharedMemorySize, LDS_BYTES) != hipSuccess) { fprintf(stderr, "kernel_launch: hipFuncSetAttribute(%d B LDS) failed\n", LDS_BYTES); grid = -1; return; }
        if (hipOccupancyMaxActiveBlocksPerMultiprocessor(&per_cu, (const void*)hybrid_fwd, NWAVES * 64, LDS_BYTES) != hipSuccess || per_cu < 1)
            fprintf(stderr, "kernel_launch: note: occupancy query reports %d workgroups per CU\n", per_cu);
        (void)hipGetLastError();
        grid = cus;
    }
    if (grid < 0) return;
    if (hipMemsetAsync((char*)d_ws + WS_CTL, 0, CTL_ZERO_BYTES, stream) != hipSuccess) { fprintf(stderr, "kernel_launch: hipMemsetAsync failed\n"); return; }
    Args a{};
    for (int i = 0; i < 22; ++i) a.in[i] = d_in[i];
    a.out = (float*)d_out; a.ws = (unsigned char*)d_ws;
#if MK_ONE_LAUNCH
    a.ph_lo = 0; a.ph_hi = N_PHASES;
    hipLaunchKernelGGL(hybrid_fwd, dim3(grid), dim3(NWAVES * 64), LDS_BYTES, stream, a);
#else
    for (int p = 0; p < N_PHASES; ++p) { a.ph_lo = p; a.ph_hi = p + 1; hipLaunchKernelGGL(hybrid_fwd, dim3(grid), dim3(NWAVES * 64), LDS_BYTES, stream, a); }
#endif
    const hipError_t le = hipPeekAtLastError();
    if (le != hipSuccess) fprintf(stderr, "kernel_launch: launch failed: %s (grid %d x %d threads, %d B LDS)\n", hipGetErrorName(le), grid, NWAVES * 64, LDS_BYTES);
}
```

```cpp
#include <hip/hip_runtime.h>
#include <hip/hip_bf16.h>
#include <cstdio>
#include <cstdint>
#include <cmath>
namespace pg8 {
#define PG8_LAS __attribute__((address_space(3)))
typedef unsigned short bf16_t;
typedef short bf16x8 __attribute__((ext_vector_type(8)));
typedef float f32x4 __attribute__((ext_vector_type(4)));
typedef unsigned u32x4 __attribute__((ext_vector_type(4)));
constexpr int PROBE_LDS_OFF = 153600 + 448 - 16;
constexpr int BM = 256, BK = 64, HALF = 128, HTB = HALF * BK * 2  , STAGE_BYTES = 8 * HTB, NXCD = 8, WGM = 8;

__host__ __device__ __forceinline__ int lds_byte(int r, int c) { const int st = (r >> 4) * 2 + (c >> 5), rr = r & 15, cc = c & 31, ob = rr * 64 + cc * 2; return st * 1024 + (ob ^ (((ob >> 9) & 1) << 5)); }
__host__ __device__ __forceinline__ void stage_rc(int b, int& R, int& C) { const int st = b / 1024, sb = b % 1024, swz = sb ^ (((sb >> 9) & 1) << 5); R = (st >> 1) * 16 + swz / 64; C = (st & 1) * 32 + (swz % 64) / 2; }
__host__ __device__ __forceinline__ int perm32(int rho) { const int n = rho >> 4, i = rho & 15; return 8 * (i >> 2) + 4 * n + (i & 3); }

struct Unit { int pm, pn; };
struct Gemm { const bf16_t* A; const bf16_t* Bt; int M, N, K; };

struct StaticOrder {
    int nM, nN, nwg, G, c;
    __host__ __device__ void init(int M, int N, int G_, int c_) { nM = M / BM; nN = N / BM; nwg = nM * nN; G = G_; c = c_; }
    __host__ __device__ bool next(int i, Unit& u) const {
        const long L = (long)i * G + c; if (L >= nwg) return false;
        int wgid = (int)L; { const int q = nwg / NXCD, r = nwg % NXCD, xcd = wgid % NXCD, off = wgid / NXCD; wgid = (xcd < r ? xcd * (q + 1) : r * (q + 1) + (xcd - r) * q) + off; }
        const int nig = WGM * nN, gid = wgid / nig, fm = gid * WGM, gsz = (nM - fm) < WGM ? (nM - fm) : WGM;
        u.pm = fm + ((wgid % nig) % gsz); u.pn = (wgid % nig) / gsz; return true;
    }
    __device__ __forceinline__ void a_ready(const Unit&) const {}
    __device__ __forceinline__ void done(const Unit&) const {}
};

__device__ __forceinline__ unsigned cvt_pk_bf16(float lo, float hi) { unsigned r; asm volatile("v_cvt_pk_bf16_f32 %0, %1, %2" : "=v"(r) : "v"(lo), "v"(hi)); return r; }
typedef float f32x2 __attribute__((ext_vector_type(2)));

__device__ __forceinline__ void store8(bf16_t* p, const f32x4 a, const f32x4 b) {
    u32x4 w; w.x = cvt_pk_bf16(a[0], a[1]); w.y = cvt_pk_bf16(a[2], a[3]); w.z = cvt_pk_bf16(b[0], b[1]); w.w = cvt_pk_bf16(b[2], b[3]);
#ifdef STORE_SC1
    asm volatile("global_store_dwordx4 %0, %1, off sc1\n\ts_nop 1" :: "v"(p), "v"(w) : "memory");
#else
    *(u32x4*)p = w;
#endif

}
__device__ __forceinline__ float sigmoid_f(float g) { return __builtin_amdgcn_rcpf(1.f + __builtin_amdgcn_exp2f(-1.4426950408889634f * g)); }
__device__ __forceinline__ float silu_f(float g) { return g * sigmoid_f(g); }
__device__ __forceinline__ void rope_invf(float (&invf)[4], int wc, int fq) {
    const int j = 4 * (wc & 1) + fq;
#pragma unroll
    for (int e = 0; e < 4; ++e) invf[e] = exp2f(-(float)(4 * j + e) * 0.41524101186092029f) * 0.15915494309189535f;
}
__device__ __forceinline__ void rope_sincos(float (&sn)[4], float (&cs)[4], float p, const float (&invf)[4]) {
#pragma unroll
    for (int e = 0; e < 4; ++e) { const float r = __builtin_amdgcn_fractf(p * invf[e]); sn[e] = __builtin_amdgcn_sinf(r); cs[e] = __builtin_amdgcn_cosf(r); }
}
__device__ __forceinline__ void rope_apply(f32x4& x1, f32x4& x2, const float (&sn)[4], const float (&cs)[4]) {
    f32x4 o1, o2;
#pragma unroll
    for (int e = 0; e < 4; ++e) { o1[e] = x1[e] * cs[e] - x2[e] * sn[e]; o2[e] = x2[e] * cs[e] + x1[e] * sn[e]; }
    x1 = o1; x2 = o2;
}

struct EpiIn {
    static constexpr bool PERM = true, AFTER_DRAIN = false; static constexpr int PROBE = 2;
    bf16_t *CQ, *K, *V, *KI, *QM, *KM, *VM, *OM; float *SSQ, *WI, *IG, *LF; const int* pos; const float *b_ig, *b_fg;
    __device__ __forceinline__ void operator()(const f32x4 (&acc)[2][2][4][2], const Unit& u, int wr, int wc, int fr, int fq) const {
        { unsigned ones_ = ~0u; asm volatile("" : "+s"(ones_)); const int ln_ = (int)__builtin_amdgcn_mbcnt_hi(ones_, __builtin_amdgcn_mbcnt_lo(ones_, 0u)); fr = ln_ & 15; fq = ln_ >> 4; }
        const int row0 = u.pm * BM + wr * 64 + fr, ct = wc * 32 + 8 * fq, pn = u.pn;
        if (pn == 0) {
#pragma unroll
            for (int ai = 0; ai < 2; ++ai)
#pragma unroll
                for (int m = 0; m < 4; ++m) { const int row = row0 + ai * HALF + m * 16; float s = 0.f;
#pragma unroll
                    for (int bj = 0; bj < 2; ++bj) { const f32x4 v0 = acc[ai][bj][m][0], v1 = acc[ai][bj][m][1];
                        s += (v0[0] * v0[0] + v0[1] * v0[1]) + (v0[2] * v0[2] + v0[3] * v0[3]) + (v1[0] * v1[0] + v1[1] * v1[1]) + (v1[2] * v1[2] + v1[3] * v1[3]);
                        store8(CQ + (size_t)row * 256 + bj * HALF + ct, v0, v1); }
                    s += __shfl_xor(s, 16); s += __shfl_xor(s, 32);
                    if (fq == 0) SSQ[(size_t)row * 4 + wc] = s; }
        } else if (pn <= 2) {
            float invf[4]; rope_invf(invf, wc, fq);
            int psv[2][4];
#pragma unroll
            for (int ai = 0; ai < 2; ++ai)
#pragma unroll
                for (int m = 0; m < 4; ++m) psv[ai][m] = pos[row0 + ai * HALF + m * 16];
#pragma unroll
            for (int ai = 0; ai < 2; ++ai)
#pragma unroll
                for (int m = 0; m < 4; ++m) { const int row = row0 + ai * HALF + m * 16; float sn[4], cs[4]; rope_sincos(sn, cs, (float)psv[ai][m], invf);
#pragma unroll
                    for (int bj = 0; bj < 2; ++bj) { f32x4 v0 = acc[ai][bj][m][0], v1 = acc[ai][bj][m][1]; rope_apply(v0, v1, sn, cs);
                        store8(K + (size_t)row * 512 + (pn - 1) * 256 + bj * HALF + ct, v0, v1); } }
        } else if (pn <= 12) {
            const int g = (pn - 3) >> 1; bf16_t* dst = (g == 0) ? V : (g == 1) ? QM : (g == 2) ? KM : (g == 3) ? VM : OM; const int cb = ((pn - 3) & 1) * 256 + ct;
#pragma unroll
            for (int ai = 0; ai < 2; ++ai)
#pragma unroll
                for (int m = 0; m < 4; ++m) { const int row = row0 + ai * HALF + m * 16;
#pragma unroll
                    for (int bj = 0; bj < 2; ++bj) { f32x4 v0 = acc[ai][bj][m][0], v1 = acc[ai][bj][m][1];
                        if (g == 4) {
#pragma unroll
                            for (int e = 0; e < 4; ++e) { v0[e] = sigmoid_f(v0[e]); v1[e] = sigmoid_f(v1[e]); } }
                        store8(dst + (size_t)row * 512 + cb + bj * HALF, v0, v1); } }
        } else {
            if (wc < 2) {
                float invf[4]; rope_invf(invf, wc, fq);
                int psv[2][4];
#pragma unroll
                for (int ai = 0; ai < 2; ++ai)
#pragma unroll
                    for (int m = 0; m < 4; ++m) psv[ai][m] = pos[row0 + ai * HALF + m * 16];
#pragma unroll
                for (int ai = 0; ai < 2; ++ai)
#pragma unroll
                    for (int m = 0; m < 4; ++m) { const int row = row0 + ai * HALF + m * 16; float sn[4], cs[4]; rope_sincos(sn, cs, (float)psv[ai][m], invf);
                        f32x4 v0 = acc[ai][0][m][0], v1 = acc[ai][0][m][1]; rope_apply(v0, v1, sn, cs); store8(KI + (size_t)row * 64 + ct, v0, v1); }
            } else if (wc == 2 && fq == 0) {
#pragma unroll
                for (int ai = 0; ai < 2; ++ai)
#pragma unroll
                    for (int m = 0; m < 4; ++m) { const int row = row0 + ai * HALF + m * 16; const float s = 0.044194173824159216f;
                        *(f32x4*)(WI + (size_t)row * 8) = acc[ai][0][m][0] * s; *(f32x4*)(WI + (size_t)row * 8 + 4) = acc[ai][0][m][1] * s; }
            } else if (wc == 2 && fq == 1) {
                const f32x4 bi = *(const f32x4*)b_ig, bf = *(const f32x4*)b_fg;
#pragma unroll
                for (int ai = 0; ai < 2; ++ai)
#pragma unroll
                    for (int m = 0; m < 4; ++m) { const int row = row0 + ai * HALF + m * 16; const f32x4 iv = acc[ai][0][m][0] + bi, fv = acc[ai][0][m][1] + bf; f32x4 lf;
#pragma unroll
                        for (int e = 0; e < 4; ++e) lf[e] = fminf(fv[e], 0.f) - 0.6931471805599453f * __builtin_amdgcn_logf(1.f + __builtin_amdgcn_exp2f(-1.4426950408889634f * fabsf(fv[e])));
                        *(f32x4*)(IG + (size_t)row * 4) = iv; *(f32x4*)(LF + (size_t)row * 4) = lf; }
            }
        }
    }
};

struct EpiQ {
    static constexpr bool PERM = true, AFTER_DRAIN = false; static constexpr int PROBE = 3;
    bf16_t *Q, *QI; const float* SSQ; const int* pos; float qscale;
    __device__ __forceinline__ void operator()(const f32x4 (&acc)[2][2][4][2], const Unit& u, int wr, int wc, int fr, int fq) const {
        { unsigned ones_ = ~0u; asm volatile("" : "+s"(ones_)); const int ln_ = (int)__builtin_amdgcn_mbcnt_hi(ones_, __builtin_amdgcn_mbcnt_lo(ones_, 0u)); fr = ln_ & 15; fq = ln_ >> 4; }
        const int row0 = u.pm * BM + wr * 64 + fr, ct = wc * 32 + 8 * fq, pn = u.pn;
        float invf[4]; rope_invf(invf, wc, fq);
        bf16_t* dst = (pn < 2) ? Q + pn * 256 : QI + (pn - 2) * 256; const float sc = (pn < 2) ? qscale : 1.f;
#pragma unroll
        for (int ai = 0; ai < 2; ++ai) {
            float rsv[4]; int psv[4];
#pragma unroll
            for (int m = 0; m < 4; ++m) { const int row = row0 + ai * HALF + m * 16; const f32x4 ss = *(const f32x4*)(SSQ + (size_t)row * 4); psv[m] = pos[row]; rsv[m] = ((ss[0] + ss[1]) + (ss[2] + ss[3])) * (1.f / 256.f) + 1e-6f; }
#pragma unroll
            for (int m = 0; m < 4; ++m) { const int row = row0 + ai * HALF + m * 16;
                const float rstd = rsqrtf(rsv[m]);
                float sn[4], cs[4]; rope_sincos(sn, cs, (float)psv[m], invf);
#pragma unroll
                for (int bj = 0; bj < 2; ++bj) { f32x4 v0 = acc[ai][bj][m][0] * rstd, v1 = acc[ai][bj][m][1] * rstd; rope_apply(v0, v1, sn, cs);
                    store8(dst + (size_t)row * 512 + bj * HALF + ct, v0 * sc, v1 * sc); } } }
    }
};

struct EpiPlain {
    static constexpr bool PERM = true, AFTER_DRAIN = false; static constexpr int PROBE = 6;
    bf16_t* O; int ldc;
    __device__ __forceinline__ void operator()(const f32x4 (&acc)[2][2][4][2], const Unit& u, int wr, int wc, int fr, int fq) const {
        { unsigned ones_ = ~0u; asm volatile("" : "+s"(ones_)); const int ln_ = (int)__builtin_amdgcn_mbcnt_hi(ones_, __builtin_amdgcn_mbcnt_lo(ones_, 0u)); fr = ln_ & 15; fq = ln_ >> 4; }
        const int row0 = u.pm * BM + wr * 64 + fr, col0 = u.pn * BM + wc * 32 + 8 * fq;
#pragma unroll
        for (int ai = 0; ai < 2; ++ai)
#pragma unroll
            for (int m = 0; m < 4; ++m) { bf16_t* rowp = O + (size_t)(row0 + ai * HALF + m * 16) * ldc + col0;
#pragma unroll
                for (int bj = 0; bj < 2; ++bj) store8(rowp + bj * HALF, acc[ai][bj][m][0], acc[ai][bj][m][1]); }
    }
};

struct EpiSwiglu {
    static constexpr bool PERM = true, AFTER_DRAIN = false; static constexpr int PROBE = 7;
    bf16_t* H; int ldc;
    __device__ __forceinline__ void operator()(const f32x4 (&acc)[2][2][4][2], const Unit& u, int wr, int wc, int fr, int fq) const {
        { unsigned ones_ = ~0u; asm volatile("" : "+s"(ones_)); const int ln_ = (int)__builtin_amdgcn_mbcnt_hi(ones_, __builtin_amdgcn_mbcnt_lo(ones_, 0u)); fr = ln_ & 15; fq = ln_ >> 4; }
        const int row0 = u.pm * BM + wr * 64 + fr, col0 = u.pn * HALF + wc * 32 + 8 * fq;
#pragma unroll
        for (int ai = 0; ai < 2; ++ai)
#pragma unroll
            for (int m = 0; m < 4; ++m) { f32x4 o0, o1;
#pragma unroll
                for (int e = 0; e < 4; ++e) { o0[e] = silu_f(acc[ai][0][m][0][e]) * acc[ai][1][m][0][e]; o1[e] = silu_f(acc[ai][0][m][1][e]) * acc[ai][1][m][1][e]; }
                store8(H + (size_t)(row0 + ai * HALF + m * 16) * ldc + col0, o0, o1); }
    }
};

template <class Epi, class Sched, bool ALIGN_EPI = false, bool SP2 = false>
__device__ __forceinline__ void gemm_phase(PG8_LAS unsigned char* lds, const Gemm g, const Sched& S, const Epi& E, int tid_in  ) {
    int tid_o = tid_in; asm volatile("" : "+v"(tid_o));
    const int tid = tid_o, wid = __builtin_amdgcn_readfirstlane(tid >> 6), lane = tid & 63, wr = wid >> 2, wc = wid & 3, fr = lane & 15, fq = lane >> 4;
    const int K = g.K, nt = K / BK;
    unsigned voffA[2], voffB[2];
#pragma unroll
    for (int i = 0; i < 2; ++i) { int R, C; stage_rc(tid * 16 + i * 8192, R, C); const int Rb = Epi::PERM ? ((R & ~31) + perm32(R & 31)) : R;
        voffA[i] = (unsigned)(R * K + C) * 2u; voffB[i] = (unsigned)(Rb * K + C) * 2u; }
    const size_t kstep = (size_t)(BK * 2);
    const size_t hstep = (size_t)HALF * K * 2;
    const size_t tstep = 2 * hstep;
    const unsigned ldsw = (unsigned)wid * 1024u;
    const int aoff = lds_byte(wr * 64 + fr, fq * 8), boff = lds_byte(wc * 32 + fr, fq * 8);
#define PG8_SA(b, h) (((b) * 2 + (h)) * HTB)
#define PG8_SB(b, h) ((4 + (b) * 2 + (h)) * HTB)
#define PG8_STAGE(bufoff, gbase, voff) do { _Pragma("unroll") for (int _i = 0; _i < 2; ++_i) \
        __builtin_amdgcn_global_load_lds((const unsigned*)((const char*)(gbase) + (voff)[_i]), (PG8_LAS unsigned*)(lds + (bufoff) + ldsw + _i * 8192), 16, 0, 0); } while (0)
#define PG8_LDA(dst, b, h) do { _Pragma("unroll") for (int m = 0; m < 4; ++m) _Pragma("unroll") for (int k = 0; k < 2; ++k) dst[m][k] = *(const PG8_LAS bf16x8*)(lds + PG8_SA(b, h) + aoff + m * 2048 + k * 1024); } while (0)
#define PG8_LDB(dst, b, h) do { _Pragma("unroll") for (int n = 0; n < 2; ++n) _Pragma("unroll") for (int k = 0; k < 2; ++k) dst[n][k] = *(const PG8_LAS bf16x8*)(lds + PG8_SB(b, h) + boff + n * 2048 + k * 1024); } while (0)
#define PG8_MMA(ai, bj, At, Bt) do { __builtin_amdgcn_s_setprio(1); _Pragma("unroll") for (int m = 0; m < 4; ++m) _Pragma("unroll") for (int n = 0; n < 2; ++n) _Pragma("unroll") for (int k = 0; k < 2; ++k) \
        acc[ai][bj][m][n] = __builtin_amdgcn_mfma_f32_16x16x32_bf16(Bt[n][k], At[m][k], acc[ai][bj][m][n], 0, 0, 0); __builtin_amdgcn_s_setprio(0); } while (0)
#define PG8_WAIT_V(n) asm volatile("s_waitcnt vmcnt(" #n ")" ::: "memory")
#define PG8_WAIT_L(n) asm volatile("s_waitcnt lgkmcnt(" #n ")" ::: "memory")
#define PG8_BAR __builtin_amdgcn_s_barrier()
#define PG8_SCHED __builtin_amdgcn_sched_barrier(0)
#ifdef GPROBE
    volatile PG8_LAS unsigned long long* pw_ = (volatile PG8_LAS unsigned long long*)(lds + PROBE_LDS_OFF);
#define PG8_NOW() __builtin_amdgcn_s_memrealtime()
#define PG8_PROBE_ON (Epi::PROBE == GPROBE_PHASE && wid == 0 && (tid & 63) == 0)
#endif
    Unit cur, nxt; int ui = 0;
    if (!S.next(0, cur)) return;
    f32x4 acc[2][2][4][2];
#pragma unroll
    for (int a = 0; a < 2; ++a)
#pragma unroll
        for (int b = 0; b < 2; ++b)
#pragma unroll
            for (int m = 0; m < 4; ++m)
#pragma unroll
                for (int n = 0; n < 2; ++n) acc[a][b][m][n] = (f32x4){0.f, 0.f, 0.f, 0.f};
    bf16x8 At[4][2], B0[2][2], B1[2][2];
    const char* cA = (const char*)g.A + (size_t)cur.pm * tstep; const char* cB = (const char*)g.Bt + (size_t)cur.pn * tstep;
    S.a_ready(cur);
    if constexpr (SP2) {
        PG8_STAGE(PG8_SB(0, 0), cB, voffB); PG8_STAGE(PG8_SB(0, 1), cB + hstep, voffB); PG8_STAGE(PG8_SA(0, 0), cA, voffA); PG8_STAGE(PG8_SA(0, 1), cA + hstep, voffA);
        if (wr == 1) PG8_BAR;
        PG8_WAIT_V(2); PG8_BAR;
        PG8_STAGE(PG8_SB(1, 0), cB + kstep, voffB); PG8_STAGE(PG8_SA(1, 0), cA + kstep, voffA); PG8_STAGE(PG8_SB(1, 1), cB + hstep + kstep, voffB);
        PG8_WAIT_V(6); PG8_BAR;
    } else {
        PG8_STAGE(PG8_SB(0, 0), cB, voffB); PG8_STAGE(PG8_SA(0, 0), cA, voffA); PG8_STAGE(PG8_SB(0, 1), cB + hstep, voffB); PG8_STAGE(PG8_SA(0, 1), cA + hstep, voffA);
        if (wr == 1) PG8_BAR;
        PG8_WAIT_V(4); PG8_BAR;
        PG8_STAGE(PG8_SB(1, 0), cB + kstep, voffB); PG8_STAGE(PG8_SA(1, 0), cA + kstep, voffA); PG8_STAGE(PG8_SB(1, 1), cB + hstep + kstep, voffB);
        PG8_WAIT_V(6); PG8_BAR;
    }
    for (;;) {
        const bool has_next = S.next(ui + 1, nxt);
        const char* nA = has_next ? (const char*)g.A + (size_t)nxt.pm * tstep : cA; const char* nB = has_next ? (const char*)g.Bt + (size_t)nxt.pn * tstep : cB;
#ifdef GPROBE
        if (PG8_PROBE_ON) { const unsigned long long n_ = PG8_NOW(); pw_[1] = n_; if (GPROBE == 4 && ui > 0) pw_[0] += n_ - pw_[2]; }
#endif
        for (int t = 0; t < nt; t += 2) {
            const bool last = (t == nt - 2);
            const char* a1 = cA + (size_t)(t + 1) * kstep;
            const char* a2 = last ? nA : cA + (size_t)(t + 2) * kstep; const char* b2 = last ? nB : cB + (size_t)(t + 2) * kstep;
            const char* a3 = a2 + kstep; const char* b3 = b2 + kstep;
            if (last && has_next) S.a_ready(nxt);
            if constexpr (SP2) {
            PG8_LDB(B0, 0, 0); PG8_LDB(B1, 0, 1); PG8_SCHED; PG8_LDA(At, 0, 0); PG8_STAGE(PG8_SA(1, 1), a1 + hstep, voffA);
            PG8_WAIT_V(8); PG8_WAIT_L(0); PG8_BAR; PG8_MMA(0, 0, At, B0); PG8_MMA(0, 1, At, B1); PG8_BAR; PG8_SCHED;
#ifdef GPROBE
            if (GPROBE == 3 && t == 0 && PG8_PROBE_ON) pw_[0] += PG8_NOW() - pw_[1];
#endif
            PG8_LDA(At, 0, 1); PG8_STAGE(PG8_SB(0, 0), b2, voffB); PG8_STAGE(PG8_SB(0, 1), b2 + hstep, voffB); PG8_STAGE(PG8_SA(0, 0), a2, voffA);
            PG8_WAIT_V(8); PG8_WAIT_L(0); PG8_BAR; PG8_MMA(1, 0, At, B0); PG8_MMA(1, 1, At, B1); PG8_BAR; PG8_SCHED;
            PG8_LDB(B0, 1, 0); PG8_LDB(B1, 1, 1); PG8_SCHED; PG8_LDA(At, 1, 0); PG8_STAGE(PG8_SA(0, 1), a2 + hstep, voffA);
            PG8_WAIT_V(8); PG8_WAIT_L(0); PG8_BAR; PG8_MMA(0, 0, At, B0); PG8_MMA(0, 1, At, B1); PG8_BAR; PG8_SCHED;
            PG8_LDA(At, 1, 1); PG8_STAGE(PG8_SB(1, 0), b3, voffB); PG8_STAGE(PG8_SB(1, 1), b3 + hstep, voffB); PG8_STAGE(PG8_SA(1, 0), a3, voffA);
            PG8_WAIT_V(8); PG8_WAIT_L(0); PG8_BAR; PG8_MMA(1, 0, At, B0); PG8_MMA(1, 1, At, B1); PG8_BAR; PG8_SCHED;
            } else {
            PG8_LDB(B0, 0, 0); PG8_SCHED; PG8_LDA(At, 0, 0); PG8_STAGE(PG8_SA(1, 1), a1 + hstep, voffA);
            PG8_WAIT_L(8); PG8_BAR; PG8_WAIT_L(0); PG8_MMA(0, 0, At, B0); PG8_BAR; PG8_SCHED;
            PG8_LDB(B1, 0, 1); PG8_STAGE(PG8_SB(0, 0), b2, voffB);
            PG8_BAR; PG8_WAIT_L(0); PG8_MMA(0, 1, At, B1); PG8_BAR;
            PG8_LDA(At, 0, 1); PG8_STAGE(PG8_SA(0, 0), a2, voffA);
            PG8_BAR; PG8_WAIT_L(0); PG8_MMA(1, 0, At, B0); PG8_BAR; PG8_SCHED;
            PG8_STAGE(PG8_SB(0, 1), b2 + hstep, voffB);
            PG8_WAIT_V(6); PG8_BAR; PG8_MMA(1, 1, At, B1); PG8_BAR;
            PG8_LDB(B0, 1, 0); PG8_SCHED; PG8_LDA(At, 1, 0); PG8_STAGE(PG8_SA(0, 1), a2 + hstep, voffA);
            PG8_WAIT_L(8); PG8_BAR; PG8_WAIT_L(0); PG8_MMA(0, 0, At, B0); PG8_BAR; PG8_SCHED;
            PG8_LDB(B1, 1, 1); PG8_STAGE(PG8_SB(1, 0), b3, voffB);
            PG8_BAR; PG8_WAIT_L(0); PG8_MMA(0, 1, At, B1); PG8_BAR;
            PG8_LDA(At, 1, 1); PG8_STAGE(PG8_SA(1, 0), a3, voffA);
            PG8_BAR; PG8_WAIT_L(0); PG8_MMA(1, 0, At, B0); PG8_BAR; PG8_SCHED;
            PG8_STAGE(PG8_SB(1, 1), b3 + hstep, voffB);
            PG8_WAIT_V(6); PG8_BAR; PG8_MMA(1, 1, At, B1); PG8_BAR;
            }
        }
#ifdef GPROBE
        if ((GPROBE == 0 || GPROBE == 1) && PG8_PROBE_ON) { const unsigned long long n_ = PG8_NOW(); if (GPROBE == 0) pw_[0] += n_ - pw_[1]; pw_[2] = n_; }
#endif
        if constexpr (ALIGN_EPI) { if (wr == 0) PG8_BAR; }
#ifdef GPROBE
        if ((GPROBE == 1 || GPROBE == 2) && PG8_PROBE_ON) { const unsigned long long n_ = PG8_NOW(); if (GPROBE == 1) pw_[0] += n_ - pw_[2]; pw_[2] = n_; }
#endif
        if constexpr (!Epi::AFTER_DRAIN) { E(acc, cur, wr, wc, fr, fq); S.done(cur); }
#ifdef GPROBE
        if ((GPROBE == 2 || GPROBE == 4) && PG8_PROBE_ON) { const unsigned long long n_ = PG8_NOW(); if (GPROBE == 2) pw_[0] += n_ - pw_[2]; pw_[2] = n_; }
#endif
        if (!has_next) break;
#pragma unroll
        for (int a = 0; a < 2; ++a)
#pragma unroll
            for (int b = 0; b < 2; ++b)
#pragma unroll
                for (int m = 0; m < 4; ++m)
#pragma unroll
                    for (int n = 0; n < 2; ++n) acc[a][b][m][n] = (f32x4){0.f, 0.f, 0.f, 0.f};
        cur = nxt; cA = nA; cB = nB; ++ui;
        if constexpr (ALIGN_EPI) { if (wr == 1) PG8_BAR; }
    }
    PG8_WAIT_V(0);
    if constexpr (!ALIGN_EPI) { if (wr == 0) PG8_BAR; }
    PG8_BAR;
    if constexpr (Epi::AFTER_DRAIN) { E.fused(acc, cur, wr, wc, fr, fq, lds, wid, lane); S.done(cur); }
#undef PG8_SA
#undef PG8_SB
#undef PG8_STAGE
#undef PG8_LDA
#undef PG8_LDB
#undef PG8_MMA
#undef PG8_WAIT_V
#undef PG8_WAIT_L
#undef PG8_BAR
#undef PG8_SCHED
}
}
namespace attn_body {
using bf16=__hip_bfloat16;
using bf16x8=__attribute__((ext_vector_type(8)))short;
using s16x4=__attribute__((ext_vector_type(4)))short;
using f32x16=__attribute__((ext_vector_type(16)))float;
using u32x4=__attribute__((ext_vector_type(4)))unsigned;
constexpr int BATCH=16,NHEAD=8,SEQ=2048,D=64,DM=NHEAD*D,DMO=1024;
constexpr int NW=8,QBLK=32,QB=QBLK*NW,KVBLK=64,NQB=SEQ/QB;
constexpr int ATTN_PITCH=DM, ATTN_UNIT_ROWS=QB;
__device__ __forceinline__ int crow(int r,int hi){return (r&3)+8*(r>>2)+4*hi;}
#define SBAR() __builtin_amdgcn_sched_barrier(0)
__device__ __forceinline__ void cmask(f32x16&p0,f32x16&p1,int jb,int qrel,int hi){
  const float NEG=-INFINITY; int kb=64*jb+4*hi;
  #pragma unroll
  for(int r=0;r<16;++r){int kv=kb+(r&3)+8*(r>>2); if(kv>qrel)p0[r]=NEG; if(kv+32>qrel)p1[r]=NEG;}
}

__device__ __forceinline__ void bmask(f32x16&p0,f32x16&p1,unsigned long long mw,int hi){
  const unsigned lo=(unsigned)mw>>(4*hi), up=(unsigned)(mw>>32)>>(4*hi);
  #pragma unroll
  for(int r=0;r<16;++r){ const int ps=(r&3)+8*(r>>2);
    const unsigned x0=(unsigned)__builtin_amdgcn_sbfe((int)lo,ps,1), x1=(unsigned)__builtin_amdgcn_sbfe((int)up,ps,1);
    p0[r]=__uint_as_float((__float_as_uint(p0[r])&x0)|(0xFF800000u&~x0)); p1[r]=__uint_as_float((__float_as_uint(p1[r])&x1)|(0xFF800000u&~x1)); }
}
constexpr int ATTN_PROBE_OFF=153600+448-16;
constexpr int NSLOT=3, SLOTB=8192;
constexpr int LDS_K=0, LDS_V=NSLOT*SLOTB, LDS_WS=2*NSLOT*SLOTB, LDS_OST=LDS_WS+NW*64*4, LDS_MASK=LDS_OST+NW*4096, LDS_BYTES=LDS_MASK+32*256*8;
constexpr float C2=0.125f*1.4426950408889634f;
__device__ __forceinline__ void glds16(const void*gsrc,unsigned lds_dst){unsigned keep;
  asm volatile("s_mov_b32 %0, m0\n\ts_mov_b32 m0, %2\n\ts_nop 0\n\tglobal_load_lds_dwordx4 %1, off\n\ts_mov_b32 m0, %0":"=&s"(keep):"v"(gsrc),"s"(lds_dst):"memory");}
__device__ __forceinline__ float max3f(float a,float b,float c){float r;asm("v_max3_f32 %0, %1, %2, %3":"=v"(r):"v"(a),"v"(b),"v"(c));return r;}
__device__ __forceinline__ float max2f(float a,float b){float r;asm("v_max_f32_e32 %0, %1, %2":"=v"(r):"v"(a),"v"(b));return r;}
__device__ __forceinline__ float fadd_s(float a,float b){float r;asm("v_add_f32_e32 %0, %1, %2":"=v"(r):"v"(a),"v"(b));return r;}
__device__ __forceinline__ float fsub_s(float a,float b){float r;asm("v_sub_f32_e32 %0, %1, %2":"=v"(r):"v"(a),"v"(b));return r;}
typedef float f32x2_t __attribute__((ext_vector_type(2))); typedef __bf16 bf16x2_t __attribute__((ext_vector_type(2)));
__device__ __forceinline__ unsigned cvtpk_s(float lo,float hi){f32x2_t v={lo,hi};bf16x2_t b=__builtin_convertvector(v,bf16x2_t);return __builtin_bit_cast(unsigned,b);}
#define WAIT_BAR(N) asm volatile("s_waitcnt vmcnt(" #N ") lgkmcnt(0)\n\ts_barrier":::"memory")

__device__ __forceinline__ void qkt(f32x16&p0,f32x16&p1,const char*Kslot,const bf16x8*qr,const f32x16&negm,int r32,int hi){
  const char*kb=Kslot+hi*1024+r32*16;
  #pragma unroll
  for(int d0=0;d0<4;++d0){
    const bf16x8 b0=*reinterpret_cast<const bf16x8*>(kb+d0*2048);
    const bf16x8 b1=*reinterpret_cast<const bf16x8*>(kb+d0*2048+512);
    if(d0==0){p0=__builtin_amdgcn_mfma_f32_32x32x16_bf16(b0,qr[0],negm,0,0,0);p1=__builtin_amdgcn_mfma_f32_32x32x16_bf16(b1,qr[0],negm,0,0,0);}
    else{p0=__builtin_amdgcn_mfma_f32_32x32x16_bf16(b0,qr[d0],p0,0,0,0);p1=__builtin_amdgcn_mfma_f32_32x32x16_bf16(b1,qr[d0],p1,0,0,0);}}
}
typedef __attribute__((address_space(3))) const char* lds_cptr;
typedef short v4i16_t __attribute__((ext_vector_type(4)));
__device__ __forceinline__ void kload8(bf16x8*kf,lds_cptr kp){
  kf[0]=*(const __attribute__((address_space(3))) bf16x8*)(kp);      kf[1]=*(const __attribute__((address_space(3))) bf16x8*)(kp+512);
  kf[2]=*(const __attribute__((address_space(3))) bf16x8*)(kp+2048); kf[3]=*(const __attribute__((address_space(3))) bf16x8*)(kp+2560);
  kf[4]=*(const __attribute__((address_space(3))) bf16x8*)(kp+4096); kf[5]=*(const __attribute__((address_space(3))) bf16x8*)(kp+4608);
  kf[6]=*(const __attribute__((address_space(3))) bf16x8*)(kp+6144); kf[7]=*(const __attribute__((address_space(3))) bf16x8*)(kp+6656);
}
__device__ __forceinline__ void kload2(bf16x8*kf,lds_cptr kp,int j){ kf[2*j]=*(const __attribute__((address_space(3))) bf16x8*)(kp+j*2048); kf[2*j+1]=*(const __attribute__((address_space(3))) bf16x8*)(kp+j*2048+512); }
__device__ __forceinline__ s16x4 vtr(lds_cptr p){ return __builtin_bit_cast(s16x4,__builtin_amdgcn_ds_read_tr16_b64_v4i16((__attribute__((address_space(3))) v4i16_t*)p)); }
__device__ __forceinline__ float rowmax(const f32x16&p0,const f32x16&p1){
  float a=max3f(p0[0],p0[1],p1[0]),b=max3f(p0[2],p0[3],p1[1]);a=max3f(a,p1[2],p1[3]);
  #pragma unroll
  for(int r=4;r<16;r+=4){a=max3f(a,p0[r],p0[r+1]);b=max3f(b,p0[r+2],p0[r+3]);a=max3f(a,p1[r],p1[r+1]);b=max3f(b,p1[r+2],p1[r+3]);}
  const float m=max2f(a,b);
  auto rr=__builtin_amdgcn_permlane32_swap(__float_as_uint(m),__float_as_uint(m),false,false);
  return max2f(__uint_as_float(rr[0]),__uint_as_float(rr[1]));
}
__device__ __forceinline__ void pv(f32x16*o,int vb,bf16x8 pa0,bf16x8 pa1,bf16x8 pa2,bf16x8 pa3){
  #pragma unroll
  for(int d0=0;d0<2;++d0){s16x4 lo[4],hi[4];
    #pragma unroll
    for(int ks=0;ks<4;++ks){
      asm volatile("ds_read_b64_tr_b16 %0,%1 offset:%c2":"=&v"(lo[ks]):"v"(vb),"i"(d0*4096+ks*1024):"memory");
      asm volatile("ds_read_b64_tr_b16 %0,%1 offset:%c2":"=&v"(hi[ks]):"v"(vb),"i"(d0*4096+ks*1024+512):"memory");}
    asm volatile("s_waitcnt lgkmcnt(0)":::"memory");SBAR();
    #define PK(k) (bf16x8){lo[k][0],lo[k][1],lo[k][2],lo[k][3],hi[k][0],hi[k][1],hi[k][2],hi[k][3]}
    o[d0]=__builtin_amdgcn_mfma_f32_32x32x16_bf16(pa0,PK(0),o[d0],0,0,0);
    o[d0]=__builtin_amdgcn_mfma_f32_32x32x16_bf16(pa1,PK(1),o[d0],0,0,0);
    o[d0]=__builtin_amdgcn_mfma_f32_32x32x16_bf16(pa2,PK(2),o[d0],0,0,0);
    o[d0]=__builtin_amdgcn_mfma_f32_32x32x16_bf16(pa3,PK(3),o[d0],0,0,0);
    #undef PK
  }
}

#ifndef ATTN_STORE16
#define ATTN_STORE16(p,v) (*(u32x4*)(p)=(v))
#endif
template<int THRL> __device__ __forceinline__ void attn_unit(int b,int h,int qb,const bf16*Q,const bf16*__restrict__ K,const bf16*__restrict__ V,bf16*O,const u32x4*__restrict__ MaskG,const float*__restrict__ gain,char*shm,int tid_in){
  int tid_o=tid_in; asm volatile("":"+v"(tid_o)); const int tid=tid_o,lane=tid&63,r32=lane&31,hi=lane>>5; const int wid=__builtin_amdgcn_readfirstlane(tid>>6);
  const long rowbase=(long)b*SEQ; const int q0=qb*QB;
#ifdef GPROBE
  volatile __attribute__((address_space(3))) unsigned long long* apw_=(volatile __attribute__((address_space(3))) unsigned long long*)((__attribute__((address_space(3))) char*)shm+ATTN_PROBE_OFF);
  const bool apon_=(blockIdx.x==0&&wid==0&&lane==0);
  if(apon_)apw_[1]=__builtin_amdgcn_s_memrealtime();
#endif
  const bf16*Qw=Q+(rowbase+q0+wid*QBLK)*DM+h*D;
  const bf16*Kh=K+rowbase*DM+h*D,*Vh=V+rowbase*DM+h*D;
  const unsigned lds0=(unsigned)(uintptr_t)shm;
  float*wsf=(float*)(shm+LDS_WS)+wid*64;
  const bf16*ksrc=Kh+(long)lane*DM+wid*8;
  const bf16*vsrc=Vh+(long)(16*(wid&3)+(lane>>2))*DM+(wid>>2)*32+(lane&3)*8;
  const unsigned kdst=lds0+LDS_K+wid*1024, vdst=lds0+LDS_V+wid*1024;
  #define DMA_K(t,slot) glds16(ksrc+(long)(t)*KVBLK*DM,(unsigned)__builtin_amdgcn_readfirstlane(kdst+(slot)))
  #define DMA_V(t,slot) glds16(vsrc+(long)(t)*KVBLK*DM,(unsigned)__builtin_amdgcn_readfirstlane(vdst+(slot)))
  const int vb0=(int)(lds0+LDS_V)+((lane>>4)&1)*32+(lane&3)*8+(4*hi+((lane&15)>>2))*64;
  const char*Kbase=shm+LDS_K; bf16x8 kf[8];
  const lds_cptr shm3=(lds_cptr)shm; const lds_cptr kp0=shm3+LDS_K+hi*1024+r32*16; const lds_cptr vp0=shm3+LDS_V+((lane>>4)&1)*32+(lane&3)*8+(4*hi+((lane&15)>>2))*64;
  const int NT=(q0+QB)/KVBLK;
  DMA_K(0,0);DMA_V(0,0);DMA_K(1,SLOTB);
  { const u32x4*mg=MaskG+(long)(b*NQB+qb)*32*128;
    __attribute__((address_space(3))) u32x4*ml=(__attribute__((address_space(3))) u32x4*)((__attribute__((address_space(3))) char*)shm+LDS_MASK);
    u32x4 mv[8];
    _Pragma("unroll") for(int k=0;k<8;++k){ const int i=tid+NW*64*k; mv[k]=u32x4{0u,0u,0u,0u}; if(i<NT*128)mv[k]=mg[i]; }
    _Pragma("unroll") for(int k=0;k<8;++k){ const int i=tid+NW*64*k; if(i<NT*128)ml[i]=mv[k]; }
    asm volatile("s_waitcnt vmcnt(0)":::"memory"); }
  bf16x8 qr[4];
  #pragma unroll
  for(int d0=0;d0<4;++d0)qr[d0]=*reinterpret_cast<const bf16x8*>(&Qw[(long)r32*DM+d0*16+hi*8]);
  float mhat=0.f,l_reg=0.f;f32x16 o[2];o[0]=f32x16{};o[1]=f32x16{};f32x16 negm=f32x16{};asm volatile("":"+v"(negm));
  const int qrel=wid*QBLK+r32;
  const lds_cptr mkp=(lds_cptr)shm+LDS_MASK+qrel*8;
  unsigned long long mwn=0ull;
  #define CMASK(P0,P1,t) do{ bmask(P0,P1,mwn,hi); mwn=*(const __attribute__((address_space(3))) unsigned long long*)(mkp+((t)+1)*2048); }while(0)
  bool resc=false;
  #define START(P0,P1) do{ const float rm=rowmax(P0,P1); resc=false; \
    { const float dl=max2f(rm,-256.f); mhat=fadd_s(mhat,dl); \
      _Pragma("unroll") for(int r=0;r<16;++r){P0[r]=fsub_s(P0[r],dl);P1[r]=fsub_s(P1[r],dl);} \
      _Pragma("unroll") for(int r=0;r<16;++r)negm[r]=-mhat; asm volatile("":"+v"(negm)); } \
    _Pragma("unroll") for(int r=0;r<16;++r)P0[r]=__builtin_amdgcn_exp2f(P0[r]); }while(0)
  #define RESC() do{ if(resc){ asm volatile("s_waitcnt lgkmcnt(0)":::"memory"); \
      _Pragma("unroll") for(int d_=0;d_<2;++d_) _Pragma("unroll") for(int r=0;r<16;++r)o[d_][r]*=wsf[crow(r,hi)]; } }while(0)
  f32x16 pA0,pA1,pB0,pB1;
  if(wid>=4)__builtin_amdgcn_s_setprio(1);
  int sl_prev=0,sl_cur=0,sl_next=SLOTB;
  #define ROT() do{sl_prev=sl_cur;sl_cur=sl_next;sl_next=(sl_next==(NSLOT-1)*SLOTB)?0:sl_next+SLOTB;}while(0)
  DMA_K(2,2*SLOTB);
  WAIT_BAR(3);
#ifdef GPROBE
  if(apon_){const unsigned long long n_=__builtin_amdgcn_s_memrealtime(); if(GPROBE==10)apw_[0]+=n_-apw_[1]; apw_[1]=n_;}
#endif
  mwn=*(const __attribute__((address_space(3))) unsigned long long*)(mkp);
  qkt(pA0,pA1,Kbase,qr,negm,r32,hi);asm volatile("s_nop 15\n\ts_nop 7":"+v"(pA0),"+v"(pA1));CMASK(pA0,pA1,0);
  START(pA0,pA1);
  _Pragma("unroll") for(int r=0;r<16;++r)pA1[r]=__builtin_amdgcn_exp2f(pA1[r]);
  WAIT_BAR(0);
  DMA_K(3,0);DMA_V(1,SLOTB);
  ROT();
  kload8(kf,kp0+sl_cur);
  WAIT_BAR(2);
  s16x4 vlo[8],vhi[8]; u32x4 pw0,pw1,pw2,pw3;
  #define PKW(P,B) cvtpk_s(P[B],P[B+1])
  #define PAF(k) __builtin_bit_cast(bf16x8,pw##k)
  #define VFR(i) (bf16x8){vlo[i][0],vlo[i][1],vlo[i][2],vlo[i][3],vhi[i][0],vhi[i][1],vhi[i][2],vhi[i][3]}
  #define PIN(x) asm volatile("":"+v"(x))
  #define MX3(a,b,c) __builtin_fmaxf(__builtin_fmaxf((a),(b)),(c))
  #define GAPA(MF,A0,A1,A2,A3,W0,W1,PW) do{ MF; sacc+=A0; sacc+=A1; sacc+=A2; sacc+=A3; PIN(sacc); W0; W1; PIN(PW); SBAR(); }while(0)
  #define EX(v) __builtin_amdgcn_exp2f(v)
  #define GAPB(MF,X,B) do{ MF; X[B]=EX(X[B]); X[B+1]=EX(X[B+1]); X[B+2]=EX(X[B+2]); X[B+3]=EX(X[B+3]); PIN(X); SBAR(); }while(0)
  #define VRD(i) do{ vlo[i]=vtr(vp_+(((i)>>2)*4096+((i)&3)*1024)); vhi[i]=vtr(vp_+(((i)>>2)*4096+((i)&3)*1024+512)); }while(0)
  #define KRD(G,j) do{ if(G){ kload2(kf,kp0+sl_next,j); SBAR(); } }while(0)
  #define STEP(C0,C1,P0,P1,t,GK,GV,GL) do{ SBAR(); \
    const lds_cptr vp_=vp0+sl_prev; \
    VRD(0); SBAR(); float sacc=(P0[0]+P0[1]); \
    GAPA(C0=__builtin_amdgcn_mfma_f32_32x32x16_bf16(kf[0],qr[0],negm,0,0,0), P0[2],P0[3],P0[4],P0[5],     pw0[0]=PKW(P0,0), pw0[1]=PKW(P0,2), pw0); \
    VRD(4); SBAR(); GAPA(C1=__builtin_amdgcn_mfma_f32_32x32x16_bf16(kf[1],qr[0],negm,0,0,0), P0[6],P0[7],P0[8],P0[9],     pw0[2]=PKW(P0,4), pw0[3]=PKW(P0,6), pw0); \
    VRD(1); SBAR(); GAPA(C0=__builtin_amdgcn_mfma_f32_32x32x16_bf16(kf[2],qr[1],C0,0,0,0),   P0[10],P0[11],P0[12],P0[13], pw1[0]=PKW(P0,8), pw1[1]=PKW(P0,10), pw1); \
    VRD(5); SBAR(); GAPA(C1=__builtin_amdgcn_mfma_f32_32x32x16_bf16(kf[3],qr[1],C1,0,0,0),   P0[14],P0[15],P1[0],P1[1],   pw1[2]=PKW(P0,12),pw1[3]=PKW(P0,14), pw1); \
    VRD(2); SBAR(); GAPA(C0=__builtin_amdgcn_mfma_f32_32x32x16_bf16(kf[4],qr[2],C0,0,0,0),   P1[2],P1[3],P1[4],P1[5],     pw2[0]=PKW(P1,0), pw2[1]=PKW(P1,2), pw2); \
    VRD(6); SBAR(); GAPA(C1=__builtin_amdgcn_mfma_f32_32x32x16_bf16(kf[5],qr[2],C1,0,0,0),   P1[6],P1[7],P1[8],P1[9],     pw2[2]=PKW(P1,4), pw2[3]=PKW(P1,6), pw2); \
    VRD(3); SBAR(); GAPA(C0=__builtin_amdgcn_mfma_f32_32x32x16_bf16(kf[6],qr[3],C0,0,0,0),   P1[10],P1[11],P1[12],P1[13], pw3[0]=PKW(P1,8), pw3[1]=PKW(P1,10), pw3); \
    VRD(7); SBAR(); GAPA(C1=__builtin_amdgcn_mfma_f32_32x32x16_bf16(kf[7],qr[3],C1,0,0,0),   P1[14],P1[15],0.f,0.f,       pw3[2]=PKW(P1,12),pw3[3]=PKW(P1,14), pw3); \
    l_reg+=sacc; \
    if(GK){DMA_K((t)+3,sl_cur);} if(GV){DMA_V((t)+1,sl_next);} \
    CMASK(C0,C1,t); \
    { float a=MX3(C0[0],C0[1],C1[0]),b=MX3(C0[2],C0[3],C1[1]); a=MX3(a,C1[2],C1[3]); \
      _Pragma("unroll") for(int r=4;r<16;r+=4){a=MX3(a,C0[r],C0[r+1]);b=MX3(b,C0[r+2],C0[r+3]);a=MX3(a,C1[r],C1[r+1]);b=MX3(b,C1[r+2],C1[r+3]);} \
      float rm=__builtin_fmaxf(a,b); { auto rr=__builtin_amdgcn_permlane32_swap(__float_as_uint(rm),__float_as_uint(rm),false,false); rm=__builtin_fmaxf(__uint_as_float(rr[0]),__uint_as_float(rr[1])); } \
      resc=false; \
      if(__builtin_expect(__any(rm>(float)THRL),0)){ const float dl=__builtin_fmaxf(rm,0.f); mhat+=dl; \
        _Pragma("unroll") for(int r=0;r<16;++r){C0[r]-=dl;C1[r]-=dl;} \
        _Pragma("unroll") for(int r=0;r<16;++r)negm[r]=-mhat; asm volatile("":"+v"(negm)); \
        const float f=__builtin_amdgcn_exp2f(-dl); l_reg*=f; if(hi==0)wsf[r32]=f; resc=true; } } \
    SBAR(); \
    GAPB(o[0]=__builtin_amdgcn_mfma_f32_32x32x16_bf16(PAF(0),VFR(0),o[0],0,0,0), C0,0); \
    GAPB(o[1]=__builtin_amdgcn_mfma_f32_32x32x16_bf16(PAF(0),VFR(4),o[1],0,0,0), C0,4); \
    KRD(GL,0); GAPB(o[0]=__builtin_amdgcn_mfma_f32_32x32x16_bf16(PAF(1),VFR(1),o[0],0,0,0), C0,8); \
    KRD(GL,1); GAPB(o[1]=__builtin_amdgcn_mfma_f32_32x32x16_bf16(PAF(1),VFR(5),o[1],0,0,0), C0,12); \
    KRD(GL,2); GAPB(o[0]=__builtin_amdgcn_mfma_f32_32x32x16_bf16(PAF(2),VFR(2),o[0],0,0,0), C1,0); \
    KRD(GL,3); GAPB(o[1]=__builtin_amdgcn_mfma_f32_32x32x16_bf16(PAF(2),VFR(6),o[1],0,0,0), C1,4); \
    GAPB(o[0]=__builtin_amdgcn_mfma_f32_32x32x16_bf16(PAF(3),VFR(3),o[0],0,0,0), C1,8); \
    GAPB(o[1]=__builtin_amdgcn_mfma_f32_32x32x16_bf16(PAF(3),VFR(7),o[1],0,0,0), C1,12); \
    }while(0)
  int t=1;
  for(;t+5<NT;t+=2){
    STEP(pB0,pB1,pA0,pA1,t,true,true,true);     WAIT_BAR(2); RESC(); ROT();
    STEP(pA0,pA1,pB0,pB1,t+1,true,true,true);   WAIT_BAR(2); RESC(); ROT();
  }
  #define ENDW(tt) do{ if((tt)+3<NT){WAIT_BAR(2);} else if((tt)+2<NT){WAIT_BAR(1);} else {WAIT_BAR(0);} }while(0)
  for(;t+1<NT;t+=2){
    STEP(pB0,pB1,pA0,pA1,t,(t+3<NT),(t+1<NT),(t+1<NT));       ENDW(t);   RESC(); ROT();
    STEP(pA0,pA1,pB0,pB1,t+1,(t+4<NT),(t+2<NT),(t+2<NT));     ENDW(t+1); RESC(); ROT();
  }
  STEP(pB0,pB1,pA0,pA1,NT-1,false,false,false); RESC();
  { float sacc=pB0[0]+pB0[1]; _Pragma("unroll") for(int r=2;r<16;++r)sacc+=pB0[r]; _Pragma("unroll") for(int r=0;r<16;++r)sacc+=pB1[r]; l_reg+=sacc;
    pw0=(u32x4){PKW(pB0,0),PKW(pB0,2),PKW(pB0,4),PKW(pB0,6)};pw1=(u32x4){PKW(pB0,8),PKW(pB0,10),PKW(pB0,12),PKW(pB0,14)};pw2=(u32x4){PKW(pB1,0),PKW(pB1,2),PKW(pB1,4),PKW(pB1,6)};pw3=(u32x4){PKW(pB1,8),PKW(pB1,10),PKW(pB1,12),PKW(pB1,14)};
    SBAR(); pv(o,vb0+sl_cur,PAF(0),PAF(1),PAF(2),PAF(3)); }
  #undef PKW
  #undef PAF
  #undef VFR
  #undef PIN
  #undef MX3
  #undef GAPA
  #undef GAPB
  #undef EX
  #undef VRD
  #undef KRD
  #undef STEP
  #undef ENDW
  __builtin_amdgcn_s_setprio(0);
#ifdef GPROBE
  if(apon_){const unsigned long long n_=__builtin_amdgcn_s_memrealtime(); if(GPROBE==11)apw_[0]+=n_-apw_[1]; apw_[1]=n_;}
#endif
  {auto rr=__builtin_amdgcn_permlane32_swap(__float_as_uint(l_reg),__float_as_uint(l_reg),false,false);l_reg=__uint_as_float(rr[0])+__uint_as_float(rr[1]);}
  if(hi==0)wsf[32+r32]=l_reg;asm volatile("s_waitcnt lgkmcnt(0)":::"memory");
  float rli[16];
  #pragma unroll
  for(int r=0;r<16;++r)rli[r]=__builtin_amdgcn_rcpf(wsf[32+crow(r,hi)]);
  bf16*Ow=O+(rowbase+q0+wid*QBLK)*DMO+h*D;
  { bf16*stg=(bf16*)(shm+LDS_OST)+wid*2048;
    #pragma unroll
    for(int r=0;r<16;++r){const int orow=crow(r,hi);
      #pragma unroll
      for(int d0=0;d0<2;++d0)stg[orow*64+d0*32+r32]=__float2bfloat16(o[d0][r]*rli[r]);}
    asm volatile("s_waitcnt lgkmcnt(0)":::"memory");
    float gn[8];
    #pragma unroll
    for(int e=0;e<8;++e)gn[e]=gain[h*D+(lane&7)*8+e];
    #pragma unroll
    for(int i=0;i<4;++i){const int row=i*8+(lane>>3),ch=lane&7; const u32x4 v=*(const u32x4*)(stg+row*64+ch*8);
      float f[8]; f[0]=__uint_as_float(v.x<<16);f[1]=__uint_as_float(v.x&0xffff0000u);f[2]=__uint_as_float(v.y<<16);f[3]=__uint_as_float(v.y&0xffff0000u);
      f[4]=__uint_as_float(v.z<<16);f[5]=__uint_as_float(v.z&0xffff0000u);f[6]=__uint_as_float(v.w<<16);f[7]=__uint_as_float(v.w&0xffff0000u);
      float ss=0.f;
      #pragma unroll
      for(int e=0;e<8;++e)ss+=f[e]*f[e];
      ss+=__shfl_xor(ss,1);ss+=__shfl_xor(ss,2);ss+=__shfl_xor(ss,4);
      const float rs=rsqrtf(ss*(1.f/64.f)+1e-6f);
      u32x4 w; w.x=cvtpk_s(f[0]*rs*gn[0],f[1]*rs*gn[1]); w.y=cvtpk_s(f[2]*rs*gn[2],f[3]*rs*gn[3]); w.z=cvtpk_s(f[4]*rs*gn[4],f[5]*rs*gn[5]); w.w=cvtpk_s(f[6]*rs*gn[6],f[7]*rs*gn[7]);
      ATTN_STORE16(Ow+(long)row*DMO+ch*8,w);} }
  asm volatile("s_waitcnt lgkmcnt(0)\n\ts_barrier":::"memory");
#ifdef GPROBE
  if(apon_){const unsigned long long n_=__builtin_amdgcn_s_memrealtime(); if(GPROBE==12)apw_[0]+=n_-apw_[1];}
#endif
  #undef DMA_K
  #undef DMA_V
  #undef CMASK
  #undef START
  #undef RESC
  #undef ROT
}
constexpr int ATTN_LDS_BYTES=LDS_BYTES;
struct AttnTensors { const bf16* Q; const bf16* K; const bf16* V; bf16* O; const u32x4* Mask; const float* gain; };
struct AttnUnit { int bh; int qb; };
struct StaticOrder {
  int vcu, G;
  __device__ __forceinline__ explicit StaticOrder(int grid,int block):vcu((grid%8==0)?(block%8)*(grid/8)+block/8:block),G(grid){}
  __device__ __forceinline__ bool next(int i,AttnUnit&u)const{
    if(G==256){ if(i>=4)return false; const int s=vcu&1; u.bh=vcu>>1; u.qb=(i==0)?s:(i==1)?7-s:(i==2)?3-s:4+s; return true; }
    const int L=i*G+vcu; if(L>=BATCH*NHEAD*NQB)return false; u.bh=L/NQB; u.qb=L%NQB; return true; }
  __device__ __forceinline__ void a_ready(const AttnUnit&)const{}
  __device__ __forceinline__ void done(const AttnUnit&)const{}
};
template<class Sched,int THRL=8> __device__ __forceinline__ void attn_phase(char*lds,const AttnTensors&T,const Sched&S,int tid_in){
  AttnUnit u;
  for(int i=0;S.next(i,u);++i){ S.a_ready(u); attn_unit<THRL>(u.bh/NHEAD,u.bh%NHEAD,u.qb,T.Q,T.K,T.V,T.O,T.Mask,T.gain,lds,tid_in); S.done(u); }
}
#undef SBAR
#undef WAIT_BAR
}

constexpr int NWAVES = 8;
#ifndef MK_ONE_LAUNCH
#define MK_ONE_LAUNCH 1
#endif
constexpr int BATCH = 16, SEQ = 2048, D = 1024, M = BATCH * SEQ, DEPTH = 2;
constexpr int NIN = 3408, NINP = 3584, QRK = 256, FF = 2816, NMOD = 6 * D;
constexpr float EPS = 1e-6f;
constexpr int N_PHASES = 2 + 9 * DEPTH;

constexpr size_t MiB = 1u << 20;
constexpr size_t WS_CTL = 0, CTL_ZERO_BYTES = 64 * 1024;
constexpr size_t WS_MOD = 1 * MiB;
constexpr size_t WS_SSQ = 2 * MiB;
constexpr size_t WS_W = 3 * MiB, W_LAYER = 26 * MiB;
constexpr size_t WO_IN = 0, WO_Q = 7 * MiB, WO_OUT = 7 * MiB + 512 * 1024, WO_GU = 9 * MiB + 512 * 1024, WO_DN = 20 * MiB + 512 * 1024;
constexpr size_t WS_XN = 56 * MiB;
constexpr size_t WS_MIX = 120 * MiB;
constexpr size_t MX_CQ = 0, MX_K = 16 * MiB, MX_V = 48 * MiB, MX_KI = 80 * MiB, MX_WI = 84 * MiB, MX_IG = 85 * MiB, MX_LF = 85 * MiB + 512 * 1024, MX_QM = 86 * MiB, MX_KM = 118 * MiB, MX_VM = 150 * MiB,
                 MX_OM = 182 * MiB, MX_Q = 214 * MiB, MX_QI = 246 * MiB, MX_MASK = 278 * MiB, MX_CL = 286 * MiB, MX_KC = 352 * MiB, MX_H = 0, MX_Y = 192 * MiB, MX_END = 384 * MiB;
constexpr size_t WS_END = WS_MIX + MX_END;
static_assert(WO_DN + (size_t)D * FF * 2 <= W_LAYER && WS_W + DEPTH * W_LAYER <= WS_XN && WS_XN + (size_t)M * D * 2 <= WS_MIX && (size_t)M * FF * 2 <= MX_Y && MX_Y + (size_t)M * D * 2 <= MX_CL && MX_CL + (size_t)2048 * 129 * 128 * 2 <= MX_KC && MX_KC + (size_t)2048 * 64 * 128 * 2 <= MX_END, "d_ws map");
constexpr int CW_BAR = 4096;

constexpr int RING_BYTES = 153600;
constexpr int LDSCTL_OFF = RING_BYTES, LDS_BYTES = LDSCTL_OFF + 512;
static_assert(pg8::STAGE_BYTES <= RING_BYTES && attn_body::ATTN_LDS_BYTES <= RING_BYTES && LDS_BYTES <= 160 * 1024, "LDS map");

#define GAS __attribute__((address_space(1)))
#define LAS __attribute__((address_space(3)))
typedef unsigned short bf16;
typedef unsigned v4u __attribute__((ext_vector_type(4)));
typedef float f32x4 __attribute__((ext_vector_type(4)));
typedef short bf16x8 __attribute__((ext_vector_type(8)));
typedef GAS unsigned gu32;
typedef GAS unsigned long long gu64;
#define RLX_AGENT __ATOMIC_RELAXED, __HIP_MEMORY_SCOPE_AGENT
#define LDS_WAIT() asm volatile("s_waitcnt lgkmcnt(0)" ::: "memory")
#define VM_WAIT() asm volatile("s_waitcnt vmcnt(0)" ::: "memory")
__device__ __forceinline__ unsigned long long rt() { return __builtin_amdgcn_s_memrealtime(); }
__device__ __forceinline__ unsigned f2bf(float f) { unsigned u = __builtin_bit_cast(unsigned, f); return (u + 0x7fffu + ((u >> 16) & 1u)) >> 16; }
__device__ __forceinline__ unsigned pk2(float lo, float hi) { return f2bf(lo) | (f2bf(hi) << 16); }

#define XB_TMO      128
#define XB_XCNT(j)  (256  + 64 * (j))
#define XB_XSUB(j)  (1280 + 64 * (j))
#define XB_XGEN(j)  (2304 + 64 * (j))
#define XB_TOP      3328
#define XB_TOPGEN   3392
#define XCD_BAR_WORDS 3456
#define XB_SPIN_CAP (1u << 18)

__device__ __forceinline__ unsigned xb_ld(unsigned* p)              { return __hip_atomic_load(p, __ATOMIC_RELAXED, __HIP_MEMORY_SCOPE_AGENT); }
__device__ __forceinline__ unsigned xb_add(unsigned* p, unsigned v) { return __hip_atomic_fetch_add(p, v, __ATOMIC_RELAXED, __HIP_MEMORY_SCOPE_AGENT); }
__device__ __forceinline__ unsigned xb_xcc_id() { return (unsigned)__builtin_amdgcn_s_getreg((3 << 11) | 20) & 0xFu; }
#define XB_SPIN(cond, bar) do { unsigned _sp = 0; while (cond) { __builtin_amdgcn_s_sleep(1); \
    if ((++_sp & 255u) == 0u) { if (xb_ld(&(bar)[XB_TMO])) break; if (_sp > XB_SPIN_CAP) { atomicAdd(&(bar)[XB_TMO], 1u); break; } } } } while (0)

struct XcdBarrier {
    unsigned* bar; unsigned x;
    volatile LAS unsigned* st;
};

__device__ __forceinline__ XcdBarrier xcd_barrier_post(unsigned* bar, volatile LAS unsigned* st) {
    XcdBarrier b; b.bar = bar; b.x = xb_xcc_id(); b.st = st;
    if (threadIdx.x == 0) (void)xb_add(&bar[XB_XCNT(b.x)], 1u);
    return b;
}
__device__ __forceinline__ void xcd_barrier_complete(unsigned* bar, unsigned x, unsigned& nloc, unsigned& nx) {
    const unsigned G = gridDim.x * gridDim.y * gridDim.z;
    unsigned sum, cnt, mine, sp = 0u;
    for (;;) {
        sum = 0u; cnt = 0u; mine = 0u;
#pragma unroll
        for (unsigned j = 0; j < 16; ++j) { const unsigned c = xb_ld(&bar[XB_XCNT(j)]); sum += c; cnt += (c > 0u) ? 1u : 0u; mine = (j == x) ? c : mine; }
        if (sum == G) break;
        __builtin_amdgcn_s_sleep(1);
        if ((++sp & 255u) == 0u) { if (xb_ld(&bar[XB_TMO])) break; if (sp > XB_SPIN_CAP) { atomicAdd(&bar[XB_TMO], 1u); break; } }
    }
    nloc = mine > 0u ? mine : 1u; nx = cnt > 0u ? cnt : 1u;
}

__device__ __forceinline__ void xcd_barrier(const XcdBarrier& b) {
    asm volatile("s_waitcnt vmcnt(0)" ::: "memory");
    __syncthreads();
    if (threadIdx.x == 0) {
        unsigned* bar = b.bar;
        const unsigned bx = xb_xcc_id();
        __builtin_amdgcn_s_waitcnt(0);
        unsigned nloc = b.st[0], nx = b.st[1];
        if (nloc == 0u) { xcd_barrier_complete(bar, bx, nloc, nx); b.st[0] = nloc; b.st[1] = nx; }
        const unsigned old = xb_add(&bar[XB_XSUB(bx)], 1u);
        const unsigned gen = old / nloc;
        if (old + 1u == (gen + 1u) * nloc) {
            __builtin_amdgcn_fence(__ATOMIC_RELEASE, "agent");
            asm volatile("s_waitcnt vmcnt(0)" ::: "memory");
            const unsigned og = xb_add(&bar[XB_TOP], 1u);
            const unsigned tg = og / nx;
            if (og + 1u == (tg + 1u) * nx) xb_add(&bar[XB_TOPGEN], 1u);
            else XB_SPIN(xb_ld(&bar[XB_TOPGEN]) == tg, bar);
            __builtin_amdgcn_fence(__ATOMIC_ACQUIRE, "agent");
            xb_add(&bar[XB_XGEN(bx)], 1u);
            asm volatile("s_waitcnt vmcnt(0)" ::: "memory");
        } else {
            XB_SPIN(xb_ld(&bar[XB_XGEN(bx)]) == gen, bar);
            __builtin_amdgcn_fence(__ATOMIC_ACQUIRE, "agent");
            asm volatile("s_waitcnt vmcnt(0)" ::: "memory");
        }
    }
    __syncthreads();
}

typedef float f32x16 __attribute__((ext_vector_type(16)));
typedef unsigned u32x2 __attribute__((ext_vector_type(2)));
__device__ __forceinline__ float wave_sum(float v) {
#pragma unroll
    for (int o = 1; o < 64; o <<= 1) v += __shfl_xor(v, o);
    return v;
}
__device__ __forceinline__ float bf_lo(unsigned u) { return __uint_as_float(u << 16); }
__device__ __forceinline__ float bf_hi(unsigned u) { return __uint_as_float(u & 0xffff0000u); }
__device__ __forceinline__ float sigmoid_f(float g) { return __builtin_amdgcn_rcpf(1.f + __builtin_amdgcn_exp2f(-1.4426950408889634f * g)); }
__device__ __forceinline__ float silu_f(float g) { return g * sigmoid_f(g); }
__device__ __forceinline__ int ropeperm(int p) { const int j = p >> 3, e = p & 7; return (e < 4) ? 4 * j + e : 32 + 4 * j + (e - 4); }

__device__ __forceinline__ void conv_item(int kind, const float* W0, const float* W1, const float* gain, int K, int Nphys, bf16* WT, LAS float* scr, int item, int lane) {
    const int nblk = Nphys / 32, kb = item / nblk, nb = item % nblk, k0 = 64 * kb, n0 = 32 * nb;
    const int n = n0 + (lane & 31);
    const float* src = W0; int ld = Nphys, col = n;
    if (kind == 1) {
        ld = NIN; const int tile = n >> 8, r = n & 255;
        if (tile == 0) col = r;
        else if (tile <= 2) { const int idx = (tile - 1) * 256 + r; col = 256 + (idx >> 6) * 64 + ropeperm(idx & 63); }
        else if (tile <= 4) col = 768 + (tile - 3) * 256 + r;
        else if (tile <= 12) col = 1352 + (tile - 5) * 256 + r;
        else { if (r < 64) col = 1280 + ropeperm(r); else if (r < 72) col = 1344 + (r - 64); else if (r < 76) col = 3400 + (r - 72); else if (r < 80) col = 3404 + (r - 76); else { src = nullptr; col = 0; } }
    } else if (kind == 2) {
        ld = 512; src = (n < 512) ? W0 : W1; const int idx = n & 511; col = (idx >> 6) * 64 + ropeperm(idx & 63);
    } else if (kind == 3) {
        ld = 2 * FF; col = ((n >> 7) & 1) * FF + (n >> 8) * 128 + (n & 127);
    }
    float wv[32];
#pragma unroll
    for (int i = 0; i < 32; ++i) { const int kk = 2 * i + (lane >> 5); wv[i] = src ? src[(size_t)(k0 + kk) * ld + col] : 0.f; }
#pragma unroll
    for (int i = 0; i < 32; ++i) { const int kk = 2 * i + (lane >> 5); float v = wv[i]; if (gain) v *= gain[k0 + kk]; scr[kk * 33 + (lane & 31)] = v; }
    LDS_WAIT(); asm volatile("" ::: "memory");
    const int c = lane & 7;
#pragma unroll
    for (int j = 0; j < 4; ++j) { const int nn = (lane >> 3) + 8 * j; const LAS float* s = scr + (8 * c) * 33 + nn;
        v4u o; o.x = pk2(s[0 * 33], s[1 * 33]); o.y = pk2(s[2 * 33], s[3 * 33]); o.z = pk2(s[4 * 33], s[5 * 33]); o.w = pk2(s[6 * 33], s[7 * 33]);
        *(GAS v4u*)(WT + (size_t)(n0 + nn) * K + k0 + 8 * c) = o; }
    LDS_WAIT(); asm volatile("" ::: "memory");
}

enum { I_X = 0, I_C, I_POS, I_WMOD, I_BMOD, I_MIXPRE, I_MIXPOST, I_WIN, I_QLN, I_WQUP, I_WQIUP, I_CONVW, I_CONVB, I_BIG, I_BFG, I_ATTN, I_MLN, I_WOUT, I_FFNPRE, I_FFNPOST, I_WGU, I_WDN, I_OUT, I_WS };
__device__ __forceinline__ unsigned long long ldptr(LAS unsigned char* lds, int k) {
    const volatile LAS unsigned* p = (const volatile LAS unsigned*)(lds + LDSCTL_OFF + 64 + 8 * k);
    const unsigned lo = __builtin_amdgcn_readfirstlane(p[0]), hi = __builtin_amdgcn_readfirstlane(p[1]);
    return ((unsigned long long)hi << 32) | lo;
}
#define GPTR(T, x) ((T*)(GAS T*)(x))
#define FP(k) GPTR(const float, ldptr(lds, (k)))
#define WSP() ((unsigned char*)ldptr(lds, I_WS))
#define WSPG() GPTR(unsigned char, ldptr(lds, I_WS))

__device__ __forceinline__ void p0_prologue(LAS unsigned char* lds, int tid, int lane, int wave, int vcu, int G) {
    LAS float* scr = (LAS float*)(lds + wave * 16384);
    const int gw = vcu * NWAVES + wave, NGW = G * NWAVES;
    constexpr int I_IN = (D / 64) * (NINP / 32), I_Q = (QRK / 64) * (1024 / 32), I_O = (D / 64) * (D / 32), I_GU = (D / 64) * (2 * FF / 32), I_DN = (FF / 64) * (D / 32);
    constexpr int I_LAYER = I_IN + I_Q + I_O + I_GU + I_DN;
    for (int it = gw; it < DEPTH * I_LAYER; it += NGW) {
        const int l = it / I_LAYER; int r = it % I_LAYER; unsigned char* wl = WSP() + WS_W + (size_t)l * W_LAYER;
        if (r < I_IN) { conv_item(1, FP(I_WIN) + (size_t)l * D * NIN, nullptr, nullptr, D, NINP, (bf16*)(wl + WO_IN), scr, r, lane); continue; } r -= I_IN;
        if (r < I_Q) { conv_item(2, FP(I_WQUP) + (size_t)l * QRK * 512, FP(I_WQIUP) + (size_t)l * QRK * 512, FP(I_QLN) + (size_t)l * QRK, QRK, 1024, (bf16*)(wl + WO_Q), scr, r, lane); continue; } r -= I_Q;
        if (r < I_O) { conv_item(0, FP(I_WOUT) + (size_t)l * D * D, nullptr, nullptr, D, D, (bf16*)(wl + WO_OUT), scr, r, lane); continue; } r -= I_O;
        if (r < I_GU) { conv_item(3, FP(I_WGU) + (size_t)l * D * 2 * FF, nullptr, nullptr, D, 2 * FF, (bf16*)(wl + WO_GU), scr, r, lane); continue; } r -= I_GU;
        conv_item(0, FP(I_WDN) + (size_t)l * FF * D, nullptr, nullptr, FF, D, (bf16*)(wl + WO_DN), scr, r, lane);
    }
    __syncthreads();
    constexpr int NU = DEPTH * (NMOD / 64);
    if (vcu < NU) {
        LAS float* sc = (LAS float*)lds;
        LAS float* part = (LAS float*)(lds + 65536);
        { const float* cin = FP(I_C);
#pragma unroll
          for (int h2 = 0; h2 < 2; ++h2) { float cv[16];
#pragma unroll
              for (int q = 0; q < 16; ++q) cv[q] = cin[tid + NWAVES * 64 * (16 * h2 + q)];
#pragma unroll
              for (int q = 0; q < 16; ++q) { const int i = tid + NWAVES * 64 * (16 * h2 + q), b = i / D, k = i % D; sc[k * 16 + b] = silu_f(cv[q]); } } }
        __syncthreads();
        const float* wmod = FP(I_WMOD); const float* bmod = FP(I_BMOD); float* modo = (float*)(WSP() + WS_MOD);
        for (int u = vcu; u < NU; u += G) {
            const int l = u / (NMOD / 64), n0 = (u % (NMOD / 64)) * 64;
            const float* W = wmod + (size_t)l * D * NMOD + n0 + lane;
            float acc[16];
#pragma unroll
            for (int b = 0; b < 16; ++b) acc[b] = 0.f;
            for (int k0 = wave * 128; k0 < wave * 128 + 128; k0 += 32) { float wv[32];
#pragma unroll
                for (int kk = 0; kk < 32; ++kk) wv[kk] = W[(size_t)(k0 + kk) * NMOD];
#pragma unroll
                for (int kk = 0; kk < 32; ++kk) {
#pragma unroll
                    for (int q = 0; q < 4; ++q) { const f32x4 s4 = *(const LAS f32x4*)(sc + (k0 + kk) * 16 + 4 * q);
                        acc[4 * q + 0] += s4[0] * wv[kk]; acc[4 * q + 1] += s4[1] * wv[kk]; acc[4 * q + 2] += s4[2] * wv[kk]; acc[4 * q + 3] += s4[3] * wv[kk]; }
                    __builtin_amdgcn_sched_barrier(0); } }
#pragma unroll
            for (int b = 0; b < 16; ++b) part[(wave * 16 + b) * 64 + lane] = acc[b];
            __syncthreads();
            for (int i = tid; i < 16 * 64; i += NWAVES * 64) { const int b = i >> 6, ln = i & 63; float s = bmod[(size_t)l * NMOD + n0 + ln];
#pragma unroll
                for (int w = 0; w < 8; ++w) s += part[(w * 16 + b) * 64 + ln];
                modo[((size_t)l * BATCH + b) * NMOD + n0 + ln] = s; }
            __syncthreads();
        }
    }
}

__device__ __forceinline__ void norm_phase(const bf16* y, const float* xin, float* xout, const float* gpost, const float* gate, const float* gnext, const float* sc, const float* sh, bf16* XN,
                                           int lane, int wave, int vcu, int G) {
    const int gw = vcu * NWAVES + wave, NGW = G * NWAVES;
    for (int m0 = gw * 16; m0 < M; m0 += NGW * 16) {
        const int b = m0 / SEQ;
        f32x4 vg[4], vt[4], vn[4], vs[4], vh[4];
#pragma unroll
        for (int j = 0; j < 4; ++j) { const int e = 256 * j + 4 * lane;
            if (y) { vg[j] = *(const f32x4*)(gpost + e); vt[j] = *(const f32x4*)(gate + (size_t)b * NMOD + e); }
            if (gnext) { vn[j] = *(const f32x4*)(gnext + e); vs[j] = *(const f32x4*)(sc + (size_t)b * NMOD + e) + 1.f; vh[j] = *(const f32x4*)(sh + (size_t)b * NMOD + e); vn[j] = vn[j] * vs[j]; } }
        for (int r = 0; r < 16; ++r) {
            const size_t row = (size_t)(m0 + r);
            f32x4 xv[4];
#pragma unroll
            for (int j = 0; j < 4; ++j) xv[j] = *(const f32x4*)(xin + row * D + 256 * j + 4 * lane);
            if (y) {
                f32x4 yv[4]; float ss = 0.f;
#pragma unroll
                for (int j = 0; j < 4; ++j) { const u32x2 w = *(const u32x2*)(y + row * D + 256 * j + 4 * lane); yv[j] = (f32x4){bf_lo(w.x), bf_hi(w.x), bf_lo(w.y), bf_hi(w.y)};
                    ss += (yv[j][0] * yv[j][0] + yv[j][1] * yv[j][1]) + (yv[j][2] * yv[j][2] + yv[j][3] * yv[j][3]); }
                const float rstd = rsqrtf(wave_sum(ss) * (1.f / D) + EPS);
#pragma unroll
                for (int j = 0; j < 4; ++j) { xv[j] = xv[j] + vt[j] * (yv[j] * rstd * vg[j]); *(f32x4*)(xout + row * D + 256 * j + 4 * lane) = xv[j]; }
            }
            if (gnext) {
                float ss = 0.f;
#pragma unroll
                for (int j = 0; j < 4; ++j) ss += (xv[j][0] * xv[j][0] + xv[j][1] * xv[j][1]) + (xv[j][2] * xv[j][2] + xv[j][3] * xv[j][3]);
                const float rstd = rsqrtf(wave_sum(ss) * (1.f / D) + EPS);
#pragma unroll
                for (int j = 0; j < 4; ++j) { const f32x4 o = xv[j] * rstd * vn[j] + vh[j]; u32x2 w; w.x = pk2(o[0], o[1]); w.y = pk2(o[2], o[3]); *(u32x2*)(XN + row * D + 256 * j + 4 * lane) = w; }
            }
        }
    }
}

constexpr int IX_SC = 0, IX_KCH = 131072, IX_KPITCH = 144, IX_HIST = IX_KCH, IX_MSK = IX_KCH + 128 * IX_KPITCH, IX_END = IX_MSK + 4096;
static_assert(IX_END <= RING_BYTES && 8 * 576 * 4 <= 128 * IX_KPITCH, "indexer LDS");
__device__ __forceinline__ unsigned ord_key(float f) { const unsigned u = __float_as_uint(f); return u ^ ((unsigned)((int)u >> 31) | 0x80000000u); }
__device__ __forceinline__ unsigned wave_scan_add(unsigned v) {
    v += (unsigned)__builtin_amdgcn_update_dpp(0, (int)v, 0x111, 0xf, 0xf, false);
    v += (unsigned)__builtin_amdgcn_update_dpp(0, (int)v, 0x112, 0xf, 0xf, false);
    v += (unsigned)__builtin_amdgcn_update_dpp(0, (int)v, 0x114, 0xf, 0xf, false);
    v += (unsigned)__builtin_amdgcn_update_dpp(0, (int)v, 0x118, 0xf, 0xf, false);
    v += (unsigned)__builtin_amdgcn_update_dpp(0, (int)v, 0x142, 0xa, 0xf, false);
    v += (unsigned)__builtin_amdgcn_update_dpp(0, (int)v, 0x143, 0xc, 0xf, false);
    return v;
}
template <int NJ> __device__ __forceinline__ void radix_rows(const unsigned (&xa)[NJ], const unsigned (&xb)[NJ],
                                                              unsigned& thrA, unsigned& needA_o, unsigned& eqA_o, unsigned& thrB, unsigned& needB_o, unsigned& eqB_o) {
    constexpr int G = NJ / 4;
    unsigned pfA = 0u, ndA = 256u, pfB = 0u, ndB = 256u, candA = ~0u, candB = ~0u;
#pragma unroll
    for (int k = 3; k >= 0; --k) {
        unsigned wa[8], wb[8];
        unsigned s01 = (unsigned)k | ((unsigned)(4 + k) << 8) | 0x0c0c0000u, s23 = 0x00000c0cu | ((unsigned)k << 16) | ((unsigned)(4 + k) << 24);
        asm volatile("" : "+s"(s01), "+s"(s23), "+s"(ndA), "+s"(ndB));
#pragma unroll
        for (int g = 0; g < 8; ++g) {
            if (g < G) { wa[g] = __builtin_amdgcn_perm(xa[4 * g + 1], xa[4 * g], s01) | __builtin_amdgcn_perm(xa[4 * g + 3], xa[4 * g + 2], s23);
                         wb[g] = __builtin_amdgcn_perm(xb[4 * g + 1], xb[4 * g], s01) | __builtin_amdgcn_perm(xb[4 * g + 3], xb[4 * g + 2], s23); }
            else { wa[g] = 0u; wb[g] = 0u; } }
#pragma unroll
        for (int st = 0; st < 3; ++st) { const int sh = 1 << st; const unsigned mk = (st == 0) ? 0x55555555u : (st == 1) ? 0x33333333u : 0x0f0f0f0fu;
#pragma unroll
            for (int g = 0; g < 8; ++g) if (!(g & sh)) { const int h = g | sh;
                { const unsigned A = wa[g], B = wa[h]; wa[g] = (A & mk) | ((B << sh) & ~mk); wa[h] = ((A >> sh) & mk) | (B & ~mk); }
                { const unsigned A = wb[g], B = wb[h]; wb[g] = (A & mk) | ((B << sh) & ~mk); wb[h] = ((A >> sh) & mk) | (B & ~mk); } } }
#pragma unroll
        for (int bb = 7; bb >= 0; --bb) { const unsigned bit = 1u << (8 * k + bb);
            const unsigned oA = candA & wa[bb], oB = candB & wb[bb];
            const unsigned n = (unsigned)__builtin_amdgcn_readlane((int)wave_scan_add((unsigned)__builtin_popcount(oA) | ((unsigned)__builtin_popcount(oB) << 16)), 63);
            const unsigned nA = n & 0xffffu, nB = n >> 16;
            if (nA >= ndA) { pfA |= bit; candA = oA; } else { ndA -= nA; candA ^= oA; }
            if (nB >= ndB) { pfB |= bit; candB = oB; } else { ndB -= nB; candB ^= oB; }
        }
    }
    const unsigned ne = (unsigned)__builtin_amdgcn_readlane((int)wave_scan_add((unsigned)__builtin_popcount(candA) | ((unsigned)__builtin_popcount(candB) << 16)), 63);
    thrA = pfA; needA_o = ndA; eqA_o = ne & 0xffffu; thrB = pfB; needB_o = ndB; eqB_o = ne >> 16;
}
template <int NJ> __device__ __forceinline__ void select_rows(const LAS unsigned* scb, LAS unsigned long long* msk, LAS unsigned* hist, int nk, int wave, int lane) {
    unsigned xa[NJ], xb[NJ];
#pragma unroll
    for (int j = 0; j < NJ; ++j) { const unsigned va = scb[(2 * wave) * 2048 + 64 * j + lane], vb = scb[(2 * wave + 1) * 2048 + 64 * j + lane]; const bool in = (64 * j + lane) < nk; xa[j] = in ? va : 0u; xb[j] = in ? vb : 0u; }
    unsigned pA, pB, needA, needB, eA, eB;
    radix_rows<NJ>(xa, xb, pA, needA, eA, pB, needB, eB);
    unsigned xiA = 2047u, xiB = 2047u;
    if ((eA > needA) || (eB > needB)) {
        xiA = 0u; xiB = 0u;
#pragma unroll 1
        for (int bit = 10; bit >= 0; --bit) {
            const unsigned cA = xiA | (1u << bit), cB = xiB | (1u << bit); unsigned nA = 0u, nB = 0u;
#pragma unroll
            for (int j = 0; j < NJ; ++j) { int ll = lane; asm volatile("" : "+v"(ll)); const unsigned key = 64u * j + ll;
                nA += (xa[j] == pA && key < cA) ? 1u : 0u; nB += (xb[j] == pB && key < cB) ? 1u : 0u; if (j & 1) __builtin_amdgcn_sched_barrier(0); }
            unsigned n = nA | (nB << 16);
#pragma unroll
            for (int o = 1; o < 64; o <<= 1) n += __shfl_xor(n, o);
            if ((n & 0xffffu) < needA) xiA = cA;
            if ((n >> 16) < needB) xiB = cB;
        }
    }
    unsigned a0 = 0u, a1 = 0u, b0 = 0u, b1 = 0u;
    const bool ties = (xiA != 2047u) || (xiB != 2047u);
#pragma unroll
    for (int j = 0; j < NJ; ++j) { int ll = lane; asm volatile("" : "+v"(ll)); const unsigned key = 64u * j + ll;
        bool sA = xa[j] >= pA, sB = xb[j] >= pB;
        if (ties) { sA = (xa[j] > pA) || (xa[j] == pA && key <= xiA); sB = (xb[j] > pB) || (xb[j] == pB && key <= xiB); }
        const unsigned long long ba = __ballot(sA), bb = __ballot(sB);
        asm volatile("v_writelane_b32 %0, %4, %8\n\tv_writelane_b32 %1, %5, %8\n\tv_writelane_b32 %2, %6, %8\n\tv_writelane_b32 %3, %7, %8"
                     : "+v"(a0), "+v"(a1), "+v"(b0), "+v"(b1) : "s"((unsigned)ba), "s"((unsigned)(ba >> 32)), "s"((unsigned)bb), "s"((unsigned)(bb >> 32)), "n"(j));
        __builtin_amdgcn_sched_barrier(0);
    }
    if (lane < 32) { msk[lane * 16 + 2 * wave] = (unsigned long long)a0 | ((unsigned long long)a1 << 32); msk[lane * 16 + 2 * wave + 1] = (unsigned long long)b0 | ((unsigned long long)b1 << 32); }
}
constexpr int B_CLE = 129 * 128;
struct BReg { v4u x[4]; float ak[4], tk[4]; };
struct BState { float cst[8]; float m; };
__device__ __forceinline__ void mlstm_B_load(BReg& R, const bf16* CL, const float* MSC, int item, int k0) {
    asm volatile("" : "+v"(item));
    constexpr int PCS = B_CLE / 8; const int bh = item / PCS, pc = item % PCS;
    const bf16* base = CL + (size_t)bh * 32 * B_CLE + pc * 8; const float* ms = MSC + (size_t)bh * 32 * 4;
#pragma unroll
    for (int k = 0; k < 4; ++k) { R.x[k] = *(const v4u*)(base + (size_t)(k0 + k) * B_CLE); R.ak[k] = ms[(k0 + k) * 4 + 0]; R.tk[k] = ms[(k0 + k) * 4 + 1]; }
}
__device__ __forceinline__ void mlstm_B_apply(const BReg& R, BState& S, bf16* CL, float* MSC, int item, int k0) {
    asm volatile("" : "+v"(item));
    constexpr int PCS = B_CLE / 8; const int bh = item / PCS, pc = item % PCS;
    bf16* base = CL + (size_t)bh * 32 * B_CLE + pc * 8; float* ms = MSC + (size_t)bh * 32 * 4;
#pragma unroll
    for (int k = 0; k < 4; ++k) {
        const float Mx = fmaxf(S.m, R.ak[k]), dec = __expf(S.m - Mx), w = __expf(R.ak[k] - Mx);
        v4u o; o.x = pk2(S.cst[0], S.cst[1]); o.y = pk2(S.cst[2], S.cst[3]); o.z = pk2(S.cst[4], S.cst[5]); o.w = pk2(S.cst[6], S.cst[7]);
        *(v4u*)(base + (size_t)(k0 + k) * B_CLE) = o;
        if (pc == 0) ms[(k0 + k) * 4 + 2] = S.m;
        S.cst[0] = dec * S.cst[0] + w * bf_lo(R.x[k].x); S.cst[1] = dec * S.cst[1] + w * bf_hi(R.x[k].x); S.cst[2] = dec * S.cst[2] + w * bf_lo(R.x[k].y); S.cst[3] = dec * S.cst[3] + w * bf_hi(R.x[k].y);
        S.cst[4] = dec * S.cst[4] + w * bf_lo(R.x[k].z); S.cst[5] = dec * S.cst[5] + w * bf_hi(R.x[k].z); S.cst[6] = dec * S.cst[6] + w * bf_lo(R.x[k].w); S.cst[7] = dec * S.cst[7] + w * bf_hi(R.x[k].w);
        S.m = R.tk[k] + Mx; }
}

__device__ __forceinline__ void mlstm_B_extras(bf16* CL, float* MSC, int tid, int vcu) {
    if (tid < 4) { int item = 256 * NWAVES * 64 + vcu * 4 + tid; asm volatile("" : "+v"(item));
        constexpr int PCS = B_CLE / 8; const int bh = item / PCS, pc = item % PCS;
        bf16* base = CL + (size_t)bh * 32 * B_CLE + pc * 8; float* ms = MSC + (size_t)bh * 32 * 4;
        float cst[8];
#pragma unroll
        for (int e = 0; e < 8; ++e) cst[e] = 0.f;
        float m = 0.f;
#pragma unroll 1
        for (int k0 = 0; k0 < 32; k0 += 16) {
            v4u x[16]; float ak[16], tk[16];
#pragma unroll
            for (int k = 0; k < 16; ++k) { x[k] = *(const v4u*)(base + (size_t)(k0 + k) * B_CLE); ak[k] = ms[(k0 + k) * 4 + 0]; tk[k] = ms[(k0 + k) * 4 + 1]; }
#pragma unroll
            for (int k = 0; k < 16; ++k) {
                const float Mx = fmaxf(m, ak[k]), dec = __expf(m - Mx), w = __expf(ak[k] - Mx);
                v4u o; o.x = pk2(cst[0], cst[1]); o.y = pk2(cst[2], cst[3]); o.z = pk2(cst[4], cst[5]); o.w = pk2(cst[6], cst[7]);
                *(v4u*)(base + (size_t)(k0 + k) * B_CLE) = o;
                if (pc == 0) ms[(k0 + k) * 4 + 2] = m;
                cst[0] = dec * cst[0] + w * bf_lo(x[k].x); cst[1] = dec * cst[1] + w * bf_hi(x[k].x); cst[2] = dec * cst[2] + w * bf_lo(x[k].y); cst[3] = dec * cst[3] + w * bf_hi(x[k].y);
                cst[4] = dec * cst[4] + w * bf_lo(x[k].z); cst[5] = dec * cst[5] + w * bf_hi(x[k].z); cst[6] = dec * cst[6] + w * bf_lo(x[k].w); cst[7] = dec * cst[7] + w * bf_hi(x[k].w);
                m = tk[k] + Mx; }
        } }
}
struct IxReg { bf16x8 af[4]; float wA[8], wB[8]; v4u pre[2]; };
__device__ __forceinline__ void indexer_load(IxReg& R, int b, int qb16, const bf16* QI, const bf16* KI, const float* WI, int tid, int lane, int wave) {
    if (qb16 < 16) return;
    const int r = lane & 31, hh = lane >> 5, mt = wave & 3, q0 = qb16 * 16; const size_t rowb = (size_t)b * SEQ;
    { const int g = r >> 2, ql = 2 * (g & 1) + (g >> 2), hd = 4 * ((g >> 1) & 1) + (r & 3);
      const bf16* qp = QI + (rowb + q0 + 4 * mt + ql) * 512 + hd * 64 + 8 * hh;
#pragma unroll
      for (int s = 0; s < 4; ++s) R.af[s] = *(const bf16x8*)(qp + 16 * s); }
    { const float* wp = WI + (rowb + q0 + 4 * mt + 2 * hh) * 8;
#pragma unroll
      for (int j = 0; j < 8; ++j) { R.wA[j] = wp[j]; R.wB[j] = wp[8 + j]; } }
#pragma unroll
    for (int i = 0; i < 2; ++i) { const int idx = tid + 512 * i; R.pre[i] = *(const v4u*)(KI + (rowb + (idx >> 3)) * 64 + (idx & 7) * 8); }
}
__device__ __forceinline__ void indexer_unit(LAS unsigned char* lds, int b, int qb16, int nb, int nqb16, IxReg& R, const bf16* QI, const bf16* KI, const float* WI, unsigned long long* MaskG, int tid, int lane, int wave,
                                             BState& SB1, int vcuB, int k0B) {
    BReg RB1 = {};
#define IX_B_CL  ((bf16*)(WSPG() + WS_MIX + MX_CL))
#define IX_B_MSC ((float*)(WSPG() + WS_SSQ + 512 * 1024))
#define IX_B_I1  (vcuB * (NWAVES * 64) + tid)
    if (k0B >= 0) mlstm_B_load(RB1, IX_B_CL, IX_B_MSC, IX_B_I1, k0B);
#define IX_B_APPLY() do { if (k0B >= 0) mlstm_B_apply(RB1, SB1, IX_B_CL, IX_B_MSC, IX_B_I1, k0B); } while (0)
    asm volatile("" : "+v"(tid), "+v"(lane));
    LAS unsigned* scb = (LAS unsigned*)(lds + IX_SC);
    LAS unsigned long long* msk = (LAS unsigned long long*)(lds + IX_MSK);
    const int q0 = qb16 * 16, n_kt = (q0 + 47) >> 5, nk = 32 * n_kt;
    const size_t rowb = (size_t)b * SEQ;
    __syncthreads();
    if (qb16 < 16) {
        { const int T = tid >> 4, i = tid & 15, t = q0 + i;
          msk[T * 16 + i] = (64 * T + 63 <= t) ? ~0ull : (64 * T > t) ? 0ull : ((1ull << (t - 64 * T + 1)) - 1ull); }
        IX_B_APPLY();
        if (nqb16 >= 0) indexer_load(R, nb, nqb16, QI, KI, WI, tid, lane, wave);
    } else {
        const int r = lane & 31, hh = lane >> 5, mt = wave & 3, par = wave >> 2;
#ifdef GPROBE
        volatile LAS unsigned long long* ipw_ = (volatile LAS unsigned long long*)(lds + LDSCTL_OFF + 432);
        const bool ipon_ = (blockIdx.x == 0 && wave == 0 && lane == 0);
        if (ipon_) ipw_[1] = __builtin_amdgcn_s_memrealtime();
#endif
        bf16x8 af[4]; float wA[8], wB[8]; v4u pre[2];
#pragma unroll
        for (int s = 0; s < 4; ++s) af[s] = R.af[s];
#pragma unroll
        for (int j = 0; j < 8; ++j) { wA[j] = R.wA[j]; wB[j] = R.wB[j]; }
        pre[0] = R.pre[0]; pre[1] = R.pre[1];
        const int rowA = 4 * mt + 2 * hh, tA = q0 + rowA;
        for (int c = 0; 4 * c < n_kt; ++c) {
            if (c) __syncthreads();
#pragma unroll
            for (int i = 0; i < 2; ++i) { const int idx = tid + 512 * i; *(LAS v4u*)(lds + IX_KCH + (idx >> 3) * IX_KPITCH + (idx & 7) * 16) = pre[i]; }
            __syncthreads();
            if (4 * (c + 1) < n_kt) {
#pragma unroll
                for (int i = 0; i < 2; ++i) { const int idx = tid + 512 * i; pre[i] = *(const v4u*)(KI + (rowb + 128 * (c + 1) + (idx >> 3)) * 64 + (idx & 7) * 8); } }
#pragma unroll
            for (int k = 0; k < 2; ++k) { const int tt = par + 2 * k, tile = 4 * c + tt;
                if (tile < n_kt) {
                    f32x16 acc = {};
#pragma unroll
                    for (int s = 0; s < 4; ++s) { const bf16x8 bfr = *(const LAS bf16x8*)(lds + IX_KCH + (32 * tt + r) * IX_KPITCH + 32 * s + 16 * hh);
                        acc = __builtin_amdgcn_mfma_f32_32x32x16_bf16(af[s], bfr, acc, 0, 0, 0); }
                    float sa = 0.f, sb = 0.f;
#pragma unroll
                    for (int j = 0; j < 8; ++j) { sa += wA[j] * fmaxf(acc[j], 0.f); sb += wB[j] * fmaxf(acc[8 + j], 0.f); }
                    const int key = 32 * tile + r;
                    scb[rowA * 2048 + key] = (key <= tA) ? ord_key(sa) : 0u; scb[(rowA + 1) * 2048 + key] = (key <= tA + 1) ? ord_key(sb) : 0u;
                } }
        }
        __syncthreads();
#ifdef GPROBE
        if (ipon_) { const unsigned long long n_ = __builtin_amdgcn_s_memrealtime(); if (GPROBE == 20) ipw_[0] += n_ - ipw_[1]; ipw_[1] = n_; }
#endif
        IX_B_APPLY();
        if (nqb16 >= 0) indexer_load(R, nb, nqb16, QI, KI, WI, tid, lane, wave);
#ifdef DUP
#pragma unroll 1
        for (int rep_ = 0; rep_ < ((DUP == 44) ? 2 : 1); ++rep_)
#endif
        { LAS unsigned* hist = (LAS unsigned*)(lds + IX_HIST) + 576 * wave;
          if (nk <= 512) select_rows<8>(scb, msk, hist, nk, wave, lane); else if (nk <= 1024) select_rows<16>(scb, msk, hist, nk, wave, lane);
          else if (nk <= 1536) select_rows<24>(scb, msk, hist, nk, wave, lane); else select_rows<32>(scb, msk, hist, nk, wave, lane); }
#ifdef GPROBE
        if (ipon_) { const unsigned long long n_ = __builtin_amdgcn_s_memrealtime(); if (GPROBE == 21) ipw_[0] += n_ - ipw_[1]; ipw_[1] = n_; }
#endif
    }
    __syncthreads();
    asm volatile("" : "+v"(tid));
    { const int T = tid >> 4, i = tid & 15;
      MaskG[((size_t)(b * 8 + (qb16 >> 4)) * 32 + T) * 256 + (qb16 & 15) * 16 + i] = msk[T * 16 + i]; }
#undef IX_B_APPLY
#undef IX_B_CL
#undef IX_B_MSC
#undef IX_B_I1
}

constexpr int ML_PQ = 272, ML_PV = 320, ML_PS = 144, ML_PN = 132;
constexpr int MA_VS = 0, MA_KW = 20480, MA_CT = 40960, MA_GT = 76288, ML_CW = 137216, ML_END = 142336;
constexpr int MC_QT = 0, MC_KT = 17408, MC_NUM = 0, MC_VS = 34816, MC_SS = 55296, MC_CT = 64512, MC_GT = 99840;
constexpr int ML_CLE = 129 * 128; static_assert(ML_CLE == B_CLE, "state image");
static_assert(ML_END <= RING_BYTES && MA_GT + 1024 <= ML_CW && MC_GT + 1024 <= ML_CW && 64 * ML_PN * 4 <= MC_VS && MC_CT + 129 * ML_PQ <= MC_GT && MA_CT + 129 * ML_PQ <= MA_GT, "mLSTM LDS");
__device__ __forceinline__ int crow16(int reg, int hh) { return (reg & 3) + 8 * (reg >> 2) + 4 * hh; }
typedef short v4i16_t __attribute__((ext_vector_type(4)));
__device__ __forceinline__ bf16x8 tr_frag(const LAS unsigned char* tb, int pitch, int c, int ks) {
    const v4i16_t lo = __builtin_amdgcn_ds_read_tr16_b64_v4i16((LAS v4i16_t*)(tb + (16 * ks) * pitch + 64 * c));
    const v4i16_t hi = __builtin_amdgcn_ds_read_tr16_b64_v4i16((LAS v4i16_t*)(tb + (16 * ks + 4) * pitch + 64 * c));
    return (bf16x8){lo[0], lo[1], lo[2], lo[3], hi[0], hi[1], hi[2], hi[3]};
}
__device__ __forceinline__ int tr_base(int lane, int pitch) { return ((lane >> 5) * 8 + ((lane & 15) >> 2)) * pitch + (((lane >> 4) & 1) * 16 + (lane & 3) * 4) * 2; }
__device__ __forceinline__ void mma_tile(f32x16& acc, const LAS unsigned char* a, int pa, const LAS unsigned char* bt, int pb, int ks, int r, int hh) {
    for (int s = 0; s < ks; ++s) { const bf16x8 av = *(const LAS bf16x8*)(a + r * pa + 32 * s + 16 * hh), bv = *(const LAS bf16x8*)(bt + r * pb + 32 * s + 16 * hh);
        acc = __builtin_amdgcn_mfma_f32_32x32x16_bf16(av, bv, acc, 0, 0, 0); }
}
__device__ __forceinline__ void ml_stage_cw(LAS unsigned char* lds, const float* conv_w, const float* conv_b, int hd, int tid) {
    LAS float* cwl = (LAS float*)(lds + ML_CW);
    float tv[3];
#pragma unroll
    for (int k = 0; k < 3; ++k) { const int i = tid + NWAVES * 64 * k; tv[k] = 0.f; if (i < 2 * 5 * 128) { const int z = i / 640, j = (i % 640) >> 7, ch = i & 127, gch = z * 512 + hd * 128 + ch; tv[k] = (j < 4) ? conv_w[j * 1024 + gch] : conv_b[gch]; } }
#pragma unroll
    for (int k = 0; k < 3; ++k) { const int i = tid + NWAVES * 64 * k; if (i < 2 * 5 * 128) cwl[i] = tv[k]; }
}
__device__ __forceinline__ void conv8(float (&y)[8], const bf16* src, int tt0, const LAS float* cw) {
    { const f32x4 b0 = *(const LAS f32x4*)(cw + 4 * 128), b1 = *(const LAS f32x4*)(cw + 4 * 128 + 4); y[0] = b0[0]; y[1] = b0[1]; y[2] = b0[2]; y[3] = b0[3]; y[4] = b1[0]; y[5] = b1[1]; y[6] = b1[2]; y[7] = b1[3]; }
#pragma unroll
    for (int j = 0; j < 4; ++j) { const int tt = tt0 - 3 + j;
        if (tt >= 0) { const v4u xw = *(const v4u*)(src + (size_t)tt * 512); const f32x4 w0 = *(const LAS f32x4*)(cw + j * 128), w1 = *(const LAS f32x4*)(cw + j * 128 + 4);
            y[0] += w0[0] * bf_lo(xw.x); y[1] += w0[1] * bf_hi(xw.x); y[2] += w0[2] * bf_lo(xw.y); y[3] += w0[3] * bf_hi(xw.y);
            y[4] += w1[0] * bf_lo(xw.z); y[5] += w1[1] * bf_hi(xw.z); y[6] += w1[2] * bf_lo(xw.w); y[7] += w1[3] * bf_hi(xw.w); } }
#pragma unroll
    for (int e = 0; e < 8; ++e) y[e] = silu_f(y[e]);
}

__device__ __forceinline__ void conv8r(float (&y)[8], const v4u (&xr)[4], const LAS float* cw) {
    { const f32x4 b0 = *(const LAS f32x4*)(cw + 4 * 128), b1 = *(const LAS f32x4*)(cw + 4 * 128 + 4); y[0] = b0[0]; y[1] = b0[1]; y[2] = b0[2]; y[3] = b0[3]; y[4] = b1[0]; y[5] = b1[1]; y[6] = b1[2]; y[7] = b1[3]; }
#pragma unroll
    for (int j = 0; j < 4; ++j) { const v4u xw = xr[j]; const f32x4 w0 = *(const LAS f32x4*)(cw + j * 128), w1 = *(const LAS f32x4*)(cw + j * 128 + 4);
        y[0] += w0[0] * bf_lo(xw.x); y[1] += w0[1] * bf_hi(xw.x); y[2] += w0[2] * bf_lo(xw.y); y[3] += w0[3] * bf_hi(xw.y);
        y[4] += w1[0] * bf_lo(xw.z); y[5] += w1[1] * bf_hi(xw.z); y[6] += w1[2] * bf_lo(xw.w); y[7] += w1[3] * bf_hi(xw.w); }
#pragma unroll
    for (int e = 0; e < 8; ++e) y[e] = silu_f(y[e]);
}
__device__ __forceinline__ void load_taps(v4u (&xr)[4], const bf16* src, int tt0) {
#pragma unroll
    for (int j = 0; j < 4; ++j) { const int tt = tt0 - 3 + j; xr[j] = (v4u){0u, 0u, 0u, 0u}; if (tt >= 0) xr[j] = *(const v4u*)(src + (size_t)tt * 512); }
}

struct AReg { v4u kx[2][4]; v4u vv[2]; float ig, lf; };
__device__ __forceinline__ void mlstm_A_load(AReg& R, int u, const bf16* KM, const bf16* VM, const float* IG, const float* LF, int tid, int lane, int wave) {
    const int c = u & 31, hd = (u >> 5) & 3, b = u >> 7; const size_t rowb = (size_t)b * SEQ, t0 = rowb + 64 * c;
#pragma unroll
    for (int it = 0; it < 2; ++it) { const int idx = tid + 512 * it, t = (idx >> 4) & 63, g = idx & 15;
        load_taps(R.kx[it], KM + rowb * 512 + hd * 128 + 8 * g, 64 * c + t); R.vv[it] = *(const v4u*)(VM + (t0 + t) * 512 + hd * 128 + 8 * g); }
    R.ig = 0.f; R.lf = 0.f; if (wave == 0) { R.ig = IG[(t0 + lane) * 4 + hd]; R.lf = LF[(t0 + lane) * 4 + hd]; }
}
__device__ __forceinline__ void mlstm_A(LAS unsigned char* lds, int u, int u_next, AReg& R, const bf16* KM, const bf16* VM, const float* IG, const float* LF, bf16* KC, bf16* CL, float* MSC,
                                        int tid, int lane, int wave) {
    asm volatile("" : "+v"(tid), "+v"(lane)); asm volatile("" : "+s"(wave));
    const int r = lane & 31, hh = lane >> 5;
    LAS float* gt = (LAS float*)(lds + MA_GT); LAS bf16* ct = (LAS bf16*)(lds + MA_CT);
    __syncthreads();
    if (wave == 0) {
        float bc = R.lf;
#pragma unroll
        for (int o = 1; o < 64; o <<= 1) { const float v = __shfl_up(bc, o); if (lane >= o) bc += v; }
        const float a = R.ig - bc; float am = a;
#pragma unroll
        for (int o = 1; o < 64; o <<= 1) am = fmaxf(am, __shfl_xor(am, o));
        gt[lane] = __expf(a - am);
        if (lane == 63) { MSC[(size_t)u * 4 + 0] = am; MSC[(size_t)u * 4 + 1] = bc; }
    }
#pragma unroll
    for (int it = 0; it < 2; ++it) { const int idx = tid + 512 * it, t = (idx >> 4) & 63, g = idx & 15;
        float y[8]; conv8r(y, R.kx[it], (const LAS float*)(lds + ML_CW) + 640 + 8 * g);
        v4u o; o.x = pk2(y[0], y[1]); o.y = pk2(y[2], y[3]); o.z = pk2(y[4], y[5]); o.w = pk2(y[6], y[7]);
        *(LAS v4u*)(lds + MA_KW + t * ML_PV + 16 * g) = o; *(v4u*)(KC + ((size_t)u * 64 + t) * 128 + 8 * g) = o;
        *(LAS v4u*)(lds + MA_VS + t * ML_PV + 16 * g) = R.vv[it]; }
    if (u_next >= 0) mlstm_A_load(R, u_next, KM, VM, IG, LF, tid, lane, wave);
    __syncthreads();
#pragma unroll
    for (int it = 0; it < 2; ++it) { const int idx = tid + 512 * it, t = (idx >> 4) & 63, g = idx & 15; const float ws = gt[t];
        LAS v4u* kp = (LAS v4u*)(lds + MA_KW + t * ML_PV + 16 * g); const v4u xw = *kp;
        v4u o; o.x = pk2(ws * bf_lo(xw.x), ws * bf_hi(xw.x)); o.y = pk2(ws * bf_lo(xw.y), ws * bf_hi(xw.y)); o.z = pk2(ws * bf_lo(xw.z), ws * bf_hi(xw.z)); o.w = pk2(ws * bf_lo(xw.w), ws * bf_hi(xw.w)); *kp = o; }
    __syncthreads();
    { const int vi = wave >> 1; const LAS unsigned char* va = lds + MA_VS + tr_base(lane, ML_PV); const LAS unsigned char* kb = lds + MA_KW + tr_base(lane, ML_PV);
      f32x16 acc0 = f32x16{}, acc1 = f32x16{};
#pragma unroll
      for (int ks = 0; ks < 4; ++ks) { const bf16x8 af = tr_frag(va, ML_PV, vi, ks), b0 = tr_frag(kb, ML_PV, 2 * (wave & 1), ks), b1 = tr_frag(kb, ML_PV, 2 * (wave & 1) + 1, ks);
          acc0 = __builtin_amdgcn_mfma_f32_32x32x16_bf16(af, b0, acc0, 0, 0, 0); acc1 = __builtin_amdgcn_mfma_f32_32x32x16_bf16(af, b1, acc1, 0, 0, 0); }
#pragma unroll
      for (int q = 0; q < 16; ++q) { LAS bf16* cp = ct + (32 * vi + crow16(q, hh)) * (ML_PQ / 2) + 64 * (wave & 1) + r; cp[0] = (bf16)f2bf(acc0[q]); cp[32] = (bf16)f2bf(acc1[q]); } }
    if (tid < 128) { float sacc = 0.f;
#pragma unroll 8
        for (int s2 = 0; s2 < 64; ++s2) sacc += __uint_as_float((unsigned)(*(const LAS bf16*)(lds + MA_KW + s2 * ML_PV + 2 * tid)) << 16);
        ct[128 * (ML_PQ / 2) + tid] = (bf16)f2bf(sacc); }
    __syncthreads();
    bf16* dst = CL + (size_t)u * ML_CLE;
    for (int i = tid; i < 129 * 16; i += NWAVES * 64) { const int row = i >> 4, pc = i & 15; *(v4u*)(dst + row * 128 + pc * 8) = *(const LAS v4u*)(lds + MA_CT + row * ML_PQ + pc * 16); }
}

__device__ __forceinline__ void mlstm_B(bf16* CL, float* MSC, int tid, int vcu, int G) {
    constexpr int PCS = ML_CLE / 8;
    for (int item = vcu * (NWAVES * 64) + tid; item < 64 * PCS; item += G * NWAVES * 64) {
        const int bh = item / PCS, pc = item % PCS;
        bf16* base = CL + (size_t)bh * 32 * ML_CLE + pc * 8; float* ms = MSC + (size_t)bh * 32 * 4;
        float cst[8];
#pragma unroll
        for (int e = 0; e < 8; ++e) cst[e] = 0.f;
        float m = 0.f;
#pragma unroll 1
        for (int k0 = 0; k0 < 32; k0 += 8) {
            v4u x[8]; float ak[8], tk[8];
#pragma unroll
            for (int k = 0; k < 8; ++k) { x[k] = *(const v4u*)(base + (size_t)(k0 + k) * ML_CLE); ak[k] = ms[(k0 + k) * 4 + 0]; tk[k] = ms[(k0 + k) * 4 + 1]; }
#pragma unroll
            for (int k = 0; k < 8; ++k) {
                const float Mx = fmaxf(m, ak[k]), dec = __expf(m - Mx), w = __expf(ak[k] - Mx);
                v4u o; o.x = pk2(cst[0], cst[1]); o.y = pk2(cst[2], cst[3]); o.z = pk2(cst[4], cst[5]); o.w = pk2(cst[6], cst[7]);
                *(v4u*)(base + (size_t)(k0 + k) * ML_CLE) = o;
                if (pc == 0) ms[(k0 + k) * 4 + 2] = m;
                cst[0] = dec * cst[0] + w * bf_lo(x[k].x); cst[1] = dec * cst[1] + w * bf_hi(x[k].x); cst[2] = dec * cst[2] + w * bf_lo(x[k].y); cst[3] = dec * cst[3] + w * bf_hi(x[k].y);
                cst[4] = dec * cst[4] + w * bf_lo(x[k].z); cst[5] = dec * cst[5] + w * bf_hi(x[k].z); cst[6] = dec * cst[6] + w * bf_lo(x[k].w); cst[7] = dec * cst[7] + w * bf_hi(x[k].w);
                m = tk[k] + Mx; }
        }
    }
}

struct CReg { v4u cl[5]; v4u kc[2]; v4u vv[2]; v4u qx[2][4]; v4u om[2]; float ig, lf, mp; };
__device__ __forceinline__ void mlstm_C_load(CReg& R, int u, const bf16* QM, const bf16* KC, const bf16* VM, const bf16* OM, const float* IG, const float* LF, const bf16* CL, const float* MSC,
                                             int tid, int lane, int wave) {
    const int c = u & 31, hd = (u >> 5) & 3, b = u >> 7; const size_t rowb = (size_t)b * SEQ, t0 = rowb + 64 * c;
    const bf16* src = CL + (size_t)u * ML_CLE;
#pragma unroll
    for (int k = 0; k < 5; ++k) { const int i = tid + 512 * k; R.cl[k] = (v4u){0u, 0u, 0u, 0u}; if (i < 129 * 16) R.cl[k] = *(const v4u*)(src + (i >> 4) * 128 + (i & 15) * 8); }
#pragma unroll
    for (int it = 0; it < 2; ++it) { const int idx = tid + 512 * it, t = (idx >> 4) & 63, g = idx & 15;
        R.kc[it] = *(const v4u*)(KC + ((size_t)u * 64 + t) * 128 + 8 * g); R.vv[it] = *(const v4u*)(VM + (t0 + t) * 512 + hd * 128 + 8 * g);
        load_taps(R.qx[it], QM + rowb * 512 + hd * 128 + 8 * g, 64 * c + t); }
    { const int ot = tid >> 3, op8 = tid & 7; R.om[0] = *(const v4u*)(OM + (t0 + ot) * 512 + hd * 128 + 16 * op8); R.om[1] = *(const v4u*)(OM + (t0 + ot) * 512 + hd * 128 + 16 * op8 + 8); }
    R.ig = 0.f; R.lf = 0.f; R.mp = 0.f; if (wave == 0) { R.ig = IG[(t0 + lane) * 4 + hd]; R.lf = LF[(t0 + lane) * 4 + hd]; R.mp = MSC[(size_t)u * 4 + 2]; }
}
__device__ __forceinline__ void mlstm_C(LAS unsigned char* lds, int u, int u_next, CReg& R, const bf16* QM, const bf16* KC, const bf16* VM, const bf16* OM, const float* IG, const float* LF,
                                        const float* gain, const bf16* CL, const float* MSC, bf16* ATT, int tid, int lane, int wave) {
    asm volatile("" : "+v"(tid), "+v"(lane)); asm volatile("" : "+s"(wave));
    const int r = lane & 31, hh = lane >> 5, c = u & 31, hd = (u >> 5) & 3, b = u >> 7;
    LAS float* gt = (LAS float*)(lds + MC_GT);
    const size_t rowb = (size_t)b * SEQ, t0 = rowb + 64 * c;
    __syncthreads();
#pragma unroll
    for (int k = 0; k < 5; ++k) { const int i = tid + 512 * k; if (i < 129 * 16) *(LAS v4u*)(lds + MC_CT + (i >> 4) * ML_PQ + (i & 15) * 16) = R.cl[k]; }
    if (wave == 0) {
        const float m_prev = R.mp;
        float bc = R.lf;
#pragma unroll
        for (int o = 1; o < 64; o <<= 1) { const float v = __shfl_up(bc, o); if (lane >= o) bc += v; }
        const float a = R.ig - bc; float pm = a;
#pragma unroll
        for (int o = 1; o < 64; o <<= 1) { const float v = __shfl_up(pm, o); if (lane >= o) pm = fmaxf(pm, v); }
        gt[lane] = a; gt[64 + lane] = fmaxf(m_prev, pm); gt[128 + lane] = bc;
        if (lane == 0) gt[194] = m_prev;
    }
    const int ot = tid >> 3, op8 = tid & 7;
    const v4u og0 = R.om[0], og1 = R.om[1];
#pragma unroll
    for (int it = 0; it < 2; ++it) { const int idx = tid + 512 * it, t = (idx >> 4) & 63, g = idx & 15;
        *(LAS v4u*)(lds + MC_KT + t * ML_PQ + 16 * g) = R.kc[it];
        *(LAS v4u*)(lds + MC_VS + t * ML_PV + 16 * g) = R.vv[it];
        float y[8]; conv8r(y, R.qx[it], (const LAS float*)(lds + ML_CW) + 8 * g);
        const float sc = 0.08838834764831845f;
        v4u o; o.x = pk2(y[0] * sc, y[1] * sc); o.y = pk2(y[2] * sc, y[3] * sc); o.z = pk2(y[4] * sc, y[5] * sc); o.w = pk2(y[6] * sc, y[7] * sc);
        *(LAS v4u*)(lds + MC_QT + t * ML_PQ + 16 * g) = o; }
    if (u_next >= 0) mlstm_C_load(R, u_next, QM, KC, VM, OM, IG, LF, CL, MSC, tid, lane, wave);
    __syncthreads();
    if (wave < 4) { const int ti = wave >> 1, si = wave & 1; f32x16 g = f32x16{};
        if (si <= ti) mma_tile(g, lds + MC_QT + 32 * ti * ML_PQ, ML_PQ, lds + MC_KT + 32 * si * ML_PQ, ML_PQ, 8, r, hh);
        const float as = gt[32 * si + r]; LAS bf16* sp = (LAS bf16*)(lds + MC_SS);
#pragma unroll
        for (int q = 0; q < 16; ++q) { const int tl = crow16(q, hh), t = 32 * ti + tl, s2 = 32 * si + r;
            const float v = g[q] * __expf(fminf(as - gt[64 + t], 0.f)); sp[t * (ML_PS / 2) + s2] = (bf16)f2bf((s2 <= t) ? v : 0.f); } }
    __syncthreads();
    f32x16 nm = f32x16{};
    { const int ti = wave >> 2, vi = wave & 3;
      mma_tile(nm, lds + MC_QT + 32 * ti * ML_PQ, ML_PQ, lds + MC_CT + 32 * vi * ML_PQ, ML_PQ, 8, r, hh);
      const float mp = gt[194];
#pragma unroll
      for (int q = 0; q < 16; ++q) nm[q] *= __expf(mp - gt[64 + 32 * ti + crow16(q, hh)]);
      const LAS unsigned char* vb = lds + MC_VS + tr_base(lane, ML_PV);
#pragma unroll
      for (int ks = 0; ks < 4; ++ks) { const bf16x8 av = *(const LAS bf16x8*)(lds + MC_SS + (32 * ti + r) * ML_PS + 32 * ks + 16 * hh), bv = tr_frag(vb, ML_PV, vi, ks);
          nm = __builtin_amdgcn_mfma_f32_32x32x16_bf16(av, bv, nm, 0, 0, 0); } }
    float den;
    { const v4u sw = *(const LAS v4u*)(lds + MC_SS + ot * ML_PS + 16 * op8);
      float d1 = (bf_lo(sw.x) + bf_hi(sw.x)) + (bf_lo(sw.y) + bf_hi(sw.y)) + (bf_lo(sw.z) + bf_hi(sw.z)) + (bf_lo(sw.w) + bf_hi(sw.w)), d2 = 0.f;
#pragma unroll
      for (int k = 0; k < 2; ++k) { const v4u qw = *(const LAS v4u*)(lds + MC_QT + ot * ML_PQ + 32 * op8 + 16 * k), nw = *(const LAS v4u*)(lds + MC_CT + 128 * ML_PQ + 32 * op8 + 16 * k);
          d2 += bf_lo(qw.x) * bf_lo(nw.x) + bf_hi(qw.x) * bf_hi(nw.x) + bf_lo(qw.y) * bf_lo(nw.y) + bf_hi(qw.y) * bf_hi(nw.y) + bf_lo(qw.z) * bf_lo(nw.z) + bf_hi(qw.z) * bf_hi(nw.z) + bf_lo(qw.w) * bf_lo(nw.w) + bf_hi(qw.w) * bf_hi(nw.w); }
      den = d1 + __expf(gt[194] - gt[64 + ot]) * d2;
      den += __shfl_xor(den, 1); den += __shfl_xor(den, 2); den += __shfl_xor(den, 4); }
    __syncthreads();
    { const int ti = wave >> 2, vi = wave & 3; LAS float* np = (LAS float*)(lds + MC_NUM);
#pragma unroll
      for (int q = 0; q < 16; ++q) np[(32 * ti + crow16(q, hh)) * ML_PN + 32 * vi + r] = nm[q]; }
    __syncthreads();
    { const int t = ot, p = op8; const LAS float* np = (const LAS float*)(lds + MC_NUM) + t * ML_PN;
      const float mrow = gt[128 + t] + gt[64 + t], scl = 1.f / fmaxf(fabsf(den), __expf(-mrow));
      float hv[16]; float ss = 0.f;
#pragma unroll
      for (int e = 0; e < 16; ++e) { hv[e] = np[16 * p + e] * scl; ss += hv[e] * hv[e]; }
      ss += __shfl_xor(ss, 1); ss += __shfl_xor(ss, 2); ss += __shfl_xor(ss, 4);
      const float rs = rsqrtf(ss * (1.f / 128.f) + EPS);
      const v4u o0 = og0, o1 = og1;
      const float og[16] = {bf_lo(o0.x), bf_hi(o0.x), bf_lo(o0.y), bf_hi(o0.y), bf_lo(o0.z), bf_hi(o0.z), bf_lo(o0.w), bf_hi(o0.w), bf_lo(o1.x), bf_hi(o1.x), bf_lo(o1.y), bf_hi(o1.y), bf_lo(o1.z), bf_hi(o1.z), bf_lo(o1.w), bf_hi(o1.w)};
      const float* gp = gain + hd * 128 + 16 * p;
#pragma unroll
      for (int e = 0; e < 16; ++e) hv[e] = hv[e] * rs * gp[e] * og[e];
      v4u w0, w1; w0.x = pk2(hv[0], hv[1]); w0.y = pk2(hv[2], hv[3]); w0.z = pk2(hv[4], hv[5]); w0.w = pk2(hv[6], hv[7]); w1.x = pk2(hv[8], hv[9]); w1.y = pk2(hv[10], hv[11]); w1.z = pk2(hv[12], hv[13]); w1.w = pk2(hv[14], hv[15]);
      bf16* op = ATT + (t0 + t) * 1024 + 512 + hd * 128 + 16 * p; *(v4u*)op = w0; *(v4u*)(op + 8) = w1; }
}

struct Args { const void* in[22]; float* out; unsigned char* ws; int ph_lo, ph_hi; };
__global__ void __launch_bounds__(NWAVES * 64, 2) hybrid_fwd(Args args) {
    extern __shared__ __attribute__((aligned(16))) unsigned char lds_raw[];
    LAS unsigned char* lds = (LAS unsigned char*)lds_raw;
    volatile LAS unsigned* MISC = (volatile LAS unsigned*)(lds + LDSCTL_OFF);
    const int G0 = gridDim.x, bid0 = blockIdx.x; const int vcu0 = (G0 % 8 == 0) ? (bid0 % 8) * (G0 / 8) + bid0 / 8 : bid0;
#define PHASE_BEGIN() unsigned ones_ = ~0u; asm volatile("" : "+s"(ones_)); int lane = (int)__builtin_amdgcn_mbcnt_hi(ones_, __builtin_amdgcn_mbcnt_lo(ones_, 0u)), tid = wave0 * 64 + lane; asm volatile("" : "+v"(tid), "+v"(lane)); const int wave = __builtin_amdgcn_readfirstlane(tid >> 6); \
    int G = G0, vcu = vcu0, bid = bid0; asm volatile("" : "+s"(G), "+s"(vcu), "+s"(bid)); (void)wave; (void)lane; (void)vcu; (void)bid; (void)G
    const int wave0 = __builtin_amdgcn_readfirstlane((int)threadIdx.x >> 6);
    { const int tid = threadIdx.x;
    for (int u = tid; u < (LDS_BYTES - LDSCTL_OFF) / 4; u += NWAVES * 64) ((LAS unsigned*)(lds + LDSCTL_OFF))[u] = 0u;
    __syncthreads();
    if (tid == 0) { LAS unsigned long long* pb = (LAS unsigned long long*)(lds + LDSCTL_OFF + 64);
#pragma unroll
        for (int k = 0; k < 22; ++k) pb[k] = (unsigned long long)args.in[k];
        pb[I_OUT] = (unsigned long long)args.out; pb[I_WS] = (unsigned long long)args.ws; }
    __syncthreads(); }
    const int lo = args.ph_lo, hi = args.ph_hi;
    XcdBarrier bar; bar.bar = (unsigned*)(args.ws + WS_CTL) + CW_BAR; bar.x = 0; bar.st = nullptr;
    if (hi - lo > 1) bar = xcd_barrier_post((unsigned*)(args.ws + WS_CTL) + CW_BAR, MISC + 8);
#ifndef ONLY
#define ONLY -1
#endif
#define PH_ON(c) (ONLY < 0 || ONLY == (c))
#ifndef DUP
#define DUP -1
#endif
#define REPS(c) _Pragma("unroll 1") for (int rep_ = 0; rep_ < ((DUP == (c)) ? 2 : 1); ++rep_)
#define IN(k) (lo <= (k) && (k) < hi)
#define OPAQUE_GEMM(g) asm volatile("" : "+s"(g.A), "+s"(g.Bt))
#define SEAM(k) do { if (IN(k) && IN((k) + 1)) { bar.bar = (unsigned*)(WSP() + WS_CTL) + CW_BAR; xcd_barrier(bar); } } while (0)
#ifdef GPROBE
#define PSTAMP(kind, p, begin) do { if (GPROBE == (kind) && GPROBE_PHASE == (p) && bid0 == 0 && wave0 == 0 && __builtin_amdgcn_mbcnt_hi(~0u, __builtin_amdgcn_mbcnt_lo(~0u, 0u)) == 0u) { \
        volatile LAS unsigned long long* pw_ = (volatile LAS unsigned long long*)(lds + pg8::PROBE_LDS_OFF); const unsigned long long n_ = __builtin_amdgcn_s_memrealtime(); if (begin) pw_[-2] = n_; else pw_[0] += n_ - pw_[-2]; } } while (0)
#else
#define PSTAMP(kind, p, begin) do { } while (0)
#endif
#define LSEAM(p) do { PSTAMP(30, p, 0); PSTAMP(31, p, 1); SEAM(pb + (p)); PSTAMP(31, p, 0); PSTAMP(30, (p) + 1, 1); } while (0)
#define XNB   ((bf16*)(WSPG() + WS_XN))
#define MXB(o) (WSPG() + WS_MIX + (o))
#define MODB  ((float*)(WSPG() + WS_MOD))
#define SSQB  ((float*)(WSPG() + WS_SSQ))

    PSTAMP(32, 0, 1);
    REPS(0) { PHASE_BEGIN(); if (PH_ON(0) && IN(0)) p0_prologue(lds, tid, lane, wave, vcu, G); }
    PSTAMP(32, 0, 0); PSTAMP(33, 0, 1);
    SEAM(0);
    PSTAMP(33, 0, 0); PSTAMP(34, 0, 1);
#if defined(DUP) && DUP == 50
    for (int xb_ = 0; xb_ < 20; ++xb_) SEAM(0);
#endif
    { PHASE_BEGIN(); if (PH_ON(1) && IN(1)) norm_phase(nullptr, FP(I_X), nullptr, nullptr, nullptr, FP(I_MIXPRE), MODB + 1 * D, MODB + 0 * D, XNB, lane, wave, vcu, G); }
    PSTAMP(34, 0, 0); PSTAMP(35, 0, 1);
    SEAM(1);
    PSTAMP(35, 0, 0);

    for (int l = 0; l < DEPTH; ++l) {
        const int pb = 2 + 9 * l;
        PSTAMP(30, 0, 1);
        if (PH_ON(2) && IN(pb + 0)) REPS(2) { PHASE_BEGIN();
            unsigned char* wl = WSP() + WS_W + (size_t)l * W_LAYER;
            pg8::Gemm g{XNB, (const bf16*)(wl + WO_IN), M, NINP, D}; OPAQUE_GEMM(g); pg8::StaticOrder S; S.init(M, NINP, G, bid);
            pg8::EpiIn E{(bf16*)MXB(MX_CQ), (bf16*)MXB(MX_K), (bf16*)MXB(MX_V), (bf16*)MXB(MX_KI), (bf16*)MXB(MX_QM), (bf16*)MXB(MX_KM), (bf16*)MXB(MX_VM), (bf16*)MXB(MX_OM), SSQB, (float*)MXB(MX_WI), (float*)MXB(MX_IG), (float*)MXB(MX_LF),
                         GPTR(const int, ldptr(lds, I_POS)), FP(I_BIG) + l * 4, FP(I_BFG) + l * 4};
            pg8::gemm_phase<pg8::EpiIn, pg8::StaticOrder, true, true>(lds, g, S, E, tid);
        }
        LSEAM(0);
#ifndef SUB
#define SUB 0
#endif
#define MSCB ((float*)(WSPG() + WS_SSQ + 512 * 1024))
#define MLSTM_A_BLOCK() do { PHASE_BEGIN(); int cur_hd = -1; \
            if (SUB != 1 && vcu < 2048) { AReg RA; mlstm_A_load(RA, vcu, (const bf16*)MXB(MX_KM), (const bf16*)MXB(MX_VM), (const float*)MXB(MX_IG), (const float*)MXB(MX_LF), tid, lane, wave); \
              for (int u = vcu; u < 2048; u += G) { const int hd = (u >> 5) & 3; \
                if (hd != cur_hd) { __syncthreads(); ml_stage_cw(lds, FP(I_CONVW) + (size_t)l * 4 * 1024, FP(I_CONVB) + (size_t)l * 1024, hd, tid); cur_hd = hd; }       \
                mlstm_A(lds, u, (u + G < 2048) ? u + G : -1, RA, (const bf16*)MXB(MX_KM), (const bf16*)MXB(MX_VM), (const float*)MXB(MX_IG), (const float*)MXB(MX_LF), (bf16*)MXB(MX_KC), (bf16*)MXB(MX_CL), MSCB, tid, lane, wave); } } \
            __syncthreads(); } while (0)
        if (PH_ON(3) && IN(pb + 1)) REPS(3) { PHASE_BEGIN();
            unsigned char* wl = WSP() + WS_W + (size_t)l * W_LAYER;
            pg8::Gemm g{(const bf16*)MXB(MX_CQ), (const bf16*)(wl + WO_Q), M, 1024, QRK}; OPAQUE_GEMM(g); pg8::StaticOrder S; S.init(M, 1024, G, bid);
            pg8::EpiQ E{(bf16*)MXB(MX_Q), (bf16*)MXB(MX_QI), SSQB, GPTR(const int, ldptr(lds, I_POS)), attn_body::C2};
            pg8::gemm_phase<pg8::EpiQ, pg8::StaticOrder, true, true>(lds, g, S, E, tid);
        }
        if (PH_ON(4) && IN(pb + 1)) REPS(41) MLSTM_A_BLOCK();
        LSEAM(1);
        if (PH_ON(4) && IN(pb + 2)) { PHASE_BEGIN();
            const bool bmix = (G == 256) && (SUB == 0);
            if (SUB != 1 && !bmix) REPS(42) mlstm_B((bf16*)MXB(MX_CL), MSCB, tid, vcu, G);
            if (SUB != 2) REPS(40) { IxReg RI = {}; BState SB1 = {};
#define IX_L(i) ((i) * G + (((i) & 1) ? G - 1 - vcu : vcu))
                if (IX_L(0) < BATCH * 128) indexer_load(RI, IX_L(0) & 15, 127 - (IX_L(0) >> 4), (const bf16*)MXB(MX_QI), (const bf16*)MXB(MX_KI), (const float*)MXB(MX_WI), tid, lane, wave);
                if (bmix) mlstm_B_extras((bf16*)MXB(MX_CL), MSCB, tid, vcu);
                for (int i = 0; i * G < BATCH * 128; ++i) { const int L = IX_L(i), Ln = IX_L(i + 1); const bool hn = ((i + 1) * G < BATCH * 128) && (Ln < BATCH * 128);
                    if (L < BATCH * 128) indexer_unit(lds, L & 15, 127 - (L >> 4), hn ? (Ln & 15) : 0, hn ? 127 - (Ln >> 4) : -1, RI, (const bf16*)MXB(MX_QI), (const bf16*)MXB(MX_KI), (const float*)MXB(MX_WI), (unsigned long long*)MXB(MX_MASK), tid, lane, wave,
                                                         SB1, vcu, bmix ? 4 * i : -1); }
#undef IX_L
            }
        }
        LSEAM(2);
#define MLSTM_C_BLOCK() do { PHASE_BEGIN(); int cur_hd = -1; \
            if (SUB != 1 && vcu < 2048) { CReg RC; mlstm_C_load(RC, vcu, (const bf16*)MXB(MX_QM), (const bf16*)MXB(MX_KC), (const bf16*)MXB(MX_VM), (const bf16*)MXB(MX_OM), (const float*)MXB(MX_IG), (const float*)MXB(MX_LF), (const bf16*)MXB(MX_CL), MSCB, tid, lane, wave); \
              for (int u = vcu; u < 2048; u += G) { const int hd = (u >> 5) & 3; \
                if (hd != cur_hd) { __syncthreads(); ml_stage_cw(lds, FP(I_CONVW) + (size_t)l * 4 * 1024, FP(I_CONVB) + (size_t)l * 1024, hd, tid); cur_hd = hd; } \
                mlstm_C(lds, u, (u + G < 2048) ? u + G : -1, RC, (const bf16*)MXB(MX_QM), (const bf16*)MXB(MX_KC), (const bf16*)MXB(MX_VM), (const bf16*)MXB(MX_OM), (const float*)MXB(MX_IG), (const float*)MXB(MX_LF), \
                        FP(I_MLN) + (size_t)l * 512, (const bf16*)MXB(MX_CL), MSCB, XNB, tid, lane, wave); } } \
            __syncthreads(); } while (0)
        if (PH_ON(4) && IN(pb + 3)) REPS(43) MLSTM_C_BLOCK();
        if (PH_ON(5) && IN(pb + 3)) REPS(5) { PHASE_BEGIN();
            const attn_body::AttnTensors AT{(const attn_body::bf16*)MXB(MX_Q), (const attn_body::bf16*)MXB(MX_K), (const attn_body::bf16*)MXB(MX_V), (attn_body::bf16*)XNB, (const attn_body::u32x4*)MXB(MX_MASK), FP(I_ATTN) + (size_t)l * 512};
            const attn_body::StaticOrder S(G, bid);
            attn_body::attn_phase<attn_body::StaticOrder>((char*)lds_raw, AT, S, tid);
        }
        LSEAM(3);
        if (PH_ON(6) && IN(pb + 4)) REPS(6) { PHASE_BEGIN();
            unsigned char* wl = WSP() + WS_W + (size_t)l * W_LAYER;
            pg8::Gemm g{XNB, (const bf16*)(wl + WO_OUT), M, D, D}; OPAQUE_GEMM(g); pg8::StaticOrder S; S.init(M, D, G, bid);
            pg8::EpiPlain E{(bf16*)MXB(MX_Y), D};
            pg8::gemm_phase<pg8::EpiPlain, pg8::StaticOrder, true, true>(lds, g, S, E, tid);
        }
        LSEAM(4);
        if (PH_ON(1) && IN(pb + 5)) { PHASE_BEGIN(); const float* modl = MODB + (size_t)l * BATCH * NMOD; float* outp = GPTR(float, ldptr(lds, I_OUT));
            norm_phase((const bf16*)MXB(MX_Y), l == 0 ? FP(I_X) : (const float*)outp, outp, FP(I_MIXPOST) + (size_t)l * D, modl + 2 * D, FP(I_FFNPRE) + (size_t)l * D, modl + 4 * D, modl + 3 * D, XNB, lane, wave, vcu, G); }
        LSEAM(5);
        if (PH_ON(7) && IN(pb + 6)) REPS(7) { PHASE_BEGIN();
            unsigned char* wl = WSP() + WS_W + (size_t)l * W_LAYER;
            pg8::Gemm g{XNB, (const bf16*)(wl + WO_GU), M, 2 * FF, D}; OPAQUE_GEMM(g); pg8::StaticOrder S; S.init(M, 2 * FF, G, bid);
            pg8::EpiSwiglu E{(bf16*)MXB(MX_H), FF};
            pg8::gemm_phase<pg8::EpiSwiglu, pg8::StaticOrder, true, true>(lds, g, S, E, tid);
        }
        LSEAM(6);
        if (PH_ON(6) && IN(pb + 7)) REPS(8) { PHASE_BEGIN();
            unsigned char* wl = WSP() + WS_W + (size_t)l * W_LAYER;
            pg8::Gemm g{(const bf16*)MXB(MX_H), (const bf16*)(wl + WO_DN), M, D, FF}; OPAQUE_GEMM(g); pg8::StaticOrder S; S.init(M, D, G, bid);
            pg8::EpiPlain E{(bf16*)MXB(MX_Y), D};
            pg8::gemm_phase<pg8::EpiPlain, pg8::StaticOrder, true, true>(lds, g, S, E, tid);
        }
        LSEAM(7);
        if (PH_ON(1) && IN(pb + 8)) { PHASE_BEGIN();
            const bool last = (l == DEPTH - 1); const float* modl = MODB + (size_t)l * BATCH * NMOD; const float* modn = MODB + (size_t)(l + 1) * BATCH * NMOD; float* outp = GPTR(float, ldptr(lds, I_OUT));
            norm_phase((const bf16*)MXB(MX_Y), outp, outp, FP(I_FFNPOST) + (size_t)l * D, modl + 5 * D, last ? nullptr : FP(I_MIXPRE) + (size_t)(l + 1) * D, modn + 1 * D, modn + 0 * D, XNB, lane, wave, vcu, G);
        }
        LSEAM(8);
    }
#ifdef GPROBE
    if (bid0 == 0 && wave0 == 0 && __builtin_amdgcn_mbcnt_hi(~0u, __builtin_amdgcn_mbcnt_lo(~0u, 0u)) == 0u) { const unsigned long long tot_ = *(volatile LAS unsigned long long*)(lds + pg8::PROBE_LDS_OFF) * (unsigned long long)(GPROBE_FACTOR);
        const unsigned long long t0_ = __builtin_amdgcn_s_memrealtime(); while (__builtin_amdgcn_s_memrealtime() - t0_ < tot_) __builtin_amdgcn_s_sleep(16); }
#endif
#undef IN
#undef SEAM
}

extern "C" void kernel_launch(void* const* d_in, const int* in_sizes, int n_in, void* d_out, int out_size, void* d_ws, size_t ws_size, hipStream_t stream) {
    static int grid = 0;
    if (grid == 0) {
        if (n_in != 22 || in_sizes[0] != M * D || out_size != M * D || ws_size < WS_END) { fprintf(stderr, "kernel_launch: built for 22 inputs, x/out of %d floats, >= %zu bytes of workspace; got n_in %d, in0 %d, out %d, ws %zu; nothing launched\n", M * D, (size_t)WS_END, n_in, n_in > 0 ? in_sizes[0] : -1, out_size, ws_size); grid = -1; return; }
        int dev = 0, cus = 0, per_cu = 0;
        if (hipGetDevice(&dev) != hipSuccess || hipDeviceGetAttribute(&cus, hipDeviceAttributeMultiprocessorCount, dev) != hipSuccess) { fprintf(stderr, "kernel_launch: device query failed\n"); grid = -1; return; }
        if (hipFuncSetAttribute((const void*)hybrid_fwd, hipFuncAttributeMaxDynamicSharedMemorySize, LDS_BYTES) != hipSuccess) { fprintf(stderr, "kernel_launch: hipFuncSetAttribute(%d B LDS) failed\n", LDS_BYTES); grid = -1; return; }
        if (hipOccupancyMaxActiveBlocksPerMultiprocessor(&per_cu, (const void*)hybrid_fwd, NWAVES * 64, LDS_BYTES) != hipSuccess || per_cu < 1)
            fprintf(stderr, "kernel_launch: note: occupancy query reports %d workgroups per CU\n", per_cu);
        (void)hipGetLastError();
        grid = cus;
    }
    if (grid < 0) return;
    if (hipMemsetAsync((char*)d_ws + WS_CTL, 0, CTL_ZERO_BYTES, stream) != hipSuccess) { fprintf(stderr, "kernel_launch: hipMemsetAsync failed\n"); return; }
    Args a{};
    for (int i = 0; i < 22; ++i) a.in[i] = d_in[i];
    a.out = (float*)d_out; a.ws = (unsigned char*)d_ws;
#if MK_ONE_LAUNCH
    a.ph_lo = 0; a.ph_hi = N_PHASES;
    hipLaunchKernelGGL(hybrid_fwd, dim3(grid), dim3(NWAVES * 64), LDS_BYTES, stream, a);
#else
    for (int p = 0; p < N_PHASES; ++p) { a.ph_lo = p; a.ph_hi = p + 1; hipLaunchKernelGGL(hybrid_fwd, dim3(grid), dim3(NWAVES * 64), LDS_BYTES, stream, a); }
#endif
    const hipError_t le = hipPeekAtLastError();
    if (le != hipSuccess) fprintf(stderr, "kernel_launch: launch failed: %s (grid %d x %d threads, %d B LDS)\n", hipGetErrorName(le), grid, NWAVES * 64, LDS_BYTES);
}
```

```cpp
#include <hip/hip_runtime.h>
#include <hip/hip_bf16.h>
#include <cstdio>
#include <cstdint>
#include <cmath>
namespace pg8 {
#define PG8_LAS __attribute__((address_space(3)))
typedef unsigned short bf16_t;
typedef short bf16x8 __attribute__((ext_vector_type(8)));
typedef float f32x4 __attribute__((ext_vector_type(4)));
typedef unsigned u32x4 __attribute__((ext_vector_type(4)));
constexpr int PROBE_LDS_OFF = 153600 + 448 - 16;
constexpr int BM = 256, BK = 64, HALF = 128, HTB = HALF * BK * 2  , STAGE_BYTES = 8 * HTB, NXCD = 8, WGM = 8;

__host__ __device__ __forceinline__ int lds_byte(int r, int c) { const int st = (r >> 4) * 2 + (c >> 5), rr = r & 15, cc = c & 31, ob = rr * 64 + cc * 2; return st * 1024 + (ob ^ (((ob >> 9) & 1) << 5)); }
__host__ __device__ __forceinline__ void stage_rc(int b, int& R, int& C) { const int st = b / 1024, sb = b % 1024, swz = sb ^ (((sb >> 9) & 1) << 5); R = (st >> 1) * 16 + swz / 64; C = (st & 1) * 32 + (swz % 64) / 2; }
__host__ __device__ __forceinline__ int perm32(int rho) { const int n = rho >> 4, i = rho & 15; return 8 * (i >> 2) + 4 * n + (i & 3); }

struct Unit { int pm, pn; };
struct Gemm { const bf16_t* A; const bf16_t* Bt; int M, N, K; };

struct StaticOrder {
    int nM, nN, nwg, G, c, hp0;
    __host__ __device__ void init(int M, int N, int G_, int c_) { nM = M / BM; nN = N / BM; nwg = nM * nN; G = G_; c = c_; hp0 = -1; }
    __host__ __device__ void init_half(int p0, int r16) { hp0 = p0; c = r16; }
    __host__ __device__ bool next(int i, Unit& u) const {
        if (hp0 >= 0) { const int L = i * 16 + c; if (L >= 8 * nN) return false; const int t = L >> 2; u.pm = hp0 + 4 * (t / nN) + (L & 3); u.pn = t % nN; return true; }
        const long L = (long)i * G + c; if (L >= nwg) return false;
        int wgid = (int)L; { const int q = nwg / NXCD, r = nwg % NXCD, xcd = wgid % NXCD, off = wgid / NXCD; wgid = (xcd < r ? xcd * (q + 1) : r * (q + 1) + (xcd - r) * q) + off; }
        const int nig = WGM * nN, gid = wgid / nig, fm = gid * WGM, gsz = (nM - fm) < WGM ? (nM - fm) : WGM;
        u.pm = fm + ((wgid % nig) % gsz); u.pn = (wgid % nig) / gsz; return true;
    }
    __device__ __forceinline__ void a_ready(const Unit&) const {}
    __device__ __forceinline__ void done(const Unit&) const {}
};

__device__ __forceinline__ unsigned cvt_pk_bf16(float lo, float hi) { unsigned r; asm volatile("v_cvt_pk_bf16_f32 %0, %1, %2" : "=v"(r) : "v"(lo), "v"(hi)); return r; }
typedef float f32x2 __attribute__((ext_vector_type(2)));

__device__ __forceinline__ void store8(bf16_t* p, const f32x4 a, const f32x4 b) {
    u32x4 w; w.x = cvt_pk_bf16(a[0], a[1]); w.y = cvt_pk_bf16(a[2], a[3]); w.z = cvt_pk_bf16(b[0], b[1]); w.w = cvt_pk_bf16(b[2], b[3]);
#ifdef STORE_SC1
    asm volatile("global_store_dwordx4 %0, %1, off sc1\n\ts_nop 1" :: "v"(p), "v"(w) : "memory");
#else
    *(u32x4*)p = w;
#endif

}
__device__ __forceinline__ float sigmoid_f(float g) { return __builtin_amdgcn_rcpf(1.f + __builtin_amdgcn_exp2f(-1.4426950408889634f * g)); }
__device__ __forceinline__ float silu_f(float g) { return g * sigmoid_f(g); }
__device__ __forceinline__ void rope_invf(float (&invf)[4], int wc, int fq) {
    const int j = 4 * (wc & 1) + fq;
#pragma unroll
    for (int e = 0; e < 4; ++e) invf[e] = exp2f(-(float)(4 * j + e) * 0.41524101186092029f) * 0.15915494309189535f;
}
__device__ __forceinline__ void rope_sincos(float (&sn)[4], float (&cs)[4], float p, const float (&invf)[4]) {
#pragma unroll
    for (int e = 0; e < 4; ++e) { const float r = __builtin_amdgcn_fractf(p * invf[e]); sn[e] = __builtin_amdgcn_sinf(r); cs[e] = __builtin_amdgcn_cosf(r); }
}
__device__ __forceinline__ void rope_apply(f32x4& x1, f32x4& x2, const float (&sn)[4], const float (&cs)[4]) {
    f32x4 o1, o2;
#pragma unroll
    for (int e = 0; e < 4; ++e) { o1[e] = x1[e] * cs[e] - x2[e] * sn[e]; o2[e] = x2[e] * cs[e] + x1[e] * sn[e]; }
    x1 = o1; x2 = o2;
}

struct EpiIn {
    static constexpr bool PERM = true, AFTER_DRAIN = false; static constexpr int PROBE = 2;
    bf16_t *CQ, *K, *V, *KI, *QM, *KM, *VM, *OM; float *SSQ, *WI, *IG, *LF; const int* pos; const float *b_ig, *b_fg;
    __device__ __forceinline__ void operator()(const f32x4 (&acc)[2][2][4][2], const Unit& u, int wr, int wc, int fr, int fq) const {
        { unsigned ones_ = ~0u; asm volatile("" : "+s"(ones_)); const int ln_ = (int)__builtin_amdgcn_mbcnt_hi(ones_, __builtin_amdgcn_mbcnt_lo(ones_, 0u)); fr = ln_ & 15; fq = ln_ >> 4; }
        const int row0 = u.pm * BM + wr * 64 + fr, ct = wc * 32 + 8 * fq, pn = u.pn;
        if (pn == 0) {
#pragma unroll
            for (int ai = 0; ai < 2; ++ai)
#pragma unroll
                for (int m = 0; m < 4; ++m) { const int row = row0 + ai * HALF + m * 16; float s = 0.f;
#pragma unroll
                    for (int bj = 0; bj < 2; ++bj) { const f32x4 v0 = acc[ai][bj][m][0], v1 = acc[ai][bj][m][1];
                        s += (v0[0] * v0[0] + v0[1] * v0[1]) + (v0[2] * v0[2] + v0[3] * v0[3]) + (v1[0] * v1[0] + v1[1] * v1[1]) + (v1[2] * v1[2] + v1[3] * v1[3]);
                        store8(CQ + (size_t)row * 256 + bj * HALF + ct, v0, v1); }
                    s += __shfl_xor(s, 16); s += __shfl_xor(s, 32);
                    if (fq == 0) SSQ[(size_t)row * 4 + wc] = s; }
        } else if (pn <= 2) {
            float invf[4]; rope_invf(invf, wc, fq);
            int psv[2][4];
#pragma unroll
            for (int ai = 0; ai < 2; ++ai)
#pragma unroll
                for (int m = 0; m < 4; ++m) psv[ai][m] = pos[row0 + ai * HALF + m * 16];
#pragma unroll
            for (int ai = 0; ai < 2; ++ai)
#pragma unroll
                for (int m = 0; m < 4; ++m) { const int row = row0 + ai * HALF + m * 16; float sn[4], cs[4]; rope_sincos(sn, cs, (float)psv[ai][m], invf);
#pragma unroll
                    for (int bj = 0; bj < 2; ++bj) { f32x4 v0 = acc[ai][bj][m][0], v1 = acc[ai][bj][m][1]; rope_apply(v0, v1, sn, cs);
                        store8(K + (size_t)row * 512 + (pn - 1) * 256 + bj * HALF + ct, v0, v1); } }
        } else if (pn <= 12) {
            const int g = (pn - 3) >> 1; bf16_t* dst = (g == 0) ? V : (g == 1) ? QM : (g == 2) ? KM : (g == 3) ? VM : OM; const int cb = ((pn - 3) & 1) * 256 + ct;
#pragma unroll
            for (int ai = 0; ai < 2; ++ai)
#pragma unroll
                for (int m = 0; m < 4; ++m) { const int row = row0 + ai * HALF + m * 16;
#pragma unroll
                    for (int bj = 0; bj < 2; ++bj) { f32x4 v0 = acc[ai][bj][m][0], v1 = acc[ai][bj][m][1];
                        if (g == 4) {
#pragma unroll
                            for (int e = 0; e < 4; ++e) { v0[e] = sigmoid_f(v0[e]); v1[e] = sigmoid_f(v1[e]); } }
                        store8(dst + (size_t)row * 512 + cb + bj * HALF, v0, v1); } }
        } else {
            if (wc < 2) {
                float invf[4]; rope_invf(invf, wc, fq);
                int psv[2][4];
#pragma unroll
                for (int ai = 0; ai < 2; ++ai)
#pragma unroll
                    for (int m = 0; m < 4; ++m) psv[ai][m] = pos[row0 + ai * HALF + m * 16];
#pragma unroll
                for (int ai = 0; ai < 2; ++ai)
#pragma unroll
                    for (int m = 0; m < 4; ++m) { const int row = row0 + ai * HALF + m * 16; float sn[4], cs[4]; rope_sincos(sn, cs, (float)psv[ai][m], invf);
                        f32x4 v0 = acc[ai][0][m][0], v1 = acc[ai][0][m][1]; rope_apply(v0, v1, sn, cs); store8(KI + (size_t)row * 64 + ct, v0, v1); }
            } else if (wc == 2 && fq == 0) {
#pragma unroll
                for (int ai = 0; ai < 2; ++ai)
#pragma unroll
                    for (int m = 0; m < 4; ++m) { const int row = row0 + ai * HALF + m * 16; const float s = 0.044194173824159216f;
                        *(f32x4*)(WI + (size_t)row * 8) = acc[ai][0][m][0] * s; *(f32x4*)(WI + (size_t)row * 8 + 4) = acc[ai][0][m][1] * s; }
            } else if (wc == 2 && fq == 1) {
                const f32x4 bi = *(const f32x4*)b_ig, bf = *(const f32x4*)b_fg;
#pragma unroll
                for (int ai = 0; ai < 2; ++ai)
#pragma unroll
                    for (int m = 0; m < 4; ++m) { const int row = row0 + ai * HALF + m * 16; const f32x4 iv = acc[ai][0][m][0] + bi, fv = acc[ai][0][m][1] + bf; f32x4 lf;
#pragma unroll
                        for (int e = 0; e < 4; ++e) lf[e] = fminf(fv[e], 0.f) - 0.6931471805599453f * __builtin_amdgcn_logf(1.f + __builtin_amdgcn_exp2f(-1.4426950408889634f * fabsf(fv[e])));
                        *(f32x4*)(IG + (size_t)row * 4) = iv; *(f32x4*)(LF + (size_t)row * 4) = lf; }
            }
        }
    }
};

struct EpiQ {
    static constexpr bool PERM = true, AFTER_DRAIN = false; static constexpr int PROBE = 3;
    bf16_t *Q, *QI; const float* SSQ; const int* pos; float qscale;
    __device__ __forceinline__ void operator()(const f32x4 (&acc)[2][2][4][2], const Unit& u, int wr, int wc, int fr, int fq) const {
        { unsigned ones_ = ~0u; asm volatile("" : "+s"(ones_)); const int ln_ = (int)__builtin_amdgcn_mbcnt_hi(ones_, __builtin_amdgcn_mbcnt_lo(ones_, 0u)); fr = ln_ & 15; fq = ln_ >> 4; }
        const int row0 = u.pm * BM + wr * 64 + fr, ct = wc * 32 + 8 * fq, pn = u.pn;
        float invf[4]; rope_invf(invf, wc, fq);
        bf16_t* dst = (pn < 2) ? Q + pn * 256 : QI + (pn - 2) * 256; const float sc = (pn < 2) ? qscale : 1.f;
#pragma unroll
        for (int ai = 0; ai < 2; ++ai) {
            float rsv[4]; int psv[4];
#pragma unroll
            for (int m = 0; m < 4; ++m) { const int row = row0 + ai * HALF + m * 16; const f32x4 ss = *(const f32x4*)(SSQ + (size_t)row * 4); psv[m] = pos[row]; rsv[m] = ((ss[0] + ss[1]) + (ss[2] + ss[3])) * (1.f / 256.f) + 1e-6f; }
#pragma unroll
            for (int m = 0; m < 4; ++m) { const int row = row0 + ai * HALF + m * 16;
                const float rstd = rsqrtf(rsv[m]);
                float sn[4], cs[4]; rope_sincos(sn, cs, (float)psv[m], invf);
#pragma unroll
                for (int bj = 0; bj < 2; ++bj) { f32x4 v0 = acc[ai][bj][m][0] * rstd, v1 = acc[ai][bj][m][1] * rstd; rope_apply(v0, v1, sn, cs);
                    store8(dst + (size_t)row * 512 + bj * HALF + ct, v0 * sc, v1 * sc); } } }
    }
};

struct EpiPlain {
    static constexpr bool PERM = true, AFTER_DRAIN = false; static constexpr int PROBE = 6;
    bf16_t* O; int ldc;
    __device__ __forceinline__ void operator()(const f32x4 (&acc)[2][2][4][2], const Unit& u, int wr, int wc, int fr, int fq) const {
        { unsigned ones_ = ~0u; asm volatile("" : "+s"(ones_)); const int ln_ = (int)__builtin_amdgcn_mbcnt_hi(ones_, __builtin_amdgcn_mbcnt_lo(ones_, 0u)); fr = ln_ & 15; fq = ln_ >> 4; }
        const int row0 = u.pm * BM + wr * 64 + fr, col0 = u.pn * BM + wc * 32 + 8 * fq;
#pragma unroll
        for (int ai = 0; ai < 2; ++ai)
#pragma unroll
            for (int m = 0; m < 4; ++m) { bf16_t* rowp = O + (size_t)(row0 + ai * HALF + m * 16) * ldc + col0;
#pragma unroll
                for (int bj = 0; bj < 2; ++bj) store8(rowp + bj * HALF, acc[ai][bj][m][0], acc[ai][bj][m][1]); }
    }
};

struct EpiSwiglu {
    static constexpr bool PERM = true, AFTER_DRAIN = false; static constexpr int PROBE = 7;
    bf16_t* H; int ldc;
    __device__ __forceinline__ void operator()(const f32x4 (&acc)[2][2][4][2], const Unit& u, int wr, int wc, int fr, int fq) const {
        { unsigned ones_ = ~0u; asm volatile("" : "+s"(ones_)); const int ln_ = (int)__builtin_amdgcn_mbcnt_hi(ones_, __builtin_amdgcn_mbcnt_lo(ones_, 0u)); fr = ln_ & 15; fq = ln_ >> 4; }
        const int row0 = u.pm * BM + wr * 64 + fr, col0 = u.pn * HALF + wc * 32 + 8 * fq;
#pragma unroll
        for (int ai = 0; ai < 2; ++ai)
#pragma unroll
            for (int m = 0; m < 4; ++m) { f32x4 o0, o1;
#pragma unroll
                for (int e = 0; e < 4; ++e) { o0[e] = silu_f(acc[ai][0][m][0][e]) * acc[ai][1][m][0][e]; o1[e] = silu_f(acc[ai][0][m][1][e]) * acc[ai][1][m][1][e]; }
                store8(H + (size_t)(row0 + ai * HALF + m * 16) * ldc + col0, o0, o1); }
    }
};

template <class Epi, class Sched, bool ALIGN_EPI = false, bool SP2 = false>
__device__ __forceinline__ void gemm_phase(PG8_LAS unsigned char* lds, const Gemm g, const Sched& S, const Epi& E, int tid_in  ) {
    int tid_o = tid_in; asm volatile("" : "+v"(tid_o));
    const int tid = tid_o, wid = __builtin_amdgcn_readfirstlane(tid >> 6), lane = tid & 63, wr = wid >> 2, wc = wid & 3, fr = lane & 15, fq = lane >> 4;
    const int K = g.K, nt = K / BK;
    unsigned voffA[2], voffB[2];
#pragma unroll
    for (int i = 0; i < 2; ++i) { int R, C; stage_rc(tid * 16 + i * 8192, R, C); const int Rb = Epi::PERM ? ((R & ~31) + perm32(R & 31)) : R;
        voffA[i] = (unsigned)(R * K + C) * 2u; voffB[i] = (unsigned)(Rb * K + C) * 2u; }
    const size_t kstep = (size_t)(BK * 2);
    const size_t hstep = (size_t)HALF * K * 2;
    const size_t tstep = 2 * hstep;
    const unsigned ldsw = (unsigned)wid * 1024u;
    const int aoff = lds_byte(wr * 64 + fr, fq * 8), boff = lds_byte(wc * 32 + fr, fq * 8);
#define PG8_SA(b, h) (((b) * 2 + (h)) * HTB)
#define PG8_SB(b, h) ((4 + (b) * 2 + (h)) * HTB)
#define PG8_STAGE(bufoff, gbase, voff) do { _Pragma("unroll") for (int _i = 0; _i < 2; ++_i) \
        __builtin_amdgcn_global_load_lds((const unsigned*)((const char*)(gbase) + (voff)[_i]), (PG8_LAS unsigned*)(lds + (bufoff) + ldsw + _i * 8192), 16, 0, 0); } while (0)
#define PG8_LDA(dst, b, h) do { _Pragma("unroll") for (int m = 0; m < 4; ++m) _Pragma("unroll") for (int k = 0; k < 2; ++k) dst[m][k] = *(const PG8_LAS bf16x8*)(lds + PG8_SA(b, h) + aoff + m * 2048 + k * 1024); } while (0)
#define PG8_LDB(dst, b, h) do { _Pragma("unroll") for (int n = 0; n < 2; ++n) _Pragma("unroll") for (int k = 0; k < 2; ++k) dst[n][k] = *(const PG8_LAS bf16x8*)(lds + PG8_SB(b, h) + boff + n * 2048 + k * 1024); } while (0)
#define PG8_MMA(ai, bj, At, Bt) do { __builtin_amdgcn_s_setprio(1); _Pragma("unroll") for (int m = 0; m < 4; ++m) _Pragma("unroll") for (int n = 0; n < 2; ++n) _Pragma("unroll") for (int k = 0; k < 2; ++k) \
        acc[ai][bj][m][n] = __builtin_amdgcn_mfma_f32_16x16x32_bf16(Bt[n][k], At[m][k], acc[ai][bj][m][n], 0, 0, 0); __builtin_amdgcn_s_setprio(0); } while (0)
#define PG8_WAIT_V(n) asm volatile("s_waitcnt vmcnt(" #n ")" ::: "memory")
#define PG8_WAIT_L(n) asm volatile("s_waitcnt lgkmcnt(" #n ")" ::: "memory")
#define PG8_BAR __builtin_amdgcn_s_barrier()
#define PG8_SCHED __builtin_amdgcn_sched_barrier(0)
#ifdef GPROBE
    volatile PG8_LAS unsigned long long* pw_ = (volatile PG8_LAS unsigned long long*)(lds + PROBE_LDS_OFF);
#define PG8_NOW() __builtin_amdgcn_s_memrealtime()
#define PG8_PROBE_ON (Epi::PROBE == GPROBE_PHASE && wid == 0 && (tid & 63) == 0)
#endif
    Unit cur, nxt; int ui = 0;
    if (!S.next(0, cur)) return;
    f32x4 acc[2][2][4][2];
#pragma unroll
    for (int a = 0; a < 2; ++a)
#pragma unroll
        for (int b = 0; b < 2; ++b)
#pragma unroll
            for (int m = 0; m < 4; ++m)
#pragma unroll
                for (int n = 0; n < 2; ++n) acc[a][b][m][n] = (f32x4){0.f, 0.f, 0.f, 0.f};
    bf16x8 At[4][2], B0[2][2], B1[2][2];
    const char* cA = (const char*)g.A + (size_t)cur.pm * tstep; const char* cB = (const char*)g.Bt + (size_t)cur.pn * tstep;
    S.a_ready(cur);
    if constexpr (SP2) {
        PG8_STAGE(PG8_SB(0, 0), cB, voffB); PG8_STAGE(PG8_SB(0, 1), cB + hstep, voffB); PG8_STAGE(PG8_SA(0, 0), cA, voffA); PG8_STAGE(PG8_SA(0, 1), cA + hstep, voffA);
        if (wr == 1) PG8_BAR;
        PG8_WAIT_V(2); PG8_BAR;
        PG8_STAGE(PG8_SB(1, 0), cB + kstep, voffB); PG8_STAGE(PG8_SA(1, 0), cA + kstep, voffA); PG8_STAGE(PG8_SB(1, 1), cB + hstep + kstep, voffB);
        PG8_WAIT_V(6); PG8_BAR;
    } else {
        PG8_STAGE(PG8_SB(0, 0), cB, voffB); PG8_STAGE(PG8_SA(0, 0), cA, voffA); PG8_STAGE(PG8_SB(0, 1), cB + hstep, voffB); PG8_STAGE(PG8_SA(0, 1), cA + hstep, voffA);
        if (wr == 1) PG8_BAR;
        PG8_WAIT_V(4); PG8_BAR;
        PG8_STAGE(PG8_SB(1, 0), cB + kstep, voffB); PG8_STAGE(PG8_SA(1, 0), cA + kstep, voffA); PG8_STAGE(PG8_SB(1, 1), cB + hstep + kstep, voffB);
        PG8_WAIT_V(6); PG8_BAR;
    }
    for (;;) {
        const bool has_next = S.next(ui + 1, nxt);
        const char* nA = has_next ? (const char*)g.A + (size_t)nxt.pm * tstep : cA; const char* nB = has_next ? (const char*)g.Bt + (size_t)nxt.pn * tstep : cB;
#ifdef GPROBE
        if (PG8_PROBE_ON) { const unsigned long long n_ = PG8_NOW(); pw_[1] = n_; if (GPROBE == 4 && ui > 0) pw_[0] += n_ - pw_[2]; }
#endif
        for (int t = 0; t < nt; t += 2) {
            const bool last = (t == nt - 2);
            const char* a1 = cA + (size_t)(t + 1) * kstep;
            const char* a2 = last ? nA : cA + (size_t)(t + 2) * kstep; const char* b2 = last ? nB : cB + (size_t)(t + 2) * kstep;
            const char* a3 = a2 + kstep; const char* b3 = b2 + kstep;
            if (last && has_next) S.a_ready(nxt);
            if constexpr (SP2) {
            PG8_LDB(B0, 0, 0); PG8_LDB(B1, 0, 1); PG8_SCHED; PG8_LDA(At, 0, 0); PG8_STAGE(PG8_SA(1, 1), a1 + hstep, voffA);
            PG8_WAIT_V(8); PG8_WAIT_L(0); PG8_BAR; PG8_MMA(0, 0, At, B0); PG8_MMA(0, 1, At, B1); PG8_BAR; PG8_SCHED;
#ifdef GPROBE
            if (GPROBE == 3 && t == 0 && PG8_PROBE_ON) pw_[0] += PG8_NOW() - pw_[1];
#endif
            PG8_LDA(At, 0, 1); PG8_STAGE(PG8_SB(0, 0), b2, voffB); PG8_STAGE(PG8_SB(0, 1), b2 + hstep, voffB); PG8_STAGE(PG8_SA(0, 0), a2, voffA);
            PG8_WAIT_V(8); PG8_WAIT_L(0); PG8_BAR; PG8_MMA(1, 0, At, B0); PG8_MMA(1, 1, At, B1); PG8_BAR; PG8_SCHED;
            PG8_LDB(B0, 1, 0); PG8_LDB(B1, 1, 1); PG8_SCHED; PG8_LDA(At, 1, 0); PG8_STAGE(PG8_SA(0, 1), a2 + hstep, voffA);
            PG8_WAIT_V(8); PG8_WAIT_L(0); PG8_BAR; PG8_MMA(0, 0, At, B0); PG8_MMA(0, 1, At, B1); PG8_BAR; PG8_SCHED;
            PG8_LDA(At, 1, 1); PG8_STAGE(PG8_SB(1, 0), b3, voffB); PG8_STAGE(PG8_SB(1, 1), b3 + hstep, voffB); PG8_STAGE(PG8_SA(1, 0), a3, voffA);
            PG8_WAIT_V(8); PG8_WAIT_L(0); PG8_BAR; PG8_MMA(1, 0, At, B0); PG8_MMA(1, 1, At, B1); PG8_BAR; PG8_SCHED;
            } else {
            PG8_LDB(B0, 0, 0); PG8_SCHED; PG8_LDA(At, 0, 0); PG8_STAGE(PG8_SA(1, 1), a1 + hstep, voffA);
            PG8_WAIT_L(8); PG8_BAR; PG8_WAIT_L(0); PG8_MMA(0, 0, At, B0); PG8_BAR; PG8_SCHED;
            PG8_LDB(B1, 0, 1); PG8_STAGE(PG8_SB(0, 0), b2, voffB);
            PG8_BAR; PG8_WAIT_L(0); PG8_MMA(0, 1, At, B1); PG8_BAR;
            PG8_LDA(At, 0, 1); PG8_STAGE(PG8_SA(0, 0), a2, voffA);
            PG8_BAR; PG8_WAIT_L(0); PG8_MMA(1, 0, At, B0); PG8_BAR; PG8_SCHED;
            PG8_STAGE(PG8_SB(0, 1), b2 + hstep, voffB);
            PG8_WAIT_V(6); PG8_BAR; PG8_MMA(1, 1, At, B1); PG8_BAR;
            PG8_LDB(B0, 1, 0); PG8_SCHED; PG8_LDA(At, 1, 0); PG8_STAGE(PG8_SA(0, 1), a2 + hstep, voffA);
            PG8_WAIT_L(8); PG8_BAR; PG8_WAIT_L(0); PG8_MMA(0, 0, At, B0); PG8_BAR; PG8_SCHED;
            PG8_LDB(B1, 1, 1); PG8_STAGE(PG8_SB(1, 0), b3, voffB);
            PG8_BAR; PG8_WAIT_L(0); PG8_MMA(0, 1, At, B1); PG8_BAR;
            PG8_LDA(At, 1, 1); PG8_STAGE(PG8_SA(1, 0), a3, voffA);
            PG8_BAR; PG8_WAIT_L(0); PG8_MMA(1, 0, At, B0); PG8_BAR; PG8_SCHED;
            PG8_STAGE(PG8_SB(1, 1), b3 + hstep, voffB);
            PG8_WAIT_V(6); PG8_BAR; PG8_MMA(1, 1, At, B1); PG8_BAR;
            }
        }
#ifdef GPROBE
        if ((GPROBE == 0 || GPROBE == 1) && PG8_PROBE_ON) { const unsigned long long n_ = PG8_NOW(); if (GPROBE == 0) pw_[0] += n_ - pw_[1]; pw_[2] = n_; }
#endif
        if constexpr (ALIGN_EPI) { if (wr == 0) PG8_BAR; }
#ifdef GPROBE
        if ((GPROBE == 1 || GPROBE == 2) && PG8_PROBE_ON) { const unsigned long long n_ = PG8_NOW(); if (GPROBE == 1) pw_[0] += n_ - pw_[2]; pw_[2] = n_; }
#endif
        if constexpr (!Epi::AFTER_DRAIN) { E(acc, cur, wr, wc, fr, fq); S.done(cur); }
#ifdef GPROBE
        if ((GPROBE == 2 || GPROBE == 4) && PG8_PROBE_ON) { const unsigned long long n_ = PG8_NOW(); if (GPROBE == 2) pw_[0] += n_ - pw_[2]; pw_[2] = n_; }
#endif
        if (!has_next) break;
#pragma unroll
        for (int a = 0; a < 2; ++a)
#pragma unroll
            for (int b = 0; b < 2; ++b)
#pragma unroll
                for (int m = 0; m < 4; ++m)
#pragma unroll
                    for (int n = 0; n < 2; ++n) acc[a][b][m][n] = (f32x4){0.f, 0.f, 0.f, 0.f};
        cur = nxt; cA = nA; cB = nB; ++ui;
        if constexpr (ALIGN_EPI) { if (wr == 1) PG8_BAR; }
    }
    PG8_WAIT_V(0);
    if constexpr (!ALIGN_EPI) { if (wr == 0) PG8_BAR; }
    PG8_BAR;
    if constexpr (Epi::AFTER_DRAIN) { E.fused(acc, cur, wr, wc, fr, fq, lds, wid, lane); S.done(cur); }
#undef PG8_SA
#undef PG8_SB
#undef PG8_STAGE
#undef PG8_LDA
#undef PG8_LDB
#undef PG8_MMA
#undef PG8_WAIT_V
#undef PG8_WAIT_L
#undef PG8_BAR
#undef PG8_SCHED
}
}
namespace attn_body {
using bf16=__hip_bfloat16;
using bf16x8=__attribute__((ext_vector_type(8)))short;
using s16x4=__attribute__((ext_vector_type(4)))short;
using f32x16=__attribute__((ext_vector_type(16)))float;
using u32x4=__attribute__((ext_vector_type(4)))unsigned;
constexpr int BATCH=16,NHEAD=8,SEQ=2048,D=64,DM=NHEAD*D,DMO=1024;
constexpr int NW=8,QBLK=32,QB=QBLK*NW,KVBLK=64,NQB=SEQ/QB;
constexpr int ATTN_PITCH=DM, ATTN_UNIT_ROWS=QB;
__device__ __forceinline__ int crow(int r,int hi){return (r&3)+8*(r>>2)+4*hi;}
#define SBAR() __builtin_amdgcn_sched_barrier(0)
__device__ __forceinline__ void cmask(f32x16&p0,f32x16&p1,int jb,int qrel,int hi){
  const float NEG=-INFINITY; int kb=64*jb+4*hi;
  #pragma unroll
  for(int r=0;r<16;++r){int kv=kb+(r&3)+8*(r>>2); if(kv>qrel)p0[r]=NEG; if(kv+32>qrel)p1[r]=NEG;}
}

__device__ __forceinline__ void bmask(f32x16&p0,f32x16&p1,unsigned long long mw,int hi){
  const unsigned lo=(unsigned)mw>>(4*hi), up=(unsigned)(mw>>32)>>(4*hi);
  #pragma unroll
  for(int r=0;r<16;++r){ const int ps=(r&3)+8*(r>>2);
    const unsigned x0=(unsigned)__builtin_amdgcn_sbfe((int)lo,ps,1), x1=(unsigned)__builtin_amdgcn_sbfe((int)up,ps,1);
    p0[r]=__uint_as_float((__float_as_uint(p0[r])&x0)|(0xFF800000u&~x0)); p1[r]=__uint_as_float((__float_as_uint(p1[r])&x1)|(0xFF800000u&~x1)); }
}
constexpr int ATTN_PROBE_OFF=153600+448-16;
constexpr int NSLOT=3, SLOTB=8192;
constexpr int LDS_K=0, LDS_V=NSLOT*SLOTB, LDS_WS=2*NSLOT*SLOTB, LDS_OST=LDS_WS+NW*64*4, LDS_MASK=LDS_OST+NW*4096, LDS_BYTES=LDS_MASK+32*256*8;
constexpr float C2=0.125f*1.4426950408889634f;
__device__ __forceinline__ void glds16(const void*gsrc,unsigned lds_dst){unsigned keep;
  asm volatile("s_mov_b32 %0, m0\n\ts_mov_b32 m0, %2\n\ts_nop 0\n\tglobal_load_lds_dwordx4 %1, off\n\ts_mov_b32 m0, %0":"=&s"(keep):"v"(gsrc),"s"(lds_dst):"memory");}
__device__ __forceinline__ float max3f(float a,float b,float c){float r;asm("v_max3_f32 %0, %1, %2, %3":"=v"(r):"v"(a),"v"(b),"v"(c));return r;}
__device__ __forceinline__ float max2f(float a,float b){float r;asm("v_max_f32_e32 %0, %1, %2":"=v"(r):"v"(a),"v"(b));return r;}
__device__ __forceinline__ float fadd_s(float a,float b){float r;asm("v_add_f32_e32 %0, %1, %2":"=v"(r):"v"(a),"v"(b));return r;}
__device__ __forceinline__ float fsub_s(float a,float b){float r;asm("v_sub_f32_e32 %0, %1, %2":"=v"(r):"v"(a),"v"(b));return r;}
typedef float f32x2_t __attribute__((ext_vector_type(2))); typedef __bf16 bf16x2_t __attribute__((ext_vector_type(2)));
__device__ __forceinline__ unsigned cvtpk_s(float lo,float hi){f32x2_t v={lo,hi};bf16x2_t b=__builtin_convertvector(v,bf16x2_t);return __builtin_bit_cast(unsigned,b);}
#define WAIT_BAR(N) asm volatile("s_waitcnt vmcnt(" #N ") lgkmcnt(0)\n\ts_barrier":::"memory")

__device__ __forceinline__ void qkt(f32x16&p0,f32x16&p1,const char*Kslot,const bf16x8*qr,const f32x16&negm,int r32,int hi){
  const char*kb=Kslot+hi*1024+r32*16;
  #pragma unroll
  for(int d0=0;d0<4;++d0){
    const bf16x8 b0=*reinterpret_cast<const bf16x8*>(kb+d0*2048);
    const bf16x8 b1=*reinterpret_cast<const bf16x8*>(kb+d0*2048+512);
    if(d0==0){p0=__builtin_amdgcn_mfma_f32_32x32x16_bf16(b0,qr[0],negm,0,0,0);p1=__builtin_amdgcn_mfma_f32_32x32x16_bf16(b1,qr[0],negm,0,0,0);}
    else{p0=__builtin_amdgcn_mfma_f32_32x32x16_bf16(b0,qr[d0],p0,0,0,0);p1=__builtin_amdgcn_mfma_f32_32x32x16_bf16(b1,qr[d0],p1,0,0,0);}}
}
typedef __attribute__((address_space(3))) const char* lds_cptr;
typedef short v4i16_t __attribute__((ext_vector_type(4)));
__device__ __forceinline__ void kload8(bf16x8*kf,lds_cptr kp){
  kf[0]=*(const __attribute__((address_space(3))) bf16x8*)(kp);      kf[1]=*(const __attribute__((address_space(3))) bf16x8*)(kp+512);
  kf[2]=*(const __attribute__((address_space(3))) bf16x8*)(kp+2048); kf[3]=*(const __attribute__((address_space(3))) bf16x8*)(kp+2560);
  kf[4]=*(const __attribute__((address_space(3))) bf16x8*)(kp+4096); kf[5]=*(const __attribute__((address_space(3))) bf16x8*)(kp+4608);
  kf[6]=*(const __attribute__((address_space(3))) bf16x8*)(kp+6144); kf[7]=*(const __attribute__((address_space(3))) bf16x8*)(kp+6656);
}
__device__ __forceinline__ void kload2(bf16x8*kf,lds_cptr kp,int j){ kf[2*j]=*(const __attribute__((address_space(3))) bf16x8*)(kp+j*2048); kf[2*j+1]=*(const __attribute__((address_space(3))) bf16x8*)(kp+j*2048+512); }
__device__ __forceinline__ s16x4 vtr(lds_cptr p){ return __builtin_bit_cast(s16x4,__builtin_amdgcn_ds_read_tr16_b64_v4i16((__attribute__((address_space(3))) v4i16_t*)p)); }
__device__ __forceinline__ float rowmax(const f32x16&p0,const f32x16&p1){
  float a=max3f(p0[0],p0[1],p1[0]),b=max3f(p0[2],p0[3],p1[1]);a=max3f(a,p1[2],p1[3]);
  #pragma unroll
  for(int r=4;r<16;r+=4){a=max3f(a,p0[r],p0[r+1]);b=max3f(b,p0[r+2],p0[r+3]);a=max3f(a,p1[r],p1[r+1]);b=max3f(b,p1[r+2],p1[r+3]);}
  const float m=max2f(a,b);
  auto rr=__builtin_amdgcn_permlane32_swap(__float_as_uint(m),__float_as_uint(m),false,false);
  return max2f(__uint_as_float(rr[0]),__uint_as_float(rr[1]));
}
__device__ __forceinline__ void pv(f32x16*o,int vb,bf16x8 pa0,bf16x8 pa1,bf16x8 pa2,bf16x8 pa3){
  #pragma unroll
  for(int d0=0;d0<2;++d0){s16x4 lo[4],hi[4];
    #pragma unroll
    for(int ks=0;ks<4;++ks){
      asm volatile("ds_read_b64_tr_b16 %0,%1 offset:%c2":"=&v"(lo[ks]):"v"(vb),"i"(d0*4096+ks*1024):"memory");
      asm volatile("ds_read_b64_tr_b16 %0,%1 offset:%c2":"=&v"(hi[ks]):"v"(vb),"i"(d0*4096+ks*1024+512):"memory");}
    asm volatile("s_waitcnt lgkmcnt(0)":::"memory");SBAR();
    #define PK(k) (bf16x8){lo[k][0],lo[k][1],lo[k][2],lo[k][3],hi[k][0],hi[k][1],hi[k][2],hi[k][3]}
    o[d0]=__builtin_amdgcn_mfma_f32_32x32x16_bf16(pa0,PK(0),o[d0],0,0,0);
    o[d0]=__builtin_amdgcn_mfma_f32_32x32x16_bf16(pa1,PK(1),o[d0],0,0,0);
    o[d0]=__builtin_amdgcn_mfma_f32_32x32x16_bf16(pa2,PK(2),o[d0],0,0,0);
    o[d0]=__builtin_amdgcn_mfma_f32_32x32x16_bf16(pa3,PK(3),o[d0],0,0,0);
    #undef PK
  }
}

#ifndef ATTN_STORE16
#define ATTN_STORE16(p,v) (*(u32x4*)(p)=(v))
#endif
template<int THRL> __device__ __forceinline__ void attn_unit(int b,int h,int qb,const bf16*Q,const bf16*__restrict__ K,const bf16*__restrict__ V,bf16*O,const u32x4*__restrict__ MaskG,const float*__restrict__ gain,char*shm,int tid_in){
  int tid_o=tid_in; asm volatile("":"+v"(tid_o)); const int tid=tid_o,lane=tid&63,r32=lane&31,hi=lane>>5; const int wid=__builtin_amdgcn_readfirstlane(tid>>6);
  const long rowbase=(long)b*SEQ; const int q0=qb*QB;
#ifdef GPROBE
  volatile __attribute__((address_space(3))) unsigned long long* apw_=(volatile __attribute__((address_space(3))) unsigned long long*)((__attribute__((address_space(3))) char*)shm+ATTN_PROBE_OFF);
  const bool apon_=(blockIdx.x==0&&wid==0&&lane==0);
  if(apon_)apw_[1]=__builtin_amdgcn_s_memrealtime();
#endif
  const bf16*Qw=Q+(rowbase+q0+wid*QBLK)*DM+h*D;
  const bf16*Kh=K+rowbase*DM+h*D,*Vh=V+rowbase*DM+h*D;
  const unsigned lds0=(unsigned)(uintptr_t)shm;
  float*wsf=(float*)(shm+LDS_WS)+wid*64;
  const bf16*ksrc=Kh+(long)lane*DM+wid*8;
  const bf16*vsrc=Vh+(long)(16*(wid&3)+(lane>>2))*DM+(wid>>2)*32+(lane&3)*8;
  const unsigned kdst=lds0+LDS_K+wid*1024, vdst=lds0+LDS_V+wid*1024;
  #define DMA_K(t,slot) glds16(ksrc+(long)(t)*KVBLK*DM,(unsigned)__builtin_amdgcn_readfirstlane(kdst+(slot)))
  #define DMA_V(t,slot) glds16(vsrc+(long)(t)*KVBLK*DM,(unsigned)__builtin_amdgcn_readfirstlane(vdst+(slot)))
  const int vb0=(int)(lds0+LDS_V)+((lane>>4)&1)*32+(lane&3)*8+(4*hi+((lane&15)>>2))*64;
  const char*Kbase=shm+LDS_K; bf16x8 kf[8];
  const lds_cptr shm3=(lds_cptr)shm; const lds_cptr kp0=shm3+LDS_K+hi*1024+r32*16; const lds_cptr vp0=shm3+LDS_V+((lane>>4)&1)*32+(lane&3)*8+(4*hi+((lane&15)>>2))*64;
  const int NT=(q0+QB)/KVBLK;
  DMA_K(0,0);DMA_V(0,0);DMA_K(1,SLOTB);
  bf16x8 qr[4];
  #pragma unroll
  for(int d0=0;d0<4;++d0)qr[d0]=*reinterpret_cast<const bf16x8*>(&Qw[(long)r32*DM+d0*16+hi*8]);
  { const u32x4*mg=MaskG+(long)(b*NQB+qb)*32*128;
    const unsigned mdst=lds0+LDS_MASK+wid*1024;
    _Pragma("unroll") for(int k=0;k<8;++k){ if(4*k<NT) glds16(mg+tid+NW*64*k,(unsigned)__builtin_amdgcn_readfirstlane(mdst+8192*k)); } }
  float mhat=0.f,l_reg=0.f;f32x16 o[2];o[0]=f32x16{};o[1]=f32x16{};f32x16 negm=f32x16{};asm volatile("":"+v"(negm));
  const int qrel=wid*QBLK+r32;
  const lds_cptr mkp=(lds_cptr)shm+LDS_MASK+qrel*8;
  unsigned long long mwn=0ull;
  #define CMASK(P0,P1,t) do{ bmask(P0,P1,mwn,hi); mwn=*(const __attribute__((address_space(3))) unsigned long long*)(mkp+((t)+1)*2048); }while(0)
  bool resc=false;
  #define START(P0,P1) do{ const float rm=rowmax(P0,P1); resc=false; \
    { const float dl=max2f(rm,-256.f); mhat=fadd_s(mhat,dl); \
      _Pragma("unroll") for(int r=0;r<16;++r){P0[r]=fsub_s(P0[r],dl);P1[r]=fsub_s(P1[r],dl);} \
      _Pragma("unroll") for(int r=0;r<16;++r)negm[r]=-mhat; asm volatile("":"+v"(negm)); } \
    _Pragma("unroll") for(int r=0;r<16;++r)P0[r]=__builtin_amdgcn_exp2f(P0[r]); }while(0)
  #define RESC() do{ if(resc){ asm volatile("s_waitcnt lgkmcnt(0)":::"memory"); \
      _Pragma("unroll") for(int d_=0;d_<2;++d_) _Pragma("unroll") for(int r=0;r<16;++r)o[d_][r]*=wsf[crow(r,hi)]; } }while(0)
  f32x16 pA0,pA1,pB0,pB1;
  if(wid>=4)__builtin_amdgcn_s_setprio(1);
  int sl_prev=0,sl_cur=0,sl_next=SLOTB;
  #define ROT() do{sl_prev=sl_cur;sl_cur=sl_next;sl_next=(sl_next==(NSLOT-1)*SLOTB)?0:sl_next+SLOTB;}while(0)
  DMA_K(2,2*SLOTB);
  WAIT_BAR(1);
#ifdef GPROBE
  if(apon_){const unsigned long long n_=__builtin_amdgcn_s_memrealtime(); if(GPROBE==10)apw_[0]+=n_-apw_[1]; apw_[1]=n_;}
#endif
  mwn=*(const __attribute__((address_space(3))) unsigned long long*)(mkp);
  qkt(pA0,pA1,Kbase,qr,negm,r32,hi);asm volatile("s_nop 15\n\ts_nop 7":"+v"(pA0),"+v"(pA1));CMASK(pA0,pA1,0);
  START(pA0,pA1);
  _Pragma("unroll") for(int r=0;r<16;++r)pA1[r]=__builtin_amdgcn_exp2f(pA1[r]);
  WAIT_BAR(0);
  DMA_K(3,0);DMA_V(1,SLOTB);
  ROT();
  kload8(kf,kp0+sl_cur);
  WAIT_BAR(2);
  s16x4 vlo[8],vhi[8]; u32x4 pw0,pw1,pw2,pw3;
  #define PKW(P,B) cvtpk_s(P[B],P[B+1])
  #define PAF(k) __builtin_bit_cast(bf16x8,pw##k)
  #define VFR(i) (bf16x8){vlo[i][0],vlo[i][1],vlo[i][2],vlo[i][3],vhi[i][0],vhi[i][1],vhi[i][2],vhi[i][3]}
  #define PIN(x) asm volatile("":"+v"(x))
  #define MX3(a,b,c) __builtin_fmaxf(__builtin_fmaxf((a),(b)),(c))
  #define GAPA(MF,A0,A1,A2,A3,W0,W1,PW) do{ MF; sacc+=A0; sacc+=A1; sacc+=A2; sacc+=A3; PIN(sacc); W0; W1; PIN(PW); SBAR(); }while(0)
  #define EX(v) __builtin_amdgcn_exp2f(v)
  #define GAPB(MF,X,B) do{ MF; X[B]=EX(X[B]); X[B+1]=EX(X[B+1]); X[B+2]=EX(X[B+2]); X[B+3]=EX(X[B+3]); PIN(X); SBAR(); }while(0)
  #define VRD(i) do{ vlo[i]=vtr(vp_+(((i)>>2)*4096+((i)&3)*1024)); vhi[i]=vtr(vp_+(((i)>>2)*4096+((i)&3)*1024+512)); }while(0)
  #define KRD(G,j) do{ if(G){ kload2(kf,kp0+sl_next,j); SBAR(); } }while(0)
  #define STEP(C0,C1,P0,P1,t,GK,GV,GL) do{ SBAR(); \
    const lds_cptr vp_=vp0+sl_prev; \
    VRD(0); SBAR(); float sacc=(P0[0]+P0[1]); \
    GAPA(C0=__builtin_amdgcn_mfma_f32_32x32x16_bf16(kf[0],qr[0],negm,0,0,0), P0[2],P0[3],P0[4],P0[5],     pw0[0]=PKW(P0,0), pw0[1]=PKW(P0,2), pw0); \
    VRD(4); SBAR(); GAPA(C1=__builtin_amdgcn_mfma_f32_32x32x16_bf16(kf[1],qr[0],negm,0,0,0), P0[6],P0[7],P0[8],P0[9],     pw0[2]=PKW(P0,4), pw0[3]=PKW(P0,6), pw0); \
    VRD(1); SBAR(); GAPA(C0=__builtin_amdgcn_mfma_f32_32x32x16_bf16(kf[2],qr[1],C0,0,0,0),   P0[10],P0[11],P0[12],P0[13], pw1[0]=PKW(P0,8), pw1[1]=PKW(P0,10), pw1); \
    VRD(5); SBAR(); GAPA(C1=__builtin_amdgcn_mfma_f32_32x32x16_bf16(kf[3],qr[1],C1,0,0,0),   P0[14],P0[15],P1[0],P1[1],   pw1[2]=PKW(P0,12),pw1[3]=PKW(P0,14), pw1); \
    VRD(2); SBAR(); GAPA(C0=__builtin_amdgcn_mfma_f32_32x32x16_bf16(kf[4],qr[2],C0,0,0,0),   P1[2],P1[3],P1[4],P1[5],     pw2[0]=PKW(P1,0), pw2[1]=PKW(P1,2), pw2); \
    VRD(6); SBAR(); GAPA(C1=__builtin_amdgcn_mfma_f32_32x32x16_bf16(kf[5],qr[2],C1,0,0,0),   P1[6],P1[7],P1[8],P1[9],     pw2[2]=PKW(P1,4), pw2[3]=PKW(P1,6), pw2); \
    VRD(3); SBAR(); GAPA(C0=__builtin_amdgcn_mfma_f32_32x32x16_bf16(kf[6],qr[3],C0,0,0,0),   P1[10],P1[11],P1[12],P1[13], pw3[0]=PKW(P1,8), pw3[1]=PKW(P1,10), pw3); \
    VRD(7); SBAR(); GAPA(C1=__builtin_amdgcn_mfma_f32_32x32x16_bf16(kf[7],qr[3],C1,0,0,0),   P1[14],P1[15],0.f,0.f,       pw3[2]=PKW(P1,12),pw3[3]=PKW(P1,14), pw3); \
    l_reg+=sacc; \
    if(GK){DMA_K((t)+3,sl_cur);} if(GV){DMA_V((t)+1,sl_next);} \
    CMASK(C0,C1,t); \
    { float a=MX3(C0[0],C0[1],C1[0]),b=MX3(C0[2],C0[3],C1[1]); a=MX3(a,C1[2],C1[3]); \
      _Pragma("unroll") for(int r=4;r<16;r+=4){a=MX3(a,C0[r],C0[r+1]);b=MX3(b,C0[r+2],C0[r+3]);a=MX3(a,C1[r],C1[r+1]);b=MX3(b,C1[r+2],C1[r+3]);} \
      float rm=__builtin_fmaxf(a,b); { auto rr=__builtin_amdgcn_permlane32_swap(__float_as_uint(rm),__float_as_uint(rm),false,false); rm=__builtin_fmaxf(__uint_as_float(rr[0]),__uint_as_float(rr[1])); } \
      resc=false; \
      if(__builtin_expect(__any(rm>(float)THRL),0)){ const float dl=__builtin_fmaxf(rm,0.f); mhat+=dl; \
        _Pragma("unroll") for(int r=0;r<16;++r){C0[r]-=dl;C1[r]-=dl;} \
        _Pragma("unroll") for(int r=0;r<16;++r)negm[r]=-mhat; asm volatile("":"+v"(negm)); \
        const float f=__builtin_amdgcn_exp2f(-dl); l_reg*=f; if(hi==0)wsf[r32]=f; resc=true; } } \
    SBAR(); \
    GAPB(o[0]=__builtin_amdgcn_mfma_f32_32x32x16_bf16(PAF(0),VFR(0),o[0],0,0,0), C0,0); \
    GAPB(o[1]=__builtin_amdgcn_mfma_f32_32x32x16_bf16(PAF(0),VFR(4),o[1],0,0,0), C0,4); \
    KRD(GL,0); GAPB(o[0]=__builtin_amdgcn_mfma_f32_32x32x16_bf16(PAF(1),VFR(1),o[0],0,0,0), C0,8); \
    KRD(GL,1); GAPB(o[1]=__builtin_amdgcn_mfma_f32_32x32x16_bf16(PAF(1),VFR(5),o[1],0,0,0), C0,12); \
    KRD(GL,2); GAPB(o[0]=__builtin_amdgcn_mfma_f32_32x32x16_bf16(PAF(2),VFR(2),o[0],0,0,0), C1,0); \
    KRD(GL,3); GAPB(o[1]=__builtin_amdgcn_mfma_f32_32x32x16_bf16(PAF(2),VFR(6),o[1],0,0,0), C1,4); \
    GAPB(o[0]=__builtin_amdgcn_mfma_f32_32x32x16_bf16(PAF(3),VFR(3),o[0],0,0,0), C1,8); \
    GAPB(o[1]=__builtin_amdgcn_mfma_f32_32x32x16_bf16(PAF(3),VFR(7),o[1],0,0,0), C1,12); \
    }while(0)
  int t=1;
  for(;t+5<NT;t+=2){
    STEP(pB0,pB1,pA0,pA1,t,true,true,true);     WAIT_BAR(2); RESC(); ROT();
    STEP(pA0,pA1,pB0,pB1,t+1,true,true,true);   WAIT_BAR(2); RESC(); ROT();
  }
  #define ENDW(tt) do{ if((tt)+3<NT){WAIT_BAR(2);} else if((tt)+2<NT){WAIT_BAR(1);} else {WAIT_BAR(0);} }while(0)
  for(;t+1<NT;t+=2){
    STEP(pB0,pB1,pA0,pA1,t,(t+3<NT),(t+1<NT),(t+1<NT));       ENDW(t);   RESC(); ROT();
    STEP(pA0,pA1,pB0,pB1,t+1,(t+4<NT),(t+2<NT),(t+2<NT));     ENDW(t+1); RESC(); ROT();
  }
  STEP(pB0,pB1,pA0,pA1,NT-1,false,false,false); RESC();
  { float sacc=pB0[0]+pB0[1]; _Pragma("unroll") for(int r=2;r<16;++r)sacc+=pB0[r]; _Pragma("unroll") for(int r=0;r<16;++r)sacc+=pB1[r]; l_reg+=sacc;
    pw0=(u32x4){PKW(pB0,0),PKW(pB0,2),PKW(pB0,4),PKW(pB0,6)};pw1=(u32x4){PKW(pB0,8),PKW(pB0,10),PKW(pB0,12),PKW(pB0,14)};pw2=(u32x4){PKW(pB1,0),PKW(pB1,2),PKW(pB1,4),PKW(pB1,6)};pw3=(u32x4){PKW(pB1,8),PKW(pB1,10),PKW(pB1,12),PKW(pB1,14)};
    SBAR(); pv(o,vb0+sl_cur,PAF(0),PAF(1),PAF(2),PAF(3)); }
  #undef PKW
  #undef PAF
  #undef VFR
  #undef PIN
  #undef MX3
  #undef GAPA
  #undef GAPB
  #undef EX
  #undef VRD
  #undef KRD
  #undef STEP
  #undef ENDW
  __builtin_amdgcn_s_setprio(0);
#ifdef GPROBE
  if(apon_){const unsigned long long n_=__builtin_amdgcn_s_memrealtime(); if(GPROBE==11)apw_[0]+=n_-apw_[1]; apw_[1]=n_;}
#endif
  float gn[8];
  #pragma unroll
  for(int e=0;e<8;++e)gn[e]=gain[h*D+(lane&7)*8+e];
  {auto rr=__builtin_amdgcn_permlane32_swap(__float_as_uint(l_reg),__float_as_uint(l_reg),false,false);l_reg=__uint_as_float(rr[0])+__uint_as_float(rr[1]);}
  if(hi==0)wsf[32+r32]=l_reg;asm volatile("s_waitcnt lgkmcnt(0)":::"memory");
  float rli[16];
  #pragma unroll
  for(int r=0;r<16;++r)rli[r]=__builtin_amdgcn_rcpf(wsf[32+crow(r,hi)]);
  bf16*Ow=O+(rowbase+q0+wid*QBLK)*DMO+h*D;
  { bf16*stg=(bf16*)(shm+LDS_OST)+wid*2048;
    #pragma unroll
    for(int r=0;r<16;++r){const int orow=crow(r,hi);
      #pragma unroll
      for(int d0=0;d0<2;++d0)stg[orow*64+d0*32+r32]=__float2bfloat16(o[d0][r]*rli[r]);}
    asm volatile("s_waitcnt lgkmcnt(0)":::"memory");
    #pragma unroll
    for(int i=0;i<4;++i){const int row=i*8+(lane>>3),ch=lane&7; const u32x4 v=*(const u32x4*)(stg+row*64+ch*8);
      float f[8]; f[0]=__uint_as_float(v.x<<16);f[1]=__uint_as_float(v.x&0xffff0000u);f[2]=__uint_as_float(v.y<<16);f[3]=__uint_as_float(v.y&0xffff0000u);
      f[4]=__uint_as_float(v.z<<16);f[5]=__uint_as_float(v.z&0xffff0000u);f[6]=__uint_as_float(v.w<<16);f[7]=__uint_as_float(v.w&0xffff0000u);
      float ss=0.f;
      #pragma unroll
      for(int e=0;e<8;++e)ss+=f[e]*f[e];
      ss+=__int_as_float(__builtin_amdgcn_update_dpp(0,__float_as_int(ss),0xB1,0xf,0xf,false));
      ss+=__int_as_float(__builtin_amdgcn_update_dpp(0,__float_as_int(ss),0x4E,0xf,0xf,false));
      ss+=__int_as_float(__builtin_amdgcn_update_dpp(0,__float_as_int(ss),0x141,0xf,0xf,false));
      const float rs=rsqrtf(ss*(1.f/64.f)+1e-6f);
      u32x4 w; w.x=cvtpk_s(f[0]*rs*gn[0],f[1]*rs*gn[1]); w.y=cvtpk_s(f[2]*rs*gn[2],f[3]*rs*gn[3]); w.z=cvtpk_s(f[4]*rs*gn[4],f[5]*rs*gn[5]); w.w=cvtpk_s(f[6]*rs*gn[6],f[7]*rs*gn[7]);
      ATTN_STORE16(Ow+(long)row*DMO+ch*8,w);} }
  asm volatile("s_waitcnt lgkmcnt(0)\n\ts_barrier":::"memory");
#ifdef GPROBE
  if(apon_){const unsigned long long n_=__builtin_amdgcn_s_memrealtime(); if(GPROBE==12)apw_[0]+=n_-apw_[1];}
#endif
  #undef DMA_K
  #undef DMA_V
  #undef CMASK
  #undef START
  #undef RESC
  #undef ROT
}
constexpr int ATTN_LDS_BYTES=LDS_BYTES;
struct AttnTensors { const bf16* Q; const bf16* K; const bf16* V; bf16* O; const u32x4* Mask; const float* gain; };
struct AttnUnit { int bh; int qb; };
struct StaticOrder {
  int vcu, G;
  __device__ __forceinline__ explicit StaticOrder(int grid,int block):vcu((grid%8==0)?(block%8)*(grid/8)+block/8:block),G(grid){}
  __device__ __forceinline__ bool next(int i,AttnUnit&u)const{
    if(G==256){ if(i>=4)return false; const int s=vcu&1; u.bh=vcu>>1; u.qb=(i==0)?s:(i==1)?7-s:(i==2)?3-s:4+s; return true; }
    const int L=i*G+vcu; if(L>=BATCH*NHEAD*NQB)return false; u.bh=L/NQB; u.qb=L%NQB; return true; }
  __device__ __forceinline__ void a_ready(const AttnUnit&)const{}
  __device__ __forceinline__ void done(const AttnUnit&)const{}
};
template<class Sched,int THRL=8> __device__ __forceinline__ void attn_phase(char*lds,const AttnTensors&T,const Sched&S,int tid_in){
  AttnUnit u;
  for(int i=0;S.next(i,u);++i){ S.a_ready(u); attn_unit<THRL>(u.bh/NHEAD,u.bh%NHEAD,u.qb,T.Q,T.K,T.V,T.O,T.Mask,T.gain,lds,tid_in); S.done(u); }
}
#undef SBAR
#undef WAIT_BAR
}

constexpr int NWAVES = 8;
#ifndef MK_ONE_LAUNCH
#define MK_ONE_LAUNCH 1
#endif
constexpr int BATCH = 16, SEQ = 2048, D = 1024, M = BATCH * SEQ, DEPTH = 2;
constexpr int NIN = 3408, NINP = 3584, QRK = 256, FF = 2816, NMOD = 6 * D;
constexpr float EPS = 1e-6f;
constexpr int N_PHASES = 2 + 9 * DEPTH;

constexpr size_t MiB = 1u << 20;
constexpr size_t WS_CTL = 0, CTL_ZERO_BYTES = 64 * 1024;
constexpr size_t WS_MOD = 1 * MiB;
constexpr size_t WS_SSQ = 2 * MiB;
constexpr size_t WS_W = 3 * MiB, W_LAYER = 26 * MiB;
constexpr size_t WO_IN = 0, WO_Q = 7 * MiB, WO_OUT = 7 * MiB + 512 * 1024, WO_GU = 9 * MiB + 512 * 1024, WO_DN = 20 * MiB + 512 * 1024;
constexpr size_t WS_XN = 56 * MiB;
constexpr size_t WS_MIX = 120 * MiB;
constexpr size_t MX_CQ = 0, MX_K = 16 * MiB, MX_V = 48 * MiB, MX_KI = 80 * MiB, MX_WI = 84 * MiB, MX_IG = 85 * MiB, MX_LF = 85 * MiB + 512 * 1024, MX_QM = 86 * MiB, MX_KM = 118 * MiB, MX_VM = 150 * MiB,
                 MX_OM = 182 * MiB, MX_Q = 214 * MiB, MX_QI = 246 * MiB, MX_MASK = 278 * MiB, MX_CL = 286 * MiB, MX_KC = 352 * MiB, MX_H = 0, MX_Y = 192 * MiB, MX_END = 384 * MiB;
constexpr size_t MXS_CQ = 16 * MiB, MXS_K = 32 * MiB, MXS_V = 32 * MiB, MXS_KI = 4 * MiB, MXS_WI = 1 * MiB, MXS_IG = MiB / 2, MXS_LF = MiB / 2, MXS_QM = 32 * MiB, MXS_KM = 32 * MiB, MXS_VM = 32 * MiB, MXS_OM = 32 * MiB,
                 MXS_Q = 32 * MiB, MXS_QI = 32 * MiB, MXS_MASK = 8 * MiB, MXS_CL = (size_t)2048 * 129 * 128 * 2, MXS_KC = 32 * MiB, MXS_H = (size_t)M * FF * 2, MXS_Y = (size_t)M * D * 2, MX_SLAB = MX_END / BATCH;
__device__ __forceinline__ long long mx_shift(size_t off, size_t sz, int gx) {
    const int v = (gx < 0) ? 0 : gx * (int)(MX_SLAB - sz / BATCH) + (int)((long long)(off / BATCH) - (long long)off);
    return (long long)__builtin_amdgcn_readfirstlane(v); }
static_assert(MX_KC / BATCH + MXS_KC / BATCH <= MX_SLAB && MX_CL / BATCH + MXS_CL / BATCH <= MX_KC / BATCH && MX_Y / BATCH + MXS_Y / BATCH <= MX_CL / BATCH && MXS_H / BATCH <= MX_Y / BATCH && MX_MASK / BATCH + MXS_MASK / BATCH <= MX_CL / BATCH && MXS_CL % BATCH == 0, "slab map");
constexpr size_t WS_END = WS_MIX + MX_END;
static_assert(WO_DN + (size_t)D * FF * 2 <= W_LAYER && WS_W + DEPTH * W_LAYER <= WS_XN && WS_XN + (size_t)M * D * 2 <= WS_MIX && (size_t)M * FF * 2 <= MX_Y && MX_Y + (size_t)M * D * 2 <= MX_CL && MX_CL + (size_t)2048 * 129 * 128 * 2 <= MX_KC && MX_KC + (size_t)2048 * 64 * 128 * 2 <= MX_END, "d_ws map");
constexpr int CW_TICKET = 8192;
constexpr int CW_LOC = 12288;
constexpr int CW_BAR = 4096;

constexpr int RING_BYTES = 153600;
constexpr int LDSCTL_OFF = RING_BYTES, LDS_BYTES = LDSCTL_OFF + 512;
static_assert(pg8::STAGE_BYTES <= RING_BYTES && attn_body::ATTN_LDS_BYTES <= RING_BYTES && LDS_BYTES <= 160 * 1024, "LDS map");

#define GAS __attribute__((address_space(1)))
#define LAS __attribute__((address_space(3)))
typedef unsigned short bf16;
typedef unsigned v4u __attribute__((ext_vector_type(4)));
typedef float f32x4 __attribute__((ext_vector_type(4)));
typedef short bf16x8 __attribute__((ext_vector_type(8)));
typedef GAS unsigned gu32;
typedef GAS unsigned long long gu64;
#define RLX_AGENT __ATOMIC_RELAXED, __HIP_MEMORY_SCOPE_AGENT
#define LDS_WAIT() asm volatile("s_waitcnt lgkmcnt(0)" ::: "memory")
#define VM_WAIT() asm volatile("s_waitcnt vmcnt(0)" ::: "memory")
__device__ __forceinline__ unsigned long long rt() { return __builtin_amdgcn_s_memrealtime(); }
__device__ __forceinline__ unsigned f2bf(float f) { unsigned u = __builtin_bit_cast(unsigned, f); return (u + 0x7fffu + ((u >> 16) & 1u)) >> 16; }
typedef float pk2_f2_t __attribute__((ext_vector_type(2))); typedef __bf16 pk2_b2_t __attribute__((ext_vector_type(2)));
__device__ __forceinline__ unsigned pk2(float lo, float hi) { const pk2_f2_t v = {lo, hi}; const pk2_b2_t b = __builtin_convertvector(v, pk2_b2_t); return __builtin_bit_cast(unsigned, b); }

#define XB_TMO      128
#define XB_XCNT(j)  (256  + 64 * (j))
#define XB_XSUB(j)  (1280 + 64 * (j))
#define XB_XGEN(j)  (2304 + 64 * (j))
#define XB_TOP      3328
#define XB_TOPGEN   3392
#define XCD_BAR_WORDS 3456
#define XB_SPIN_CAP (1u << 18)

__device__ __forceinline__ unsigned xb_ld(unsigned* p)              { return __hip_atomic_load(p, __ATOMIC_RELAXED, __HIP_MEMORY_SCOPE_AGENT); }
__device__ __forceinline__ unsigned xb_add(unsigned* p, unsigned v) { return __hip_atomic_fetch_add(p, v, __ATOMIC_RELAXED, __HIP_MEMORY_SCOPE_AGENT); }
__device__ __forceinline__ unsigned xb_xcc_id() { return (unsigned)__builtin_amdgcn_s_getreg((3 << 11) | 20) & 0xFu; }
#define XB_SPIN(cond, bar) do { unsigned _sp = 0; while (cond) { __builtin_amdgcn_s_sleep(1); \
    if ((++_sp & 255u) == 0u) { if (xb_ld(&(bar)[XB_TMO])) break; if (_sp > XB_SPIN_CAP) { atomicAdd(&(bar)[XB_TMO], 1u); break; } } } } while (0)

struct XcdBarrier {
    unsigned* bar; unsigned x;
    volatile LAS unsigned* st;
};

__device__ __forceinline__ XcdBarrier xcd_barrier_post(unsigned* bar, volatile LAS unsigned* st) {
    XcdBarrier b; b.bar = bar; b.x = xb_xcc_id(); b.st = st;
    if (threadIdx.x == 0) (void)xb_add(&bar[XB_XCNT(b.x)], 1u);
    return b;
}
__device__ __forceinline__ void xcd_barrier_complete(unsigned* bar, unsigned x, unsigned& nloc, unsigned& nx) {
    const unsigned G = gridDim.x * gridDim.y * gridDim.z;
    unsigned sum, cnt, mine, sp = 0u;
    for (;;) {
        sum = 0u; cnt = 0u; mine = 0u;
#pragma unroll
        for (unsigned j = 0; j < 16; ++j) { const unsigned c = xb_ld(&bar[XB_XCNT(j)]); sum += c; cnt += (c > 0u) ? 1u : 0u; mine = (j == x) ? c : mine; }
        if (sum == G) break;
        __builtin_amdgcn_s_sleep(1);
        if ((++sp & 255u) == 0u) { if (xb_ld(&bar[XB_TMO])) break; if (sp > XB_SPIN_CAP) { atomicAdd(&bar[XB_TMO], 1u); break; } }
    }
    nloc = mine > 0u ? mine : 1u; nx = cnt > 0u ? cnt : 1u;
}

__device__ __forceinline__ void xcd_barrier(const XcdBarrier& b, bool t0) {
    asm volatile("s_waitcnt vmcnt(0)" ::: "memory");
    __syncthreads();
    if (t0) {
        unsigned* bar = b.bar;
        const unsigned bx = xb_xcc_id();
        __builtin_amdgcn_s_waitcnt(0);
        unsigned nloc = b.st[0], nx = b.st[1];
        if (nloc == 0u) { xcd_barrier_complete(bar, bx, nloc, nx); b.st[0] = nloc; b.st[1] = nx; }
        const unsigned old = xb_add(&bar[XB_XSUB(bx)], 1u);
        const unsigned gen = old / nloc;
        if (old + 1u == (gen + 1u) * nloc) {
            __builtin_amdgcn_fence(__ATOMIC_RELEASE, "agent");
            asm volatile("s_waitcnt vmcnt(0)" ::: "memory");
            const unsigned og = xb_add(&bar[XB_TOP], 1u);
            const unsigned tg = og / nx;
            if (og + 1u == (tg + 1u) * nx) xb_add(&bar[XB_TOPGEN], 1u);
            else XB_SPIN(xb_ld(&bar[XB_TOPGEN]) == tg, bar);
            __builtin_amdgcn_fence(__ATOMIC_ACQUIRE, "agent");
            xb_add(&bar[XB_XGEN(bx)], 1u);
            asm volatile("s_waitcnt vmcnt(0)" ::: "memory");
        } else {
            XB_SPIN(xb_ld(&bar[XB_XGEN(bx)]) == gen, bar);
            __builtin_amdgcn_fence(__ATOMIC_ACQUIRE, "agent");
            asm volatile("s_waitcnt vmcnt(0)" ::: "memory");
        }
    }
    __syncthreads();
}

__device__ __forceinline__ void xcd_local_barrier(unsigned* cnt, unsigned* genw, unsigned nmemb, unsigned* tmo_bar, bool t0) {
    asm volatile("s_waitcnt vmcnt(0)" ::: "memory");
    __syncthreads();
    if (t0) {
        __builtin_amdgcn_s_waitcnt(0);
        const unsigned old = xb_add(cnt, 1u), gen = old / nmemb;
        if (old + 1u == (gen + 1u) * nmemb) (void)xb_add(genw, 1u);
        else XB_SPIN(xb_ld(genw) == gen, tmo_bar);
        __builtin_amdgcn_fence(__ATOMIC_ACQUIRE, "agent");
        asm volatile("s_waitcnt vmcnt(0)" ::: "memory");
    }
    __syncthreads();
}

typedef float f32x16 __attribute__((ext_vector_type(16)));
typedef unsigned u32x2 __attribute__((ext_vector_type(2)));
__device__ __forceinline__ float wave_sum(float v) {
#define WS_STEP(ctrl, rm) v += __int_as_float(__builtin_amdgcn_update_dpp(0, __float_as_int(v), ctrl, rm, 0xf, false))
    WS_STEP(0x111, 0xf); WS_STEP(0x112, 0xf); WS_STEP(0x114, 0xf); WS_STEP(0x118, 0xf); WS_STEP(0x142, 0xa); WS_STEP(0x143, 0xc);
#undef WS_STEP
    return __int_as_float(__builtin_amdgcn_readlane(__float_as_int(v), 63));
}
__device__ __forceinline__ float bf_lo(unsigned u) { return __uint_as_float(u << 16); }
__device__ __forceinline__ float bf_hi(unsigned u) { return __uint_as_float(u & 0xffff0000u); }
__device__ __forceinline__ float sigmoid_f(float g) { return __builtin_amdgcn_rcpf(1.f + __builtin_amdgcn_exp2f(-1.4426950408889634f * g)); }
__device__ __forceinline__ float silu_f(float g) { return g * sigmoid_f(g); }
__device__ __forceinline__ int ropeperm(int p) { const int j = p >> 3, e = p & 7; return (e < 4) ? 4 * j + e : 32 + 4 * j + (e - 4); }

__device__ __forceinline__ void conv_item(int kind, const float* W0, const float* W1, const float* gain, int K, int Nphys, bf16* WT, LAS float* scr, int item, int lane) {
    const int nblk = Nphys / 32, kb = item / nblk, nb = item % nblk, k0 = 64 * kb, n0 = 32 * nb;
    const int n = n0 + (lane & 31);
    const float* src = W0; int ld = Nphys, col = n;
    if (kind == 1) {
        ld = NIN; const int tile = n >> 8, r = n & 255;
        if (tile == 0) col = r;
        else if (tile <= 2) { const int idx = (tile - 1) * 256 + r; col = 256 + (idx >> 6) * 64 + ropeperm(idx & 63); }
        else if (tile <= 4) col = 768 + (tile - 3) * 256 + r;
        else if (tile <= 12) col = 1352 + (tile - 5) * 256 + r;
        else { if (r < 64) col = 1280 + ropeperm(r); else if (r < 72) col = 1344 + (r - 64); else if (r < 76) col = 3400 + (r - 72); else if (r < 80) col = 3404 + (r - 76); else { src = nullptr; col = 0; } }
    } else if (kind == 2) {
        ld = 512; src = (n < 512) ? W0 : W1; const int idx = n & 511; col = (idx >> 6) * 64 + ropeperm(idx & 63);
    } else if (kind == 3) {
        ld = 2 * FF; col = ((n >> 7) & 1) * FF + (n >> 8) * 128 + (n & 127);
    }
    float wv[32];
#pragma unroll
    for (int i = 0; i < 32; ++i) { const int kk = 2 * i + (lane >> 5); wv[i] = src ? src[(size_t)(k0 + kk) * ld + col] : 0.f; }
#pragma unroll
    for (int i = 0; i < 32; ++i) { const int kk = 2 * i + (lane >> 5); float v = wv[i]; if (gain) v *= gain[k0 + kk]; scr[kk * 33 + (lane & 31)] = v; }
    LDS_WAIT(); asm volatile("" ::: "memory");
    const int c = lane & 7;
#pragma unroll
    for (int j = 0; j < 4; ++j) { const int nn = (lane >> 3) + 8 * j; const LAS float* s = scr + (8 * c) * 33 + nn;
        v4u o; o.x = pk2(s[0 * 33], s[1 * 33]); o.y = pk2(s[2 * 33], s[3 * 33]); o.z = pk2(s[4 * 33], s[5 * 33]); o.w = pk2(s[6 * 33], s[7 * 33]);
        *(GAS v4u*)(WT + (size_t)(n0 + nn) * K + k0 + 8 * c) = o; }
    LDS_WAIT(); asm volatile("" ::: "memory");
}

enum { I_X = 0, I_C, I_POS, I_WMOD, I_BMOD, I_MIXPRE, I_MIXPOST, I_WIN, I_QLN, I_WQUP, I_WQIUP, I_CONVW, I_CONVB, I_BIG, I_BFG, I_ATTN, I_MLN, I_WOUT, I_FFNPRE, I_FFNPOST, I_WGU, I_WDN, I_OUT, I_WS };
__device__ __forceinline__ unsigned long long ldptr(LAS unsigned char* lds, int k) {
    const volatile LAS unsigned* p = (const volatile LAS unsigned*)(lds + LDSCTL_OFF + 64 + 8 * k);
    const unsigned lo = __builtin_amdgcn_readfirstlane(p[0]), hi = __builtin_amdgcn_readfirstlane(p[1]);
    return ((unsigned long long)hi << 32) | lo;
}
#define GPTR(T, x) ((T*)(GAS T*)(x))
#define FP(k) GPTR(const float, ldptr(lds, (k)))
#define WSP() ((unsigned char*)ldptr(lds, I_WS))
#define WSPG() GPTR(unsigned char, ldptr(lds, I_WS))

__device__ __forceinline__ void p0_prologue(LAS unsigned char* lds, int tid, int lane, int wave, int vcu, int G) {
    LAS float* scr = (LAS float*)(lds + wave * 16384);
    const int gw = vcu * NWAVES + wave, NGW = G * NWAVES;
    constexpr int I_IN = (D / 64) * (NINP / 32), I_Q = (QRK / 64) * (1024 / 32), I_O = (D / 64) * (D / 32), I_GU = (D / 64) * (2 * FF / 32), I_DN = (FF / 64) * (D / 32);
    constexpr int I_LAYER = I_IN + I_Q + I_O + I_GU + I_DN;
    unsigned char* const wsp_ = WSP(); const float* const p_in = FP(I_WIN); const float* const p_qu = FP(I_WQUP); const float* const p_qi = FP(I_WQIUP); const float* const p_ql = FP(I_QLN);
    const float* const p_o = FP(I_WOUT); const float* const p_gu = FP(I_WGU); const float* const p_dn = FP(I_WDN);
    constexpr int NITEM = DEPTH * I_LAYER, NU_ = DEPTH * (NMOD / 64);
    const bool deal = (G == 256) && (NITEM == 6 * NU_ * NWAVES + 8 * (256 - NU_) * NWAVES);
    const int it0 = !deal ? gw : (vcu < NU_) ? gw : NU_ * NWAVES * 6 + (gw - NU_ * NWAVES), itstep = !deal ? NGW : (vcu < NU_) ? NU_ * NWAVES : (256 - NU_) * NWAVES,
              itend = !deal ? NITEM : (vcu < NU_) ? NU_ * NWAVES * 6 : NITEM;
    for (int it = it0; it < itend; it += itstep) {
        const int l = it / I_LAYER; int r = it % I_LAYER; unsigned char* wl = wsp_ + WS_W + (size_t)l * W_LAYER;
        if (r < I_IN) { conv_item(1, p_in + (size_t)l * D * NIN, nullptr, nullptr, D, NINP, (bf16*)(wl + WO_IN), scr, r, lane); continue; } r -= I_IN;
        if (r < I_Q) { conv_item(2, p_qu + (size_t)l * QRK * 512, p_qi + (size_t)l * QRK * 512, p_ql + (size_t)l * QRK, QRK, 1024, (bf16*)(wl + WO_Q), scr, r, lane); continue; } r -= I_Q;
        if (r < I_O) { conv_item(0, p_o + (size_t)l * D * D, nullptr, nullptr, D, D, (bf16*)(wl + WO_OUT), scr, r, lane); continue; } r -= I_O;
        if (r < I_GU) { conv_item(3, p_gu + (size_t)l * D * 2 * FF, nullptr, nullptr, D, 2 * FF, (bf16*)(wl + WO_GU), scr, r, lane); continue; } r -= I_GU;
        conv_item(0, p_dn + (size_t)l * FF * D, nullptr, nullptr, FF, D, (bf16*)(wl + WO_DN), scr, r, lane);
    }
    __syncthreads();
    constexpr int NU = DEPTH * (NMOD / 64);
    if (vcu < NU) {
        LAS float* sc = (LAS float*)lds;
        LAS float* part = (LAS float*)(lds + 65536);
        { const float* cin = FP(I_C);
#pragma unroll
          for (int h2 = 0; h2 < 2; ++h2) { float cv[16];
#pragma unroll
              for (int q = 0; q < 16; ++q) cv[q] = cin[tid + NWAVES * 64 * (16 * h2 + q)];
#pragma unroll
              for (int q = 0; q < 16; ++q) { const int i = tid + NWAVES * 64 * (16 * h2 + q), b = i / D, k = i % D; sc[k * 16 + b] = silu_f(cv[q]); } } }
        __syncthreads();
        const float* wmod = FP(I_WMOD); const float* bmod = FP(I_BMOD); float* modo = (float*)(WSP() + WS_MOD);
        for (int u = vcu; u < NU; u += G) {
            const int l = u / (NMOD / 64), n0 = (u % (NMOD / 64)) * 64;
            const float* W = wmod + (size_t)l * D * NMOD + n0 + lane;
            float acc[16];
#pragma unroll
            for (int b = 0; b < 16; ++b) acc[b] = 0.f;
            for (int k0 = wave * 128; k0 < wave * 128 + 128; k0 += 32) { float wv[32];
#pragma unroll
                for (int kk = 0; kk < 32; ++kk) wv[kk] = W[(size_t)(k0 + kk) * NMOD];
#pragma unroll
                for (int kk = 0; kk < 32; ++kk) {
#pragma unroll
                    for (int q = 0; q < 4; ++q) { const f32x4 s4 = *(const LAS f32x4*)(sc + (k0 + kk) * 16 + 4 * q);
                        acc[4 * q + 0] += s4[0] * wv[kk]; acc[4 * q + 1] += s4[1] * wv[kk]; acc[4 * q + 2] += s4[2] * wv[kk]; acc[4 * q + 3] += s4[3] * wv[kk]; }
                    __builtin_amdgcn_sched_barrier(0); } }
#pragma unroll
            for (int b = 0; b < 16; ++b) part[(wave * 16 + b) * 64 + lane] = acc[b];
            __syncthreads();
            for (int i = tid; i < 16 * 64; i += NWAVES * 64) { const int b = i >> 6, ln = i & 63; float s = bmod[(size_t)l * NMOD + n0 + ln];
#pragma unroll
                for (int w = 0; w < 8; ++w) s += part[(w * 16 + b) * 64 + ln];
                modo[((size_t)l * BATCH + b) * NMOD + n0 + ln] = s; }
            __syncthreads();
        }
    }
}

__device__ __forceinline__ void norm_phase(const bf16* y, const float* xin, float* xout, const float* gpost, const float* gate, const float* gnext, const float* sc, const float* sh, bf16* XN,
                                           int lane, int wave, int vcu, int G) {
    const int gw = vcu * NWAVES + wave, NGW = G * NWAVES;
    for (int m0 = gw * 16; m0 < M; m0 += NGW * 16) {
        const int b = m0 / SEQ;
        f32x4 vg[4], vt[4], vn[4], vs[4], vh[4];
#pragma unroll
        for (int j = 0; j < 4; ++j) { const int e = 256 * j + 4 * lane;
            if (y) { vg[j] = *(const f32x4*)(gpost + e); vt[j] = *(const f32x4*)(gate + (size_t)b * NMOD + e); }
            if (gnext) { vn[j] = *(const f32x4*)(gnext + e); vs[j] = *(const f32x4*)(sc + (size_t)b * NMOD + e) + 1.f; vh[j] = *(const f32x4*)(sh + (size_t)b * NMOD + e); vn[j] = vn[j] * vs[j]; } }
        for (int r = 0; r < 16; ++r) {
            const size_t row = (size_t)(m0 + r);
            f32x4 xv[4];
#pragma unroll
            for (int j = 0; j < 4; ++j) xv[j] = *(const f32x4*)(xin + row * D + 256 * j + 4 * lane);
            if (y) {
                f32x4 yv[4]; float ss = 0.f;
#pragma unroll
                for (int j = 0; j < 4; ++j) { const u32x2 w = *(const u32x2*)(y + row * D + 256 * j + 4 * lane); yv[j] = (f32x4){bf_lo(w.x), bf_hi(w.x), bf_lo(w.y), bf_hi(w.y)};
                    ss += (yv[j][0] * yv[j][0] + yv[j][1] * yv[j][1]) + (yv[j][2] * yv[j][2] + yv[j][3] * yv[j][3]); }
                const float rstd = rsqrtf(wave_sum(ss) * (1.f / D) + EPS);
#pragma unroll
                for (int j = 0; j < 4; ++j) { xv[j] = xv[j] + vt[j] * (yv[j] * rstd * vg[j]); *(f32x4*)(xout + row * D + 256 * j + 4 * lane) = xv[j]; }
            }
            if (gnext) {
                float ss = 0.f;
#pragma unroll
                for (int j = 0; j < 4; ++j) ss += (xv[j][0] * xv[j][0] + xv[j][1] * xv[j][1]) + (xv[j][2] * xv[j][2] + xv[j][3] * xv[j][3]);
                const float rstd = rsqrtf(wave_sum(ss) * (1.f / D) + EPS);
#pragma unroll
                for (int j = 0; j < 4; ++j) { const f32x4 o = xv[j] * rstd * vn[j] + vh[j]; u32x2 w; w.x = pk2(o[0], o[1]); w.y = pk2(o[2], o[3]); *(u32x2*)(XN + row * D + 256 * j + 4 * lane) = w; }
            }
        }
    }
}

constexpr int IX_SC = 0, IX_KCH = 131072, IX_KPITCH = 144, IX_HIST = IX_KCH, IX_MSK = IX_KCH + 128 * IX_KPITCH, IX_END = IX_MSK + 4096;
static_assert(IX_END <= RING_BYTES && 8 * 576 * 4 <= 128 * IX_KPITCH, "indexer LDS");
__device__ __forceinline__ float relu_f(float x) { const int i = __float_as_int(x); return __int_as_float(i > 0 ? i : 0); }
__device__ __forceinline__ unsigned ord_key(float f) { const unsigned u = __float_as_uint(f); return u ^ ((unsigned)((int)u >> 31) | 0x80000000u); }
__device__ __forceinline__ unsigned wave_scan_add(unsigned v) {
    v += (unsigned)__builtin_amdgcn_update_dpp(0, (int)v, 0x111, 0xf, 0xf, false);
    v += (unsigned)__builtin_amdgcn_update_dpp(0, (int)v, 0x112, 0xf, 0xf, false);
    v += (unsigned)__builtin_amdgcn_update_dpp(0, (int)v, 0x114, 0xf, 0xf, false);
    v += (unsigned)__builtin_amdgcn_update_dpp(0, (int)v, 0x118, 0xf, 0xf, false);
    v += (unsigned)__builtin_amdgcn_update_dpp(0, (int)v, 0x142, 0xa, 0xf, false);
    v += (unsigned)__builtin_amdgcn_update_dpp(0, (int)v, 0x143, 0xc, 0xf, false);
    return v;
}
__device__ __forceinline__ float wave_scan_addf(float v) {
#define WS_STEP(ctrl, rm) v += __int_as_float(__builtin_amdgcn_update_dpp(0, __float_as_int(v), ctrl, rm, 0xf, false))
    WS_STEP(0x111, 0xf); WS_STEP(0x112, 0xf); WS_STEP(0x114, 0xf); WS_STEP(0x118, 0xf); WS_STEP(0x142, 0xa); WS_STEP(0x143, 0xc);
#undef WS_STEP
    return v;
}
__device__ __forceinline__ float wave_scan_maxf(float v) {
#define WS_STEP(ctrl, rm) v = fmaxf(v, __int_as_float(__builtin_amdgcn_update_dpp(__float_as_int(v), __float_as_int(v), ctrl, rm, 0xf, false)))
    WS_STEP(0x111, 0xf); WS_STEP(0x112, 0xf); WS_STEP(0x114, 0xf); WS_STEP(0x118, 0xf); WS_STEP(0x142, 0xa); WS_STEP(0x143, 0xc);
#undef WS_STEP
    return v;
}
__device__ __forceinline__ float sum8_dpp(float v) {
    v += __int_as_float(__builtin_amdgcn_update_dpp(0, __float_as_int(v), 0xB1, 0xf, 0xf, false));
    v += __int_as_float(__builtin_amdgcn_update_dpp(0, __float_as_int(v), 0x4E, 0xf, 0xf, false));
    v += __int_as_float(__builtin_amdgcn_update_dpp(0, __float_as_int(v), 0x141, 0xf, 0xf, false));
    return v;
}
template <int NJ> __device__ __forceinline__ void radix_rows(const unsigned (&xa)[NJ], const unsigned (&xb)[NJ],
                                                              unsigned& thrA, unsigned& needA_o, unsigned& eqA_o, unsigned& thrB, unsigned& needB_o, unsigned& eqB_o) {
    constexpr int G = NJ / 4;
    bool fin = false; unsigned cnA = 2048u, cnB = 2048u; unsigned pfA = 0u, ndA = 256u, pfB = 0u, ndB = 256u, candA = ~0u, candB = ~0u;
#pragma unroll
    for (int k = 3; k >= 0; --k) {
        unsigned wa[8], wb[8];
        unsigned s01 = (unsigned)k | ((unsigned)(4 + k) << 8) | 0x0c0c0000u, s23 = 0x00000c0cu | ((unsigned)k << 16) | ((unsigned)(4 + k) << 24);
        asm volatile("" : "+s"(s01), "+s"(s23), "+s"(ndA), "+s"(ndB));
#pragma unroll
        for (int g = 0; g < 8; ++g) {
            if (g < G) { wa[g] = __builtin_amdgcn_perm(xa[4 * g + 1], xa[4 * g], s01) | __builtin_amdgcn_perm(xa[4 * g + 3], xa[4 * g + 2], s23);
                         wb[g] = __builtin_amdgcn_perm(xb[4 * g + 1], xb[4 * g], s01) | __builtin_amdgcn_perm(xb[4 * g + 3], xb[4 * g + 2], s23); }
            else { wa[g] = 0u; wb[g] = 0u; } }
#pragma unroll
        for (int st = 0; st < 3; ++st) { const int sh = 1 << st; const unsigned mk = (st == 0) ? 0x55555555u : (st == 1) ? 0x33333333u : 0x0f0f0f0fu;
#pragma unroll
            for (int g = 0; g < 8; ++g) if (!(g & sh)) { const int h = g | sh;
                { const unsigned A = wa[g], B = wa[h]; wa[g] = (A & mk) | ((B << sh) & ~mk); wa[h] = ((A >> sh) & mk) | (B & ~mk); }
                { const unsigned A = wb[g], B = wb[h]; wb[g] = (A & mk) | ((B << sh) & ~mk); wb[h] = ((A >> sh) & mk) | (B & ~mk); } } }
#pragma unroll
        for (int bb = 7; bb >= 0; --bb) { const unsigned bit = 1u << (8 * k + bb);
            const unsigned oA = candA & wa[bb], oB = candB & wb[bb];
            const unsigned n = (unsigned)__builtin_amdgcn_readlane((int)wave_scan_add((unsigned)__builtin_popcount(oA) | ((unsigned)__builtin_popcount(oB) << 16)), 63);
            const unsigned nA = n & 0xffffu, nB = n >> 16;
            if (nA >= ndA) { pfA |= bit; candA = oA; cnA = nA; } else { ndA -= nA; candA ^= oA; cnA -= nA; }
            if (nB >= ndB) { pfB |= bit; candB = oB; cnB = nB; } else { ndB -= nB; candB ^= oB; cnB -= nB; }
            if (cnA == ndA && cnB == ndB) { fin = true; break; }
        }
        if (fin) break;
    }
    thrA = pfA; needA_o = ndA; eqA_o = cnA; thrB = pfB; needB_o = ndB; eqB_o = cnB;
}
template <int NJ> __device__ __forceinline__ void select_rows(const LAS unsigned* scb, LAS unsigned long long* msk, LAS unsigned* hist, int nk, int wave, int lane) {
    unsigned xa[NJ], xb[NJ];
#pragma unroll
    for (int j0 = 0; j0 < NJ; j0 += 8) {
#pragma unroll
        for (int j = j0; j < j0 + 8; ++j) { xa[j] = scb[(2 * wave) * 2048 + 64 * j + lane]; xb[j] = scb[(2 * wave + 1) * 2048 + 64 * j + lane]; }
        __builtin_amdgcn_sched_group_barrier(0x100, 16, 0);
        __builtin_amdgcn_sched_group_barrier(0x002, 32, 0);
#pragma unroll
        for (int j = j0; j < j0 + 8; ++j) { const bool in = (64 * j + lane) < nk; xa[j] = in ? xa[j] : 0u; xb[j] = in ? xb[j] : 0u; } }
    unsigned pA, pB, needA, needB, eA, eB;
    radix_rows<NJ>(xa, xb, pA, needA, eA, pB, needB, eB);
    unsigned xiA = 2047u, xiB = 2047u;
    if ((eA > needA) || (eB > needB)) {
        xiA = 0u; xiB = 0u;
#pragma unroll 1
        for (int bit = 10; bit >= 0; --bit) {
            const unsigned cA = xiA | (1u << bit), cB = xiB | (1u << bit); unsigned nA = 0u, nB = 0u;
#pragma unroll
            for (int j = 0; j < NJ; ++j) { int ll = lane; asm volatile("" : "+v"(ll)); const unsigned key = 64u * j + ll;
                nA += (xa[j] == pA && key < cA) ? 1u : 0u; nB += (xb[j] == pB && key < cB) ? 1u : 0u; if (j & 1) __builtin_amdgcn_sched_barrier(0); }
            unsigned n = nA | (nB << 16);
#pragma unroll
            for (int o = 1; o < 64; o <<= 1) n += __shfl_xor(n, o);
            if ((n & 0xffffu) < needA) xiA = cA;
            if ((n >> 16) < needB) xiB = cB;
        }
    }
    unsigned a0 = 0u, a1 = 0u, b0 = 0u, b1 = 0u;
    const bool ties = (xiA != 2047u) || (xiB != 2047u);
#pragma unroll
    for (int j = 0; j < NJ; ++j) { int ll = lane; asm volatile("" : "+v"(ll)); const unsigned key = 64u * j + ll;
        bool sA = xa[j] >= pA, sB = xb[j] >= pB;
        if (ties) { sA = (xa[j] > pA) || (xa[j] == pA && key <= xiA); sB = (xb[j] > pB) || (xb[j] == pB && key <= xiB); }
        const unsigned long long ba = __ballot(sA), bb = __ballot(sB);
        asm volatile("v_writelane_b32 %0, %4, %8\n\tv_writelane_b32 %1, %5, %8\n\tv_writelane_b32 %2, %6, %8\n\tv_writelane_b32 %3, %7, %8"
                     : "+v"(a0), "+v"(a1), "+v"(b0), "+v"(b1) : "s"((unsigned)ba), "s"((unsigned)(ba >> 32)), "s"((unsigned)bb), "s"((unsigned)(bb >> 32)), "n"(j));
        __builtin_amdgcn_sched_barrier(0);
    }
    if (lane < 32) { msk[lane * 16 + 2 * wave] = (unsigned long long)a0 | ((unsigned long long)a1 << 32); msk[lane * 16 + 2 * wave + 1] = (unsigned long long)b0 | ((unsigned long long)b1 << 32); }
}
constexpr int B_CLE = 129 * 128;
struct BReg { v4u x[4]; float ak[4], tk[4]; };
struct BState { float cst[8]; float m; };
__device__ __forceinline__ void mlstm_B_load(BReg& R, const bf16* CL, const float* MSC, int item, int k0) {
    asm volatile("" : "+v"(item));
    constexpr int PCS = B_CLE / 8; const int bh = item / PCS, pc = item % PCS;
    const bf16* base = CL + (size_t)bh * 32 * B_CLE + pc * 8; const float* ms = MSC + (size_t)bh * 32 * 4;
#pragma unroll
    for (int k = 0; k < 4; ++k) { R.x[k] = *(const v4u*)(base + (size_t)(k0 + k) * B_CLE); R.ak[k] = ms[(k0 + k) * 4 + 0]; R.tk[k] = ms[(k0 + k) * 4 + 1]; }
}
__device__ __forceinline__ void mlstm_B_apply(const BReg& R, BState& S, bf16* CL, float* MSC, int item, int k0) {
    asm volatile("" : "+v"(item));
    constexpr int PCS = B_CLE / 8; const int bh = item / PCS, pc = item % PCS;
    bf16* base = CL + (size_t)bh * 32 * B_CLE + pc * 8; float* ms = MSC + (size_t)bh * 32 * 4;
#pragma unroll
    for (int k = 0; k < 4; ++k) {
        const float Mx = fmaxf(S.m, R.ak[k]), dec = __expf(S.m - Mx), w = __expf(R.ak[k] - Mx);
        v4u o; o.x = pk2(S.cst[0], S.cst[1]); o.y = pk2(S.cst[2], S.cst[3]); o.z = pk2(S.cst[4], S.cst[5]); o.w = pk2(S.cst[6], S.cst[7]);
        *(v4u*)(base + (size_t)(k0 + k) * B_CLE) = o;
        if (pc == 0) ms[(k0 + k) * 4 + 2] = S.m;
        S.cst[0] = dec * S.cst[0] + w * bf_lo(R.x[k].x); S.cst[1] = dec * S.cst[1] + w * bf_hi(R.x[k].x); S.cst[2] = dec * S.cst[2] + w * bf_lo(R.x[k].y); S.cst[3] = dec * S.cst[3] + w * bf_hi(R.x[k].y);
        S.cst[4] = dec * S.cst[4] + w * bf_lo(R.x[k].z); S.cst[5] = dec * S.cst[5] + w * bf_hi(R.x[k].z); S.cst[6] = dec * S.cst[6] + w * bf_lo(R.x[k].w); S.cst[7] = dec * S.cst[7] + w * bf_hi(R.x[k].w);
        S.m = R.tk[k] + Mx; }
}

__device__ __forceinline__ void mlstm_B_extras(bf16* CL, float* MSC, int tid, int vcu) {
    if ((vcu & 3) == 0 && tid < 16) { int item = (2 * (vcu >> 5) + ((vcu & 31) >> 4)) * (4 * (B_CLE / 8)) + 16 * NWAVES * 64 + ((vcu >> 2) & 3) * 16 + tid;
        constexpr int PCS = B_CLE / 8; const int bh = item / PCS, pc = item % PCS;
        bf16* base = CL + (size_t)bh * 32 * B_CLE + pc * 8; float* ms = MSC + (size_t)bh * 32 * 4;
        float cst[8];
#pragma unroll
        for (int e = 0; e < 8; ++e) cst[e] = 0.f;
        float m = 0.f;
#pragma unroll 1
        for (int k0 = 0; k0 < 32; k0 += 16) {
            v4u x[16]; float ak[16], tk[16];
#pragma unroll
            for (int k = 0; k < 16; ++k) { x[k] = *(const v4u*)(base + (size_t)(k0 + k) * B_CLE); ak[k] = ms[(k0 + k) * 4 + 0]; tk[k] = ms[(k0 + k) * 4 + 1]; }
#pragma unroll
            for (int k = 0; k < 16; ++k) {
                const float Mx = fmaxf(m, ak[k]), dec = __expf(m - Mx), w = __expf(ak[k] - Mx);
                v4u o; o.x = pk2(cst[0], cst[1]); o.y = pk2(cst[2], cst[3]); o.z = pk2(cst[4], cst[5]); o.w = pk2(cst[6], cst[7]);
                *(v4u*)(base + (size_t)(k0 + k) * B_CLE) = o;
                if (pc == 0) ms[(k0 + k) * 4 + 2] = m;
                cst[0] = dec * cst[0] + w * bf_lo(x[k].x); cst[1] = dec * cst[1] + w * bf_hi(x[k].x); cst[2] = dec * cst[2] + w * bf_lo(x[k].y); cst[3] = dec * cst[3] + w * bf_hi(x[k].y);
                cst[4] = dec * cst[4] + w * bf_lo(x[k].z); cst[5] = dec * cst[5] + w * bf_hi(x[k].z); cst[6] = dec * cst[6] + w * bf_lo(x[k].w); cst[7] = dec * cst[7] + w * bf_hi(x[k].w);
                m = tk[k] + Mx; }
        } }
}
struct IxReg { bf16x8 af[4]; float wA[8], wB[8]; v4u pre[2], pre2[2]; };
__device__ __forceinline__ void indexer_load(IxReg& R, int b, int qb16, const bf16* QI, const bf16* KI, const float* WI, int tid, int lane, int wave) {
    if (qb16 < 16) return;
    const int r = lane & 31, hh = lane >> 5, mt = wave & 3, q0 = qb16 * 16; const size_t rowb = (size_t)b * SEQ;
    { const int g = r >> 2, ql = 2 * (g & 1) + (g >> 2), hd = 4 * ((g >> 1) & 1) + (r & 3);
      const bf16* qp = QI + (rowb + q0 + 4 * mt + ql) * 512 + hd * 64 + 8 * hh;
#pragma unroll
      for (int s = 0; s < 4; ++s) R.af[s] = *(const bf16x8*)(qp + 16 * s); }
    { const float* wp = WI + (rowb + q0 + 4 * mt + 2 * hh) * 8;
#pragma unroll
      for (int j = 0; j < 8; ++j) { R.wA[j] = wp[j]; R.wB[j] = wp[8 + j]; } }
#pragma unroll
    for (int i = 0; i < 2; ++i) { const int idx = tid + 512 * i; R.pre[i] = *(const v4u*)(KI + (rowb + (idx >> 3)) * 64 + (idx & 7) * 8); R.pre2[i] = *(const v4u*)(KI + (rowb + 128 + (idx >> 3)) * 64 + (idx & 7) * 8); }
}
__device__ __forceinline__ void indexer_unit(LAS unsigned char* lds, int b, int qb16, int nb, int nqb16, IxReg& R, const bf16* QI, const bf16* KI, const float* WI, unsigned long long* MaskG, int tid, int lane, int wave,
                                             BState& SB1, int vcuB, int k0B, unsigned* ctr, int tkbase, unsigned char* wsg, int gx) {
    BReg RB1 = {};
#define IX_B_CL  ((bf16*)(wsg + WS_MIX + MX_CL + mx_shift(MX_CL, MXS_CL, 2 * (vcuB >> 5) + ((vcuB & 31) >> 4))))
#define IX_B_MSC ((float*)(wsg + WS_SSQ + 512 * 1024))
#define IX_B_I1  ((2 * (vcuB >> 5) + ((vcuB & 31) >> 4)) * (4 * (B_CLE / 8)) + (vcuB & 15) * (NWAVES * 64) + tid)
    if (k0B >= 0) mlstm_B_load(RB1, IX_B_CL, IX_B_MSC, IX_B_I1, k0B);
#define IX_B_APPLY() do { if (k0B >= 0) mlstm_B_apply(RB1, SB1, IX_B_CL, IX_B_MSC, IX_B_I1, k0B); } while (0)
    asm volatile("" : "+v"(tid), "+v"(lane));
#ifdef GPROBE
    volatile LAS unsigned long long* upw_ = (volatile LAS unsigned long long*)(lds + LDSCTL_OFF + 432);
    const bool upon_ = (blockIdx.x == 0 && wave == 0 && lane == 0);
    if (upon_ && GPROBE == 22) upw_[-1] = __builtin_amdgcn_s_memrealtime();
#endif
    LAS unsigned* scb = (LAS unsigned*)(lds + IX_SC);
    LAS unsigned long long* msk = (LAS unsigned long long*)(lds + IX_MSK);
    const int q0 = qb16 * 16, n_kt = (q0 + 47) >> 5, nk = 32 * n_kt;
    const size_t rowb = (size_t)b * SEQ;
    __syncthreads();
    volatile LAS unsigned* tkw = (volatile LAS unsigned*)(lds + LDSCTL_OFF + 8);
    unsigned tk_ = 0u;
    if (ctr != nullptr && tid == 0) tk_ = (unsigned)tkbase + __hip_atomic_fetch_add(ctr, 1u, __ATOMIC_RELAXED, __HIP_MEMORY_SCOPE_AGENT);
#define IX_NEXT() do { if (ctr != nullptr) { const int nL_ = __builtin_amdgcn_readfirstlane((int)*tkw); \
        if (gx >= 0) { nb = gx; nqb16 = (nL_ < 128) ? 127 - nL_ : -1; } else { nb = nL_ & 15; nqb16 = (nL_ < BATCH * 128) ? 127 - (nL_ >> 4) : -1; } } } while (0)
    if (qb16 < 16) {
        { const int T = tid >> 4, i = tid & 15, t = q0 + i;
          msk[T * 16 + i] = (64 * T + 63 <= t) ? ~0ull : (64 * T > t) ? 0ull : ((1ull << (t - 64 * T + 1)) - 1ull); }
        IX_B_APPLY();
        if (ctr != nullptr) { if (tid == 0) *tkw = tk_; __syncthreads(); IX_NEXT(); }
        if (nqb16 >= 0) indexer_load(R, nb, nqb16, QI, KI, WI, tid, lane, wave);
    } else {
        const int r = lane & 31, hh = lane >> 5, mt = wave & 3, par = wave >> 2;
#ifdef GPROBE
        volatile LAS unsigned long long* ipw_ = (volatile LAS unsigned long long*)(lds + LDSCTL_OFF + 432);
        const bool ipon_ = (blockIdx.x == 0 && wave == 0 && lane == 0);
        if (ipon_) ipw_[1] = __builtin_amdgcn_s_memrealtime();
        if (ipon_ && GPROBE == 22) ipw_[0] += ipw_[1] - ipw_[-1];
#endif
        bf16x8 af[4]; float wA[8], wB[8]; v4u pre[2], pre2[2];
#pragma unroll
        for (int s = 0; s < 4; ++s) af[s] = R.af[s];
#pragma unroll
        for (int j = 0; j < 8; ++j) { wA[j] = R.wA[j]; wB[j] = R.wB[j]; }
        pre[0] = R.pre[0]; pre[1] = R.pre[1]; pre2[0] = R.pre2[0]; pre2[1] = R.pre2[1];
        const int rowA = 4 * mt + 2 * hh, tA = q0 + rowA;
#define IX_STEP(c_, P) do { const int cc_ = (c_); \
            if (cc_) __syncthreads();                               \
            _Pragma("unroll") for (int i = 0; i < 2; ++i) { const int idx = tid + 512 * i; *(LAS v4u*)(lds + IX_KCH + (idx >> 3) * IX_KPITCH + (idx & 7) * 16) = P[i]; } \
            if (4 * (cc_ + 2) < n_kt) {                            \
                _Pragma("unroll") for (int i = 0; i < 2; ++i) { const int idx = tid + 512 * i; P[i] = *(const v4u*)(KI + (rowb + 128 * (cc_ + 2) + (idx >> 3)) * 64 + (idx & 7) * 8); } } \
            __syncthreads(); \
            bf16x8 bq0[4], bq1[4]; \
            _Pragma("unroll") for (int s = 0; s < 4; ++s) { bq0[s] = *(const LAS bf16x8*)(lds + IX_KCH + (32 * par + r) * IX_KPITCH + 32 * s + 16 * hh); \
                                                            bq1[s] = *(const LAS bf16x8*)(lds + IX_KCH + (32 * (par + 2) + r) * IX_KPITCH + 32 * s + 16 * hh); } \
            __builtin_amdgcn_sched_barrier(0);                     \
            f32x16 acc0 = {}, acc1 = {}; \
            _Pragma("unroll") for (int s = 0; s < 4; ++s) { acc0 = __builtin_amdgcn_mfma_f32_32x32x16_bf16(af[s], bq0[s], acc0, 0, 0, 0); acc1 = __builtin_amdgcn_mfma_f32_32x32x16_bf16(af[s], bq1[s], acc1, 0, 0, 0); } \
            float sa0 = 0.f, sb0 = 0.f, sa1 = 0.f, sb1 = 0.f; \
            _Pragma("unroll") for (int j = 0; j < 8; ++j) { sa0 += wA[j] * relu_f(acc0[j]); sb0 += wB[j] * relu_f(acc0[8 + j]); sa1 += wA[j] * relu_f(acc1[j]); sb1 += wB[j] * relu_f(acc1[8 + j]); } \
            const int key0 = 32 * (4 * cc_ + par) + r, key1 = key0 + 64; \
            scb[rowA * 2048 + key0] = (key0 <= tA) ? ord_key(sa0) : 0u; scb[(rowA + 1) * 2048 + key0] = (key0 <= tA + 1) ? ord_key(sb0) : 0u; \
            scb[rowA * 2048 + key1] = (key1 <= tA) ? ord_key(sa1) : 0u; scb[(rowA + 1) * 2048 + key1] = (key1 <= tA + 1) ? ord_key(sb1) : 0u; } while (0)
#pragma unroll 1
        for (int c = 0; 4 * c < n_kt; c += 2) { IX_STEP(c, pre); if (4 * (c + 1) < n_kt) IX_STEP(c + 1, pre2); }
#undef IX_STEP
        if (ctr != nullptr && tid == 0) *tkw = tk_;
        __syncthreads();
#ifdef GPROBE
        if (ipon_) { const unsigned long long n_ = __builtin_amdgcn_s_memrealtime(); if (GPROBE == 20) ipw_[0] += n_ - ipw_[1]; ipw_[1] = n_; }
#endif
        IX_B_APPLY();
        IX_NEXT();
        if (nqb16 >= 0) indexer_load(R, nb, nqb16, QI, KI, WI, tid, lane, wave);
#ifdef DUP
#pragma unroll 1
        for (int rep_ = 0; rep_ < ((DUP == 44) ? 2 : 1); ++rep_)
#endif
        { LAS unsigned* hist = (LAS unsigned*)(lds + IX_HIST) + 576 * wave;
          if (nk <= 512) select_rows<8>(scb, msk, hist, nk, wave, lane); else if (nk <= 1024) select_rows<16>(scb, msk, hist, nk, wave, lane);
          else if (nk <= 1536) select_rows<24>(scb, msk, hist, nk, wave, lane); else select_rows<32>(scb, msk, hist, nk, wave, lane); }
#ifdef GPROBE
        if (ipon_) { const unsigned long long n_ = __builtin_amdgcn_s_memrealtime(); if (GPROBE == 21) ipw_[0] += n_ - ipw_[1]; ipw_[1] = n_; }
#endif
    }
    __syncthreads();
    asm volatile("" : "+v"(tid));
    { const int T = tid >> 4, i = tid & 15;
      MaskG[((size_t)(b * 8 + (qb16 >> 4)) * 32 + T) * 256 + (qb16 & 15) * 16 + i] = msk[T * 16 + i]; }
#ifdef GPROBE
    if (upon_ && GPROBE == 23 && qb16 >= 16) upw_[0] += __builtin_amdgcn_s_memrealtime() - upw_[1];
    if (upon_ && GPROBE == 24 && qb16 < 16) upw_[0] += __builtin_amdgcn_s_memrealtime() - upw_[-1];
    if (upon_ && GPROBE == 24) upw_[-1] = __builtin_amdgcn_s_memrealtime();
#endif
#undef IX_B_APPLY
#undef IX_NEXT
#undef IX_B_CL
#undef IX_B_MSC
#undef IX_B_I1
}

constexpr int ML_PQ = 272, ML_PV = 320, ML_PS = 144, ML_PN = 132;
constexpr int MA_VS = 0, MA_KW = 20480, MA_CT = 40960, MA_GT = 76288, ML_CW = 137216, ML_END = 142336;
constexpr int MC_QT = 0, MC_KT = 17408, MC_NUM = 0, MC_VS = 34816, MC_SS = 55296, MC_CT = 64512, MC_GT = 99840;
constexpr int ML_CLE = 129 * 128; static_assert(ML_CLE == B_CLE, "state image");
static_assert(ML_END + 512 <= RING_BYTES && MA_GT + 1024 <= ML_CW && MC_GT + 1024 <= ML_CW && 64 * ML_PN * 4 <= MC_VS && MC_CT + 129 * ML_PQ <= MC_GT && MA_CT + 129 * ML_PQ <= MA_GT, "mLSTM LDS");
__device__ __forceinline__ int crow16(int reg, int hh) { return (reg & 3) + 8 * (reg >> 2) + 4 * hh; }
typedef short v4i16_t __attribute__((ext_vector_type(4)));
__device__ __forceinline__ bf16x8 tr_frag(const LAS unsigned char* tb, int pitch, int c, int ks) {
    const v4i16_t lo = __builtin_amdgcn_ds_read_tr16_b64_v4i16((LAS v4i16_t*)(tb + (16 * ks) * pitch + 64 * c));
    const v4i16_t hi = __builtin_amdgcn_ds_read_tr16_b64_v4i16((LAS v4i16_t*)(tb + (16 * ks + 4) * pitch + 64 * c));
    return (bf16x8){lo[0], lo[1], lo[2], lo[3], hi[0], hi[1], hi[2], hi[3]};
}
__device__ __forceinline__ int tr_base(int lane, int pitch) { return ((lane >> 5) * 8 + ((lane & 15) >> 2)) * pitch + (((lane >> 4) & 1) * 16 + (lane & 3) * 4) * 2; }
__device__ __forceinline__ void mma_tile(f32x16& acc, const LAS unsigned char* a, int pa, const LAS unsigned char* bt, int pb, int ks, int r, int hh) {
    for (int s = 0; s < ks; ++s) { const bf16x8 av = *(const LAS bf16x8*)(a + r * pa + 32 * s + 16 * hh), bv = *(const LAS bf16x8*)(bt + r * pb + 32 * s + 16 * hh);
        acc = __builtin_amdgcn_mfma_f32_32x32x16_bf16(av, bv, acc, 0, 0, 0); }
}
__device__ __forceinline__ void ml_stage_cw(LAS unsigned char* lds, const float* conv_w, const float* conv_b, int hd, int tid) {
    LAS float* cwl = (LAS float*)(lds + ML_CW);
    float tv[3];
#pragma unroll
    for (int k = 0; k < 3; ++k) { const int i = tid + NWAVES * 64 * k; tv[k] = 0.f; if (i < 2 * 5 * 128) { const int z = i / 640, j = (i % 640) >> 7, ch = i & 127, gch = z * 512 + hd * 128 + ch; tv[k] = (j < 4) ? conv_w[j * 1024 + gch] : conv_b[gch]; } }
#pragma unroll
    for (int k = 0; k < 3; ++k) { const int i = tid + NWAVES * 64 * k; if (i < 2 * 5 * 128) cwl[i] = tv[k]; }
}
__device__ __forceinline__ void conv8(float (&y)[8], const bf16* src, int tt0, const LAS float* cw) {
    { const f32x4 b0 = *(const LAS f32x4*)(cw + 4 * 128), b1 = *(const LAS f32x4*)(cw + 4 * 128 + 4); y[0] = b0[0]; y[1] = b0[1]; y[2] = b0[2]; y[3] = b0[3]; y[4] = b1[0]; y[5] = b1[1]; y[6] = b1[2]; y[7] = b1[3]; }
#pragma unroll
    for (int j = 0; j < 4; ++j) { const int tt = tt0 - 3 + j;
        if (tt >= 0) { const v4u xw = *(const v4u*)(src + (size_t)tt * 512); const f32x4 w0 = *(const LAS f32x4*)(cw + j * 128), w1 = *(const LAS f32x4*)(cw + j * 128 + 4);
            y[0] += w0[0] * bf_lo(xw.x); y[1] += w0[1] * bf_hi(xw.x); y[2] += w0[2] * bf_lo(xw.y); y[3] += w0[3] * bf_hi(xw.y);
            y[4] += w1[0] * bf_lo(xw.z); y[5] += w1[1] * bf_hi(xw.z); y[6] += w1[2] * bf_lo(xw.w); y[7] += w1[3] * bf_hi(xw.w); } }
#pragma unroll
    for (int e = 0; e < 8; ++e) y[e] = silu_f(y[e]);
}

__device__ __forceinline__ void conv8r(float (&y)[8], const v4u (&xr)[4], const LAS float* cw) {
    { const f32x4 b0 = *(const LAS f32x4*)(cw + 4 * 128), b1 = *(const LAS f32x4*)(cw + 4 * 128 + 4); y[0] = b0[0]; y[1] = b0[1]; y[2] = b0[2]; y[3] = b0[3]; y[4] = b1[0]; y[5] = b1[1]; y[6] = b1[2]; y[7] = b1[3]; }
#pragma unroll
    for (int j = 0; j < 4; ++j) { const v4u xw = xr[j]; const f32x4 w0 = *(const LAS f32x4*)(cw + j * 128), w1 = *(const LAS f32x4*)(cw + j * 128 + 4);
        y[0] += w0[0] * bf_lo(xw.x); y[1] += w0[1] * bf_hi(xw.x); y[2] += w0[2] * bf_lo(xw.y); y[3] += w0[3] * bf_hi(xw.y);
        y[4] += w1[0] * bf_lo(xw.z); y[5] += w1[1] * bf_hi(xw.z); y[6] += w1[2] * bf_lo(xw.w); y[7] += w1[3] * bf_hi(xw.w); }
#pragma unroll
    for (int e = 0; e < 8; ++e) y[e] = silu_f(y[e]);
}
__device__ __forceinline__ void load_taps(v4u (&xr)[4], const bf16* src, int tt0) {
#pragma unroll
    for (int j = 0; j < 4; ++j) { const int tt = tt0 - 3 + j; xr[j] = (v4u){0u, 0u, 0u, 0u}; if (tt >= 0) xr[j] = *(const v4u*)(src + (size_t)tt * 512); }
}

struct AReg { v4u kx[2][4]; v4u vv[2]; float ig, lf; };
__device__ __forceinline__ void mlstm_A_load(AReg& R, int u, const bf16* KM, const bf16* VM, const float* IG, const float* LF, int tid, int lane, int wave) {
    const int c = u & 31, hd = (u >> 5) & 3, b = u >> 7; const size_t rowb = (size_t)b * SEQ, t0 = rowb + 64 * c;
#pragma unroll
    for (int it = 0; it < 2; ++it) { const int idx = tid + 512 * it, t = (idx >> 4) & 63, g = idx & 15;
        load_taps(R.kx[it], KM + rowb * 512 + hd * 128 + 8 * g, 64 * c + t); R.vv[it] = *(const v4u*)(VM + (t0 + t) * 512 + hd * 128 + 8 * g); }
    R.ig = IG[(t0 + lane) * 4 + hd]; R.lf = LF[(t0 + lane) * 4 + hd];
}
__device__ __forceinline__ void mlstm_A(LAS unsigned char* lds, int u, int u_next, AReg& R, const bf16* KM, const bf16* VM, const float* IG, const float* LF, bf16* KC, bf16* CL, float* MSC,
                                        int tid, int lane, int wave) {
    asm volatile("" : "+v"(tid), "+v"(lane)); asm volatile("" : "+s"(wave));
    const int r = lane & 31, hh = lane >> 5;
    LAS float* gt = (LAS float*)(lds + MA_GT); LAS bf16* ct = (LAS bf16*)(lds + MA_CT);
    __syncthreads();
    float wv;
    { const float bc = wave_scan_addf(R.lf);
      const float a = R.ig - bc; const float am = __int_as_float(__builtin_amdgcn_readlane(__float_as_int(wave_scan_maxf(a)), 63));
      wv = __expf(a - am);
      if (wave == 0 && lane == 63) { MSC[(size_t)u * 4 + 0] = am; MSC[(size_t)u * 4 + 1] = bc; } }
#pragma unroll
    for (int it = 0; it < 2; ++it) { const int idx = tid + 512 * it, t = (idx >> 4) & 63, g = idx & 15;
        float y[8]; conv8r(y, R.kx[it], (const LAS float*)(lds + ML_CW) + 640 + 8 * g);
        v4u o; o.x = pk2(y[0], y[1]); o.y = pk2(y[2], y[3]); o.z = pk2(y[4], y[5]); o.w = pk2(y[6], y[7]);
        *(v4u*)(KC + ((size_t)u * 64 + t) * 128 + 8 * g) = o;
        const float ws = __shfl(wv, t);
        v4u os; os.x = pk2(ws * bf_lo(o.x), ws * bf_hi(o.x)); os.y = pk2(ws * bf_lo(o.y), ws * bf_hi(o.y)); os.z = pk2(ws * bf_lo(o.z), ws * bf_hi(o.z)); os.w = pk2(ws * bf_lo(o.w), ws * bf_hi(o.w));
        *(LAS v4u*)(lds + MA_KW + t * ML_PV + 16 * g) = os;
        *(LAS v4u*)(lds + MA_VS + t * ML_PV + 16 * g) = R.vv[it]; }
    if (u_next >= 0) mlstm_A_load(R, u_next, KM, VM, IG, LF, tid, lane, wave);
    __syncthreads();
    { const int vi = wave >> 1; const LAS unsigned char* va = lds + MA_VS + tr_base(lane, ML_PV); const LAS unsigned char* kb = lds + MA_KW + tr_base(lane, ML_PV);
      f32x16 acc0 = f32x16{}, acc1 = f32x16{};
#pragma unroll
      for (int ks = 0; ks < 4; ++ks) { const bf16x8 af = tr_frag(va, ML_PV, vi, ks), b0 = tr_frag(kb, ML_PV, 2 * (wave & 1), ks), b1 = tr_frag(kb, ML_PV, 2 * (wave & 1) + 1, ks);
          acc0 = __builtin_amdgcn_mfma_f32_32x32x16_bf16(b0, af, acc0, 0, 0, 0); acc1 = __builtin_amdgcn_mfma_f32_32x32x16_bf16(b1, af, acc1, 0, 0, 0); }
      LAS unsigned char* cp = lds + MA_CT + (32 * vi + r) * ML_PQ + 2 * (64 * (wave & 1) + 4 * hh);
#pragma unroll
      for (int g4 = 0; g4 < 4; ++g4) { u32x2 w0, w1; w0.x = pk2(acc0[4 * g4], acc0[4 * g4 + 1]); w0.y = pk2(acc0[4 * g4 + 2], acc0[4 * g4 + 3]); w1.x = pk2(acc1[4 * g4], acc1[4 * g4 + 1]); w1.y = pk2(acc1[4 * g4 + 2], acc1[4 * g4 + 3]);
          *(LAS u32x2*)(cp + 16 * g4) = w0; *(LAS u32x2*)(cp + 64 + 16 * g4) = w1; } }
    { const int sg = lane & 3, d = 16 * wave + (lane >> 2); float sacc = 0.f;
#pragma unroll
        for (int s2 = 0; s2 < 16; ++s2) sacc += __uint_as_float((unsigned)(*(const LAS bf16*)(lds + MA_KW + (16 * sg + s2) * ML_PV + 2 * d)) << 16);
        sacc += __int_as_float(__builtin_amdgcn_update_dpp(0, __float_as_int(sacc), 0xB1, 0xf, 0xf, false));
        sacc += __int_as_float(__builtin_amdgcn_update_dpp(0, __float_as_int(sacc), 0x4E, 0xf, 0xf, false));
        if (sg == 0) ct[128 * (ML_PQ / 2) + d] = (bf16)f2bf(sacc); }
    __syncthreads();
    bf16* dst = CL + (size_t)u * ML_CLE;
    for (int i = tid; i < 129 * 16; i += NWAVES * 64) { const int row = i >> 4, pc = i & 15; *(v4u*)(dst + row * 128 + pc * 8) = *(const LAS v4u*)(lds + MA_CT + row * ML_PQ + pc * 16); }
}

__device__ __forceinline__ void mlstm_B(bf16* CL, float* MSC, int tid, int vcu, int G) {
    constexpr int PCS = ML_CLE / 8;
    for (int item = vcu * (NWAVES * 64) + tid; item < 64 * PCS; item += G * NWAVES * 64) {
        const int bh = item / PCS, pc = item % PCS;
        bf16* base = CL + (size_t)bh * 32 * ML_CLE + pc * 8; float* ms = MSC + (size_t)bh * 32 * 4;
        float cst[8];
#pragma unroll
        for (int e = 0; e < 8; ++e) cst[e] = 0.f;
        float m = 0.f;
#pragma unroll 1
        for (int k0 = 0; k0 < 32; k0 += 8) {
            v4u x[8]; float ak[8], tk[8];
#pragma unroll
            for (int k = 0; k < 8; ++k) { x[k] = *(const v4u*)(base + (size_t)(k0 + k) * ML_CLE); ak[k] = ms[(k0 + k) * 4 + 0]; tk[k] = ms[(k0 + k) * 4 + 1]; }
#pragma unroll
            for (int k = 0; k < 8; ++k) {
                const float Mx = fmaxf(m, ak[k]), dec = __expf(m - Mx), w = __expf(ak[k] - Mx);
                v4u o; o.x = pk2(cst[0], cst[1]); o.y = pk2(cst[2], cst[3]); o.z = pk2(cst[4], cst[5]); o.w = pk2(cst[6], cst[7]);
                *(v4u*)(base + (size_t)(k0 + k) * ML_CLE) = o;
                if (pc == 0) ms[(k0 + k) * 4 + 2] = m;
                cst[0] = dec * cst[0] + w * bf_lo(x[k].x); cst[1] = dec * cst[1] + w * bf_hi(x[k].x); cst[2] = dec * cst[2] + w * bf_lo(x[k].y); cst[3] = dec * cst[3] + w * bf_hi(x[k].y);
                cst[4] = dec * cst[4] + w * bf_lo(x[k].z); cst[5] = dec * cst[5] + w * bf_hi(x[k].z); cst[6] = dec * cst[6] + w * bf_lo(x[k].w); cst[7] = dec * cst[7] + w * bf_hi(x[k].w);
                m = tk[k] + Mx; }
        }
    }
}

struct CReg { v4u cl[5]; v4u kc[2]; v4u vv[2]; v4u qx[2][4]; v4u om[2]; float ig, lf, mp; };
__device__ __forceinline__ void mlstm_C_load(CReg& R, int u, const bf16* QM, const bf16* KC, const bf16* VM, const bf16* OM, const float* IG, const float* LF, const bf16* CL, const float* MSC,
                                             int tid, int lane, int wave) {
    const int c = u & 31, hd = (u >> 5) & 3, b = u >> 7; const size_t rowb = (size_t)b * SEQ, t0 = rowb + 64 * c;
    const bf16* src = CL + (size_t)u * ML_CLE;
#pragma unroll
    for (int k = 0; k < 5; ++k) { const int i = tid + 512 * k; R.cl[k] = (v4u){0u, 0u, 0u, 0u}; if (i < 129 * 16) R.cl[k] = *(const v4u*)(src + (i >> 4) * 128 + (i & 15) * 8); }
#pragma unroll
    for (int it = 0; it < 2; ++it) { const int idx = tid + 512 * it, t = (idx >> 4) & 63, g = idx & 15;
        R.kc[it] = *(const v4u*)(KC + ((size_t)u * 64 + t) * 128 + 8 * g); R.vv[it] = *(const v4u*)(VM + (t0 + t) * 512 + hd * 128 + 8 * g);
        load_taps(R.qx[it], QM + rowb * 512 + hd * 128 + 8 * g, 64 * c + t); }
    { const int ot = tid >> 3, op8 = tid & 7; R.om[0] = *(const v4u*)(OM + (t0 + ot) * 512 + hd * 128 + 16 * op8); R.om[1] = *(const v4u*)(OM + (t0 + ot) * 512 + hd * 128 + 16 * op8 + 8); }
    R.ig = 0.f; R.lf = 0.f; R.mp = 0.f; if (wave == 0) { R.ig = IG[(t0 + lane) * 4 + hd]; R.lf = LF[(t0 + lane) * 4 + hd]; R.mp = MSC[(size_t)u * 4 + 2]; }
}
__device__ __forceinline__ void mlstm_C(LAS unsigned char* lds, int u, int u_next, CReg& R, const bf16* QM, const bf16* KC, const bf16* VM, const bf16* OM, const float* IG, const float* LF,
                                        const float* gain, const bf16* CL, const float* MSC, bf16* ATT, int tid, int lane, int wave) {
    asm volatile("" : "+v"(tid), "+v"(lane)); asm volatile("" : "+s"(wave));
    const int r = lane & 31, hh = lane >> 5, c = u & 31, hd = (u >> 5) & 3, b = u >> 7;
    LAS float* gt = (LAS float*)(lds + MC_GT);
    const size_t rowb = (size_t)b * SEQ, t0 = rowb + 64 * c;
    __syncthreads();
#pragma unroll
    for (int k = 0; k < 5; ++k) { const int i = tid + 512 * k; if (i < 129 * 16) *(LAS v4u*)(lds + MC_CT + (i >> 4) * ML_PQ + (i & 15) * 16) = R.cl[k]; }
    if (wave == 0) {
        const float m_prev = R.mp;
        const float bc = wave_scan_addf(R.lf);
        const float a = R.ig - bc; const float pm = wave_scan_maxf(a);
        gt[lane] = a; gt[64 + lane] = fmaxf(m_prev, pm); gt[128 + lane] = bc;
        if (lane == 0) gt[194] = m_prev;
    }
    const int ot = tid >> 3, op8 = tid & 7;
    const v4u og0 = R.om[0], og1 = R.om[1];
#pragma unroll
    for (int it = 0; it < 2; ++it) { const int idx = tid + 512 * it, t = (idx >> 4) & 63, g = idx & 15;
        *(LAS v4u*)(lds + MC_KT + t * ML_PQ + 16 * g) = R.kc[it];
        *(LAS v4u*)(lds + MC_VS + t * ML_PV + 16 * g) = R.vv[it];
        float y[8]; conv8r(y, R.qx[it], (const LAS float*)(lds + ML_CW) + 8 * g);
        const float sc = 0.08838834764831845f;
        v4u o; o.x = pk2(y[0] * sc, y[1] * sc); o.y = pk2(y[2] * sc, y[3] * sc); o.z = pk2(y[4] * sc, y[5] * sc); o.w = pk2(y[6] * sc, y[7] * sc);
        *(LAS v4u*)(lds + MC_QT + t * ML_PQ + 16 * g) = o; }
    if (u_next >= 0) mlstm_C_load(R, u_next, QM, KC, VM, OM, IG, LF, CL, MSC, tid, lane, wave);
    __syncthreads();
    if (wave < 4) { const int ti = wave >> 1, si = wave & 1; f32x16 g = f32x16{};
        if (si <= ti) mma_tile(g, lds + MC_QT + 32 * ti * ML_PQ, ML_PQ, lds + MC_KT + 32 * si * ML_PQ, ML_PQ, 8, r, hh);
        const float as = gt[32 * si + r]; LAS bf16* sp = (LAS bf16*)(lds + MC_SS);
#pragma unroll
        for (int q = 0; q < 16; ++q) { const int tl = crow16(q, hh), t = 32 * ti + tl, s2 = 32 * si + r;
            const float v = g[q] * __expf(fminf(as - gt[64 + t], 0.f)); sp[t * (ML_PS / 2) + s2] = (bf16)f2bf((s2 <= t) ? v : 0.f); } }
    __syncthreads();
    f32x16 nm = f32x16{};
    { const int ti = wave >> 2, vi = wave & 3;
      mma_tile(nm, lds + MC_QT + 32 * ti * ML_PQ, ML_PQ, lds + MC_CT + 32 * vi * ML_PQ, ML_PQ, 8, r, hh);
      const float mp = gt[194];
#pragma unroll
      for (int q = 0; q < 16; ++q) nm[q] *= __expf(mp - gt[64 + 32 * ti + crow16(q, hh)]);
      const LAS unsigned char* vb = lds + MC_VS + tr_base(lane, ML_PV);
#pragma unroll
      for (int ks = 0; ks < 4; ++ks) { const bf16x8 av = *(const LAS bf16x8*)(lds + MC_SS + (32 * ti + r) * ML_PS + 32 * ks + 16 * hh), bv = tr_frag(vb, ML_PV, vi, ks);
          nm = __builtin_amdgcn_mfma_f32_32x32x16_bf16(av, bv, nm, 0, 0, 0); } }
    float den;
    { const v4u sw = *(const LAS v4u*)(lds + MC_SS + ot * ML_PS + 16 * op8);
      float d1 = (bf_lo(sw.x) + bf_hi(sw.x)) + (bf_lo(sw.y) + bf_hi(sw.y)) + (bf_lo(sw.z) + bf_hi(sw.z)) + (bf_lo(sw.w) + bf_hi(sw.w)), d2 = 0.f;
#pragma unroll
      for (int k = 0; k < 2; ++k) { const v4u qw = *(const LAS v4u*)(lds + MC_QT + ot * ML_PQ + 32 * op8 + 16 * k), nw = *(const LAS v4u*)(lds + MC_CT + 128 * ML_PQ + 32 * op8 + 16 * k);
          d2 += bf_lo(qw.x) * bf_lo(nw.x) + bf_hi(qw.x) * bf_hi(nw.x) + bf_lo(qw.y) * bf_lo(nw.y) + bf_hi(qw.y) * bf_hi(nw.y) + bf_lo(qw.z) * bf_lo(nw.z) + bf_hi(qw.z) * bf_hi(nw.z) + bf_lo(qw.w) * bf_lo(nw.w) + bf_hi(qw.w) * bf_hi(nw.w); }
      den = d1 + __expf(gt[194] - gt[64 + ot]) * d2;
      den = sum8_dpp(den); }
    __syncthreads();
    { const int ti = wave >> 2, vi = wave & 3; LAS float* np = (LAS float*)(lds + MC_NUM);
#pragma unroll
      for (int q = 0; q < 16; ++q) np[(32 * ti + crow16(q, hh)) * ML_PN + 32 * vi + r] = nm[q]; }
    __syncthreads();
    { const int t = ot, p = op8; const LAS float* np = (const LAS float*)(lds + MC_NUM) + t * ML_PN;
      const float mrow = gt[128 + t] + gt[64 + t], scl = 1.f / fmaxf(fabsf(den), __expf(-mrow));
      float hv[16]; float ss = 0.f;
#pragma unroll
      for (int e = 0; e < 16; ++e) { hv[e] = np[16 * p + e] * scl; ss += hv[e] * hv[e]; }
      ss = sum8_dpp(ss);
      const float rs = rsqrtf(ss * (1.f / 128.f) + EPS);
      const v4u o0 = og0, o1 = og1;
      const float og[16] = {bf_lo(o0.x), bf_hi(o0.x), bf_lo(o0.y), bf_hi(o0.y), bf_lo(o0.z), bf_hi(o0.z), bf_lo(o0.w), bf_hi(o0.w), bf_lo(o1.x), bf_hi(o1.x), bf_lo(o1.y), bf_hi(o1.y), bf_lo(o1.z), bf_hi(o1.z), bf_lo(o1.w), bf_hi(o1.w)};
      const LAS float* gp = (const LAS float*)(lds + ML_END) + 16 * p;
#pragma unroll
      for (int e = 0; e < 16; ++e) hv[e] = hv[e] * rs * gp[e] * og[e];
      v4u w0, w1; w0.x = pk2(hv[0], hv[1]); w0.y = pk2(hv[2], hv[3]); w0.z = pk2(hv[4], hv[5]); w0.w = pk2(hv[6], hv[7]); w1.x = pk2(hv[8], hv[9]); w1.y = pk2(hv[10], hv[11]); w1.z = pk2(hv[12], hv[13]); w1.w = pk2(hv[14], hv[15]);
      bf16* op = ATT + (t0 + t) * 1024 + 512 + hd * 128 + 16 * p; *(v4u*)op = w0; *(v4u*)(op + 8) = w1; }
}

struct Args { const void* in[22]; float* out; unsigned char* ws; int ph_lo, ph_hi; };
__global__ void __launch_bounds__(NWAVES * 64, 2) hybrid_fwd(Args args) {
    extern __shared__ __attribute__((aligned(16))) unsigned char lds_raw[];
    LAS unsigned char* lds = (LAS unsigned char*)lds_raw;
    volatile LAS unsigned* MISC = (volatile LAS unsigned*)(lds + LDSCTL_OFF);
    const int G0 = gridDim.x, bid0 = blockIdx.x; const int vcu0 = (G0 % 8 == 0) ? (bid0 % 8) * (G0 / 8) + bid0 / 8 : bid0;
#define PHASE_BEGIN() unsigned ones_ = ~0u; asm volatile("" : "+s"(ones_)); int lane = (int)__builtin_amdgcn_mbcnt_hi(ones_, __builtin_amdgcn_mbcnt_lo(ones_, 0u)), tid = wave0 * 64 + lane; asm volatile("" : "+v"(tid), "+v"(lane)); const int wave = __builtin_amdgcn_readfirstlane(tid >> 6); \
    int G = G0, vcu = vcu0, bid = bid0; asm volatile("" : "+s"(G), "+s"(vcu), "+s"(bid)); (void)wave; (void)lane; (void)vcu; (void)bid; (void)G
    const int wave0 = __builtin_amdgcn_readfirstlane((int)threadIdx.x >> 6);
    { const int tid = threadIdx.x;
    for (int u = tid; u < (LDS_BYTES - LDSCTL_OFF) / 4; u += NWAVES * 64) ((LAS unsigned*)(lds + LDSCTL_OFF))[u] = 0u;
    __syncthreads();
    if (tid == 0) { LAS unsigned long long* pb = (LAS unsigned long long*)(lds + LDSCTL_OFF + 64);
#pragma unroll
        for (int k = 0; k < 22; ++k) pb[k] = (unsigned long long)args.in[k];
        pb[I_OUT] = (unsigned long long)args.out; pb[I_WS] = (unsigned long long)args.ws; }
    __syncthreads(); }
    const int lo = args.ph_lo, hi = args.ph_hi;
    XcdBarrier bar; bar.bar = (unsigned*)(args.ws + WS_CTL) + CW_BAR; bar.x = 0; bar.st = nullptr;
    if (hi - lo > 1) bar = xcd_barrier_post((unsigned*)(args.ws + WS_CTL) + CW_BAR, MISC + 8);
    if (hi - lo > 1 && threadIdx.x == 0 && (bid0 >> 3) == 0) __hip_atomic_store((unsigned*)(args.ws + WS_CTL) + CW_LOC + 64 * (bid0 & 7), xb_xcc_id() + 1u, __ATOMIC_RELAXED, __HIP_MEMORY_SCOPE_AGENT);
#ifndef ONLY
#define ONLY -1
#endif
#define PH_ON(c) (ONLY < 0 || ONLY == (c))
#ifndef DUP
#define DUP -1
#endif
#define REPS(c) _Pragma("unroll 1") for (int rep_ = 0; rep_ < ((DUP == (c)) ? 2 : 1); ++rep_)
#define IN(k) (lo <= (k) && (k) < hi)
#define OPAQUE_GEMM(g) asm volatile("" : "+s"(g.A), "+s"(g.Bt))
#define T0_() (wave0 == 0 && __builtin_amdgcn_mbcnt_hi(~0u, __builtin_amdgcn_mbcnt_lo(~0u, 0u)) == 0u)
#define SEAM(k) do { if (IN(k) && IN((k) + 1)) { bar.bar = (unsigned*)(WSP() + WS_CTL) + CW_BAR; xcd_barrier(bar, T0_()); } } while (0)
#ifdef GPROBE
#ifndef GPROBE_BLOCK
#define GPROBE_BLOCK 0
#endif
#define PSTAMP(kind, p, begin) do { if (GPROBE == (kind) && GPROBE_PHASE == (p) && bid0 == GPROBE_BLOCK && wave0 == 0 && __builtin_amdgcn_mbcnt_hi(~0u, __builtin_amdgcn_mbcnt_lo(~0u, 0u)) == 0u) { \
        volatile LAS unsigned long long* pw_ = (volatile LAS unsigned long long*)(lds + pg8::PROBE_LDS_OFF); const unsigned long long n_ = __builtin_amdgcn_s_memrealtime(); if (begin) pw_[-2] = n_; else pw_[0] += n_ - pw_[-2]; } } while (0)
#else
#define PSTAMP(kind, p, begin) do { } while (0)
#endif
#define LSEAM(p) do { PSTAMP(30, p, 0); PSTAMP(31, p, 1); SEAM(pb + (p)); PSTAMP(31, p, 0); PSTAMP(30, (p) + 1, 1); } while (0)
#define LOCSEAM_(k, cntw, genw, nmemb) do { if (IN(k) && IN((k) + 1)) { unsigned* ctl_ = (unsigned*)(WSP() + WS_CTL); \
        if (MISC[4] != 0u) xcd_local_barrier(ctl_ + CW_LOC + (cntw), ctl_ + CW_LOC + (genw), nmemb, ctl_ + CW_BAR, \
                                             wave0 == 0 && __builtin_amdgcn_mbcnt_hi(~0u, __builtin_amdgcn_mbcnt_lo(~0u, 0u)) == 0u); \
        else { bar.bar = ctl_ + CW_BAR; xcd_barrier(bar, T0_()); } } } while (0)
#define LOCSEAM(k)   LOCSEAM_(k, 1024 + 64 * (2 * (bid0 & 7) + (bid0 >> 7)), 2048 + 64 * (2 * (bid0 & 7) + (bid0 >> 7)), 16u)
#define LOCSEAM32(k) LOCSEAM_(k, 3072 + 64 * (bid0 & 7), 3584 + 64 * (bid0 & 7), 32u)
#define LSEAM_LOC(p) do { PSTAMP(30, p, 0); PSTAMP(31, p, 1); LOCSEAM(pb + (p)); PSTAMP(31, p, 0); PSTAMP(30, (p) + 1, 1); } while (0)
#define LSEAM_LOC32(p) do { PSTAMP(30, p, 0); PSTAMP(31, p, 1); LOCSEAM32(pb + (p)); PSTAMP(31, p, 0); PSTAMP(30, (p) + 1, 1); } while (0)
#define XNB   ((bf16*)(WSPG() + WS_XN))
#define MXB(o) (WSPG() + WS_MIX + (o))
#define GX_   ((G == 256) ? 2 * (vcu >> 5) + ((vcu & 31) >> 4) : -1)
#define MXP(N) (MXB(MX_##N) + mx_shift(MX_##N, MXS_##N, GX_))
#define MODB  ((float*)(WSPG() + WS_MOD))
#define SSQB  ((float*)(WSPG() + WS_SSQ))

    PSTAMP(32, 0, 1);
    REPS(0) { PHASE_BEGIN(); if (PH_ON(0) && IN(0)) p0_prologue(lds, tid, lane, wave, vcu, G); }
    PSTAMP(32, 0, 0); PSTAMP(33, 0, 1);
    if (IN(0) && IN(1) && T0_()) { unsigned* ctl_ = (unsigned*)(WSP() + WS_CTL); if (xb_ld(ctl_ + CW_LOC + 64 * (bid0 & 7)) != xb_xcc_id() + 1u) (void)xb_add(ctl_ + CW_LOC + 512, 1u); }
    SEAM(0);
    if (IN(0) && IN(1) && T0_()) { unsigned* ctl_ = (unsigned*)(WSP() + WS_CTL); MISC[4] = (G0 == 256 && xb_ld(ctl_ + CW_LOC + 512) == 0u) ? 1u : 0u; }
    if (IN(0) && IN(1)) __syncthreads();
    PSTAMP(33, 0, 0); PSTAMP(34, 0, 1);
#if defined(DUP) && DUP == 50
    for (int xb_ = 0; xb_ < 20; ++xb_) SEAM(0);
#endif
    { PHASE_BEGIN(); if (PH_ON(1) && IN(1)) norm_phase(nullptr, FP(I_X), nullptr, nullptr, nullptr, FP(I_MIXPRE), MODB + 1 * D, MODB + 0 * D, XNB, lane, wave, vcu, G); }
    PSTAMP(34, 0, 0); PSTAMP(35, 0, 1);
    LOCSEAM(1);
    PSTAMP(35, 0, 0);

    for (int l = 0; l < DEPTH; ++l) {
        const int pb = 2 + 9 * l;
        PSTAMP(30, 0, 1);
        if (PH_ON(2) && IN(pb + 0)) REPS(2) { PHASE_BEGIN();
            unsigned char* wl = WSP() + WS_W + (size_t)l * W_LAYER;
            pg8::Gemm g{XNB, (const bf16*)(wl + WO_IN), M, NINP, D}; OPAQUE_GEMM(g); pg8::StaticOrder S; S.init(M, NINP, G, bid); if (G == 256) S.init_half(16 * (vcu >> 5) + 8 * ((vcu & 31) >> 4), vcu & 15);
            pg8::EpiIn E{(bf16*)MXP(CQ), (bf16*)MXP(K), (bf16*)MXP(V), (bf16*)MXP(KI), (bf16*)MXP(QM), (bf16*)MXP(KM), (bf16*)MXP(VM), (bf16*)MXP(OM), SSQB, (float*)MXP(WI), (float*)MXP(IG), (float*)MXP(LF),
                         GPTR(const int, ldptr(lds, I_POS)), FP(I_BIG) + l * 4, FP(I_BFG) + l * 4};
            pg8::gemm_phase<pg8::EpiIn, pg8::StaticOrder, true, true>(lds, g, S, E, tid);
        }
        LSEAM_LOC(0);
#ifndef SUB
#define SUB 0
#endif
#define MSCB ((float*)(WSPG() + WS_SSQ + 512 * 1024))
#define MLU(i) ((G == 256) ? ((((2 * (vcu >> 5) + ((vcu & 31) >> 4)) * 4 + (vcu & 3)) << 5) + (((vcu >> 2) & 3) + 4 * (i))) : vcu + (i) * G)
#define MLN(i) ((G == 256) ? ((i) < 8) : (vcu + (i) * G < 2048))
#define MLSTM_A_BLOCK() do { PHASE_BEGIN(); int cur_hd = -1; \
            if (SUB != 1 && MLN(0)) { AReg RA; mlstm_A_load(RA, MLU(0), (const bf16*)MXP(KM), (const bf16*)MXP(VM), (const float*)MXP(IG), (const float*)MXP(LF), tid, lane, wave); \
              for (int i_ = 0; MLN(i_); ++i_) { const int u = MLU(i_), un_ = MLN(i_ + 1) ? MLU(i_ + 1) : -1; const int hd = (u >> 5) & 3; unsigned char* wsg_ = WSPG();     \
                if (hd != cur_hd) { __syncthreads(); ml_stage_cw(lds, FP(I_CONVW) + (size_t)l * 4 * 1024, FP(I_CONVB) + (size_t)l * 1024, hd, tid); cur_hd = hd; }       \
                mlstm_A(lds, u, un_, RA, (const bf16*)(wsg_ + WS_MIX + MX_KM + mx_shift(MX_KM, MXS_KM, GX_)), (const bf16*)(wsg_ + WS_MIX + MX_VM + mx_shift(MX_VM, MXS_VM, GX_)), (const float*)(wsg_ + WS_MIX + MX_IG + mx_shift(MX_IG, MXS_IG, GX_)), (const float*)(wsg_ + WS_MIX + MX_LF + mx_shift(MX_LF, MXS_LF, GX_)), (bf16*)(wsg_ + WS_MIX + MX_KC + mx_shift(MX_KC, MXS_KC, GX_)), (bf16*)(wsg_ + WS_MIX + MX_CL + mx_shift(MX_CL, MXS_CL, GX_)), (float*)(wsg_ + WS_SSQ + 512 * 1024), tid, lane, wave); } } \
            __syncthreads(); } while (0)
        if (PH_ON(3) && IN(pb + 1)) REPS(3) { PHASE_BEGIN();
            unsigned char* wl = WSP() + WS_W + (size_t)l * W_LAYER;
            pg8::Gemm g{(const bf16*)MXP(CQ), (const bf16*)(wl + WO_Q), M, 1024, QRK}; OPAQUE_GEMM(g); pg8::StaticOrder S; S.init(M, 1024, G, bid); if (G == 256) S.init_half(16 * (vcu >> 5) + 8 * ((vcu & 31) >> 4), vcu & 15);
            pg8::EpiQ E{(bf16*)MXP(Q), (bf16*)MXP(QI), SSQB, GPTR(const int, ldptr(lds, I_POS)), attn_body::C2};
            pg8::gemm_phase<pg8::EpiQ, pg8::StaticOrder, true, true>(lds, g, S, E, tid);
        }
        if (PH_ON(4) && IN(pb + 1)) REPS(41) MLSTM_A_BLOCK();
        LSEAM_LOC(1);
        if (PH_ON(4) && IN(pb + 2)) { PHASE_BEGIN();
            const bool bmix = (G == 256) && (SUB == 0);
            if (SUB != 1 && !bmix) REPS(42) mlstm_B((bf16*)MXP(CL), MSCB, tid, vcu, G);
            if (SUB != 2) REPS(40) { IxReg RI = {}; BState SB1 = {};
#define IX_L(i) 0
                {
                    const int gx = (G == 256) ? 2 * (vcu >> 5) + ((vcu & 31) >> 4) : -1, lim = (gx >= 0) ? 128 : BATCH * 128;
                    unsigned* ctr = (unsigned*)(WSP() + WS_CTL) + CW_TICKET + 64 * (16 * l + (gx >= 0 ? gx : 0));
#define IXB_(j) ((gx >= 0) ? gx : ((j) & 15))
#define IXQ_(j) ((gx >= 0) ? 127 - (j) : 127 - ((j) >> 4))
                    int L = (gx >= 0) ? (vcu & 15) : vcu, nbd = 0;
                    if (L < lim) indexer_load(RI, IXB_(L), IXQ_(L), (const bf16*)MXP(QI), (const bf16*)MXP(KI), (const float*)MXP(WI), tid, lane, wave);
                    if (bmix) mlstm_B_extras((bf16*)MXP(CL), MSCB, tid, vcu);
#pragma unroll 1
                    while (L < lim) {
                        unsigned char* wsg_ = WSPG();
                        indexer_unit(lds, IXB_(L), IXQ_(L), 0, -1, RI, (const bf16*)(wsg_ + WS_MIX + MX_QI + mx_shift(MX_QI, MXS_QI, GX_)), (const bf16*)(wsg_ + WS_MIX + MX_KI + mx_shift(MX_KI, MXS_KI, GX_)), (const float*)(wsg_ + WS_MIX + MX_WI + mx_shift(MX_WI, MXS_WI, GX_)), (unsigned long long*)(wsg_ + WS_MIX + MX_MASK + mx_shift(MX_MASK, MXS_MASK, GX_)), tid, lane, wave,
                                     SB1, vcu, (bmix && nbd < 8) ? 4 * nbd : -1, ctr, (gx >= 0) ? 16 : G, wsg_, gx);
                        ++nbd; L = __builtin_amdgcn_readfirstlane((int)*(volatile LAS unsigned*)(lds + LDSCTL_OFF + 8)); }
                    if (bmix) {
#pragma unroll 1
                        for (; nbd < 8; ++nbd) { BReg RB = {}; const int item1 = (2 * (vcu >> 5) + ((vcu & 31) >> 4)) * (4 * (B_CLE / 8)) + (vcu & 15) * (NWAVES * 64) + tid; mlstm_B_load(RB, (const bf16*)MXP(CL), MSCB, item1, 4 * nbd); mlstm_B_apply(RB, SB1, (bf16*)MXP(CL), MSCB, item1, 4 * nbd); } }
#undef IXB_
#undef IXQ_
                }
#undef IX_L
            }
        }
        LSEAM_LOC(2);
#define MLSTM_C_BLOCK() do { PHASE_BEGIN(); int cur_hd = -1; \
            if (SUB != 1 && MLN(0)) { CReg RC; mlstm_C_load(RC, MLU(0), (const bf16*)MXP(QM), (const bf16*)MXP(KC), (const bf16*)MXP(VM), (const bf16*)MXP(OM), (const float*)MXP(IG), (const float*)MXP(LF), (const bf16*)MXP(CL), MSCB, tid, lane, wave); \
              for (int i_ = 0; MLN(i_); ++i_) { const int u = MLU(i_), un_ = MLN(i_ + 1) ? MLU(i_ + 1) : -1; const int hd = (u >> 5) & 3; unsigned char* wsg_ = WSPG(); \
                if (hd != cur_hd) { __syncthreads(); ml_stage_cw(lds, FP(I_CONVW) + (size_t)l * 4 * 1024, FP(I_CONVB) + (size_t)l * 1024, hd, tid); \
                                    if (tid < 128) ((LAS float*)(lds + ML_END))[tid] = (FP(I_MLN) + (size_t)l * 512)[hd * 128 + tid]; cur_hd = hd; } \
                mlstm_C(lds, u, un_, RC, (const bf16*)(wsg_ + WS_MIX + MX_QM + mx_shift(MX_QM, MXS_QM, GX_)), (const bf16*)(wsg_ + WS_MIX + MX_KC + mx_shift(MX_KC, MXS_KC, GX_)), (const bf16*)(wsg_ + WS_MIX + MX_VM + mx_shift(MX_VM, MXS_VM, GX_)), (const bf16*)(wsg_ + WS_MIX + MX_OM + mx_shift(MX_OM, MXS_OM, GX_)), (const float*)(wsg_ + WS_MIX + MX_IG + mx_shift(MX_IG, MXS_IG, GX_)), (const float*)(wsg_ + WS_MIX + MX_LF + mx_shift(MX_LF, MXS_LF, GX_)), \
                        nullptr  , (const bf16*)(wsg_ + WS_MIX + MX_CL + mx_shift(MX_CL, MXS_CL, GX_)), (float*)(wsg_ + WS_SSQ + 512 * 1024), (bf16*)(wsg_ + WS_XN), tid, lane, wave); } } \
            __syncthreads(); } while (0)
        if (PH_ON(4) && IN(pb + 3)) REPS(43) MLSTM_C_BLOCK();
        if (PH_ON(5) && IN(pb + 3)) REPS(5) { PHASE_BEGIN();
            const attn_body::AttnTensors AT{(const attn_body::bf16*)MXP(Q), (const attn_body::bf16*)MXP(K), (const attn_body::bf16*)MXP(V), (attn_body::bf16*)XNB, (const attn_body::u32x4*)MXP(MASK), FP(I_ATTN) + (size_t)l * 512};
            const attn_body::StaticOrder S(G, bid);
            attn_body::attn_phase<attn_body::StaticOrder>((char*)lds_raw, AT, S, tid);
        }
        LSEAM_LOC(3);
        if (PH_ON(6) && IN(pb + 4)) REPS(6) { PHASE_BEGIN();
            unsigned char* wl = WSP() + WS_W + (size_t)l * W_LAYER;
            pg8::Gemm g{XNB, (const bf16*)(wl + WO_OUT), M, D, D}; OPAQUE_GEMM(g); pg8::StaticOrder S; S.init(M, D, G, bid); if (G == 256) S.init_half(16 * (vcu >> 5) + 8 * ((vcu & 31) >> 4), vcu & 15);
            pg8::EpiPlain E{(bf16*)MXP(Y), D};
            pg8::gemm_phase<pg8::EpiPlain, pg8::StaticOrder, true, true>(lds, g, S, E, tid);
        }
        LSEAM_LOC(4);
        if (PH_ON(1) && IN(pb + 5)) { PHASE_BEGIN(); const float* modl = MODB + (size_t)l * BATCH * NMOD; float* outp = GPTR(float, ldptr(lds, I_OUT));
            norm_phase((const bf16*)MXP(Y), l == 0 ? FP(I_X) : (const float*)outp, outp, FP(I_MIXPOST) + (size_t)l * D, modl + 2 * D, FP(I_FFNPRE) + (size_t)l * D, modl + 4 * D, modl + 3 * D, XNB, lane, wave, vcu, G); }
        LSEAM_LOC(5);
        if (PH_ON(7) && IN(pb + 6)) REPS(7) { PHASE_BEGIN();
            unsigned char* wl = WSP() + WS_W + (size_t)l * W_LAYER;
            pg8::Gemm g{XNB, (const bf16*)(wl + WO_GU), M, 2 * FF, D}; OPAQUE_GEMM(g); pg8::StaticOrder S; S.init(M, 2 * FF, G, bid); if (G == 256) S.init_half(16 * (vcu >> 5) + 8 * ((vcu & 31) >> 4), vcu & 15);
            pg8::EpiSwiglu E{(bf16*)MXP(H), FF};
            pg8::gemm_phase<pg8::EpiSwiglu, pg8::StaticOrder, true, true>(lds, g, S, E, tid);
        }
        LSEAM_LOC(6);
        if (PH_ON(6) && IN(pb + 7)) REPS(8) { PHASE_BEGIN();
            unsigned char* wl = WSP() + WS_W + (size_t)l * W_LAYER;
            pg8::Gemm g{(const bf16*)MXP(H), (const bf16*)(wl + WO_DN), M, D, FF}; OPAQUE_GEMM(g); pg8::StaticOrder S; S.init(M, D, G, bid); if (G == 256) S.init_half(16 * (vcu >> 5) + 8 * ((vcu & 31) >> 4), vcu & 15);
            pg8::EpiPlain E{(bf16*)MXP(Y), D};
            pg8::gemm_phase<pg8::EpiPlain, pg8::StaticOrder, true, true>(lds, g, S, E, tid);
        }
        LSEAM_LOC(7);
        if (PH_ON(1) && IN(pb + 8)) { PHASE_BEGIN();
            const bool last = (l == DEPTH - 1); const float* modl = MODB + (size_t)l * BATCH * NMOD; const float* modn = MODB + (size_t)(l + 1) * BATCH * NMOD; float* outp = GPTR(float, ldptr(lds, I_OUT));
            norm_phase((const bf16*)MXP(Y), outp, outp, FP(I_FFNPOST) + (size_t)l * D, modl + 5 * D, last ? nullptr : FP(I_MIXPRE) + (size_t)(l + 1) * D, modn + 1 * D, modn + 0 * D, XNB, lane, wave, vcu, G);
        }
        LSEAM_LOC(8);
    }
#ifdef GPROBE
    if (bid0 == GPROBE_BLOCK && wave0 == 0 && __builtin_amdgcn_mbcnt_hi(~0u, __builtin_amdgcn_mbcnt_lo(~0u, 0u)) == 0u) { const unsigned long long tot_ = *(volatile LAS unsigned long long*)(lds + pg8::PROBE_LDS_OFF) * (unsigned long long)(GPROBE_FACTOR);
        const unsigned long long t0_ = __builtin_amdgcn_s_memrealtime(); while (__builtin_amdgcn_s_memrealtime() - t0_ < tot_) __builtin_amdgcn_s_sleep(16); }
#endif
#undef IN
#undef SEAM
}

extern "C" void kernel_launch(void* const* d_in, const int* in_sizes, int n_in, void* d_out, int out_size, void* d_ws, size_t ws_size, hipStream_t stream) {
    static int grid = 0;
    if (grid == 0) {
        if (n_in != 22 || in_sizes[0] != M * D || out_size != M * D || ws_size < WS_END) { fprintf(stderr, "kernel_launch: built for 22 inputs, x/out of %d floats, >= %zu bytes of workspace; got n_in %d, in0 %d, out %d, ws %zu; nothing launched\n", M * D, (size_t)WS_END, n_in, n_in > 0 ? in_sizes[0] : -1, out_size, ws_size); grid = -1; return; }
        int dev = 0, cus = 0, per_cu = 0;
        if (hipGetDevice(&dev) != hipSuccess || hipDeviceGetAttribute(&cus, hipDeviceAttributeMultiprocessorCount, dev) != hipSuccess) { fprintf(stderr, "kernel_launch: device query failed\n"); grid = -1; return; }
        if (hipFuncSetAttribute((const void*)hybrid_fwd, hipFuncAttributeMaxDynamicSharedMemorySize, LDS_BYTES) != hipSuccess) { fprintf(stderr, "kernel_launch: hipFuncSetAttribute(%d B LDS) failed\n", LDS_BYTES); grid = -1; return; }
        if (hipOccupancyMaxActiveBlocksPerMultiprocessor(&per_cu, (const void*)hybrid_fwd, NWAVES * 64, LDS_BYTES) != hipSuccess || per_cu < 1)
            fprintf(stderr, "kernel_launch: note: occupancy query reports %d workgroups per CU\n", per_cu);
        (void)hipGetLastError();
        grid = cus;
    }
    if (grid < 0) return;
    if (hipMemsetAsync((char*)d_ws + WS_CTL, 0, CTL_ZERO_BYTES, stream) != hipSuccess) { fprintf(stderr, "kernel_launch: hipMemsetAsync failed\n"); return; }
    Args a{};
    for (int i = 0; i < 22; ++i) a.in[i] = d_in[i];
    a.out = (float*)d_out; a.ws = (unsigned char*)d_ws;
#if MK_ONE_LAUNCH
    a.ph_lo = 0; a.ph_hi = N_PHASES;
    hipLaunchKernelGGL(hybrid_fwd, dim3(grid), dim3(NWAVES * 64), LDS_BYTES, stream, a);
#else
    for (int p = 0; p < N_PHASES; ++p) { a.ph_lo = p; a.ph_hi = p + 1; hipLaunchKernelGGL(hybrid_fwd, dim3(grid), dim3(NWAVES * 64), LDS_BYTES, stream, a); }
#endif
    const hipError_t le = hipPeekAtLastError();
    if (le != hipSuccess) fprintf(stderr, "kernel_launch: launch failed: %s (grid %d x %d threads, %d B LDS)\n", hipGetErrorName(le), grid, NWAVES * 64, LDS_BYTES);
}
```
